# Optimizing an MI355X kernel written in HIP

```python
import jax, jax.numpy as jnp
from jax import lax
import numpy as np

D_MODEL = 1024
BATCH = 8
SEQ = 4096
DEPTH = 4

CHUNK = 64
HEAD_DIM = 64
N_HEADS_A = 8
N_HEADS_B = 8
WIDTH_A = N_HEADS_A * HEAD_DIM
WIDTH_B = N_HEADS_B * HEAD_DIM
LEFT_CHUNKS = 8
BAND = (LEFT_CHUNKS + 1) * CHUNK
MAX_REL = 128
N_REL = 2 * MAX_REL + 1
SB_BLOCK = 128
N_EXPERTS = 16
N_GROUPS = 4
EXPERTS_PER_GROUP = N_EXPERTS // N_GROUPS
TOP_K = 2
D_EXPERT = 512
ALPHA = (2 * DEPTH) ** 0.25
BETA_INIT = (8 * DEPTH) ** -0.25
LN_EPS = 1e-5
SPLIT_A = 3 * WIDTH_A
SPLIT_B = SPLIT_A + 3 * WIDTH_B
PROJ_COLS = SPLIT_B + 2 * D_MODEL

kernel_name = "hybrid_chunked_relpos_stickbreaking_grouped_moe_deepnorm"


def layer_norm(x, g, b):
    xf = x.astype(jnp.float32)
    mu = jnp.mean(xf, axis=-1, keepdims=True)
    var = jnp.mean(jnp.square(xf - mu), axis=-1, keepdims=True)
    return ((xf - mu) * lax.rsqrt(var + LN_EPS)).astype(x.dtype) * g + b


def chunked_relpos_attention(q, k, v, rel_bias):
    b, h, s, dh = q.shape
    n_chunks = s // CHUNK
    pad = LEFT_CHUNKS * CHUNK
    k_pad = jnp.pad(k, ((0, 0), (0, 0), (pad, 0), (0, 0)))
    v_pad = jnp.pad(v, ((0, 0), (0, 0), (pad, 0), (0, 0)))
    q_chunks = q.reshape(b, h, n_chunks, CHUNK, dh).transpose(2, 0, 1, 3, 4)
    qi = jnp.arange(CHUNK)[:, None]
    kj = jnp.arange(BAND)[None, :]
    dist = pad + qi - kj
    rel_idx = jnp.clip(dist, -MAX_REL, MAX_REL) + MAX_REL
    bias = rel_bias[:, rel_idx].astype(jnp.float32)
    scale = dh ** -0.5

    def one_chunk(args):
        c, qc = args
        start = c * CHUNK
        kb = lax.dynamic_slice_in_dim(k_pad, start, BAND, axis=2)
        vb = lax.dynamic_slice_in_dim(v_pad, start, BAND, axis=2)
        scores = jnp.einsum('bhqd,bhkd->bhqk', qc, kb).astype(jnp.float32) * scale + bias
        valid = (kj + start - pad) >= 0
        scores = jnp.where(valid[None, None], scores, -jnp.inf)
        p = jax.nn.softmax(scores, axis=-1).astype(v.dtype)
        return jnp.einsum('bhqk,bhkd->bhqd', p, vb)

    out = lax.map(one_chunk, (jnp.arange(n_chunks), q_chunks))
    return out.transpose(1, 2, 0, 3, 4).reshape(b, h, s, dh)


def stick_breaking_attention(q, k, v):
    b, h, s, dh = q.shape
    n_blocks = s // SB_BLOCK
    scale = dh ** -0.5
    q_blocks = q.reshape(b, h, n_blocks, SB_BLOCK, dh).transpose(2, 0, 1, 3, 4)
    key_pos = jnp.arange(s)

    def one_block(args):
        blk, qb = args
        q_pos = blk * SB_BLOCK + jnp.arange(SB_BLOCK)
        z = jnp.einsum('bhqd,bhkd->bhqk', qb, k).astype(jnp.float32) * scale
        before = (key_pos[None, :] < q_pos[:, None])[None, None]
        log_beta = jax.nn.log_sigmoid(z)
        log_keep = jnp.where(before, jax.nn.log_sigmoid(-z), 0.0)
        suffix = lax.cumsum(log_keep, axis=3, reverse=True) - log_keep
        a = jnp.where(before, jnp.exp(log_beta + suffix), 0.0).astype(v.dtype)
        return jnp.einsum('bhqk,bhkd->bhqd', a, v)

    out = lax.map(one_block, (jnp.arange(n_blocks), q_blocks))
    return out.transpose(1, 2, 0, 3, 4).reshape(b, h, s, dh)


def hybrid_mixer(x, w_in, rel_bias, w_up_a, w_up_b, w_out):
    b, s, _ = x.shape
    proj = x @ w_in
    qkv_a, qkv_b, gate_logits = jnp.split(proj, [SPLIT_A, SPLIT_B], axis=-1)

    def to_heads(t, n):
        return t.reshape(b, s, 3, n, HEAD_DIM).transpose(2, 0, 3, 1, 4)

    qa, ka, va = to_heads(qkv_a, N_HEADS_A)
    qb, kb, vb = to_heads(qkv_b, N_HEADS_B)
    ya = chunked_relpos_attention(qa, ka, va, rel_bias)
    yb = stick_breaking_attention(qb, kb, vb)
    ya = ya.transpose(0, 2, 1, 3).reshape(b, s, WIDTH_A) @ w_up_a
    yb = yb.transpose(0, 2, 1, 3).reshape(b, s, WIDTH_B) @ w_up_b
    gate_a, gate_b = jnp.split(jax.nn.sigmoid(gate_logits), 2, axis=-1)
    return (gate_a * ya + gate_b * yb) @ w_out


def grouped_top2_moe(x, w_router, b_router, w_gate, w_up, w_down):
    b, s, d = x.shape
    x2d = x.reshape(b * s, d)
    logits = x2d.astype(jnp.float32) @ w_router.astype(jnp.float32) + b_router.astype(jnp.float32)
    probs = jax.nn.softmax(logits, axis=-1)
    grouped = probs.reshape(-1, N_GROUPS, EXPERTS_PER_GROUP)
    group_idx = jnp.argmax(jnp.max(grouped, axis=-1), axis=-1)
    in_group = jnp.take_along_axis(grouped, group_idx[:, None, None], axis=1)[:, 0]
    top_w, top_i = lax.top_k(in_group, TOP_K)
    top_w = top_w / jnp.sum(top_w, axis=-1, keepdims=True)
    expert_id = group_idx[:, None] * EXPERTS_PER_GROUP + top_i
    combine = jnp.sum(jax.nn.one_hot(expert_id, N_EXPERTS, dtype=jnp.float32) * top_w[..., None], axis=1)
    combine = combine.astype(x.dtype)
    out = jnp.zeros_like(x2d)
    for e in range(N_EXPERTS):
        hdn = jax.nn.silu(x2d @ w_gate[e]) * (x2d @ w_up[e])
        out = out + combine[:, e:e + 1] * (hdn @ w_down[e])
    return out.reshape(b, s, d)


def setup_inputs(seed: int = 0) -> dict:
    key = jax.random.key(seed)
    ks = jax.random.split(key, 16)
    f32 = jnp.float32
    col_scale = np.ones((PROJ_COLS,), np.float32)
    col_scale[2 * WIDTH_A:3 * WIDTH_A] = BETA_INIT
    col_scale[SPLIT_A + 2 * WIDTH_B:SPLIT_B] = BETA_INIT
    x = jax.random.normal(ks[0], (BATCH, SEQ, D_MODEL), f32)
    w_in = jax.random.normal(ks[1], (DEPTH, D_MODEL, PROJ_COLS), f32) * D_MODEL ** -0.5 * jnp.asarray(col_scale)
    rel_bias = jax.random.normal(ks[2], (DEPTH, N_HEADS_A, N_REL), f32) * 0.1
    w_up_a = jax.random.normal(ks[3], (DEPTH, WIDTH_A, D_MODEL), f32) * WIDTH_A ** -0.5 * BETA_INIT
    w_up_b = jax.random.normal(ks[4], (DEPTH, WIDTH_B, D_MODEL), f32) * WIDTH_B ** -0.5 * BETA_INIT
    w_out = jax.random.normal(ks[5], (DEPTH, D_MODEL, D_MODEL), f32) * D_MODEL ** -0.5 * BETA_INIT
    ln1_g = 1.0 + 0.02 * jax.random.normal(ks[6], (DEPTH, D_MODEL), f32)
    ln1_b = 0.02 * jax.random.normal(ks[7], (DEPTH, D_MODEL), f32)
    w_router = jax.random.normal(ks[8], (D_MODEL, N_EXPERTS), f32) * D_MODEL ** -0.5
    b_router = 0.01 * jax.random.normal(ks[9], (N_EXPERTS,), f32)
    w_gate = jax.random.normal(ks[10], (DEPTH, N_EXPERTS, D_MODEL, D_EXPERT), f32) * D_MODEL ** -0.5 * BETA_INIT
    w_up = jax.random.normal(ks[11], (DEPTH, N_EXPERTS, D_MODEL, D_EXPERT), f32) * D_MODEL ** -0.5 * BETA_INIT
    w_down = jax.random.normal(ks[12], (DEPTH, N_EXPERTS, D_EXPERT, D_MODEL), f32) * D_EXPERT ** -0.5 * BETA_INIT
    ln2_g = 1.0 + 0.02 * jax.random.normal(ks[13], (DEPTH, D_MODEL), f32)
    ln2_b = 0.02 * jax.random.normal(ks[14], (DEPTH, D_MODEL), f32)
    return {"x": x, "w_in": w_in, "rel_bias": rel_bias, "w_up_a": w_up_a, "w_up_b": w_up_b,
            "w_out": w_out, "ln1_g": ln1_g, "ln1_b": ln1_b, "w_router": w_router,
            "b_router": b_router, "w_gate": w_gate, "w_up": w_up, "w_down": w_down,
            "ln2_g": ln2_g, "ln2_b": ln2_b}


def reference(x, w_in, rel_bias, w_up_a, w_up_b, w_out, ln1_g, ln1_b, w_router,
              b_router, w_gate, w_up, w_down, ln2_g, ln2_b):
    for l in range(DEPTH):
        mixed = hybrid_mixer(x, w_in[l], rel_bias[l], w_up_a[l], w_up_b[l], w_out[l])
        x = layer_norm(ALPHA * x + mixed, ln1_g[l], ln1_b[l])
        ffn = grouped_top2_moe(x, w_router, b_router, w_gate[l], w_up[l], w_down[l])
        x = layer_norm(ALPHA * x + ffn, ln2_g[l], ln2_b[l])
    return x
```

```cpp
#include <hip/hip_runtime.h>
#include <cstdio>
#include <cstdint>

#ifndef MK_MULTI
#define MK_MULTI 1
#endif

#ifndef PHASE_MASK
#define PHASE_MASK 0x1ff
#endif
#define HAS(k) ((PHASE_MASK >> (k)) & 1)
#define LAS __attribute__((address_space(3)))
#define GAS __attribute__((address_space(1)))
typedef unsigned short bf16_t;
typedef short bf16x8 __attribute__((ext_vector_type(8)));
typedef short s16x4 __attribute__((ext_vector_type(4)));
typedef float f32x4 __attribute__((ext_vector_type(4)));
typedef float f32x2 __attribute__((ext_vector_type(2)));
typedef float f32x16 __attribute__((ext_vector_type(16)));
typedef unsigned u32x4 __attribute__((ext_vector_type(4)));
typedef unsigned u32x2 __attribute__((ext_vector_type(2)));

constexpr int D_MODEL = 1024, BATCH = 8, SEQ = 4096, DEPTH = 4, T = BATCH * SEQ;
constexpr int NH = 8, HD = 64, WA = NH * HD;
constexpr int PROJ = 3 * WA + 3 * WA + 2 * D_MODEL;
constexpr int N_REL = 257, NE = 16, FE = 512;
constexpr float ALPHA = 1.681792830507429f;
constexpr float LN_EPS = 1e-5f;
constexpr float LOG2E = 1.4426950408889634f;
constexpr float C2 = 0.125f * LOG2E;

constexpr size_t MiB = 1u << 20;
constexpr size_t WS_CTL = 0, CTL_ZERO_BYTES = 1 * MiB;
constexpr size_t WS_RECW = 2 * MiB;
constexpr size_t WS_LIST = 4 * MiB;
constexpr size_t WS_WIN = 8 * MiB, WS_WUPA = 18 * MiB, WS_WUPB = 19 * MiB, WS_WOUT = 20 * MiB, WS_WGU = 22 * MiB, WS_WD = 54 * MiB;
constexpr size_t WS_XB = 72 * MiB;
constexpr size_t WS_QA = 136 * MiB, QKV_STRIDE = 32 * MiB;
constexpr size_t WS_GA = 328 * MiB, WS_GB = 392 * MiB;
constexpr size_t WS_PRE = 328 * MiB;
constexpr size_t WS_MERGED = 456 * MiB;
constexpr size_t WS_Y = 136 * MiB;
constexpr size_t WS_H = 456 * MiB;
constexpr size_t WS_END = 526 * MiB;
constexpr int CW_TMO = 0;
constexpr int CW_BAR = 4096;
constexpr int CW_CNT = 16384;

constexpr int RING_BYTES = 131072;
constexpr int LDSCTL_OFF = RING_BYTES, MISC_OFF = LDSCTL_OFF + 320;
constexpr int UTAB_OFF = LDSCTL_OFF + 1024;
constexpr int LDS_BYTES = 147456;

__device__ __forceinline__ unsigned cvt_pk_bf16(float lo, float hi) { unsigned r; asm volatile("v_cvt_pk_bf16_f32 %0, %1, %2" : "=v"(r) : "v"(lo), "v"(hi)); return r; }
__device__ __forceinline__ float bf_lo(unsigned w) { return __uint_as_float(w << 16); }
__device__ __forceinline__ float bf_hi(unsigned w) { return __uint_as_float(w & 0xffff0000u); }
__device__ __forceinline__ float fast_exp2(float x) { return __builtin_amdgcn_exp2f(x); }
__device__ __forceinline__ float fast_rcp(float x) { return __builtin_amdgcn_rcpf(x); }
__device__ __forceinline__ float sigmoidf_(float v) { return fast_rcp(1.0f + fast_exp2(-LOG2E * v)); }
__device__ __forceinline__ float wave_sum(float v) {
#pragma unroll
    for (int o = 1; o < 64; o <<= 1) v += __shfl_xor(v, o);
    return v;
}
#define LDS_WAIT() asm volatile("s_waitcnt lgkmcnt(0)" ::: "memory")
#define VM_WAIT() asm volatile("s_waitcnt vmcnt(0)" ::: "memory")

namespace pg8 {
constexpr int BM = 256, BK = 64, HALF = 128, HTB = HALF * BK * 2, STAGE_BYTES = 8 * HTB, NXCD = 8, WGM = 8;
__host__ __device__ __forceinline__ int lds_byte(int r, int c) { const int st = (r >> 4) * 2 + (c >> 5), rr = r & 15, cc = c & 31, ob = rr * 64 + cc * 2; return st * 1024 + (ob ^ (((ob >> 9) & 1) << 5)); }
__host__ __device__ __forceinline__ void stage_rc(int b, int& R, int& C) { const int st = b / 1024, sb = b % 1024, swz = sb ^ (((sb >> 9) & 1) << 5); R = (st >> 1) * 16 + swz / 64; C = (st & 1) * 32 + (swz % 64) / 2; }
__host__ __device__ __forceinline__ int perm32(int rho) { const int n = rho >> 4, i = rho & 15; return 8 * (i >> 2) + 4 * n + (i & 3); }

struct Unit { const char* A; const char* B; int pm, pn, x0, x1, x2; };

struct TileOrder {
    int nM, nN, nwg, G, c;
    __device__ __forceinline__ void init(int nM_, int nN_, int G_, int c_) { nM = nM_; nN = nN_; nwg = nM * nN; G = G_; c = c_; }
    __device__ __forceinline__ bool next(int i, int& pm, int& pn) const {
        const long L = (long)i * G + c; if (L >= nwg) return false;
        int wgid = (int)L; { const int q = nwg / NXCD, r = nwg % NXCD, xcd = wgid % NXCD, off = wgid / NXCD; wgid = (xcd < r ? xcd * (q + 1) : r * (q + 1) + (xcd - r) * q) + off; }
        const int nig = WGM * nN, gid = wgid / nig, fm = gid * WGM, gsz = (nM - fm) < WGM ? (nM - fm) : WGM;
        pm = fm + ((wgid % nig) % gsz); pn = (wgid % nig) / gsz; return true;
    }
};

template <class Epi, class Sched, bool GATHER, bool ALIGN_EPI>
__device__ __forceinline__ void gemm_phase(LAS unsigned char* lds, const int K, const Sched& S, const Epi& E) {
    int tid_ = threadIdx.x; asm volatile("" : "+v"(tid_));
    const int tid = tid_, wid = __builtin_amdgcn_readfirstlane(tid >> 6), lane = tid & 63, wr = wid >> 2, wc = wid & 3, fr = lane & 15, fq = lane >> 4;
    const int nt = K / BK;
    unsigned voffB[2]; int RA[2], CA2[2];
#pragma unroll
    for (int i = 0; i < 2; ++i) { int R, C; stage_rc(tid * 16 + i * 8192, R, C); const int Rb = Epi::PERM ? ((R & ~31) + perm32(R & 31)) : R;
        RA[i] = R; CA2[i] = C * 2; voffB[i] = (unsigned)(Rb * K + C) * 2u; }
    const size_t kstep = (size_t)(BK * 2);
    const size_t hstep = (size_t)HALF * K * 2;
    const unsigned ldsw = (unsigned)wid * 1024u;
    const int aoff = lds_byte(wr * 64 + fr, fq * 8), boff = lds_byte(wc * 32 + fr, fq * 8);
#define PG8_SA(b, h) (((b) * 2 + (h)) * HTB)
#define PG8_SB(b, h) ((4 + (b) * 2 + (h)) * HTB)
#define PG8_STAGE(bufoff, gbase, voff) do { _Pragma("unroll") for (int _i = 0; _i < 2; ++_i) \
        __builtin_amdgcn_global_load_lds((const unsigned*)((const char*)(gbase) + (voff)[_i]), (LAS unsigned*)(lds + (bufoff) + ldsw + _i * 8192), 16, 0, 0); } while (0)
#define PG8_LDA(dst, b, h) do { _Pragma("unroll") for (int m = 0; m < 4; ++m) _Pragma("unroll") for (int k = 0; k < 2; ++k) dst[m][k] = *(const LAS bf16x8*)(lds + PG8_SA(b, h) + aoff + m * 2048 + k * 1024); } while (0)
#define PG8_LDB(dst, b, h) do { _Pragma("unroll") for (int n = 0; n < 2; ++n) _Pragma("unroll") for (int k = 0; k < 2; ++k) dst[n][k] = *(const LAS bf16x8*)(lds + PG8_SB(b, h) + boff + n * 2048 + k * 1024); } while (0)
#define PG8_MMA(ai, bj, At, Bt) do { __builtin_amdgcn_s_setprio(1); _Pragma("unroll") for (int m = 0; m < 4; ++m) _Pragma("unroll") for (int n = 0; n < 2; ++n) _Pragma("unroll") for (int k = 0; k < 2; ++k) \
        acc[ai][bj][m][n] = __builtin_amdgcn_mfma_f32_16x16x32_bf16(Bt[n][k], At[m][k], acc[ai][bj][m][n], 0, 0, 0); __builtin_amdgcn_s_setprio(0); } while (0)
#define PG8_WAIT_V(n) asm volatile("s_waitcnt vmcnt(" #n ")" ::: "memory")
#define PG8_WAIT_L(n) asm volatile("s_waitcnt lgkmcnt(" #n ")" ::: "memory")
#define PG8_BAR __builtin_amdgcn_s_barrier()
#define PG8_SCHED __builtin_amdgcn_sched_barrier(0)
    Unit cur, nxt; int ui = 0;
    if (!S.next(0, cur)) return;
    unsigned oc0[2], oc1[2], on0[2], on1[2];
    if constexpr (GATHER) { S.offs(cur, RA, CA2, oc0, oc1); }
    else {
#pragma unroll
        for (int i = 0; i < 2; ++i) { oc0[i] = (unsigned)(RA[i] * K) * 2u + (unsigned)CA2[i]; oc1[i] = oc0[i]; on0[i] = oc0[i]; on1[i] = oc0[i]; } }
    const size_t ah = GATHER ? (size_t)0 : hstep;
    f32x4 acc[2][2][4][2];
#pragma unroll
    for (int a = 0; a < 2; ++a)
#pragma unroll
        for (int b = 0; b < 2; ++b)
#pragma unroll
            for (int m = 0; m < 4; ++m)
#pragma unroll
                for (int n = 0; n < 2; ++n) acc[a][b][m][n] = (f32x4){0.f, 0.f, 0.f, 0.f};
    bf16x8 At[4][2], B0[2][2], B1[2][2];
    const char* cA = cur.A; const char* cB = cur.B;
    PG8_STAGE(PG8_SB(0, 0), cB, voffB); PG8_STAGE(PG8_SB(0, 1), cB + hstep, voffB); PG8_STAGE(PG8_SA(0, 0), cA, oc0); PG8_STAGE(PG8_SA(0, 1), cA + ah, oc1);
    if (wr == 1) PG8_BAR;
    PG8_WAIT_V(2); PG8_BAR;
    PG8_STAGE(PG8_SB(1, 0), cB + kstep, voffB); PG8_STAGE(PG8_SA(1, 0), cA + kstep, oc0); PG8_STAGE(PG8_SB(1, 1), cB + hstep + kstep, voffB);
    PG8_WAIT_V(6); PG8_BAR;
    for (;;) {
        const bool has_next = S.next(ui + 1, nxt);
        const char* nA = has_next ? nxt.A : cA; const char* nB = has_next ? nxt.B : cB;
        if constexpr (GATHER) { if (has_next) S.offs(nxt, RA, CA2, on0, on1); else { on0[0] = oc0[0]; on0[1] = oc0[1]; on1[0] = oc1[0]; on1[1] = oc1[1]; } }
        for (int t = 0; t < nt; t += 2) {
            const bool last = (t == nt - 2);
            const char* a1 = cA + (size_t)(t + 1) * kstep;
            const char* a2 = last ? nA : cA + (size_t)(t + 2) * kstep; const char* b2 = last ? nB : cB + (size_t)(t + 2) * kstep;
            const char* a3 = a2 + kstep; const char* b3 = b2 + kstep;
            unsigned o20[2], o21[2];
            if constexpr (GATHER) { o20[0] = last ? on0[0] : oc0[0]; o20[1] = last ? on0[1] : oc0[1]; o21[0] = last ? on1[0] : oc1[0]; o21[1] = last ? on1[1] : oc1[1]; }
            else { o20[0] = oc0[0]; o20[1] = oc0[1]; o21[0] = oc0[0]; o21[1] = oc0[1]; }
            PG8_LDB(B0, 0, 0); PG8_LDB(B1, 0, 1); PG8_SCHED; PG8_LDA(At, 0, 0); PG8_STAGE(PG8_SA(1, 1), a1 + ah, oc1);
            PG8_WAIT_V(8); PG8_WAIT_L(0); PG8_BAR; PG8_MMA(0, 0, At, B0); PG8_MMA(0, 1, At, B1); PG8_BAR; PG8_SCHED;
            PG8_LDA(At, 0, 1); PG8_STAGE(PG8_SB(0, 0), b2, voffB); PG8_STAGE(PG8_SB(0, 1), b2 + hstep, voffB); PG8_STAGE(PG8_SA(0, 0), a2, o20);
            PG8_WAIT_V(8); PG8_WAIT_L(0); PG8_BAR; PG8_MMA(1, 0, At, B0); PG8_MMA(1, 1, At, B1); PG8_BAR; PG8_SCHED;
            PG8_LDB(B0, 1, 0); PG8_LDB(B1, 1, 1); PG8_SCHED; PG8_LDA(At, 1, 0); PG8_STAGE(PG8_SA(0, 1), a2 + ah, o21);
            PG8_WAIT_V(8); PG8_WAIT_L(0); PG8_BAR; PG8_MMA(0, 0, At, B0); PG8_MMA(0, 1, At, B1); PG8_BAR; PG8_SCHED;
            PG8_LDA(At, 1, 1); PG8_STAGE(PG8_SB(1, 0), b3, voffB); PG8_STAGE(PG8_SB(1, 1), b3 + hstep, voffB); PG8_STAGE(PG8_SA(1, 0), a3, o20);
            PG8_WAIT_V(8); PG8_WAIT_L(0); PG8_BAR; PG8_MMA(1, 0, At, B0); PG8_MMA(1, 1, At, B1); PG8_BAR; PG8_SCHED;
        }
        if constexpr (ALIGN_EPI) { if (wr == 0) PG8_BAR; }
        E(acc, cur, wr, wc, fr, fq);
        if (!has_next) break;
#pragma unroll
        for (int a = 0; a < 2; ++a)
#pragma unroll
            for (int b = 0; b < 2; ++b)
#pragma unroll
                for (int m = 0; m < 4; ++m)
#pragma unroll
                    for (int n = 0; n < 2; ++n) acc[a][b][m][n] = (f32x4){0.f, 0.f, 0.f, 0.f};
        cur = nxt; cA = nA; cB = nB; ++ui;
        if constexpr (GATHER) { oc0[0] = on0[0]; oc0[1] = on0[1]; oc1[0] = on1[0]; oc1[1] = on1[1]; }
        if constexpr (ALIGN_EPI) { if (wr == 1) PG8_BAR; }
    }
    PG8_WAIT_V(0);
    if constexpr (!ALIGN_EPI) { if (wr == 0) PG8_BAR; }
    PG8_BAR;
#undef PG8_SA
#undef PG8_SB
#undef PG8_STAGE
#undef PG8_LDA
#undef PG8_LDB
#undef PG8_MMA
#undef PG8_WAIT_V
#undef PG8_WAIT_L
#undef PG8_BAR
#undef PG8_SCHED
}

struct SchedPlain {
    TileOrder o; const char* A; const char* B; size_t tstep;
    __device__ __forceinline__ bool next(int i, Unit& u) const { int pm, pn; if (!o.next(i, pm, pn)) return false; u.pm = pm; u.pn = pn; u.x0 = 0; u.x1 = 0; u.x2 = 0; u.A = A + (size_t)pm * tstep; u.B = B + (size_t)pn * tstep; return true; }
};
struct SchedTwo {
    TileOrder o; const char* A0; const char* A1; const char* B0; const char* B1; size_t tstep;
    __device__ __forceinline__ bool next(int i, Unit& u) const { int pm, pn; if (!o.next(i >> 1, pm, pn)) return false; const int br = i & 1; u.pm = pm; u.pn = pn; u.x0 = br; u.x1 = 0; u.x2 = 0;
        u.A = (br ? A1 : A0) + (size_t)pm * tstep; u.B = (br ? B1 : B0) + (size_t)pn * tstep; return true; }
};
struct SchedMoe {
    const LAS int* utab; int nunits;
    const char* Abase; const char* Bbase; size_t a_row_bytes; size_t b_exp_bytes; size_t b_tile_bytes; const int* list; int gather_k2;
    __device__ __forceinline__ bool next(int i, Unit& u) const {
        if (i >= nunits) return false;
        const int e = utab[i * 5 + 0], pn = utab[i * 5 + 1], lo_ = utab[i * 5 + 2], nv = utab[i * 5 + 3], rb = utab[i * 5 + 4];
        u.pm = e; u.pn = pn; u.x0 = lo_; u.x1 = nv; u.x2 = rb;
        u.A = Abase + (size_t)rb * a_row_bytes; u.B = Bbase + (size_t)e * b_exp_bytes + (size_t)pn * b_tile_bytes; return true; }
    __device__ __forceinline__ void offs(const Unit& u, const int (&RA)[2], const int (&CA2)[2], unsigned (&o0)[2], unsigned (&o1)[2]) const {
        const int* lp = list + (size_t)u.pm * T + u.x0;
#pragma unroll
        for (int i = 0; i < 2; ++i) {
            int r0 = RA[i], r1 = RA[i] + HALF; r0 = r0 < u.x1 ? r0 : u.x1 - 1; r1 = r1 < u.x1 ? r1 : u.x1 - 1;
            const int t0 = lp[r0] >> 1, t1 = lp[r1] >> 1;
            o0[i] = (unsigned)t0 * (unsigned)gather_k2 + (unsigned)CA2[i]; o1[i] = (unsigned)t1 * (unsigned)gather_k2 + (unsigned)CA2[i]; }
    }
};
}

using pg8::Unit;
struct EpiInProj {
    static constexpr bool PERM = true;
    bf16_t* qkv; bf16_t* gates;
    __device__ __forceinline__ void operator()(const f32x4 (&acc)[2][2][4][2], const Unit& u, int wr, int wc, int fr, int fq) const {
        const int pn = u.pn; bf16_t* base; int ldc, colt; float sc = 1.f; const bool gate = pn >= 12;
        if (!gate) { const int piece = pn >> 1; base = qkv + (size_t)piece * (QKV_STRIDE / 2); ldc = WA; colt = (pn & 1) * 256; if (piece == 0 || piece == 3) sc = C2; }
        else { const int g = (pn - 12) >> 2; base = gates + (size_t)g * ((size_t)T * D_MODEL); ldc = D_MODEL; colt = ((pn - 12) & 3) * 256; }
        const int row0 = u.pm * 256 + wr * 64 + fr, col0 = colt + wc * 32 + 8 * fq;
#pragma unroll
        for (int ai = 0; ai < 2; ++ai)
#pragma unroll
            for (int m = 0; m < 4; ++m) { bf16_t* rowp = base + (size_t)(row0 + ai * 128 + m * 16) * ldc + col0;
#pragma unroll
                for (int bj = 0; bj < 2; ++bj) { f32x4 v0 = acc[ai][bj][m][0], v1 = acc[ai][bj][m][1];
                    if (gate) {
#pragma unroll
                        for (int i = 0; i < 4; ++i) { v0[i] = sigmoidf_(v0[i]); v1[i] = sigmoidf_(v1[i]); } }
                    else { v0 = v0 * sc; v1 = v1 * sc; }
                    u32x4 w; w.x = cvt_pk_bf16(v0[0], v0[1]); w.y = cvt_pk_bf16(v0[2], v0[3]); w.z = cvt_pk_bf16(v1[0], v1[1]); w.w = cvt_pk_bf16(v1[2], v1[3]);
                    *(u32x4*)(rowp + bj * 128) = w; } }
    }
};
struct EpiMerge {
    static constexpr bool PERM = true;
    const bf16_t* ga; const bf16_t* gb; bf16_t* merged;
    __device__ __forceinline__ void operator()(const f32x4 (&acc)[2][2][4][2], const Unit& u, int wr, int wc, int fr, int fq) const {
        const int br = u.x0; const bf16_t* g = br ? gb : ga;
        const int row0 = u.pm * 256 + wr * 64 + fr, col0 = u.pn * 256 + wc * 32 + 8 * fq;
#pragma unroll
        for (int ai = 0; ai < 2; ++ai)
#pragma unroll
            for (int m = 0; m < 4; ++m) { const size_t ro = (size_t)(row0 + ai * 128 + m * 16) * D_MODEL + col0;
#pragma unroll
                for (int bj = 0; bj < 2; ++bj) { const f32x4 a0 = acc[ai][bj][m][0], a1 = acc[ai][bj][m][1];
                    const u32x4 gw = *(const u32x4*)(g + ro + bj * 128);
                    float v[8];
                    v[0] = bf_lo(gw.x) * a0[0]; v[1] = bf_hi(gw.x) * a0[1]; v[2] = bf_lo(gw.y) * a0[2]; v[3] = bf_hi(gw.y) * a0[3];
                    v[4] = bf_lo(gw.z) * a1[0]; v[5] = bf_hi(gw.z) * a1[1]; v[6] = bf_lo(gw.w) * a1[2]; v[7] = bf_hi(gw.w) * a1[3];
                    if (br) { const u32x4 pw = *(const u32x4*)(merged + ro + bj * 128);
                        v[0] += bf_lo(pw.x); v[1] += bf_hi(pw.x); v[2] += bf_lo(pw.y); v[3] += bf_hi(pw.y); v[4] += bf_lo(pw.z); v[5] += bf_hi(pw.z); v[6] += bf_lo(pw.w); v[7] += bf_hi(pw.w); }
                    u32x4 w; w.x = cvt_pk_bf16(v[0], v[1]); w.y = cvt_pk_bf16(v[2], v[3]); w.z = cvt_pk_bf16(v[4], v[5]); w.w = cvt_pk_bf16(v[6], v[7]);
                    *(u32x4*)(merged + ro + bj * 128) = w; } }
    }
};
struct EpiOut {
    static constexpr bool PERM = false;
    const float* xin; float* pre;
    __device__ __forceinline__ void operator()(const f32x4 (&acc)[2][2][4][2], const Unit& u, int wr, int wc, int fr, int fq) const {
        const int row0 = u.pm * 256 + wr * 64 + fr, col0 = u.pn * 256 + wc * 32 + 4 * fq;
#pragma unroll
        for (int ai = 0; ai < 2; ++ai)
#pragma unroll
            for (int m = 0; m < 4; ++m) { const size_t ro = (size_t)(row0 + ai * 128 + m * 16) * D_MODEL + col0;
#pragma unroll
                for (int bj = 0; bj < 2; ++bj)
#pragma unroll
                    for (int n = 0; n < 2; ++n) { const f32x4 xv = *(const f32x4*)(xin + ro + bj * 128 + n * 16); *(f32x4*)(pre + ro + bj * 128 + n * 16) = xv * ALPHA + acc[ai][bj][m][n]; } }
    }
};
struct EpiGU {
    static constexpr bool PERM = true;
    bf16_t* h;
    __device__ __forceinline__ void operator()(const f32x4 (&acc)[2][2][4][2], const Unit& u, int wr, int wc, int fr, int fq) const {
        const int row0 = u.x2 + wr * 64 + fr, col0 = u.pn * 128 + wc * 32 + 8 * fq;
#pragma unroll
        for (int ai = 0; ai < 2; ++ai)
#pragma unroll
            for (int m = 0; m < 4; ++m) { bf16_t* rowp = h + (size_t)(row0 + ai * 128 + m * 16) * FE + col0; float v[8];
#pragma unroll
                for (int n = 0; n < 2; ++n)
#pragma unroll
                    for (int i = 0; i < 4; ++i) { const float g = acc[ai][0][m][n][i], uu = acc[ai][1][m][n][i]; v[n * 4 + i] = g * sigmoidf_(g) * uu; }
                u32x4 w; w.x = cvt_pk_bf16(v[0], v[1]); w.y = cvt_pk_bf16(v[2], v[3]); w.z = cvt_pk_bf16(v[4], v[5]); w.w = cvt_pk_bf16(v[6], v[7]);
                *(u32x4*)rowp = w; }
    }
};
struct EpiDown {
    static constexpr bool PERM = true;
    bf16_t* y; const int* list;
    __device__ __forceinline__ void operator()(const f32x4 (&acc)[2][2][4][2], const Unit& u, int wr, int wc, int fr, int fq) const {
        const int nv = u.x1, loff = u.x0;
        const int* lp = list + (size_t)u.pm * T + loff;
        const int col0 = u.pn * 256 + wc * 32 + 8 * fq;
#pragma unroll
        for (int ai = 0; ai < 2; ++ai)
#pragma unroll
            for (int m = 0; m < 4; ++m) { const int lr = ai * 128 + wr * 64 + m * 16 + fr;
                if (lr < nv) { const int entry = lp[lr]; bf16_t* rowp = y + (size_t)entry * D_MODEL + col0;
#pragma unroll
                    for (int bj = 0; bj < 2; ++bj) { const f32x4 v0 = acc[ai][bj][m][0], v1 = acc[ai][bj][m][1];
                        u32x4 w; w.x = cvt_pk_bf16(v0[0], v0[1]); w.y = cvt_pk_bf16(v0[2], v0[3]); w.z = cvt_pk_bf16(v1[0], v1[1]); w.w = cvt_pk_bf16(v1[2], v1[3]);
                        *(u32x4*)(rowp + bj * 128) = w; } } }
    }
};

namespace att {
constexpr int DM = WA;
constexpr int SLOTB = 8192;
constexpr int LDS_K = 0, LDS_V = 2 * SLOTB, LDS_WS = 4 * SLOTB, LDS_OST = LDS_WS + 8 * 256, LDS_TAB = LDS_OST + 8 * 4096, LDS_FLG = LDS_TAB + 1024, LDS_END = LDS_FLG + 64;
#define SBAR() __builtin_amdgcn_sched_barrier(0)
#define WAIT_BAR0() asm volatile("s_waitcnt vmcnt(0) lgkmcnt(0)\n\ts_barrier" ::: "memory")
__device__ __forceinline__ int crow(int r, int hi) { return (r & 3) + 8 * (r >> 2) + 4 * hi; }
__device__ __forceinline__ void glds16(const void* gsrc, unsigned lds_dst) { unsigned keep;
    asm volatile("s_mov_b32 %0, m0\n\ts_mov_b32 m0, %2\n\ts_nop 0\n\tglobal_load_lds_dwordx4 %1, off\n\ts_mov_b32 m0, %0" : "=&s"(keep) : "v"(gsrc), "s"(lds_dst) : "memory"); }
__device__ __forceinline__ float max3f(float a, float b, float c) { return __builtin_fmaxf(__builtin_fmaxf(a, b), c); }
__device__ __forceinline__ void qkt(f32x16& p0, f32x16& p1, const LAS char* Kslot, const bf16x8* qr, const f32x16& cin, int r32, int hi) {
    const LAS char* kb = Kslot + hi * 1024 + r32 * 16;
#pragma unroll
    for (int d0 = 0; d0 < 4; ++d0) {
        const bf16x8 b0 = *(const LAS bf16x8*)(kb + d0 * 2048);
        const bf16x8 b1 = *(const LAS bf16x8*)(kb + d0 * 2048 + 512);
        if (d0 == 0) { p0 = __builtin_amdgcn_mfma_f32_32x32x16_bf16(b0, qr[0], cin, 0, 0, 0); p1 = __builtin_amdgcn_mfma_f32_32x32x16_bf16(b1, qr[0], cin, 0, 0, 0); }
        else { p0 = __builtin_amdgcn_mfma_f32_32x32x16_bf16(b0, qr[d0], p0, 0, 0, 0); p1 = __builtin_amdgcn_mfma_f32_32x32x16_bf16(b1, qr[d0], p1, 0, 0, 0); } }
}
__device__ __forceinline__ float rowmax(const f32x16& p0, const f32x16& p1) {
    float a = max3f(p0[0], p0[1], p1[0]), b = max3f(p0[2], p0[3], p1[1]); a = max3f(a, p1[2], p1[3]);
#pragma unroll
    for (int r = 4; r < 16; r += 4) { a = max3f(a, p0[r], p0[r + 1]); b = max3f(b, p0[r + 2], p0[r + 3]); a = max3f(a, p1[r], p1[r + 1]); b = max3f(b, p1[r + 2], p1[r + 3]); }
    const float m = __builtin_fmaxf(a, b);
    auto rr = __builtin_amdgcn_permlane32_swap(__float_as_uint(m), __float_as_uint(m), false, false);
    return __builtin_fmaxf(__uint_as_float(rr[0]), __uint_as_float(rr[1]));
}
__device__ __forceinline__ void pv(f32x16* o, int vb, bf16x8 pa0, bf16x8 pa1, bf16x8 pa2, bf16x8 pa3) {
#pragma unroll
    for (int d0 = 0; d0 < 2; ++d0) { s16x4 lo[4], hi[4];
#pragma unroll
        for (int ks = 0; ks < 4; ++ks) {
            asm volatile("ds_read_b64_tr_b16 %0,%1 offset:%c2" : "=&v"(lo[ks]) : "v"(vb), "i"(d0 * 4096 + ks * 1024) : "memory");
            asm volatile("ds_read_b64_tr_b16 %0,%1 offset:%c2" : "=&v"(hi[ks]) : "v"(vb), "i"(d0 * 4096 + ks * 1024 + 512) : "memory"); }
        asm volatile("s_waitcnt lgkmcnt(0)" ::: "memory"); SBAR();
#define PK(k) (bf16x8){lo[k][0], lo[k][1], lo[k][2], lo[k][3], hi[k][0], hi[k][1], hi[k][2], hi[k][3]}
        o[d0] = __builtin_amdgcn_mfma_f32_32x32x16_bf16(pa0, PK(0), o[d0], 0, 0, 0);
        o[d0] = __builtin_amdgcn_mfma_f32_32x32x16_bf16(pa1, PK(1), o[d0], 0, 0, 0);
        o[d0] = __builtin_amdgcn_mfma_f32_32x32x16_bf16(pa2, PK(2), o[d0], 0, 0, 0);
        o[d0] = __builtin_amdgcn_mfma_f32_32x32x16_bf16(pa3, PK(3), o[d0], 0, 0, 0);
#undef PK
    }
}
#define PKW(P, B) cvt_pk_bf16(P[B], P[B + 1])
__device__ __forceinline__ void store_o(const f32x16* o, const float* rs, bf16_t* Ow, LAS char* shm, int wid, int lane, int r32, int hi) {
    LAS bf16_t* stg = (LAS bf16_t*)(shm + LDS_OST) + wid * 2048;
#pragma unroll
    for (int r = 0; r < 16; ++r) { const int orow = crow(r, hi);
#pragma unroll
        for (int d0 = 0; d0 < 2; ++d0) stg[orow * 64 + d0 * 32 + r32] = (bf16_t)(cvt_pk_bf16(o[d0][r] * rs[r], 0.f) & 0xffffu); }
    LDS_WAIT();
#pragma unroll
    for (int i = 0; i < 4; ++i) { const int row = i * 8 + (lane >> 3), ch = lane & 7; const u32x4 v = *(const LAS u32x4*)(stg + row * 64 + ch * 8); *(u32x4*)(Ow + (size_t)row * DM + ch * 8) = v; }
}

__device__ __forceinline__ void attn_a_unit(int b, int h, int u, const bf16_t* Q, const bf16_t* K, const bf16_t* V, bf16_t* O, const float* bias_h, LAS char* shm) {
    int tid_ = threadIdx.x; asm volatile("" : "+v"(tid_)); const int tid = tid_, lane = tid & 63, r32 = lane & 31, hi = lane >> 5; const int wid = __builtin_amdgcn_readfirstlane(tid >> 6);
    const long rowbase = (long)b * SEQ; const int q0 = u * 256;
    const bf16_t* Qw = Q + (rowbase + q0 + wid * 32) * DM + h * HD;
    const bf16_t* Kh = K + rowbase * DM + h * HD; const bf16_t* Vh = V + rowbase * DM + h * HD;
    const unsigned lds0 = (unsigned)(size_t)shm;
    LAS float* wsf = (LAS float*)(shm + LDS_WS) + wid * 64;
    LAS float* tab = (LAS float*)(shm + LDS_TAB);
    if (tid < 256) { int rel = tid - 64; rel = rel < -128 ? -128 : (rel > 128 ? 128 : rel); tab[tid] = bias_h[rel + 128] * LOG2E; }
    const float bfar = bias_h[256] * LOG2E;
    const bf16_t* ksrc = Kh + (long)lane * DM + wid * 8;
    const bf16_t* vsrc = Vh + (long)(16 * (wid & 3) + (lane >> 2)) * DM + (wid >> 2) * 32 + (lane & 3) * 8;
    const unsigned kdst = lds0 + LDS_K + wid * 1024, vdst = lds0 + LDS_V + wid * 1024;
#define DMA_K(t, slot) glds16(ksrc + (long)(t) * 64 * DM, (unsigned)__builtin_amdgcn_readfirstlane(kdst + (slot)))
#define DMA_V(t, slot) glds16(vsrc + (long)(t) * 64 * DM, (unsigned)__builtin_amdgcn_readfirstlane(vdst + (slot)))
    const int vb0 = (int)(lds0 + LDS_V) + ((lane >> 4) & 1) * 32 + (lane & 3) * 8 + (4 * hi + ((lane & 15) >> 2)) * 64;
    const int cw = 4 * u + (wid >> 1);
    const int jlo = (4 * u - 8) > 0 ? (4 * u - 8) : 0, jhi = 4 * u + 3;
    DMA_K(jlo, 0); DMA_V(jlo, 0);
    bf16x8 qr[4];
#pragma unroll
    for (int d0 = 0; d0 < 4; ++d0) qr[d0] = *(const bf16x8*)(Qw + (long)r32 * DM + d0 * 16 + hi * 8);
    float mhat = 0.f, l_reg = 0.f; f32x16 o[2]; o[0] = f32x16{}; o[1] = f32x16{};
    bool first = true;
    for (int j = jlo; j <= jhi; ++j) {
        const int sl = ((j - jlo) & 1) * SLOTB;
        WAIT_BAR0();
        if (j < jhi) { DMA_K(j + 1, sl ^ SLOTB); DMA_V(j + 1, sl ^ SLOTB); }
        if (j >= cw - 8 && j <= cw) {
            const bool far = (j <= cw - 3);
            f32x16 cin; const float c0 = (far ? bfar : 0.f) - mhat;
#pragma unroll
            for (int r = 0; r < 16; ++r) cin[r] = c0;
            f32x16 p0, p1;
            qkt(p0, p1, shm + LDS_K + sl, qr, cin, r32, hi);
            if (!far) {
                const LAS float* tp = tab + ((cw - j) * 64 + 32 * (wid & 1) + r32 + 64 - 4 * hi);
#pragma unroll
                for (int r = 0; r < 16; ++r) { const int kv = (r & 3) + 8 * (r >> 2); p0[r] += tp[-kv]; p1[r] += tp[-kv - 32]; }
            }
            const float rm = rowmax(p0, p1);
            bool upd; float dl;
            if (first) { upd = true; dl = rm; } else { upd = __any(rm > 8.f) != 0; dl = __builtin_fmaxf(rm, 0.f); }
            if (upd) {
                mhat += dl;
#pragma unroll
                for (int r = 0; r < 16; ++r) { p0[r] -= dl; p1[r] -= dl; }
                if (!first) { const float f = fast_exp2(-dl); l_reg *= f; if (hi == 0) wsf[r32] = f; LDS_WAIT();
#pragma unroll
                    for (int r = 0; r < 16; ++r) { const float fr_ = wsf[crow(r, hi)]; o[0][r] *= fr_; o[1][r] *= fr_; } }
            }
            first = false;
            float sacc = 0.f;
#pragma unroll
            for (int r = 0; r < 16; ++r) { p0[r] = fast_exp2(p0[r]); p1[r] = fast_exp2(p1[r]); sacc += p0[r] + p1[r]; }
            l_reg += sacc;
            u32x4 pw0 = (u32x4){PKW(p0, 0), PKW(p0, 2), PKW(p0, 4), PKW(p0, 6)}, pw1 = (u32x4){PKW(p0, 8), PKW(p0, 10), PKW(p0, 12), PKW(p0, 14)};
            u32x4 pw2 = (u32x4){PKW(p1, 0), PKW(p1, 2), PKW(p1, 4), PKW(p1, 6)}, pw3 = (u32x4){PKW(p1, 8), PKW(p1, 10), PKW(p1, 12), PKW(p1, 14)};
            pv(o, vb0 + sl, __builtin_bit_cast(bf16x8, pw0), __builtin_bit_cast(bf16x8, pw1), __builtin_bit_cast(bf16x8, pw2), __builtin_bit_cast(bf16x8, pw3));
        }
    }
    { auto rr = __builtin_amdgcn_permlane32_swap(__float_as_uint(l_reg), __float_as_uint(l_reg), false, false); l_reg = __uint_as_float(rr[0]) + __uint_as_float(rr[1]); }
    if (hi == 0) wsf[32 + r32] = l_reg; LDS_WAIT();
    float rli[16];
#pragma unroll
    for (int r = 0; r < 16; ++r) rli[r] = fast_rcp(wsf[32 + crow(r, hi)]);
    store_o(o, rli, O + (rowbase + q0 + wid * 32) * DM + h * HD, shm, wid, lane, r32, hi);
    asm volatile("s_waitcnt lgkmcnt(0)\n\ts_barrier" ::: "memory");
#undef DMA_K
#undef DMA_V
}

__device__ __forceinline__ void attn_b_unit(int b, int h, int qb, const bf16_t* Q, const bf16_t* K, const bf16_t* V, bf16_t* O, LAS char* shm) {
    int tid_ = threadIdx.x; asm volatile("" : "+v"(tid_)); const int tid = tid_, lane = tid & 63, r32 = lane & 31, hi = lane >> 5; const int wid = __builtin_amdgcn_readfirstlane(tid >> 6);
    const long rowbase = (long)b * SEQ; const int q0 = qb * 256;
    const bf16_t* Qw = Q + (rowbase + q0 + wid * 32) * DM + h * HD;
    const bf16_t* Kh = K + rowbase * DM + h * HD; const bf16_t* Vh = V + rowbase * DM + h * HD;
    const unsigned lds0 = (unsigned)(size_t)shm;
    LAS unsigned* flg = (LAS unsigned*)(shm + LDS_FLG);
    const bf16_t* ksrc = Kh + (long)lane * DM + wid * 8;
    const bf16_t* vsrc = Vh + (long)(16 * (wid & 3) + (lane >> 2)) * DM + (wid >> 2) * 32 + (lane & 3) * 8;
    const unsigned kdst = lds0 + LDS_K + wid * 1024, vdst = lds0 + LDS_V + wid * 1024;
#define DMA_K(t, slot) glds16(ksrc + (long)(t) * 64 * DM, (unsigned)__builtin_amdgcn_readfirstlane(kdst + (slot)))
#define DMA_V(t, slot) glds16(vsrc + (long)(t) * 64 * DM, (unsigned)__builtin_amdgcn_readfirstlane(vdst + (slot)))
    const int vb0 = (int)(lds0 + LDS_V) + ((lane >> 4) & 1) * 32 + (lane & 3) * 8 + (4 * hi + ((lane & 15) >> 2)) * 64;
    const int jtop = 4 * qb + 3, jd = 4 * qb + (wid >> 1);
    const int tq = 32 * (wid & 1) + r32;
    DMA_K(jtop, 0); DMA_V(jtop, 0);
    bf16x8 qr[4];
#pragma unroll
    for (int d0 = 0; d0 < 4; ++d0) qr[d0] = *(const bf16x8*)(Qw + (long)r32 * DM + d0 * 16 + hi * 8);
    float R = 1.0f; bool wdone = false; f32x16 o[2]; o[0] = f32x16{}; o[1] = f32x16{};
    for (int j = jtop, it = 0; j >= 0; --j, ++it) {
        const int sl = (it & 1) * SLOTB;
        WAIT_BAR0();
        if (it > 0) { const LAS unsigned* f = flg + ((it - 1) & 1) * 8; unsigned all = 1u;
#pragma unroll
            for (int w = 0; w < 8; ++w) all &= f[w];
            if (__builtin_amdgcn_readfirstlane(all) != 0u) break; }
        if (j > 0) { DMA_K(j - 1, sl ^ SLOTB); DMA_V(j - 1, sl ^ SLOTB); }
        if (j <= jd && !wdone) {
            f32x16 cin = f32x16{}; f32x16 p0, p1;
            qkt(p0, p1, shm + LDS_K + sl, qr, cin, r32, hi);
#pragma unroll
            for (int r = 0; r < 16; ++r) { p0[r] = fast_rcp(1.0f + fast_exp2(p0[r])); p1[r] = fast_rcp(1.0f + fast_exp2(p1[r])); }
            if (j == jd) {
#pragma unroll
                for (int r = 0; r < 16; ++r) { const int kv = crow(r, hi); if (kv >= tq) p0[r] = 1.0f; if (kv + 32 >= tq) p1[r] = 1.0f; } }
            float W[8], part[8];
#pragma unroll
            for (int i = 0; i < 8; ++i) { const float pb = (i < 4) ? (p0[4 * i] * p0[4 * i + 1]) * (p0[4 * i + 2] * p0[4 * i + 3]) : (p1[4 * i - 16] * p1[4 * i - 15]) * (p1[4 * i - 14] * p1[4 * i - 13]);
                auto rr = __builtin_amdgcn_permlane32_swap(__float_as_uint(pb), __float_as_uint(pb), false, false);
                const float vlo = __uint_as_float(rr[0]), vhi = __uint_as_float(rr[1]);
                W[i] = vlo * vhi; part[i] = hi ? 1.0f : vhi; }
            float sw = R;
#pragma unroll
            for (int i = 7; i >= 0; --i) { float c = sw * part[i];
                if (i < 4) {
#pragma unroll
                    for (int rr_ = 3; rr_ >= 0; --rr_) { const float t_ = c * p0[4 * i + rr_]; p0[4 * i + rr_] = c - t_; c = t_; } }
                else {
#pragma unroll
                    for (int rr_ = 3; rr_ >= 0; --rr_) { const float t_ = c * p1[4 * i - 16 + rr_]; p1[4 * i - 16 + rr_] = c - t_; c = t_; } }
                sw *= W[i]; }
            R = sw;
            u32x4 pw0 = (u32x4){PKW(p0, 0), PKW(p0, 2), PKW(p0, 4), PKW(p0, 6)}, pw1 = (u32x4){PKW(p0, 8), PKW(p0, 10), PKW(p0, 12), PKW(p0, 14)};
            u32x4 pw2 = (u32x4){PKW(p1, 0), PKW(p1, 2), PKW(p1, 4), PKW(p1, 6)}, pw3 = (u32x4){PKW(p1, 8), PKW(p1, 10), PKW(p1, 12), PKW(p1, 14)};
            pv(o, vb0 + sl, __builtin_bit_cast(bf16x8, pw0), __builtin_bit_cast(bf16x8, pw1), __builtin_bit_cast(bf16x8, pw2), __builtin_bit_cast(bf16x8, pw3));
            wdone = __all(R == 0.0f) != 0;
        }
        if (lane == 0) flg[(it & 1) * 8 + wid] = wdone ? 1u : 0u;
    }
    float ones[16];
#pragma unroll
    for (int r = 0; r < 16; ++r) ones[r] = 1.0f;
    store_o(o, ones, O + (rowbase + q0 + wid * 32) * DM + h * HD, shm, wid, lane, r32, hi);
    asm volatile("s_waitcnt lgkmcnt(0)\n\ts_barrier" ::: "memory");
#undef DMA_K
#undef DMA_V
}
#undef PKW
#undef SBAR
#undef WAIT_BAR0
}

#define XB_TMO      128
#define XB_XCNT(j)  (256  + 64 * (j))
#define XB_XSUB(j)  (1280 + 64 * (j))
#define XB_XGEN(j)  (2304 + 64 * (j))
#define XB_TOP      3328
#define XB_TOPGEN   3392
#define XCD_BAR_WORDS 3456
#define XB_SPIN_CAP (1u << 22)
__device__ __forceinline__ unsigned xb_ld(unsigned* p)              { return __hip_atomic_load(p, __ATOMIC_RELAXED, __HIP_MEMORY_SCOPE_AGENT); }
__device__ __forceinline__ unsigned xb_add(unsigned* p, unsigned v) { return __hip_atomic_fetch_add(p, v, __ATOMIC_RELAXED, __HIP_MEMORY_SCOPE_AGENT); }
__device__ __forceinline__ unsigned xb_xcc_id() { return (unsigned)__builtin_amdgcn_s_getreg((3 << 11) | 20) & 0xFu; }
#define XB_SPIN(cond, bar) do { unsigned _sp = 0; while (cond) { __builtin_amdgcn_s_sleep(1); \
    if ((++_sp & 255u) == 0u) { if (xb_ld(&(bar)[XB_TMO])) break; if (_sp > XB_SPIN_CAP) { atomicAdd(&(bar)[XB_TMO], 1u); break; } } } } while (0)
struct XcdBarrier { unsigned* bar; unsigned x; volatile LAS unsigned* st; };
__device__ __forceinline__ XcdBarrier xcd_barrier_post(unsigned* bar, volatile LAS unsigned* st) {
    XcdBarrier b; b.bar = bar; b.x = xb_xcc_id(); b.st = st;
    if (threadIdx.x == 0) (void)xb_add(&bar[XB_XCNT(b.x)], 1u);
    return b;
}
__device__ __forceinline__ void xcd_barrier_complete(unsigned* bar, unsigned x, unsigned& nloc, unsigned& nx) {
    const unsigned G = gridDim.x * gridDim.y * gridDim.z;
    unsigned sum, cnt, mine, sp = 0u;
    for (;;) {
        sum = 0u; cnt = 0u; mine = 0u;
#pragma unroll
        for (unsigned j = 0; j < 16; ++j) { const unsigned c = xb_ld(&bar[XB_XCNT(j)]); sum += c; cnt += (c > 0u) ? 1u : 0u; mine = (j == x) ? c : mine; }
        if (sum == G) break;
        __builtin_amdgcn_s_sleep(1);
        if ((++sp & 255u) == 0u) { if (xb_ld(&bar[XB_TMO])) break; if (sp > XB_SPIN_CAP) { atomicAdd(&bar[XB_TMO], 1u); break; } }
    }
    nloc = mine > 0u ? mine : 1u; nx = cnt > 0u ? cnt : 1u;
}
__device__ __forceinline__ void xcd_barrier(const XcdBarrier& b) {
    asm volatile("s_waitcnt vmcnt(0)" ::: "memory");
    __syncthreads();
    if (threadIdx.x == 0) {
        unsigned* bar = b.bar;
        __builtin_amdgcn_s_waitcnt(0);
        unsigned nloc = b.st[0], nx = b.st[1];
        if (nloc == 0u) { xcd_barrier_complete(bar, b.x, nloc, nx); b.st[0] = nloc; b.st[1] = nx; }
        const unsigned old = xb_add(&bar[XB_XSUB(b.x)], 1u);
        const unsigned gen = old / nloc;
        if (old + 1u == (gen + 1u) * nloc) {
            __builtin_amdgcn_fence(__ATOMIC_RELEASE, "agent");
            asm volatile("s_waitcnt vmcnt(0)" ::: "memory");
            const unsigned og = xb_add(&bar[XB_TOP], 1u);
            const unsigned tg = og / nx;
            if (og + 1u == (tg + 1u) * nx) xb_add(&bar[XB_TOPGEN], 1u);
            else XB_SPIN(xb_ld(&bar[XB_TOPGEN]) == tg, bar);
            __builtin_amdgcn_fence(__ATOMIC_ACQUIRE, "agent");
            xb_add(&bar[XB_XGEN(b.x)], 1u);
            asm volatile("s_waitcnt vmcnt(0)" ::: "memory");
        } else {
            XB_SPIN(xb_ld(&bar[XB_XGEN(b.x)]) == gen, bar);
            __builtin_amdgcn_fence(__ATOMIC_ACQUIRE, "agent");
            asm volatile("s_waitcnt vmcnt(0)" ::: "memory");
        }
    }
    __syncthreads();
}

__device__ __forceinline__ unsigned f2bf(float f) { unsigned u = __builtin_bit_cast(unsigned, f); return (u + 0x7fffu + ((u >> 16) & 1u)) >> 16; }
__device__ __forceinline__ unsigned pk2(float lo, float hi) { return f2bf(lo) | (f2bf(hi) << 16); }
__device__ __forceinline__ void transpose_item(const float* W, int K, int N, bf16_t* WT, int row_off, LAS float* scr, int item, int lane) {
    const int nblk = N / 32, kb = item / nblk, nb = item % nblk, k0 = 64 * kb, n0 = 32 * nb;
#pragma unroll 8
    for (int i = 0; i < 32; ++i) { const int kk = 2 * i + (lane >> 5); scr[kk * 33 + (lane & 31)] = W[(size_t)(k0 + kk) * N + n0 + (lane & 31)]; }
    LDS_WAIT(); asm volatile("" ::: "memory");
    const int c = lane & 7;
#pragma unroll
    for (int j = 0; j < 4; ++j) { const int n = (lane >> 3) + 8 * j; const LAS float* s = scr + (8 * c) * 33 + n;
        u32x4 o; o.x = pk2(s[0 * 33], s[1 * 33]); o.y = pk2(s[2 * 33], s[3 * 33]); o.z = pk2(s[4 * 33], s[5 * 33]); o.w = pk2(s[6 * 33], s[7 * 33]);
        *(u32x4*)(WT + (size_t)(row_off + n0 + n) * K + k0 + 8 * c) = o; }
    LDS_WAIT(); asm volatile("" ::: "memory");
}

struct Args { const float* in[15]; float* out; unsigned char* ws; int ph_lo, ph_hi; };
typedef const __attribute__((address_space(4))) char* kptr_t;
__device__ __forceinline__ kptr_t kbase() { kptr_t kp = (kptr_t)__builtin_amdgcn_kernarg_segment_ptr(); asm volatile("" : "+s"(kp)); return kp; }
__device__ __forceinline__ const float* arg_in(int i) { return *(const float* const __attribute__((address_space(4)))*)(kbase() + 8 * i); }
__device__ __forceinline__ float* arg_out() { return *(float* const __attribute__((address_space(4)))*)(kbase() + 120); }
__device__ __forceinline__ unsigned char* arg_ws() { return *(unsigned char* const __attribute__((address_space(4)))*)(kbase() + 128); }
__device__ __forceinline__ int arg_lo() { return *(const __attribute__((address_space(4))) int*)(kbase() + 136); }
__device__ __forceinline__ int arg_hi() { return *(const __attribute__((address_space(4))) int*)(kbase() + 140); }
static_assert(sizeof(Args) == 144, "Args layout");

constexpr int NWAVES = 8;
constexpr int PH_PER_LAYER = 8, N_PHASES = 1 + DEPTH * PH_PER_LAYER;
#define PH_COMMON() int tid_ = threadIdx.x; asm volatile("" : "+v"(tid_)); const int tid = tid_, lane = tid & 63, wave = __builtin_amdgcn_readfirstlane(tid >> 6); const int G = gridDim.x, bx = blockIdx.x; \
    const int vcu = (G % 8 == 0) ? (bx % 8) * (G / 8) + bx / 8 : bx; const int gw = vcu * NWAVES + wave, NGW = G * NWAVES; unsigned char* ws = arg_ws(); \
    (void)tid; (void)lane; (void)wave; (void)vcu; (void)gw; (void)NGW; (void)ws

__device__ __forceinline__ void convert_weights(int l, LAS unsigned char* lds) {
    PH_COMMON();
    LAS float* scr = (LAS float*)(lds + wave * 16384);
    const float* w_in = arg_in(1) + (size_t)l * D_MODEL * PROJ;
    const float* w_upa = arg_in(3) + (size_t)l * WA * D_MODEL;
    const float* w_upb = arg_in(4) + (size_t)l * WA * D_MODEL;
    const float* w_out = arg_in(5) + (size_t)l * D_MODEL * D_MODEL;
    const float* w_gate = arg_in(10) + (size_t)l * NE * D_MODEL * FE;
    const float* w_up = arg_in(11) + (size_t)l * NE * D_MODEL * FE;
    const float* w_down = arg_in(12) + (size_t)l * NE * FE * D_MODEL;
    constexpr int I_IN = (D_MODEL / 64) * (PROJ / 32), I_UP = (WA / 64) * (D_MODEL / 32), I_OUT = (D_MODEL / 64) * (D_MODEL / 32);
    constexpr int I_G = (D_MODEL / 64) * (FE / 32), I_D = (FE / 64) * (D_MODEL / 32);
    constexpr int NITEMS = I_IN + 2 * I_UP + I_OUT + NE * (2 * I_G + I_D);
    for (int it = gw; it < NITEMS; it += NGW) {
        int r = it;
        if (r < I_IN) { transpose_item(w_in, D_MODEL, PROJ, (bf16_t*)(ws + WS_WIN), 0, scr, r, lane); continue; } r -= I_IN;
        if (r < I_UP) { transpose_item(w_upa, WA, D_MODEL, (bf16_t*)(ws + WS_WUPA), 0, scr, r, lane); continue; } r -= I_UP;
        if (r < I_UP) { transpose_item(w_upb, WA, D_MODEL, (bf16_t*)(ws + WS_WUPB), 0, scr, r, lane); continue; } r -= I_UP;
        if (r < I_OUT) { transpose_item(w_out, D_MODEL, D_MODEL, (bf16_t*)(ws + WS_WOUT), 0, scr, r, lane); continue; } r -= I_OUT;
        const int e = r / (2 * I_G + I_D); r -= e * (2 * I_G + I_D);
        if (r < 2 * I_G) { const int up = r >= I_G; if (up) r -= I_G;
            const int nb = r % (FE / 32), n0 = nb * 32;
            const int row_off = e * 1024 + (n0 / 128) * 128 + (up ? 128 : 0);
            transpose_item((up ? w_up : w_gate) + (size_t)e * D_MODEL * FE, D_MODEL, FE, (bf16_t*)(ws + WS_WGU), row_off, scr, r, lane); continue; }
        r -= 2 * I_G;
        transpose_item(w_down + (size_t)e * FE * D_MODEL, FE, D_MODEL, (bf16_t*)(ws + WS_WD), e * 1024, scr, r, lane);
    }
}

__device__ __forceinline__ void phase0(LAS unsigned char* lds) {
    convert_weights(0, lds);
    PH_COMMON();
    const float* x_in = arg_in(0); bf16_t* XB = (bf16_t*)(ws + WS_XB);
    for (int m = gw; m < T; m += NGW) { const f32x4* xr = (const f32x4*)(x_in + (size_t)m * D_MODEL) + lane; u32x2* o8 = (u32x2*)(XB + (size_t)m * D_MODEL) + lane;
#pragma unroll
        for (int j = 0; j < 4; ++j) { const f32x4 v = xr[64 * j]; u32x2 w; w.x = cvt_pk_bf16(v.x, v.y); w.y = cvt_pk_bf16(v.z, v.w); o8[64 * j] = w; } }
}
__device__ __forceinline__ void phase1(LAS unsigned char* lds) {
    PH_COMMON();
    pg8::SchedPlain S; S.o.init(T / 256, PROJ / 256, G, bx); S.A = (const char*)(ws + WS_XB); S.B = (const char*)(ws + WS_WIN); S.tstep = (size_t)256 * D_MODEL * 2;
    EpiInProj E{(bf16_t*)(ws + WS_QA), (bf16_t*)(ws + WS_GA)};
    pg8::gemm_phase<EpiInProj, pg8::SchedPlain, false, true>(lds, D_MODEL, S, E);
}
__device__ __forceinline__ void phase2(LAS unsigned char* lds, int l) {
    PH_COMMON();
    const int bh = vcu >> 2, s = vcu & 3; const int b = bh >> 3, h = bh & 7;
    if (G != 256) return;
    bf16_t* QKV = (bf16_t*)(ws + WS_QA);
    const float* bias_h = arg_in(2) + ((size_t)l * NH + h) * N_REL;
    bf16_t* QAp = QKV; bf16_t* KAp = QKV + (QKV_STRIDE / 2); bf16_t* VAp = QKV + 2 * (QKV_STRIDE / 2);
    bf16_t* QBp = QKV + 3 * (QKV_STRIDE / 2); bf16_t* KBp = QKV + 4 * (QKV_STRIDE / 2); bf16_t* VBp = QKV + 5 * (QKV_STRIDE / 2);
    for (int i = 0; i < 4; ++i) { const int u = (i == 0) ? s : (i == 1) ? 7 - s : (i == 2) ? 8 + s : 15 - s; att::attn_a_unit(b, h, u, QAp, KAp, VAp, QAp, bias_h, (LAS char*)lds); }
    for (int i = 0; i < 4; ++i) { const int u = (i == 0) ? s : (i == 1) ? 7 - s : (i == 2) ? 8 + s : 15 - s; att::attn_b_unit(b, h, u, QBp, KBp, VBp, QBp, (LAS char*)lds); }
}
__device__ __forceinline__ void phase3(LAS unsigned char* lds) {
    PH_COMMON();
    bf16_t* QKV = (bf16_t*)(ws + WS_QA);
    pg8::SchedTwo S; S.o.init(T / 256, D_MODEL / 256, G, bx); S.A0 = (const char*)QKV; S.A1 = (const char*)(QKV + 3 * (QKV_STRIDE / 2));
    S.B0 = (const char*)(ws + WS_WUPA); S.B1 = (const char*)(ws + WS_WUPB); S.tstep = (size_t)256 * WA * 2;
    EpiMerge E{(const bf16_t*)(ws + WS_GA), (const bf16_t*)(ws + WS_GB), (bf16_t*)(ws + WS_MERGED)};
    pg8::gemm_phase<EpiMerge, pg8::SchedTwo, false, true>(lds, WA, S, E);
}
__device__ __forceinline__ void phase4(LAS unsigned char* lds, int l) {
    PH_COMMON();
    pg8::SchedPlain S; S.o.init(T / 256, D_MODEL / 256, G, bx); S.A = (const char*)(ws + WS_MERGED); S.B = (const char*)(ws + WS_WOUT); S.tstep = (size_t)256 * D_MODEL * 2;
    EpiOut E{(l == 0) ? arg_in(0) : (const float*)arg_out(), (float*)(ws + WS_PRE)};
    pg8::gemm_phase<EpiOut, pg8::SchedPlain, false, true>(lds, D_MODEL, S, E);
}
__device__ __forceinline__ void phase5(LAS unsigned char* lds, int l) {
    PH_COMMON();
    const float* g1 = arg_in(6) + (size_t)l * D_MODEL; const float* b1 = arg_in(7) + (size_t)l * D_MODEL;
    const float* w_router = arg_in(8); const float* b_router = arg_in(9);
    float* xout = arg_out(); bf16_t* XB = (bf16_t*)(ws + WS_XB); const float* PRE = (const float*)(ws + WS_PRE);
    int* LIST = (int*)(ws + WS_LIST); f32x2* RECW = (f32x2*)(ws + WS_RECW);
    unsigned* gcnt = (unsigned*)(ws + WS_CTL) + CW_CNT + 64 * l;
    for (int i = tid; i < D_MODEL * 4; i += NWAVES * 64) { const int c = i >> 2, q = i & 3; *(LAS f32x4*)(lds + c * 64 + (c >> 2) * 16 + q * 16) = *(const f32x4*)(w_router + c * 16 + q * 4); }
    LAS unsigned* lcnt = (LAS unsigned*)(lds + 81920);
    LAS int* lrec = (LAS int*)(lds + 81920 + 256);
    if (tid < 32) lcnt[tid] = 0u;
    __syncthreads();
    int krow = 0;
    for (int m = gw; m < T; m += NGW, ++krow) {
        const f32x4* pr = (const f32x4*)(PRE + (size_t)m * D_MODEL) + lane;
        f32x4 v[4]; float s = 0.f;
#pragma unroll
        for (int j = 0; j < 4; ++j) { v[j] = pr[64 * j]; s += (v[j].x + v[j].y) + (v[j].z + v[j].w); }
        const float mean = wave_sum(s) * (1.f / D_MODEL); float s2 = 0.f;
#pragma unroll
        for (int j = 0; j < 4; ++j) { v[j] = v[j] - mean; s2 += (v[j].x * v[j].x + v[j].y * v[j].y) + (v[j].z * v[j].z + v[j].w * v[j].w); }
        const float rstd = 1.f / sqrtf(wave_sum(s2) * (1.f / D_MODEL) + LN_EPS);
        float lg[16];
#pragma unroll
        for (int e = 0; e < 16; ++e) lg[e] = 0.f;
#pragma unroll
        for (int j = 0; j < 4; ++j) { const f32x4 gg = *((const f32x4*)g1 + lane + 64 * j), bb = *((const f32x4*)b1 + lane + 64 * j);
            v[j] = v[j] * rstd * gg + bb;
            *((f32x4*)(xout + (size_t)m * D_MODEL) + lane + 64 * j) = v[j];
            u32x2 w; w.x = cvt_pk_bf16(v[j].x, v[j].y); w.y = cvt_pk_bf16(v[j].z, v[j].w); *((u32x2*)(XB + (size_t)m * D_MODEL) + lane + 64 * j) = w;
#pragma unroll
            for (int i = 0; i < 4; ++i) { const int c = 4 * (lane + 64 * j) + i; const LAS f32x4* wp = (const LAS f32x4*)(lds + c * 64 + (c >> 2) * 16); const float xv = v[j][i];
#pragma unroll
                for (int q = 0; q < 4; ++q) { const f32x4 wv = wp[q]; lg[4 * q + 0] += xv * wv.x; lg[4 * q + 1] += xv * wv.y; lg[4 * q + 2] += xv * wv.z; lg[4 * q + 3] += xv * wv.w; } } }
#pragma unroll
        for (int e = 0; e < 16; ++e) lg[e] = wave_sum(lg[e]) + b_router[e];
        int best = 0; float bv = lg[0];
#pragma unroll
        for (int e = 1; e < 16; ++e) if (lg[e] > bv) { bv = lg[e]; best = e; }
        const int grp = best >> 2; int e2 = -1; float v2 = 0.f;
#pragma unroll
        for (int e = 0; e < 16; ++e) { if ((e >> 2) == grp && e != best) { if (e2 < 0 || lg[e] > v2) { v2 = lg[e]; e2 = e; } } }
        const float w1 = fast_rcp(1.0f + fast_exp2((v2 - bv) * LOG2E)), w2 = 1.0f - w1;
        if (lane == 0) { RECW[m] = (f32x2){w1, w2};
            const int lp1 = (int)__hip_atomic_fetch_add(lcnt + best, 1u, __ATOMIC_RELAXED, __HIP_MEMORY_SCOPE_WORKGROUP);
            const int lp2 = (int)__hip_atomic_fetch_add(lcnt + e2, 1u, __ATOMIC_RELAXED, __HIP_MEMORY_SCOPE_WORKGROUP);
            LAS int* rp = lrec + (wave * 16 + krow) * 4; rp[0] = best; rp[1] = lp1; rp[2] = e2; rp[3] = lp2; }
    }
    __syncthreads();
    if (tid < 16) { const unsigned n = lcnt[tid]; lcnt[16 + tid] = n ? __hip_atomic_fetch_add(gcnt + tid, n, __ATOMIC_RELAXED, __HIP_MEMORY_SCOPE_AGENT) : 0u; }
    __syncthreads();
    if (lane == 0) { int k2 = 0;
        for (int m = gw; m < T; m += NGW, ++k2) { const LAS int* rp = lrec + (wave * 16 + k2) * 4;
            LIST[(size_t)rp[0] * T + lcnt[16 + rp[0]] + rp[1]] = m * 2; LIST[(size_t)rp[2] * T + lcnt[16 + rp[2]] + rp[3]] = m * 2 + 1; } }
    __syncthreads();
}
__device__ __forceinline__ int moe_units(LAS unsigned char* lds, int l) {
    PH_COMMON();
    LAS int* utab = (LAS int*)(lds + UTAB_OFF);
    unsigned* gcnt = (unsigned*)(ws + WS_CTL) + CW_CNT + 64 * l;
    __syncthreads();
    if (tid == 0) {
        LAS int* ts = utab + 128; LAS int* ncnt = utab + 160;
        int acc_t = 0;
        for (int e = 0; e < 16; ++e) { const int n = (int)__hip_atomic_load(gcnt + e, __ATOMIC_RELAXED, __HIP_MEMORY_SCOPE_AGENT); ncnt[e] = n; ts[e] = acc_t; acc_t += (n + 255) / 256; }
        ts[16] = acc_t;
        const int nunits = acc_t * 4; int cnt = 0;
        for (int i = 0; cnt < 16; ++i) { const long L = (long)i * G + bx; if (L >= nunits) break;
            int U = (int)L; { const int q = nunits / 8, r = nunits % 8, xcd = U % 8, off = U / 8; U = (xcd < r ? xcd * (q + 1) : r * (q + 1) + (xcd - r) * q) + off; }
            const int tile = U >> 2, pn = U & 3; int e = 0; while (ts[e + 1] <= tile) ++e;
            const int mt = tile - ts[e]; const int n = ncnt[e]; const int nv = (n - 256 * mt) < 256 ? (n - 256 * mt) : 256;
            utab[cnt * 5 + 0] = e; utab[cnt * 5 + 1] = pn; utab[cnt * 5 + 2] = mt * 256; utab[cnt * 5 + 3] = nv; utab[cnt * 5 + 4] = tile * 256;
            ++cnt; }
        utab[192] = cnt;
    }
    __syncthreads();
    return utab[192];
}
__device__ __forceinline__ void phase6(LAS unsigned char* lds, int l) {
    const int nun = moe_units(lds, l);
    PH_COMMON();
    pg8::SchedMoe S; S.utab = (LAS int*)(lds + UTAB_OFF); S.nunits = nun; S.Abase = (const char*)(ws + WS_XB); S.Bbase = (const char*)(ws + WS_WGU); S.a_row_bytes = 0;
    S.b_exp_bytes = (size_t)1024 * D_MODEL * 2; S.b_tile_bytes = (size_t)256 * D_MODEL * 2; S.list = (const int*)(ws + WS_LIST); S.gather_k2 = D_MODEL * 2;
    EpiGU E{(bf16_t*)(ws + WS_H)};
    pg8::gemm_phase<EpiGU, pg8::SchedMoe, true, true>(lds, D_MODEL, S, E);
}
__device__ __forceinline__ void phase7(LAS unsigned char* lds, int l) {
    const int nun = moe_units(lds, l);
    PH_COMMON();
    pg8::SchedMoe S; S.utab = (LAS int*)(lds + UTAB_OFF); S.nunits = nun; S.Abase = (const char*)(ws + WS_H); S.Bbase = (const char*)(ws + WS_WD); S.a_row_bytes = (size_t)FE * 2;
    S.b_exp_bytes = (size_t)1024 * FE * 2; S.b_tile_bytes = (size_t)256 * FE * 2; S.list = (const int*)(ws + WS_LIST); S.gather_k2 = 0;
    EpiDown E{(bf16_t*)(ws + WS_Y), (const int*)(ws + WS_LIST)};
    pg8::gemm_phase<EpiDown, pg8::SchedMoe, false, true>(lds, FE, S, E);
}
__device__ __forceinline__ void phase8(LAS unsigned char* lds, int l) {
    PH_COMMON();
    const float* g2 = arg_in(13) + (size_t)l * D_MODEL; const float* b2 = arg_in(14) + (size_t)l * D_MODEL;
    float* xout = arg_out(); bf16_t* XB = (bf16_t*)(ws + WS_XB); const bf16_t* Y = (const bf16_t*)(ws + WS_Y); const f32x2* RECW = (const f32x2*)(ws + WS_RECW);
    for (int m = gw; m < T; m += NGW) {
        const f32x2 wv = RECW[m];
        const f32x4* xr = (const f32x4*)(xout + (size_t)m * D_MODEL) + lane;
        const u32x2* y0 = (const u32x2*)(Y + (size_t)(2 * m) * D_MODEL) + lane; const u32x2* y1 = (const u32x2*)(Y + (size_t)(2 * m + 1) * D_MODEL) + lane;
        f32x4 v[4]; float s = 0.f;
#pragma unroll
        for (int j = 0; j < 4; ++j) { const f32x4 xv = xr[64 * j]; const u32x2 a = y0[64 * j], c = y1[64 * j];
            v[j].x = xv.x * ALPHA + wv.x * bf_lo(a.x) + wv.y * bf_lo(c.x); v[j].y = xv.y * ALPHA + wv.x * bf_hi(a.x) + wv.y * bf_hi(c.x);
            v[j].z = xv.z * ALPHA + wv.x * bf_lo(a.y) + wv.y * bf_lo(c.y); v[j].w = xv.w * ALPHA + wv.x * bf_hi(a.y) + wv.y * bf_hi(c.y);
            s += (v[j].x + v[j].y) + (v[j].z + v[j].w); }
        const float mean = wave_sum(s) * (1.f / D_MODEL); float s2 = 0.f;
#pragma unroll
        for (int j = 0; j < 4; ++j) { v[j] = v[j] - mean; s2 += (v[j].x * v[j].x + v[j].y * v[j].y) + (v[j].z * v[j].z + v[j].w * v[j].w); }
        const float rstd = 1.f / sqrtf(wave_sum(s2) * (1.f / D_MODEL) + LN_EPS);
#pragma unroll
        for (int j = 0; j < 4; ++j) { const f32x4 gg = *((const f32x4*)g2 + lane + 64 * j), bb = *((const f32x4*)b2 + lane + 64 * j);
            v[j] = v[j] * rstd * gg + bb;
            *((f32x4*)(xout + (size_t)m * D_MODEL) + lane + 64 * j) = v[j];
            u32x2 w; w.x = cvt_pk_bf16(v[j].x, v[j].y); w.y = cvt_pk_bf16(v[j].z, v[j].w); *((u32x2*)(XB + (size_t)m * D_MODEL) + lane + 64 * j) = w; }
    }
    if (l + 1 < DEPTH) { __syncthreads(); convert_weights(l + 1, lds); }
}

__global__ void __launch_bounds__(NWAVES * 64, 2) fwd(Args args) {
    extern __shared__ __attribute__((aligned(16))) unsigned char lds_raw[];
    LAS unsigned char* lds = (LAS unsigned char*)lds_raw;
    volatile LAS unsigned* MISC = (volatile LAS unsigned*)(lds + MISC_OFF);
    for (int u = threadIdx.x; u < (LDS_BYTES - LDSCTL_OFF) / 4; u += NWAVES * 64) ((LAS unsigned*)(lds + LDSCTL_OFF))[u] = 0u;
    __syncthreads();
    XcdBarrier bar; bar.bar = (unsigned*)(arg_ws() + WS_CTL) + CW_BAR; bar.x = 0; bar.st = nullptr;
    if (!MK_MULTI) bar = xcd_barrier_post((unsigned*)(arg_ws() + WS_CTL) + CW_BAR, MISC + 8);
    const int lo = arg_lo(), hi = arg_hi();
#define IN(k) (lo <= (k) && (k) < hi)
#define SEAM(k) do { if (!MK_MULTI && IN(k) && IN((k) + 1)) { XcdBarrier b2_ = bar; asm volatile("" : "+s"(b2_.bar)); xcd_barrier(b2_); } } while (0)
    if (HAS(0) && IN(0)) phase0(lds);
    SEAM(0);
    for (int l = 0; l < DEPTH; ++l) {
        const int pb = 1 + l * PH_PER_LAYER;
        if (HAS(1) && IN(pb + 0)) phase1(lds);
        SEAM(pb + 0);
        if (HAS(2) && IN(pb + 1)) phase2(lds, l);
        SEAM(pb + 1);
        if (HAS(3) && IN(pb + 2)) phase3(lds);
        SEAM(pb + 2);
        if (HAS(4) && IN(pb + 3)) phase4(lds, l);
        SEAM(pb + 3);
        if (HAS(5) && IN(pb + 4)) phase5(lds, l);
        SEAM(pb + 4);
        if (HAS(6) && IN(pb + 5)) phase6(lds, l);
        SEAM(pb + 5);
        if (HAS(7) && IN(pb + 6)) phase7(lds, l);
        SEAM(pb + 6);
        if (HAS(8) && IN(pb + 7)) phase8(lds, l);
        SEAM(pb + 7);
    }
#undef IN
#undef SEAM
    (void)args;
}

extern "C" void kernel_launch(void* const* d_in, const int* in_sizes, int n_in, void* d_out, int out_size, void* d_ws, size_t ws_size, hipStream_t stream) {
    static int grid = 0;
    if (grid == 0) {
        if (n_in != 15 || in_sizes[0] != T * D_MODEL || out_size != T * D_MODEL || ws_size < WS_END) {
            fprintf(stderr, "kernel_launch: unexpected shapes (n_in %d in0 %d out %d ws %zu; need ws >= %zu); nothing launched\n", n_in, n_in > 0 ? in_sizes[0] : -1, out_size, ws_size, (size_t)WS_END); grid = -1; return; }
        int dev = 0, cus = 0, per_cu = 0;
        if (hipGetDevice(&dev) != hipSuccess || hipDeviceGetAttribute(&cus, hipDeviceAttributeMultiprocessorCount, dev) != hipSuccess) { grid = -1; return; }
        if (hipFuncSetAttribute((const void*)fwd, hipFuncAttributeMaxDynamicSharedMemorySize, LDS_BYTES) != hipSuccess) { fprintf(stderr, "kernel_launch: hipFuncSetAttribute failed\n"); grid = -1; return; }
        if (hipOccupancyMaxActiveBlocksPerMultiprocessor(&per_cu, (const void*)fwd, NWAVES * 64, LDS_BYTES) != hipSuccess || per_cu < 1)
            fprintf(stderr, "kernel_launch: note: occupancy query reports %d workgroups per CU\n", per_cu);
        (void)hipGetLastError();
        grid = cus;
        if (grid != 256) fprintf(stderr, "kernel_launch: %d CUs; the attention deal needs 256\n", grid);
    }
    if (grid < 0) return;
    if (hipMemsetAsync((char*)d_ws + WS_CTL, 0, CTL_ZERO_BYTES, stream) != hipSuccess) { fprintf(stderr, "kernel_launch: memset failed\n"); return; }
    Args a{};
    for (int i = 0; i < 15; ++i) a.in[i] = (const float*)d_in[i];
    a.out = (float*)d_out; a.ws = (unsigned char*)d_ws;
#if MK_MULTI
    for (int p = 0; p < N_PHASES; ++p) { a.ph_lo = p; a.ph_hi = p + 1; hipLaunchKernelGGL(fwd, dim3(grid), dim3(NWAVES * 64), LDS_BYTES, stream, a); }
#else
    a.ph_lo = 0; a.ph_hi = N_PHASES;
    hipLaunchKernelGGL(fwd, dim3(grid), dim3(NWAVES * 64), LDS_BYTES, stream, a);
#endif
    const hipError_t le = hipPeekAtLastError();
    if (le != hipSuccess) fprintf(stderr, "kernel_launch: launch failed: %s\n", hipGetErrorName(le));
}
```

```cpp
#include <hip/hip_runtime.h>
#include <cstdio>
#include <cstdint>

#ifndef MK_MULTI
#define MK_MULTI 0
#endif

#ifndef PHASE_MASK
#define PHASE_MASK 0x1ff
#endif
#define HAS(k) ((PHASE_MASK >> (k)) & 1)
#define LAS __attribute__((address_space(3)))
#define GAS __attribute__((address_space(1)))
typedef unsigned short bf16_t;
typedef short bf16x8 __attribute__((ext_vector_type(8)));
typedef short s16x4 __attribute__((ext_vector_type(4)));
typedef float f32x4 __attribute__((ext_vector_type(4)));
typedef float f32x2 __attribute__((ext_vector_type(2)));
typedef float f32x16 __attribute__((ext_vector_type(16)));
typedef unsigned u32x4 __attribute__((ext_vector_type(4)));
typedef unsigned u32x2 __attribute__((ext_vector_type(2)));

constexpr int D_MODEL = 1024, BATCH = 8, SEQ = 4096, DEPTH = 4, T = BATCH * SEQ;
constexpr int NH = 8, HD = 64, WA = NH * HD;
constexpr int PROJ = 3 * WA + 3 * WA + 2 * D_MODEL;
constexpr int N_REL = 257, NE = 16, FE = 512;
constexpr float ALPHA = 1.681792830507429f;
constexpr float LN_EPS = 1e-5f;
constexpr float LOG2E = 1.4426950408889634f;
constexpr float C2 = 0.125f * LOG2E;

constexpr size_t MiB = 1u << 20;
constexpr size_t WS_CTL = 0, CTL_ZERO_BYTES = 1 * MiB;
constexpr size_t WS_RECW = 2 * MiB;
constexpr size_t WS_LIST = 4 * MiB;
constexpr size_t WS_WIN = 8 * MiB, WS_WUPA = 18 * MiB, WS_WUPB = 19 * MiB, WS_WOUT = 20 * MiB, WS_WGU = 22 * MiB, WS_WD = 54 * MiB;
constexpr size_t WS_XB = 72 * MiB;
constexpr size_t WS_QA = 136 * MiB, QKV_STRIDE = 32 * MiB;
constexpr size_t WS_GA = 328 * MiB, WS_GB = 392 * MiB;
constexpr size_t WS_PRE = 328 * MiB;
constexpr size_t WS_MERGED = 456 * MiB;
constexpr size_t WS_Y = 136 * MiB;
constexpr size_t WS_H = 456 * MiB;
constexpr size_t WS_END = 526 * MiB;
constexpr int CW_TMO = 0;
constexpr int CW_BAR = 4096;
constexpr int CW_CNT = 16384;

constexpr int RING_BYTES = 131072;
constexpr int LDSCTL_OFF = RING_BYTES, MISC_OFF = LDSCTL_OFF + 320;
constexpr int UTAB_OFF = LDSCTL_OFF + 1024;
constexpr int LDS_BYTES = 147456;

__device__ __forceinline__ unsigned cvt_pk_bf16(float lo, float hi) { unsigned r; asm volatile("v_cvt_pk_bf16_f32 %0, %1, %2" : "=v"(r) : "v"(lo), "v"(hi)); return r; }
__device__ __forceinline__ float bf_lo(unsigned w) { return __uint_as_float(w << 16); }
__device__ __forceinline__ float bf_hi(unsigned w) { return __uint_as_float(w & 0xffff0000u); }
__device__ __forceinline__ float fast_exp2(float x) { return __builtin_amdgcn_exp2f(x); }
__device__ __forceinline__ float fast_rcp(float x) { return __builtin_amdgcn_rcpf(x); }
__device__ __forceinline__ float sigmoidf_(float v) { return fast_rcp(1.0f + fast_exp2(-LOG2E * v)); }
__device__ __forceinline__ float wave_sum(float v) {
#pragma unroll
    for (int o = 1; o < 64; o <<= 1) v += __shfl_xor(v, o);
    return v;
}
#define LDS_WAIT() asm volatile("s_waitcnt lgkmcnt(0)" ::: "memory")
#define VM_WAIT() asm volatile("s_waitcnt vmcnt(0)" ::: "memory")

namespace pg8 {
constexpr int BM = 256, BK = 64, HALF = 128, HTB = HALF * BK * 2, STAGE_BYTES = 8 * HTB, NXCD = 8, WGM = 8;
__host__ __device__ __forceinline__ int lds_byte(int r, int c) { const int st = (r >> 4) * 2 + (c >> 5), rr = r & 15, cc = c & 31, ob = rr * 64 + cc * 2; return st * 1024 + (ob ^ (((ob >> 9) & 1) << 5)); }
__host__ __device__ __forceinline__ void stage_rc(int b, int& R, int& C) { const int st = b / 1024, sb = b % 1024, swz = sb ^ (((sb >> 9) & 1) << 5); R = (st >> 1) * 16 + swz / 64; C = (st & 1) * 32 + (swz % 64) / 2; }
__host__ __device__ __forceinline__ int perm32(int rho) { const int n = rho >> 4, i = rho & 15; return 8 * (i >> 2) + 4 * n + (i & 3); }

struct Unit { const char* A; const char* B; int pm, pn, x0, x1, x2; };

struct TileOrder {
    int nM, nN, nwg, G, c;
    __device__ __forceinline__ void init(int nM_, int nN_, int G_, int c_) { nM = nM_; nN = nN_; nwg = nM * nN; G = G_; c = c_; }
    __device__ __forceinline__ bool next(int i, int& pm, int& pn) const {
        const long L = (long)i * G + c; if (L >= nwg) return false;
        int wgid = (int)L; { const int q = nwg / NXCD, r = nwg % NXCD, xcd = wgid % NXCD, off = wgid / NXCD; wgid = (xcd < r ? xcd * (q + 1) : r * (q + 1) + (xcd - r) * q) + off; }
        const int nig = WGM * nN, gid = wgid / nig, fm = gid * WGM, gsz = (nM - fm) < WGM ? (nM - fm) : WGM;
        pm = fm + ((wgid % nig) % gsz); pn = (wgid % nig) / gsz; return true;
    }
};

template <class Epi, class Sched, bool GATHER, bool ALIGN_EPI>
__device__ __forceinline__ void gemm_phase(LAS unsigned char* lds, const int K, const Sched& S, const Epi& E) {
    int tid_ = threadIdx.x; asm volatile("" : "+v"(tid_));
    const int tid = tid_, wid = __builtin_amdgcn_readfirstlane(tid >> 6), lane = tid & 63, wr = wid >> 2, wc = wid & 3, fr = lane & 15, fq = lane >> 4;
    const int nt = K / BK;
    unsigned voffB[2]; int RA[2], CA2[2];
#pragma unroll
    for (int i = 0; i < 2; ++i) { int R, C; stage_rc(tid * 16 + i * 8192, R, C); const int Rb = Epi::PERM ? ((R & ~31) + perm32(R & 31)) : R;
        RA[i] = R; CA2[i] = C * 2; voffB[i] = (unsigned)(Rb * K + C) * 2u; }
    const size_t kstep = (size_t)(BK * 2);
    const size_t hstep = (size_t)HALF * K * 2;
    const unsigned ldsw = (unsigned)wid * 1024u;
    const int aoff = lds_byte(wr * 64 + fr, fq * 8), boff = lds_byte(wc * 32 + fr, fq * 8);
#define PG8_SA(b, h) (((b) * 2 + (h)) * HTB)
#define PG8_SB(b, h) ((4 + (b) * 2 + (h)) * HTB)
#define PG8_STAGE(bufoff, gbase, voff) do { _Pragma("unroll") for (int _i = 0; _i < 2; ++_i) \
        __builtin_amdgcn_global_load_lds((const unsigned*)((const char*)(gbase) + (voff)[_i]), (LAS unsigned*)(lds + (bufoff) + ldsw + _i * 8192), 16, 0, 0); } while (0)
#define PG8_LDA(dst, b, h) do { _Pragma("unroll") for (int m = 0; m < 4; ++m) _Pragma("unroll") for (int k = 0; k < 2; ++k) dst[m][k] = *(const LAS bf16x8*)(lds + PG8_SA(b, h) + aoff + m * 2048 + k * 1024); } while (0)
#define PG8_LDB(dst, b, h) do { _Pragma("unroll") for (int n = 0; n < 2; ++n) _Pragma("unroll") for (int k = 0; k < 2; ++k) dst[n][k] = *(const LAS bf16x8*)(lds + PG8_SB(b, h) + boff + n * 2048 + k * 1024); } while (0)
#define PG8_MMA(ai, bj, At, Bt) do { __builtin_amdgcn_s_setprio(1); _Pragma("unroll") for (int m = 0; m < 4; ++m) _Pragma("unroll") for (int n = 0; n < 2; ++n) _Pragma("unroll") for (int k = 0; k < 2; ++k) \
        acc[ai][bj][m][n] = __builtin_amdgcn_mfma_f32_16x16x32_bf16(Bt[n][k], At[m][k], acc[ai][bj][m][n], 0, 0, 0); __builtin_amdgcn_s_setprio(0); } while (0)
#define PG8_WAIT_V(n) asm volatile("s_waitcnt vmcnt(" #n ")" ::: "memory")
#define PG8_WAIT_L(n) asm volatile("s_waitcnt lgkmcnt(" #n ")" ::: "memory")
#define PG8_BAR __builtin_amdgcn_s_barrier()
#define PG8_SCHED __builtin_amdgcn_sched_barrier(0)
    Unit cur, nxt; int ui = 0;
    if (!S.next(0, cur)) return;
    unsigned oc0[2], oc1[2], on0[2], on1[2];
    if constexpr (GATHER) { S.offs(cur, RA, CA2, oc0, oc1); }
    else {
#pragma unroll
        for (int i = 0; i < 2; ++i) { oc0[i] = (unsigned)(RA[i] * K) * 2u + (unsigned)CA2[i]; oc1[i] = oc0[i]; on0[i] = oc0[i]; on1[i] = oc0[i]; } }
    const size_t ah = GATHER ? (size_t)0 : hstep;
    f32x4 acc[2][2][4][2];
#pragma unroll
    for (int a = 0; a < 2; ++a)
#pragma unroll
        for (int b = 0; b < 2; ++b)
#pragma unroll
            for (int m = 0; m < 4; ++m)
#pragma unroll
                for (int n = 0; n < 2; ++n) acc[a][b][m][n] = (f32x4){0.f, 0.f, 0.f, 0.f};
    bf16x8 At[4][2], B0[2][2], B1[2][2];
    const char* cA = cur.A; const char* cB = cur.B;
    PG8_STAGE(PG8_SB(0, 0), cB, voffB); PG8_STAGE(PG8_SB(0, 1), cB + hstep, voffB); PG8_STAGE(PG8_SA(0, 0), cA, oc0); PG8_STAGE(PG8_SA(0, 1), cA + ah, oc1);
    if (wr == 1) PG8_BAR;
    PG8_WAIT_V(2); PG8_BAR;
    PG8_STAGE(PG8_SB(1, 0), cB + kstep, voffB); PG8_STAGE(PG8_SA(1, 0), cA + kstep, oc0); PG8_STAGE(PG8_SB(1, 1), cB + hstep + kstep, voffB);
    PG8_WAIT_V(6); PG8_BAR;
    for (;;) {
        const bool has_next = S.next(ui + 1, nxt);
        const char* nA = has_next ? nxt.A : cA; const char* nB = has_next ? nxt.B : cB;
        if constexpr (GATHER) { if (has_next) S.offs(nxt, RA, CA2, on0, on1); else { on0[0] = oc0[0]; on0[1] = oc0[1]; on1[0] = oc1[0]; on1[1] = oc1[1]; } }
        for (int t = 0; t < nt; t += 2) {
            const bool last = (t == nt - 2);
            const char* a1 = cA + (size_t)(t + 1) * kstep;
            const char* a2 = last ? nA : cA + (size_t)(t + 2) * kstep; const char* b2 = last ? nB : cB + (size_t)(t + 2) * kstep;
            const char* a3 = a2 + kstep; const char* b3 = b2 + kstep;
            unsigned o20[2], o21[2];
            if constexpr (GATHER) { o20[0] = last ? on0[0] : oc0[0]; o20[1] = last ? on0[1] : oc0[1]; o21[0] = last ? on1[0] : oc1[0]; o21[1] = last ? on1[1] : oc1[1]; }
            else { o20[0] = oc0[0]; o20[1] = oc0[1]; o21[0] = oc0[0]; o21[1] = oc0[1]; }
            PG8_LDB(B0, 0, 0); PG8_LDB(B1, 0, 1); PG8_SCHED; PG8_LDA(At, 0, 0); PG8_STAGE(PG8_SA(1, 1), a1 + ah, oc1);
            PG8_WAIT_V(8); PG8_WAIT_L(0); PG8_BAR; PG8_MMA(0, 0, At, B0); PG8_MMA(0, 1, At, B1); PG8_BAR; PG8_SCHED;
            PG8_LDA(At, 0, 1); PG8_STAGE(PG8_SB(0, 0), b2, voffB); PG8_STAGE(PG8_SB(0, 1), b2 + hstep, voffB); PG8_STAGE(PG8_SA(0, 0), a2, o20);
            PG8_WAIT_V(8); PG8_WAIT_L(0); PG8_BAR; PG8_MMA(1, 0, At, B0); PG8_MMA(1, 1, At, B1); PG8_BAR; PG8_SCHED;
            PG8_LDB(B0, 1, 0); PG8_LDB(B1, 1, 1); PG8_SCHED; PG8_LDA(At, 1, 0); PG8_STAGE(PG8_SA(0, 1), a2 + ah, o21);
            PG8_WAIT_V(8); PG8_WAIT_L(0); PG8_BAR; PG8_MMA(0, 0, At, B0); PG8_MMA(0, 1, At, B1); PG8_BAR; PG8_SCHED;
            PG8_LDA(At, 1, 1); PG8_STAGE(PG8_SB(1, 0), b3, voffB); PG8_STAGE(PG8_SB(1, 1), b3 + hstep, voffB); PG8_STAGE(PG8_SA(1, 0), a3, o20);
            PG8_WAIT_V(8); PG8_WAIT_L(0); PG8_BAR; PG8_MMA(1, 0, At, B0); PG8_MMA(1, 1, At, B1); PG8_BAR; PG8_SCHED;
        }
        if constexpr (ALIGN_EPI) { if (wr == 0) PG8_BAR; }
        E(acc, cur, wr, wc, fr, fq);
        if (!has_next) break;
#pragma unroll
        for (int a = 0; a < 2; ++a)
#pragma unroll
            for (int b = 0; b < 2; ++b)
#pragma unroll
                for (int m = 0; m < 4; ++m)
#pragma unroll
                    for (int n = 0; n < 2; ++n) acc[a][b][m][n] = (f32x4){0.f, 0.f, 0.f, 0.f};
        cur = nxt; cA = nA; cB = nB; ++ui;
        if constexpr (GATHER) { oc0[0] = on0[0]; oc0[1] = on0[1]; oc1[0] = on1[0]; oc1[1] = on1[1]; }
        if constexpr (ALIGN_EPI) { if (wr == 1) PG8_BAR; }
    }
    PG8_WAIT_V(0);
    if constexpr (!ALIGN_EPI) { if (wr == 0) PG8_BAR; }
    PG8_BAR;
#undef PG8_SA
#undef PG8_SB
#undef PG8_STAGE
#undef PG8_LDA
#undef PG8_LDB
#undef PG8_MMA
#undef PG8_WAIT_V
#undef PG8_WAIT_L
#undef PG8_BAR
#undef PG8_SCHED
}

struct SchedPlain {
    TileOrder o; const char* A; const char* B; size_t tstep;
    __device__ __forceinline__ bool next(int i, Unit& u) const { int pm, pn; if (!o.next(i, pm, pn)) return false; u.pm = pm; u.pn = pn; u.x0 = 0; u.x1 = 0; u.x2 = 0; u.A = A + (size_t)pm * tstep; u.B = B + (size_t)pn * tstep; return true; }
};
struct SchedTwo {
    TileOrder o; const char* A0; const char* A1; const char* B0; const char* B1; size_t tstep;
    __device__ __forceinline__ bool next(int i, Unit& u) const { int pm, pn; if (!o.next(i >> 1, pm, pn)) return false; const int br = i & 1; u.pm = pm; u.pn = pn; u.x0 = br; u.x1 = 0; u.x2 = 0;
        u.A = (br ? A1 : A0) + (size_t)pm * tstep; u.B = (br ? B1 : B0) + (size_t)pn * tstep; return true; }
};
struct SchedMoe {
    const LAS int* utab; int nunits;
    const char* Abase; const char* Bbase; size_t a_row_bytes; size_t b_exp_bytes; size_t b_tile_bytes; const int* list; int gather_k2;
    __device__ __forceinline__ bool next(int i, Unit& u) const {
        if (i >= nunits) return false;
        const int e = utab[i * 5 + 0], pn = utab[i * 5 + 1], lo_ = utab[i * 5 + 2], nv = utab[i * 5 + 3], rb = utab[i * 5 + 4];
        u.pm = e; u.pn = pn; u.x0 = lo_; u.x1 = nv; u.x2 = rb;
        u.A = Abase + (size_t)rb * a_row_bytes; u.B = Bbase + (size_t)e * b_exp_bytes + (size_t)pn * b_tile_bytes; return true; }
    __device__ __forceinline__ void offs(const Unit& u, const int (&RA)[2], const int (&CA2)[2], unsigned (&o0)[2], unsigned (&o1)[2]) const {
        const int* lp = list + (size_t)u.pm * T + u.x0;
#pragma unroll
        for (int i = 0; i < 2; ++i) {
            int r0 = RA[i], r1 = RA[i] + HALF; r0 = r0 < u.x1 ? r0 : u.x1 - 1; r1 = r1 < u.x1 ? r1 : u.x1 - 1;
            const int t0 = lp[r0] >> 1, t1 = lp[r1] >> 1;
            o0[i] = (unsigned)t0 * (unsigned)gather_k2 + (unsigned)CA2[i]; o1[i] = (unsigned)t1 * (unsigned)gather_k2 + (unsigned)CA2[i]; }
    }
};
}

using pg8::Unit;
struct EpiInProj {
    static constexpr bool PERM = true;
    bf16_t* qkv; bf16_t* gates;
    __device__ __forceinline__ void operator()(const f32x4 (&acc)[2][2][4][2], const Unit& u, int wr, int wc, int fr, int fq) const {
        const int pn = u.pn; bf16_t* base; int ldc, colt; float sc = 1.f; const bool gate = pn >= 12;
        if (!gate) { const int piece = pn >> 1; base = qkv + (size_t)piece * (QKV_STRIDE / 2); ldc = WA; colt = (pn & 1) * 256; if (piece == 0 || piece == 3) sc = C2; }
        else { const int g = (pn - 12) >> 2; base = gates + (size_t)g * ((size_t)T * D_MODEL); ldc = D_MODEL; colt = ((pn - 12) & 3) * 256; }
        const int row0 = u.pm * 256 + wr * 64 + fr, col0 = colt + wc * 32 + 8 * fq;
#pragma unroll
        for (int ai = 0; ai < 2; ++ai)
#pragma unroll
            for (int m = 0; m < 4; ++m) { bf16_t* rowp = base + (size_t)(row0 + ai * 128 + m * 16) * ldc + col0;
#pragma unroll
                for (int bj = 0; bj < 2; ++bj) { f32x4 v0 = acc[ai][bj][m][0], v1 = acc[ai][bj][m][1];
                    if (gate) {
#pragma unroll
                        for (int i = 0; i < 4; ++i) { v0[i] = sigmoidf_(v0[i]); v1[i] = sigmoidf_(v1[i]); } }
                    else { v0 = v0 * sc; v1 = v1 * sc; }
                    u32x4 w; w.x = cvt_pk_bf16(v0[0], v0[1]); w.y = cvt_pk_bf16(v0[2], v0[3]); w.z = cvt_pk_bf16(v1[0], v1[1]); w.w = cvt_pk_bf16(v1[2], v1[3]);
                    *(u32x4*)(rowp + bj * 128) = w; } }
    }
};
struct EpiMerge {
    static constexpr bool PERM = true;
    const bf16_t* ga; const bf16_t* gb; bf16_t* merged;
    __device__ __forceinline__ void operator()(const f32x4 (&acc)[2][2][4][2], const Unit& u, int wr, int wc, int fr, int fq) const {
        const int br = u.x0; const bf16_t* g = br ? gb : ga;
        const int row0 = u.pm * 256 + wr * 64 + fr, col0 = u.pn * 256 + wc * 32 + 8 * fq;
#pragma unroll
        for (int ai = 0; ai < 2; ++ai)
#pragma unroll
            for (int m = 0; m < 4; ++m) { const size_t ro = (size_t)(row0 + ai * 128 + m * 16) * D_MODEL + col0;
#pragma unroll
                for (int bj = 0; bj < 2; ++bj) { const f32x4 a0 = acc[ai][bj][m][0], a1 = acc[ai][bj][m][1];
                    const u32x4 gw = *(const u32x4*)(g + ro + bj * 128);
                    float v[8];
                    v[0] = bf_lo(gw.x) * a0[0]; v[1] = bf_hi(gw.x) * a0[1]; v[2] = bf_lo(gw.y) * a0[2]; v[3] = bf_hi(gw.y) * a0[3];
                    v[4] = bf_lo(gw.z) * a1[0]; v[5] = bf_hi(gw.z) * a1[1]; v[6] = bf_lo(gw.w) * a1[2]; v[7] = bf_hi(gw.w) * a1[3];
                    if (br) { const u32x4 pw = *(const u32x4*)(merged + ro + bj * 128);
                        v[0] += bf_lo(pw.x); v[1] += bf_hi(pw.x); v[2] += bf_lo(pw.y); v[3] += bf_hi(pw.y); v[4] += bf_lo(pw.z); v[5] += bf_hi(pw.z); v[6] += bf_lo(pw.w); v[7] += bf_hi(pw.w); }
                    u32x4 w; w.x = cvt_pk_bf16(v[0], v[1]); w.y = cvt_pk_bf16(v[2], v[3]); w.z = cvt_pk_bf16(v[4], v[5]); w.w = cvt_pk_bf16(v[6], v[7]);
                    *(u32x4*)(merged + ro + bj * 128) = w; } }
    }
};
struct EpiOut {
    static constexpr bool PERM = false;
    const float* xin; float* pre;
    __device__ __forceinline__ void operator()(const f32x4 (&acc)[2][2][4][2], const Unit& u, int wr, int wc, int fr, int fq) const {
        const int row0 = u.pm * 256 + wr * 64 + fr, col0 = u.pn * 256 + wc * 32 + 4 * fq;
#pragma unroll
        for (int ai = 0; ai < 2; ++ai)
#pragma unroll
            for (int m = 0; m < 4; ++m) { const size_t ro = (size_t)(row0 + ai * 128 + m * 16) * D_MODEL + col0;
#pragma unroll
                for (int bj = 0; bj < 2; ++bj)
#pragma unroll
                    for (int n = 0; n < 2; ++n) { const f32x4 xv = *(const f32x4*)(xin + ro + bj * 128 + n * 16); *(f32x4*)(pre + ro + bj * 128 + n * 16) = xv * ALPHA + acc[ai][bj][m][n]; } }
    }
};
struct EpiGU {
    static constexpr bool PERM = true;
    bf16_t* h;
    __device__ __forceinline__ void operator()(const f32x4 (&acc)[2][2][4][2], const Unit& u, int wr, int wc, int fr, int fq) const {
        const int row0 = u.x2 + wr * 64 + fr, col0 = u.pn * 128 + wc * 32 + 8 * fq;
#pragma unroll
        for (int ai = 0; ai < 2; ++ai)
#pragma unroll
            for (int m = 0; m < 4; ++m) { bf16_t* rowp = h + (size_t)(row0 + ai * 128 + m * 16) * FE + col0; float v[8];
#pragma unroll
                for (int n = 0; n < 2; ++n)
#pragma unroll
                    for (int i = 0; i < 4; ++i) { const float g = acc[ai][0][m][n][i], uu = acc[ai][1][m][n][i]; v[n * 4 + i] = g * sigmoidf_(g) * uu; }
                u32x4 w; w.x = cvt_pk_bf16(v[0], v[1]); w.y = cvt_pk_bf16(v[2], v[3]); w.z = cvt_pk_bf16(v[4], v[5]); w.w = cvt_pk_bf16(v[6], v[7]);
                *(u32x4*)rowp = w; }
    }
};
struct EpiDown {
    static constexpr bool PERM = true;
    bf16_t* y; const int* list;
    __device__ __forceinline__ void operator()(const f32x4 (&acc)[2][2][4][2], const Unit& u, int wr, int wc, int fr, int fq) const {
        const int nv = u.x1, loff = u.x0;
        const int* lp = list + (size_t)u.pm * T + loff;
        const int col0 = u.pn * 256 + wc * 32 + 8 * fq;
#pragma unroll
        for (int ai = 0; ai < 2; ++ai)
#pragma unroll
            for (int m = 0; m < 4; ++m) { const int lr = ai * 128 + wr * 64 + m * 16 + fr;
                if (lr < nv) { const int entry = lp[lr]; bf16_t* rowp = y + (size_t)entry * D_MODEL + col0;
#pragma unroll
                    for (int bj = 0; bj < 2; ++bj) { const f32x4 v0 = acc[ai][bj][m][0], v1 = acc[ai][bj][m][1];
                        u32x4 w; w.x = cvt_pk_bf16(v0[0], v0[1]); w.y = cvt_pk_bf16(v0[2], v0[3]); w.z = cvt_pk_bf16(v1[0], v1[1]); w.w = cvt_pk_bf16(v1[2], v1[3]);
                        *(u32x4*)(rowp + bj * 128) = w; } } }
    }
};

namespace att {
constexpr int DM = WA;
constexpr int SLOTB = 8192;
constexpr int LDS_K = 0, LDS_V = 2 * SLOTB, LDS_WS = 4 * SLOTB, LDS_OST = LDS_WS + 8 * 256, LDS_TAB = LDS_OST + 8 * 4096, LDS_FLG = LDS_TAB + 1024, LDS_END = LDS_FLG + 64;
#define SBAR() __builtin_amdgcn_sched_barrier(0)
#define WAIT_BAR0() asm volatile("s_waitcnt vmcnt(0) lgkmcnt(0)\n\ts_barrier" ::: "memory")
__device__ __forceinline__ int crow(int r, int hi) { return (r & 3) + 8 * (r >> 2) + 4 * hi; }
__device__ __forceinline__ void glds16(const void* gsrc, unsigned lds_dst) { unsigned keep;
    asm volatile("s_mov_b32 %0, m0\n\ts_mov_b32 m0, %2\n\ts_nop 0\n\tglobal_load_lds_dwordx4 %1, off\n\ts_mov_b32 m0, %0" : "=&s"(keep) : "v"(gsrc), "s"(lds_dst) : "memory"); }
__device__ __forceinline__ float max3f(float a, float b, float c) { return __builtin_fmaxf(__builtin_fmaxf(a, b), c); }
__device__ __forceinline__ void qkt(f32x16& p0, f32x16& p1, const LAS char* Kslot, const bf16x8* qr, const f32x16& cin, int r32, int hi) {
    const LAS char* kb = Kslot + hi * 1024 + r32 * 16;
#pragma unroll
    for (int d0 = 0; d0 < 4; ++d0) {
        const bf16x8 b0 = *(const LAS bf16x8*)(kb + d0 * 2048);
        const bf16x8 b1 = *(const LAS bf16x8*)(kb + d0 * 2048 + 512);
        if (d0 == 0) { p0 = __builtin_amdgcn_mfma_f32_32x32x16_bf16(b0, qr[0], cin, 0, 0, 0); p1 = __builtin_amdgcn_mfma_f32_32x32x16_bf16(b1, qr[0], cin, 0, 0, 0); }
        else { p0 = __builtin_amdgcn_mfma_f32_32x32x16_bf16(b0, qr[d0], p0, 0, 0, 0); p1 = __builtin_amdgcn_mfma_f32_32x32x16_bf16(b1, qr[d0], p1, 0, 0, 0); } }
}
__device__ __forceinline__ float rowmax(const f32x16& p0, const f32x16& p1) {
    float a = max3f(p0[0], p0[1], p1[0]), b = max3f(p0[2], p0[3], p1[1]); a = max3f(a, p1[2], p1[3]);
#pragma unroll
    for (int r = 4; r < 16; r += 4) { a = max3f(a, p0[r], p0[r + 1]); b = max3f(b, p0[r + 2], p0[r + 3]); a = max3f(a, p1[r], p1[r + 1]); b = max3f(b, p1[r + 2], p1[r + 3]); }
    const float m = __builtin_fmaxf(a, b);
    auto rr = __builtin_amdgcn_permlane32_swap(__float_as_uint(m), __float_as_uint(m), false, false);
    return __builtin_fmaxf(__uint_as_float(rr[0]), __uint_as_float(rr[1]));
}
__device__ __forceinline__ void pv(f32x16* o, int vb, bf16x8 pa0, bf16x8 pa1, bf16x8 pa2, bf16x8 pa3) {
#pragma unroll
    for (int d0 = 0; d0 < 2; ++d0) { s16x4 lo[4], hi[4];
#pragma unroll
        for (int ks = 0; ks < 4; ++ks) {
            asm volatile("ds_read_b64_tr_b16 %0,%1 offset:%c2" : "=&v"(lo[ks]) : "v"(vb), "i"(d0 * 4096 + ks * 1024) : "memory");
            asm volatile("ds_read_b64_tr_b16 %0,%1 offset:%c2" : "=&v"(hi[ks]) : "v"(vb), "i"(d0 * 4096 + ks * 1024 + 512) : "memory"); }
        asm volatile("s_waitcnt lgkmcnt(0)" ::: "memory"); SBAR();
#define PK(k) (bf16x8){lo[k][0], lo[k][1], lo[k][2], lo[k][3], hi[k][0], hi[k][1], hi[k][2], hi[k][3]}
        o[d0] = __builtin_amdgcn_mfma_f32_32x32x16_bf16(pa0, PK(0), o[d0], 0, 0, 0);
        o[d0] = __builtin_amdgcn_mfma_f32_32x32x16_bf16(pa1, PK(1), o[d0], 0, 0, 0);
        o[d0] = __builtin_amdgcn_mfma_f32_32x32x16_bf16(pa2, PK(2), o[d0], 0, 0, 0);
        o[d0] = __builtin_amdgcn_mfma_f32_32x32x16_bf16(pa3, PK(3), o[d0], 0, 0, 0);
#undef PK
    }
}
#define PKW(P, B) cvt_pk_bf16(P[B], P[B + 1])
__device__ __forceinline__ void store_o(const f32x16* o, const float* rs, bf16_t* Ow, LAS char* shm, int wid, int lane, int r32, int hi) {
    LAS bf16_t* stg = (LAS bf16_t*)(shm + LDS_OST) + wid * 2048;
#pragma unroll
    for (int r = 0; r < 16; ++r) { const int orow = crow(r, hi);
#pragma unroll
        for (int d0 = 0; d0 < 2; ++d0) stg[orow * 64 + d0 * 32 + r32] = (bf16_t)(cvt_pk_bf16(o[d0][r] * rs[r], 0.f) & 0xffffu); }
    LDS_WAIT();
#pragma unroll
    for (int i = 0; i < 4; ++i) { const int row = i * 8 + (lane >> 3), ch = lane & 7; const u32x4 v = *(const LAS u32x4*)(stg + row * 64 + ch * 8); *(u32x4*)(Ow + (size_t)row * DM + ch * 8) = v; }
}

__device__ __forceinline__ void attn_a_unit(int b, int h, int u, const bf16_t* Q, const bf16_t* K, const bf16_t* V, bf16_t* O, const float* bias_h, LAS char* shm) {
    int tid_ = threadIdx.x; asm volatile("" : "+v"(tid_)); const int tid = tid_, lane = tid & 63, r32 = lane & 31, hi = lane >> 5; const int wid = __builtin_amdgcn_readfirstlane(tid >> 6);
    const long rowbase = (long)b * SEQ; const int q0 = u * 256;
    const bf16_t* Qw = Q + (rowbase + q0 + wid * 32) * DM + h * HD;
    const bf16_t* Kh = K + rowbase * DM + h * HD; const bf16_t* Vh = V + rowbase * DM + h * HD;
    const unsigned lds0 = (unsigned)(size_t)shm;
    LAS float* wsf = (LAS float*)(shm + LDS_WS) + wid * 64;
    LAS float* tab = (LAS float*)(shm + LDS_TAB);
    if (tid < 256) { int rel = tid - 64; rel = rel < -128 ? -128 : (rel > 128 ? 128 : rel); tab[tid] = bias_h[rel + 128] * LOG2E; }
    const float bfar = bias_h[256] * LOG2E;
    const bf16_t* ksrc = Kh + (long)lane * DM + wid * 8;
    const bf16_t* vsrc = Vh + (long)(16 * (wid & 3) + (lane >> 2)) * DM + (wid >> 2) * 32 + (lane & 3) * 8;
    const unsigned kdst = lds0 + LDS_K + wid * 1024, vdst = lds0 + LDS_V + wid * 1024;
#define DMA_K(t, slot) glds16(ksrc + (long)(t) * 64 * DM, (unsigned)__builtin_amdgcn_readfirstlane(kdst + (slot)))
#define DMA_V(t, slot) glds16(vsrc + (long)(t) * 64 * DM, (unsigned)__builtin_amdgcn_readfirstlane(vdst + (slot)))
    const int vb0 = (int)(lds0 + LDS_V) + ((lane >> 4) & 1) * 32 + (lane & 3) * 8 + (4 * hi + ((lane & 15) >> 2)) * 64;
    const int cw = 4 * u + (wid >> 1);
    const int jlo = (4 * u - 8) > 0 ? (4 * u - 8) : 0, jhi = 4 * u + 3;
    DMA_K(jlo, 0); DMA_V(jlo, 0);
    bf16x8 qr[4];
#pragma unroll
    for (int d0 = 0; d0 < 4; ++d0) qr[d0] = *(const bf16x8*)(Qw + (long)r32 * DM + d0 * 16 + hi * 8);
    float mhat = 0.f, l_reg = 0.f; f32x16 o[2]; o[0] = f32x16{}; o[1] = f32x16{};
    bool first = true;
    for (int j = jlo; j <= jhi; ++j) {
        const int sl = ((j - jlo) & 1) * SLOTB;
        WAIT_BAR0();
        if (j < jhi) { DMA_K(j + 1, sl ^ SLOTB); DMA_V(j + 1, sl ^ SLOTB); }
        if (j >= cw - 8 && j <= cw) {
            const bool far = (j <= cw - 3);
            f32x16 cin; const float c0 = (far ? bfar : 0.f) - mhat;
#pragma unroll
            for (int r = 0; r < 16; ++r) cin[r] = c0;
            f32x16 p0, p1;
            qkt(p0, p1, shm + LDS_K + sl, qr, cin, r32, hi);
            if (!far) {
                const LAS float* tp = tab + ((cw - j) * 64 + 32 * (wid & 1) + r32 + 64 - 4 * hi);
#pragma unroll
                for (int r = 0; r < 16; ++r) { const int kv = (r & 3) + 8 * (r >> 2); p0[r] += tp[-kv]; p1[r] += tp[-kv - 32]; }
            }
            const float rm = rowmax(p0, p1);
            bool upd; float dl;
            if (first) { upd = true; dl = rm; } else { upd = __any(rm > 8.f) != 0; dl = __builtin_fmaxf(rm, 0.f); }
            if (upd) {
                mhat += dl;
#pragma unroll
                for (int r = 0; r < 16; ++r) { p0[r] -= dl; p1[r] -= dl; }
                if (!first) { const float f = fast_exp2(-dl); l_reg *= f; if (hi == 0) wsf[r32] = f; LDS_WAIT();
#pragma unroll
                    for (int r = 0; r < 16; ++r) { const float fr_ = wsf[crow(r, hi)]; o[0][r] *= fr_; o[1][r] *= fr_; } }
            }
            first = false;
            float sacc = 0.f;
#pragma unroll
            for (int r = 0; r < 16; ++r) { p0[r] = fast_exp2(p0[r]); p1[r] = fast_exp2(p1[r]); sacc += p0[r] + p1[r]; }
            l_reg += sacc;
            u32x4 pw0 = (u32x4){PKW(p0, 0), PKW(p0, 2), PKW(p0, 4), PKW(p0, 6)}, pw1 = (u32x4){PKW(p0, 8), PKW(p0, 10), PKW(p0, 12), PKW(p0, 14)};
            u32x4 pw2 = (u32x4){PKW(p1, 0), PKW(p1, 2), PKW(p1, 4), PKW(p1, 6)}, pw3 = (u32x4){PKW(p1, 8), PKW(p1, 10), PKW(p1, 12), PKW(p1, 14)};
            pv(o, vb0 + sl, __builtin_bit_cast(bf16x8, pw0), __builtin_bit_cast(bf16x8, pw1), __builtin_bit_cast(bf16x8, pw2), __builtin_bit_cast(bf16x8, pw3));
        }
    }
    { auto rr = __builtin_amdgcn_permlane32_swap(__float_as_uint(l_reg), __float_as_uint(l_reg), false, false); l_reg = __uint_as_float(rr[0]) + __uint_as_float(rr[1]); }
    if (hi == 0) wsf[32 + r32] = l_reg; LDS_WAIT();
    float rli[16];
#pragma unroll
    for (int r = 0; r < 16; ++r) rli[r] = fast_rcp(wsf[32 + crow(r, hi)]);
    store_o(o, rli, O + (rowbase + q0 + wid * 32) * DM + h * HD, shm, wid, lane, r32, hi);
    asm volatile("s_waitcnt lgkmcnt(0)\n\ts_barrier" ::: "memory");
#undef DMA_K
#undef DMA_V
}

__device__ __forceinline__ void attn_b_unit(int b, int h, int qb, const bf16_t* Q, const bf16_t* K, const bf16_t* V, bf16_t* O, LAS char* shm) {
    int tid_ = threadIdx.x; asm volatile("" : "+v"(tid_)); const int tid = tid_, lane = tid & 63, r32 = lane & 31, hi = lane >> 5; const int wid = __builtin_amdgcn_readfirstlane(tid >> 6);
    const long rowbase = (long)b * SEQ; const int q0 = qb * 256;
    const bf16_t* Qw = Q + (rowbase + q0 + wid * 32) * DM + h * HD;
    const bf16_t* Kh = K + rowbase * DM + h * HD; const bf16_t* Vh = V + rowbase * DM + h * HD;
    const unsigned lds0 = (unsigned)(size_t)shm;
    LAS unsigned* flg = (LAS unsigned*)(shm + LDS_FLG);
    const bf16_t* ksrc = Kh + (long)lane * DM + wid * 8;
    const bf16_t* vsrc = Vh + (long)(16 * (wid & 3) + (lane >> 2)) * DM + (wid >> 2) * 32 + (lane & 3) * 8;
    const unsigned kdst = lds0 + LDS_K + wid * 1024, vdst = lds0 + LDS_V + wid * 1024;
#define DMA_K(t, slot) glds16(ksrc + (long)(t) * 64 * DM, (unsigned)__builtin_amdgcn_readfirstlane(kdst + (slot)))
#define DMA_V(t, slot) glds16(vsrc + (long)(t) * 64 * DM, (unsigned)__builtin_amdgcn_readfirstlane(vdst + (slot)))
    const int vb0 = (int)(lds0 + LDS_V) + ((lane >> 4) & 1) * 32 + (lane & 3) * 8 + (4 * hi + ((lane & 15) >> 2)) * 64;
    const int jtop = 4 * qb + 3, jd = 4 * qb + (wid >> 1);
    const int tq = 32 * (wid & 1) + r32;
    DMA_K(jtop, 0); DMA_V(jtop, 0);
    bf16x8 qr[4];
#pragma unroll
    for (int d0 = 0; d0 < 4; ++d0) qr[d0] = *(const bf16x8*)(Qw + (long)r32 * DM + d0 * 16 + hi * 8);
    float R = 1.0f; bool wdone = false; f32x16 o[2]; o[0] = f32x16{}; o[1] = f32x16{};
    for (int j = jtop, it = 0; j >= 0; --j, ++it) {
        const int sl = (it & 1) * SLOTB;
        WAIT_BAR0();
        if (it > 0) { const LAS unsigned* f = flg + ((it - 1) & 1) * 8; unsigned all = 1u;
#pragma unroll
            for (int w = 0; w < 8; ++w) all &= f[w];
            if (__builtin_amdgcn_readfirstlane(all) != 0u) break; }
        if (j > 0) { DMA_K(j - 1, sl ^ SLOTB); DMA_V(j - 1, sl ^ SLOTB); }
        if (j <= jd && !wdone) {
            f32x16 cin = f32x16{}; f32x16 p0, p1;
            qkt(p0, p1, shm + LDS_K + sl, qr, cin, r32, hi);
#pragma unroll
            for (int r = 0; r < 16; ++r) { p0[r] = fast_rcp(1.0f + fast_exp2(p0[r])); p1[r] = fast_rcp(1.0f + fast_exp2(p1[r])); }
            if (j == jd) {
#pragma unroll
                for (int r = 0; r < 16; ++r) { const int kv = crow(r, hi); if (kv >= tq) p0[r] = 1.0f; if (kv + 32 >= tq) p1[r] = 1.0f; } }
            float W[8], part[8];
#pragma unroll
            for (int i = 0; i < 8; ++i) { const float pb = (i < 4) ? (p0[4 * i] * p0[4 * i + 1]) * (p0[4 * i + 2] * p0[4 * i + 3]) : (p1[4 * i - 16] * p1[4 * i - 15]) * (p1[4 * i - 14] * p1[4 * i - 13]);
                auto rr = __builtin_amdgcn_permlane32_swap(__float_as_uint(pb), __float_as_uint(pb), false, false);
                const float vlo = __uint_as_float(rr[0]), vhi = __uint_as_float(rr[1]);
                W[i] = vlo * vhi; part[i] = hi ? 1.0f : vhi; }
            float sw = R;
#pragma unroll
            for (int i = 7; i >= 0; --i) { float c = sw * part[i];
                if (i < 4) {
#pragma unroll
                    for (int rr_ = 3; rr_ >= 0; --rr_) { const float t_ = c * p0[4 * i + rr_]; p0[4 * i + rr_] = c - t_; c = t_; } }
                else {
#pragma unroll
                    for (int rr_ = 3; rr_ >= 0; --rr_) { const float t_ = c * p1[4 * i - 16 + rr_]; p1[4 * i - 16 + rr_] = c - t_; c = t_; } }
                sw *= W[i]; }
            R = sw;
            u32x4 pw0 = (u32x4){PKW(p0, 0), PKW(p0, 2), PKW(p0, 4), PKW(p0, 6)}, pw1 = (u32x4){PKW(p0, 8), PKW(p0, 10), PKW(p0, 12), PKW(p0, 14)};
            u32x4 pw2 = (u32x4){PKW(p1, 0), PKW(p1, 2), PKW(p1, 4), PKW(p1, 6)}, pw3 = (u32x4){PKW(p1, 8), PKW(p1, 10), PKW(p1, 12), PKW(p1, 14)};
            pv(o, vb0 + sl, __builtin_bit_cast(bf16x8, pw0), __builtin_bit_cast(bf16x8, pw1), __builtin_bit_cast(bf16x8, pw2), __builtin_bit_cast(bf16x8, pw3));
            wdone = __all(R == 0.0f) != 0;
        }
        if (lane == 0) flg[(it & 1) * 8 + wid] = wdone ? 1u : 0u;
    }
    float ones[16];
#pragma unroll
    for (int r = 0; r < 16; ++r) ones[r] = 1.0f;
    store_o(o, ones, O + (rowbase + q0 + wid * 32) * DM + h * HD, shm, wid, lane, r32, hi);
    asm volatile("s_waitcnt lgkmcnt(0)\n\ts_barrier" ::: "memory");
#undef DMA_K
#undef DMA_V
}
#undef PKW
#undef SBAR
#undef WAIT_BAR0
}

#define XB_TMO      128
#define XB_XCNT(j)  (256  + 64 * (j))
#define XB_XSUB(j)  (1280 + 64 * (j))
#define XB_XGEN(j)  (2304 + 64 * (j))
#define XB_TOP      3328
#define XB_TOPGEN   3392
#define XCD_BAR_WORDS 3456
#define XB_SPIN_CAP (1u << 22)
__device__ __forceinline__ unsigned xb_ld(unsigned* p)              { return __hip_atomic_load(p, __ATOMIC_RELAXED, __HIP_MEMORY_SCOPE_AGENT); }
__device__ __forceinline__ unsigned xb_add(unsigned* p, unsigned v) { return __hip_atomic_fetch_add(p, v, __ATOMIC_RELAXED, __HIP_MEMORY_SCOPE_AGENT); }
__device__ __forceinline__ unsigned xb_xcc_id() { return (unsigned)__builtin_amdgcn_s_getreg((3 << 11) | 20) & 0xFu; }
#define XB_SPIN(cond, bar) do { unsigned _sp = 0; while (cond) { __builtin_amdgcn_s_sleep(1); \
    if ((++_sp & 255u) == 0u) { if (xb_ld(&(bar)[XB_TMO])) break; if (_sp > XB_SPIN_CAP) { atomicAdd(&(bar)[XB_TMO], 1u); break; } } } } while (0)
struct XcdBarrier { unsigned* bar; unsigned x; volatile LAS unsigned* st; };
__device__ __forceinline__ XcdBarrier xcd_barrier_post(unsigned* bar, volatile LAS unsigned* st) {
    XcdBarrier b; b.bar = bar; b.x = xb_xcc_id(); b.st = st;
    if (threadIdx.x == 0) (void)xb_add(&bar[XB_XCNT(b.x)], 1u);
    return b;
}
__device__ __forceinline__ void xcd_barrier_complete(unsigned* bar, unsigned x, unsigned& nloc, unsigned& nx) {
    const unsigned G = gridDim.x * gridDim.y * gridDim.z;
    unsigned sum, cnt, mine, sp = 0u;
    for (;;) {
        sum = 0u; cnt = 0u; mine = 0u;
#pragma unroll
        for (unsigned j = 0; j < 16; ++j) { const unsigned c = xb_ld(&bar[XB_XCNT(j)]); sum += c; cnt += (c > 0u) ? 1u : 0u; mine = (j == x) ? c : mine; }
        if (sum == G) break;
        __builtin_amdgcn_s_sleep(1);
        if ((++sp & 255u) == 0u) { if (xb_ld(&bar[XB_TMO])) break; if (sp > XB_SPIN_CAP) { atomicAdd(&bar[XB_TMO], 1u); break; } }
    }
    nloc = mine > 0u ? mine : 1u; nx = cnt > 0u ? cnt : 1u;
}
__device__ __forceinline__ void xcd_barrier(const XcdBarrier& b) {
    asm volatile("s_waitcnt vmcnt(0)" ::: "memory");
    __syncthreads();
    if (threadIdx.x == 0) {
        unsigned* bar = b.bar;
        __builtin_amdgcn_s_waitcnt(0);
        unsigned nloc = b.st[0], nx = b.st[1];
        if (nloc == 0u) { xcd_barrier_complete(bar, b.x, nloc, nx); b.st[0] = nloc; b.st[1] = nx; }
        const unsigned old = xb_add(&bar[XB_XSUB(b.x)], 1u);
        const unsigned gen = old / nloc;
        if (old + 1u == (gen + 1u) * nloc) {
            __builtin_amdgcn_fence(__ATOMIC_RELEASE, "agent");
            asm volatile("s_waitcnt vmcnt(0)" ::: "memory");
            const unsigned og = xb_add(&bar[XB_TOP], 1u);
            const unsigned tg = og / nx;
            if (og + 1u == (tg + 1u) * nx) xb_add(&bar[XB_TOPGEN], 1u);
            else XB_SPIN(xb_ld(&bar[XB_TOPGEN]) == tg, bar);
            __builtin_amdgcn_fence(__ATOMIC_ACQUIRE, "agent");
            xb_add(&bar[XB_XGEN(b.x)], 1u);
            asm volatile("s_waitcnt vmcnt(0)" ::: "memory");
        } else {
            XB_SPIN(xb_ld(&bar[XB_XGEN(b.x)]) == gen, bar);
            __builtin_amdgcn_fence(__ATOMIC_ACQUIRE, "agent");
            asm volatile("s_waitcnt vmcnt(0)" ::: "memory");
        }
    }
    __syncthreads();
}

__device__ __forceinline__ unsigned f2bf(float f) { unsigned u = __builtin_bit_cast(unsigned, f); return (u + 0x7fffu + ((u >> 16) & 1u)) >> 16; }
__device__ __forceinline__ unsigned pk2(float lo, float hi) { return f2bf(lo) | (f2bf(hi) << 16); }
__device__ __forceinline__ void transpose_item(const float* W, int K, int N, bf16_t* WT, int row_off, LAS float* scr, int item, int lane) {
    const int nblk = N / 32, kb = item / nblk, nb = item % nblk, k0 = 64 * kb, n0 = 32 * nb;
#pragma unroll 8
    for (int i = 0; i < 32; ++i) { const int kk = 2 * i + (lane >> 5); scr[kk * 33 + (lane & 31)] = W[(size_t)(k0 + kk) * N + n0 + (lane & 31)]; }
    LDS_WAIT(); asm volatile("" ::: "memory");
    const int c = lane & 7;
#pragma unroll
    for (int j = 0; j < 4; ++j) { const int n = (lane >> 3) + 8 * j; const LAS float* s = scr + (8 * c) * 33 + n;
        u32x4 o; o.x = pk2(s[0 * 33], s[1 * 33]); o.y = pk2(s[2 * 33], s[3 * 33]); o.z = pk2(s[4 * 33], s[5 * 33]); o.w = pk2(s[6 * 33], s[7 * 33]);
        *(u32x4*)(WT + (size_t)(row_off + n0 + n) * K + k0 + 8 * c) = o; }
    LDS_WAIT(); asm volatile("" ::: "memory");
}

struct Args { const float* in[15]; float* out; unsigned char* ws; int ph_lo, ph_hi; };
typedef const __attribute__((address_space(4))) char* kptr_t;
__device__ __forceinline__ kptr_t kbase() { kptr_t kp = (kptr_t)__builtin_amdgcn_kernarg_segment_ptr(); asm volatile("" : "+s"(kp)); return kp; }
__device__ __forceinline__ const float* arg_in(int i) { return *(const float* const __attribute__((address_space(4)))*)(kbase() + 8 * i); }
__device__ __forceinline__ float* arg_out() { return *(float* const __attribute__((address_space(4)))*)(kbase() + 120); }
__device__ __forceinline__ unsigned char* arg_ws() { return *(unsigned char* const __attribute__((address_space(4)))*)(kbase() + 128); }
__device__ __forceinline__ int arg_lo() { return *(const __attribute__((address_space(4))) int*)(kbase() + 136); }
__device__ __forceinline__ int arg_hi() { return *(const __attribute__((address_space(4))) int*)(kbase() + 140); }
static_assert(sizeof(Args) == 144, "Args layout");

constexpr int NWAVES = 8;
constexpr int PH_PER_LAYER = 8, N_PHASES = 1 + DEPTH * PH_PER_LAYER;
#define PH_COMMON() int tid_ = threadIdx.x; asm volatile("" : "+v"(tid_)); const int tid = tid_, lane = tid & 63, wave = __builtin_amdgcn_readfirstlane(tid >> 6); const int G = gridDim.x, bx = blockIdx.x; \
    const int vcu = (G % 8 == 0) ? (bx % 8) * (G / 8) + bx / 8 : bx; const int gw = vcu * NWAVES + wave, NGW = G * NWAVES; unsigned char* ws = arg_ws(); \
    (void)tid; (void)lane; (void)wave; (void)vcu; (void)gw; (void)NGW; (void)ws

__device__ __forceinline__ void convert_weights(int l, LAS unsigned char* lds) {
    PH_COMMON();
    LAS float* scr = (LAS float*)(lds + wave * 16384);
    const float* w_in = arg_in(1) + (size_t)l * D_MODEL * PROJ;
    const float* w_upa = arg_in(3) + (size_t)l * WA * D_MODEL;
    const float* w_upb = arg_in(4) + (size_t)l * WA * D_MODEL;
    const float* w_out = arg_in(5) + (size_t)l * D_MODEL * D_MODEL;
    const float* w_gate = arg_in(10) + (size_t)l * NE * D_MODEL * FE;
    const float* w_up = arg_in(11) + (size_t)l * NE * D_MODEL * FE;
    const float* w_down = arg_in(12) + (size_t)l * NE * FE * D_MODEL;
    constexpr int I_IN = (D_MODEL / 64) * (PROJ / 32), I_UP = (WA / 64) * (D_MODEL / 32), I_OUT = (D_MODEL / 64) * (D_MODEL / 32);
    constexpr int I_G = (D_MODEL / 64) * (FE / 32), I_D = (FE / 64) * (D_MODEL / 32);
    constexpr int NITEMS = I_IN + 2 * I_UP + I_OUT + NE * (2 * I_G + I_D);
    for (int it = gw; it < NITEMS; it += NGW) {
        int r = it;
        if (r < I_IN) { transpose_item(w_in, D_MODEL, PROJ, (bf16_t*)(ws + WS_WIN), 0, scr, r, lane); continue; } r -= I_IN;
        if (r < I_UP) { transpose_item(w_upa, WA, D_MODEL, (bf16_t*)(ws + WS_WUPA), 0, scr, r, lane); continue; } r -= I_UP;
        if (r < I_UP) { transpose_item(w_upb, WA, D_MODEL, (bf16_t*)(ws + WS_WUPB), 0, scr, r, lane); continue; } r -= I_UP;
        if (r < I_OUT) { transpose_item(w_out, D_MODEL, D_MODEL, (bf16_t*)(ws + WS_WOUT), 0, scr, r, lane); continue; } r -= I_OUT;
        const int e = r / (2 * I_G + I_D); r -= e * (2 * I_G + I_D);
        if (r < 2 * I_G) { const int up = r >= I_G; if (up) r -= I_G;
            const int nb = r % (FE / 32), n0 = nb * 32;
            const int row_off = e * 1024 + (n0 / 128) * 128 + (up ? 128 : 0);
            transpose_item((up ? w_up : w_gate) + (size_t)e * D_MODEL * FE, D_MODEL, FE, (bf16_t*)(ws + WS_WGU), row_off, scr, r, lane); continue; }
        r -= 2 * I_G;
        transpose_item(w_down + (size_t)e * FE * D_MODEL, FE, D_MODEL, (bf16_t*)(ws + WS_WD), e * 1024, scr, r, lane);
    }
}

__device__ __forceinline__ void phase0(LAS unsigned char* lds) {
    convert_weights(0, lds);
    PH_COMMON();
    const float* x_in = arg_in(0); bf16_t* XB = (bf16_t*)(ws + WS_XB);
    for (int m = gw; m < T; m += NGW) { const f32x4* xr = (const f32x4*)(x_in + (size_t)m * D_MODEL) + lane; u32x2* o8 = (u32x2*)(XB + (size_t)m * D_MODEL) + lane;
#pragma unroll
        for (int j = 0; j < 4; ++j) { const f32x4 v = xr[64 * j]; u32x2 w; w.x = cvt_pk_bf16(v.x, v.y); w.y = cvt_pk_bf16(v.z, v.w); o8[64 * j] = w; } }
}
__device__ __forceinline__ void phase1(LAS unsigned char* lds) {
    PH_COMMON();
    pg8::SchedPlain S; S.o.init(T / 256, PROJ / 256, G, bx); S.A = (const char*)(ws + WS_XB); S.B = (const char*)(ws + WS_WIN); S.tstep = (size_t)256 * D_MODEL * 2;
    EpiInProj E{(bf16_t*)(ws + WS_QA), (bf16_t*)(ws + WS_GA)};
    pg8::gemm_phase<EpiInProj, pg8::SchedPlain, false, true>(lds, D_MODEL, S, E);
}
__device__ __forceinline__ void phase2(LAS unsigned char* lds, int l) {
    PH_COMMON();
    const int bh = vcu >> 2, s = vcu & 3; const int b = bh >> 3, h = bh & 7;
    if (G != 256) return;
    bf16_t* QKV = (bf16_t*)(ws + WS_QA);
    const float* bias_h = arg_in(2) + ((size_t)l * NH + h) * N_REL;
    bf16_t* QAp = QKV; bf16_t* KAp = QKV + (QKV_STRIDE / 2); bf16_t* VAp = QKV + 2 * (QKV_STRIDE / 2);
    bf16_t* QBp = QKV + 3 * (QKV_STRIDE / 2); bf16_t* KBp = QKV + 4 * (QKV_STRIDE / 2); bf16_t* VBp = QKV + 5 * (QKV_STRIDE / 2);
    for (int i = 0; i < 4; ++i) { const int u = (i == 0) ? s : (i == 1) ? 7 - s : (i == 2) ? 8 + s : 15 - s; att::attn_a_unit(b, h, u, QAp, KAp, VAp, QAp, bias_h, (LAS char*)lds); }
    for (int i = 0; i < 4; ++i) { const int u = (i == 0) ? s : (i == 1) ? 7 - s : (i == 2) ? 8 + s : 15 - s; att::attn_b_unit(b, h, u, QBp, KBp, VBp, QBp, (LAS char*)lds); }
}
__device__ __forceinline__ void phase3(LAS unsigned char* lds) {
    PH_COMMON();
    bf16_t* QKV = (bf16_t*)(ws + WS_QA);
    pg8::SchedTwo S; S.o.init(T / 256, D_MODEL / 256, G, bx); S.A0 = (const char*)QKV; S.A1 = (const char*)(QKV + 3 * (QKV_STRIDE / 2));
    S.B0 = (const char*)(ws + WS_WUPA); S.B1 = (const char*)(ws + WS_WUPB); S.tstep = (size_t)256 * WA * 2;
    EpiMerge E{(const bf16_t*)(ws + WS_GA), (const bf16_t*)(ws + WS_GB), (bf16_t*)(ws + WS_MERGED)};
    pg8::gemm_phase<EpiMerge, pg8::SchedTwo, false, true>(lds, WA, S, E);
}
__device__ __forceinline__ void phase4(LAS unsigned char* lds, int l) {
    PH_COMMON();
    pg8::SchedPlain S; S.o.init(T / 256, D_MODEL / 256, G, bx); S.A = (const char*)(ws + WS_MERGED); S.B = (const char*)(ws + WS_WOUT); S.tstep = (size_t)256 * D_MODEL * 2;
    EpiOut E{(l == 0) ? arg_in(0) : (const float*)arg_out(), (float*)(ws + WS_PRE)};
    pg8::gemm_phase<EpiOut, pg8::SchedPlain, false, true>(lds, D_MODEL, S, E);
}
__device__ __forceinline__ void phase5(LAS unsigned char* lds, int l) {
    PH_COMMON();
    const float* g1 = arg_in(6) + (size_t)l * D_MODEL; const float* b1 = arg_in(7) + (size_t)l * D_MODEL;
    const float* w_router = arg_in(8); const float* b_router = arg_in(9);
    float* xout = arg_out(); bf16_t* XB = (bf16_t*)(ws + WS_XB); const float* PRE = (const float*)(ws + WS_PRE);
    int* LIST = (int*)(ws + WS_LIST); f32x2* RECW = (f32x2*)(ws + WS_RECW);
    unsigned* gcnt = (unsigned*)(ws + WS_CTL) + CW_CNT + 64 * l;
    for (int i = tid; i < D_MODEL * 4; i += NWAVES * 64) { const int c = i >> 2, q = i & 3; *(LAS f32x4*)(lds + c * 64 + (c >> 2) * 16 + q * 16) = *(const f32x4*)(w_router + c * 16 + q * 4); }
    LAS unsigned* lcnt = (LAS unsigned*)(lds + 81920);
    LAS int* lrec = (LAS int*)(lds + 81920 + 256);
    if (tid < 32) lcnt[tid] = 0u;
    __syncthreads();
    int krow = 0;
    for (int m = gw; m < T; m += NGW, ++krow) {
        const f32x4* pr = (const f32x4*)(PRE + (size_t)m * D_MODEL) + lane;
        f32x4 v[4]; float s = 0.f;
#pragma unroll
        for (int j = 0; j < 4; ++j) { v[j] = pr[64 * j]; s += (v[j].x + v[j].y) + (v[j].z + v[j].w); }
        const float mean = wave_sum(s) * (1.f / D_MODEL); float s2 = 0.f;
#pragma unroll
        for (int j = 0; j < 4; ++j) { v[j] = v[j] - mean; s2 += (v[j].x * v[j].x + v[j].y * v[j].y) + (v[j].z * v[j].z + v[j].w * v[j].w); }
        const float rstd = 1.f / sqrtf(wave_sum(s2) * (1.f / D_MODEL) + LN_EPS);
        float lg[16];
#pragma unroll
        for (int e = 0; e < 16; ++e) lg[e] = 0.f;
#pragma unroll
        for (int j = 0; j < 4; ++j) { const f32x4 gg = *((const f32x4*)g1 + lane + 64 * j), bb = *((const f32x4*)b1 + lane + 64 * j);
            v[j] = v[j] * rstd * gg + bb;
            *((f32x4*)(xout + (size_t)m * D_MODEL) + lane + 64 * j) = v[j];
            u32x2 w; w.x = cvt_pk_bf16(v[j].x, v[j].y); w.y = cvt_pk_bf16(v[j].z, v[j].w); *((u32x2*)(XB + (size_t)m * D_MODEL) + lane + 64 * j) = w;
#pragma unroll
            for (int i = 0; i < 4; ++i) { const int c = 4 * (lane + 64 * j) + i; const LAS f32x4* wp = (const LAS f32x4*)(lds + c * 64 + (c >> 2) * 16); const float xv = v[j][i];
#pragma unroll
                for (int q = 0; q < 4; ++q) { const f32x4 wv = wp[q]; lg[4 * q + 0] += xv * wv.x; lg[4 * q + 1] += xv * wv.y; lg[4 * q + 2] += xv * wv.z; lg[4 * q + 3] += xv * wv.w; } } }
#pragma unroll
        for (int e = 0; e < 16; ++e) lg[e] = wave_sum(lg[e]) + b_router[e];
        int best = 0; float bv = lg[0];
#pragma unroll
        for (int e = 1; e < 16; ++e) if (lg[e] > bv) { bv = lg[e]; best = e; }
        const int grp = best >> 2; int e2 = -1; float v2 = 0.f;
#pragma unroll
        for (int e = 0; e < 16; ++e) { if ((e >> 2) == grp && e != best) { if (e2 < 0 || lg[e] > v2) { v2 = lg[e]; e2 = e; } } }
        const float w1 = fast_rcp(1.0f + fast_exp2((v2 - bv) * LOG2E)), w2 = 1.0f - w1;
        if (lane == 0) { RECW[m] = (f32x2){w1, w2};
            const int lp1 = (int)__hip_atomic_fetch_add(lcnt + best, 1u, __ATOMIC_RELAXED, __HIP_MEMORY_SCOPE_WORKGROUP);
            const int lp2 = (int)__hip_atomic_fetch_add(lcnt + e2, 1u, __ATOMIC_RELAXED, __HIP_MEMORY_SCOPE_WORKGROUP);
            LAS int* rp = lrec + (wave * 16 + krow) * 4; rp[0] = best; rp[1] = lp1; rp[2] = e2; rp[3] = lp2; }
    }
    __syncthreads();
    if (tid < 16) { const unsigned n = lcnt[tid]; lcnt[16 + tid] = n ? __hip_atomic_fetch_add(gcnt + tid, n, __ATOMIC_RELAXED, __HIP_MEMORY_SCOPE_AGENT) : 0u; }
    __syncthreads();
    if (lane == 0) { int k2 = 0;
        for (int m = gw; m < T; m += NGW, ++k2) { const LAS int* rp = lrec + (wave * 16 + k2) * 4;
            LIST[(size_t)rp[0] * T + lcnt[16 + rp[0]] + rp[1]] = m * 2; LIST[(size_t)rp[2] * T + lcnt[16 + rp[2]] + rp[3]] = m * 2 + 1; } }
    __syncthreads();
}
__device__ __forceinline__ int moe_units(LAS unsigned char* lds, int l) {
    PH_COMMON();
    LAS int* utab = (LAS int*)(lds + UTAB_OFF);
    unsigned* gcnt = (unsigned*)(ws + WS_CTL) + CW_CNT + 64 * l;
    __syncthreads();
    if (tid == 0) {
        LAS int* ts = utab + 128; LAS int* ncnt = utab + 160;
        int acc_t = 0;
        for (int e = 0; e < 16; ++e) { const int n = (int)__hip_atomic_load(gcnt + e, __ATOMIC_RELAXED, __HIP_MEMORY_SCOPE_AGENT); ncnt[e] = n; ts[e] = acc_t; acc_t += (n + 255) / 256; }
        ts[16] = acc_t;
        const int nunits = acc_t * 4; int cnt = 0;
        for (int i = 0; cnt < 16; ++i) { const long L = (long)i * G + bx; if (L >= nunits) break;
            int U = (int)L; { const int q = nunits / 8, r = nunits % 8, xcd = U % 8, off = U / 8; U = (xcd < r ? xcd * (q + 1) : r * (q + 1) + (xcd - r) * q) + off; }
            const int tile = U >> 2, pn = U & 3; int e = 0; while (ts[e + 1] <= tile) ++e;
            const int mt = tile - ts[e]; const int n = ncnt[e]; const int nv = (n - 256 * mt) < 256 ? (n - 256 * mt) : 256;
            utab[cnt * 5 + 0] = e; utab[cnt * 5 + 1] = pn; utab[cnt * 5 + 2] = mt * 256; utab[cnt * 5 + 3] = nv; utab[cnt * 5 + 4] = tile * 256;
            ++cnt; }
        utab[192] = cnt;
    }
    __syncthreads();
    return utab[192];
}
__device__ __forceinline__ void phase6(LAS unsigned char* lds, int l) {
    const int nun = moe_units(lds, l);
    PH_COMMON();
    pg8::SchedMoe S; S.utab = (LAS int*)(lds + UTAB_OFF); S.nunits = nun; S.Abase = (const char*)(ws + WS_XB); S.Bbase = (const char*)(ws + WS_WGU); S.a_row_bytes = 0;
    S.b_exp_bytes = (size_t)1024 * D_MODEL * 2; S.b_tile_bytes = (size_t)256 * D_MODEL * 2; S.list = (const int*)(ws + WS_LIST); S.gather_k2 = D_MODEL * 2;
    EpiGU E{(bf16_t*)(ws + WS_H)};
    pg8::gemm_phase<EpiGU, pg8::SchedMoe, true, true>(lds, D_MODEL, S, E);
}
__device__ __forceinline__ void phase7(LAS unsigned char* lds, int l) {
    const int nun = moe_units(lds, l);
    PH_COMMON();
    pg8::SchedMoe S; S.utab = (LAS int*)(lds + UTAB_OFF); S.nunits = nun; S.Abase = (const char*)(ws + WS_H); S.Bbase = (const char*)(ws + WS_WD); S.a_row_bytes = (size_t)FE * 2;
    S.b_exp_bytes = (size_t)1024 * FE * 2; S.b_tile_bytes = (size_t)256 * FE * 2; S.list = (const int*)(ws + WS_LIST); S.gather_k2 = 0;
    EpiDown E{(bf16_t*)(ws + WS_Y), (const int*)(ws + WS_LIST)};
    pg8::gemm_phase<EpiDown, pg8::SchedMoe, false, true>(lds, FE, S, E);
}
__device__ __forceinline__ void phase8(LAS unsigned char* lds, int l) {
    PH_COMMON();
    const float* g2 = arg_in(13) + (size_t)l * D_MODEL; const float* b2 = arg_in(14) + (size_t)l * D_MODEL;
    float* xout = arg_out(); bf16_t* XB = (bf16_t*)(ws + WS_XB); const bf16_t* Y = (const bf16_t*)(ws + WS_Y); const f32x2* RECW = (const f32x2*)(ws + WS_RECW);
    for (int m = gw; m < T; m += NGW) {
        const f32x2 wv = RECW[m];
        const f32x4* xr = (const f32x4*)(xout + (size_t)m * D_MODEL) + lane;
        const u32x2* y0 = (const u32x2*)(Y + (size_t)(2 * m) * D_MODEL) + lane; const u32x2* y1 = (const u32x2*)(Y + (size_t)(2 * m + 1) * D_MODEL) + lane;
        f32x4 v[4]; float s = 0.f;
#pragma unroll
        for (int j = 0; j < 4; ++j) { const f32x4 xv = xr[64 * j]; const u32x2 a = y0[64 * j], c = y1[64 * j];
            v[j].x = xv.x * ALPHA + wv.x * bf_lo(a.x) + wv.y * bf_lo(c.x); v[j].y = xv.y * ALPHA + wv.x * bf_hi(a.x) + wv.y * bf_hi(c.x);
            v[j].z = xv.z * ALPHA + wv.x * bf_lo(a.y) + wv.y * bf_lo(c.y); v[j].w = xv.w * ALPHA + wv.x * bf_hi(a.y) + wv.y * bf_hi(c.y);
            s += (v[j].x + v[j].y) + (v[j].z + v[j].w); }
        const float mean = wave_sum(s) * (1.f / D_MODEL); float s2 = 0.f;
#pragma unroll
        for (int j = 0; j < 4; ++j) { v[j] = v[j] - mean; s2 += (v[j].x * v[j].x + v[j].y * v[j].y) + (v[j].z * v[j].z + v[j].w * v[j].w); }
        const float rstd = 1.f / sqrtf(wave_sum(s2) * (1.f / D_MODEL) + LN_EPS);
#pragma unroll
        for (int j = 0; j < 4; ++j) { const f32x4 gg = *((const f32x4*)g2 + lane + 64 * j), bb = *((const f32x4*)b2 + lane + 64 * j);
            v[j] = v[j] * rstd * gg + bb;
            *((f32x4*)(xout + (size_t)m * D_MODEL) + lane + 64 * j) = v[j];
            u32x2 w; w.x = cvt_pk_bf16(v[j].x, v[j].y); w.y = cvt_pk_bf16(v[j].z, v[j].w); *((u32x2*)(XB + (size_t)m * D_MODEL) + lane + 64 * j) = w; }
    }
    if (l + 1 < DEPTH) { __syncthreads(); convert_weights(l + 1, lds); }
}

__global__ void __launch_bounds__(NWAVES * 64, 2) fwd(Args args) {
    extern __shared__ __attribute__((aligned(16))) unsigned char lds_raw[];
    LAS unsigned char* lds = (LAS unsigned char*)lds_raw;
    volatile LAS unsigned* MISC = (volatile LAS unsigned*)(lds + MISC_OFF);
    for (int u = threadIdx.x; u < (LDS_BYTES - LDSCTL_OFF) / 4; u += NWAVES * 64) ((LAS unsigned*)(lds + LDSCTL_OFF))[u] = 0u;
    __syncthreads();
    XcdBarrier bar; bar.bar = (unsigned*)(arg_ws() + WS_CTL) + CW_BAR; bar.x = 0; bar.st = nullptr;
    if (!MK_MULTI) bar = xcd_barrier_post((unsigned*)(arg_ws() + WS_CTL) + CW_BAR, MISC + 8);
    const int lo = arg_lo(), hi = arg_hi();
#define IN(k) (lo <= (k) && (k) < hi)
#define SEAM(k) do { if (!MK_MULTI && IN(k) && IN((k) + 1)) { XcdBarrier b2_ = bar; asm volatile("" : "+s"(b2_.bar)); xcd_barrier(b2_); } } while (0)
    if (HAS(0) && IN(0)) phase0(lds);
    SEAM(0);
    for (int l = 0; l < DEPTH; ++l) {
        const int pb = 1 + l * PH_PER_LAYER;
        if (HAS(1) && IN(pb + 0)) phase1(lds);
        SEAM(pb + 0);
        if (HAS(2) && IN(pb + 1)) phase2(lds, l);
        SEAM(pb + 1);
        if (HAS(3) && IN(pb + 2)) phase3(lds);
        SEAM(pb + 2);
        if (HAS(4) && IN(pb + 3)) phase4(lds, l);
        SEAM(pb + 3);
        if (HAS(5) && IN(pb + 4)) phase5(lds, l);
        SEAM(pb + 4);
        if (HAS(6) && IN(pb + 5)) phase6(lds, l);
        SEAM(pb + 5);
        if (HAS(7) && IN(pb + 6)) phase7(lds, l);
        SEAM(pb + 6);
        if (HAS(8) && IN(pb + 7)) phase8(lds, l);
        SEAM(pb + 7);
    }
#undef IN
#undef SEAM
    (void)args;
}

extern "C" void kernel_launch(void* const* d_in, const int* in_sizes, int n_in, void* d_out, int out_size, void* d_ws, size_t ws_size, hipStream_t stream) {
    static int grid = 0;
    if (grid == 0) {
        if (n_in != 15 || in_sizes[0] != T * D_MODEL || out_size != T * D_MODEL || ws_size < WS_END) {
            fprintf(stderr, "kernel_launch: unexpected shapes (n_in %d in0 %d out %d ws %zu; need ws >= %zu); nothing launched\n", n_in, n_in > 0 ? in_sizes[0] : -1, out_size, ws_size, (size_t)WS_END); grid = -1; return; }
        int dev = 0, cus = 0, per_cu = 0;
        if (hipGetDevice(&dev) != hipSuccess || hipDeviceGetAttribute(&cus, hipDeviceAttributeMultiprocessorCount, dev) != hipSuccess) { grid = -1; return; }
        if (hipFuncSetAttribute((const void*)fwd, hipFuncAttributeMaxDynamicSharedMemorySize, LDS_BYTES) != hipSuccess) { fprintf(stderr, "kernel_launch: hipFuncSetAttribute failed\n"); grid = -1; return; }
        if (hipOccupancyMaxActiveBlocksPerMultiprocessor(&per_cu, (const void*)fwd, NWAVES * 64, LDS_BYTES) != hipSuccess || per_cu < 1)
            fprintf(stderr, "kernel_launch: note: occupancy query reports %d workgroups per CU\n", per_cu);
        (void)hipGetLastError();
        grid = cus;
        if (grid != 256) fprintf(stderr, "kernel_launch: %d CUs; the attention deal needs 256\n", grid);
    }
    if (grid < 0) return;
    if (hipMemsetAsync((char*)d_ws + WS_CTL, 0, CTL_ZERO_BYTES, stream) != hipSuccess) { fprintf(stderr, "kernel_launch: memset failed\n"); return; }
    Args a{};
    for (int i = 0; i < 15; ++i) a.in[i] = (const float*)d_in[i];
    a.out = (float*)d_out; a.ws = (unsigned char*)d_ws;
#if MK_MULTI
    for (int p = 0; p < N_PHASES; ++p) { a.ph_lo = p; a.ph_hi = p + 1; hipLaunchKernelGGL(fwd, dim3(grid), dim3(NWAVES * 64), LDS_BYTES, stream, a); }
#else
    a.ph_lo = 0; a.ph_hi = N_PHASES;
    hipLaunchKernelGGL(fwd, dim3(grid), dim3(NWAVES * 64), LDS_BYTES, stream, a);
#endif
    const hipError_t le = hipPeekAtLastError();
    if (le != hipSuccess) fprintf(stderr, "kernel_launch: launch failed: %s\n", hipGetErrorName(le));
}
```

```cpp
#include <hip/hip_runtime.h>
#include <cstdio>
#include <cstdint>

#ifndef MK_MULTI
#define MK_MULTI 0
#endif

#ifndef PROBE_PH
#define PROBE_PH (-1)
#endif
#ifndef PROBE_MULT
#define PROBE_MULT 1
#endif
#ifndef PHASE_MASK
#define PHASE_MASK 0x1ff
#endif
#define HAS(k) ((PHASE_MASK >> (k)) & 1)
#define LAS __attribute__((address_space(3)))
#define PBS_BEGIN(id, lds) do { if (PROBE_PH == 100 + (id) && threadIdx.x == 0) *(volatile LAS unsigned long long*)((lds) + MISC_OFF + 80) = __builtin_amdgcn_s_memrealtime(); } while (0)
#define PBS_END(id, lds) do { if (PROBE_PH == 100 + (id) && threadIdx.x == 0) { volatile LAS unsigned long long* p_ = (volatile LAS unsigned long long*)((lds) + MISC_OFF + 64); p_[0] = p_[0] + (__builtin_amdgcn_s_memrealtime() - p_[2]); } } while (0)
#define GAS __attribute__((address_space(1)))
typedef unsigned short bf16_t;
typedef short bf16x8 __attribute__((ext_vector_type(8)));
typedef short s16x4 __attribute__((ext_vector_type(4)));
typedef float f32x4 __attribute__((ext_vector_type(4)));
typedef float f32x2 __attribute__((ext_vector_type(2)));
typedef float f32x16 __attribute__((ext_vector_type(16)));
typedef unsigned u32x4 __attribute__((ext_vector_type(4)));
typedef unsigned u32x2 __attribute__((ext_vector_type(2)));

constexpr int D_MODEL = 1024, BATCH = 8, SEQ = 4096, DEPTH = 4, T = BATCH * SEQ;
constexpr int NH = 8, HD = 64, WA = NH * HD;
constexpr int PROJ = 3 * WA + 3 * WA + 2 * D_MODEL;
constexpr int N_REL = 257, NE = 16, FE = 512;
constexpr float ALPHA = 1.681792830507429f;
constexpr float LN_EPS = 1e-5f;
constexpr float LOG2E = 1.4426950408889634f;
constexpr float C2 = 0.125f * LOG2E;

constexpr size_t MiB = 1u << 20;
constexpr size_t WS_CTL = 0, CTL_ZERO_BYTES = 1 * MiB;
constexpr size_t WS_RECW = 2 * MiB;
constexpr size_t WS_LIST = 4 * MiB;
constexpr size_t WS_WIN = 8 * MiB, WS_WUPA = 18 * MiB, WS_WUPB = 19 * MiB, WS_WOUT = 20 * MiB, WS_WGU = 22 * MiB, WS_WD = 54 * MiB;
constexpr size_t WS_XB = 72 * MiB;
constexpr size_t WS_QA = 136 * MiB, QKV_STRIDE = 32 * MiB;
constexpr size_t WS_GA = 328 * MiB, WS_GB = 392 * MiB;
constexpr size_t WS_PRE = 328 * MiB;
constexpr size_t WS_MERGED = 456 * MiB;
constexpr size_t WS_Y = 136 * MiB;
constexpr size_t WS_H = 456 * MiB;
constexpr size_t WS_END = 526 * MiB;
constexpr int CW_TMO = 0;
constexpr int CW_BAR = 4096;
constexpr int CW_CNT = 32768;

constexpr int RING_BYTES = 131072;
constexpr int LDSCTL_OFF = RING_BYTES, MISC_OFF = LDSCTL_OFF + 320;
constexpr int UTAB_OFF = LDSCTL_OFF + 1024;
constexpr int LDS_BYTES = 147456;

__device__ __forceinline__ unsigned cvt_pk_bf16(float lo, float hi) { unsigned r; asm volatile("v_cvt_pk_bf16_f32 %0, %1, %2" : "=v"(r) : "v"(lo), "v"(hi)); return r; }
__device__ __forceinline__ float bf_lo(unsigned w) { return __uint_as_float(w << 16); }
__device__ __forceinline__ float bf_hi(unsigned w) { return __uint_as_float(w & 0xffff0000u); }
__device__ __forceinline__ float fast_exp2(float x) { return __builtin_amdgcn_exp2f(x); }
__device__ __forceinline__ float fast_rcp(float x) { return __builtin_amdgcn_rcpf(x); }
__device__ __forceinline__ float sigmoidf_(float v) { return fast_rcp(1.0f + fast_exp2(-LOG2E * v)); }
__device__ __forceinline__ float wave_sum(float v) {
#define DPP_ADD(ctrl, rmask) v += __builtin_bit_cast(float, __builtin_amdgcn_update_dpp(0, __builtin_bit_cast(int, v), ctrl, rmask, 0xf, false))
    DPP_ADD(0x111, 0xf); DPP_ADD(0x112, 0xf); DPP_ADD(0x114, 0xf); DPP_ADD(0x118, 0xf);
    DPP_ADD(0x142, 0xa); DPP_ADD(0x143, 0xc);
#undef DPP_ADD
    return __builtin_bit_cast(float, __builtin_amdgcn_readlane(__builtin_bit_cast(int, v), 63));
}
#define LDS_WAIT() asm volatile("s_waitcnt lgkmcnt(0)" ::: "memory")
#define VM_WAIT() asm volatile("s_waitcnt vmcnt(0)" ::: "memory")

namespace pg8 {
constexpr int BM = 256, BK = 64, HALF = 128, HTB = HALF * BK * 2, STAGE_BYTES = 8 * HTB, NXCD = 8, WGM = 8;
__host__ __device__ __forceinline__ int lds_byte(int r, int c) { const int st = (r >> 4) * 2 + (c >> 5), rr = r & 15, cc = c & 31, ob = rr * 64 + cc * 2; return st * 1024 + (ob ^ (((ob >> 9) & 1) << 5)); }
__host__ __device__ __forceinline__ void stage_rc(int b, int& R, int& C) { const int st = b / 1024, sb = b % 1024, swz = sb ^ (((sb >> 9) & 1) << 5); R = (st >> 1) * 16 + swz / 64; C = (st & 1) * 32 + (swz % 64) / 2; }
__host__ __device__ __forceinline__ int perm32(int rho) { const int n = rho >> 4, i = rho & 15; return 8 * (i >> 2) + 4 * n + (i & 3); }

struct Unit { const char* A; const char* B; int pm, pn, x0, x1, x2; };

struct TileOrder {
    int nM, nN, nwg, G, c;
    __device__ __forceinline__ void init(int nM_, int nN_, int G_, int c_) { nM = nM_; nN = nN_; nwg = nM * nN; G = G_; c = c_; }
    __device__ __forceinline__ bool next(int i, int& pm, int& pn) const {
        const long L = (long)i * G + c; if (L >= nwg) return false;
        int wgid = (int)L; { const int q = nwg / NXCD, r = nwg % NXCD, xcd = wgid % NXCD, off = wgid / NXCD; wgid = (xcd < r ? xcd * (q + 1) : r * (q + 1) + (xcd - r) * q) + off; }
        const int nig = WGM * nN, gid = wgid / nig, fm = gid * WGM, gsz = (nM - fm) < WGM ? (nM - fm) : WGM;
        pm = fm + ((wgid % nig) % gsz); pn = (wgid % nig) / gsz; return true;
    }
};

template <class Epi, class Sched, bool GATHER, bool ALIGN_EPI>
__device__ __forceinline__ void gemm_phase(LAS unsigned char* lds, const int K, const Sched& S, const Epi& E) {
    int tid_ = threadIdx.x; asm volatile("" : "+v"(tid_));
    const int tid = tid_, wid = __builtin_amdgcn_readfirstlane(tid >> 6), lane = tid & 63, wr = wid >> 2, wc = wid & 3, fr = lane & 15, fq = lane >> 4;
    const int nt = K / BK;
    unsigned voffB[2]; int RA[2], CA2[2];
#pragma unroll
    for (int i = 0; i < 2; ++i) { int R, C; stage_rc(tid * 16 + i * 8192, R, C); const int Rb = Epi::PERM ? ((R & ~31) + perm32(R & 31)) : R;
        RA[i] = R; CA2[i] = C * 2; voffB[i] = (unsigned)(Rb * K + C) * 2u; }
    const size_t kstep = (size_t)(BK * 2);
    const size_t hstep = (size_t)HALF * K * 2;
    const unsigned ldsw = (unsigned)wid * 1024u;
    const int aoff = lds_byte(wr * 64 + fr, fq * 8), boff = lds_byte(wc * 32 + fr, fq * 8);
#define PG8_SA(b, h) (((b) * 2 + (h)) * HTB)
#define PG8_SB(b, h) ((4 + (b) * 2 + (h)) * HTB)
#define PG8_STAGE(bufoff, gbase, voff) do { _Pragma("unroll") for (int _i = 0; _i < 2; ++_i) \
        __builtin_amdgcn_global_load_lds((const unsigned*)((const char*)(gbase) + (voff)[_i]), (LAS unsigned*)(lds + (bufoff) + ldsw + _i * 8192), 16, 0, 0); } while (0)
#define PG8_LDA(dst, b, h) do { _Pragma("unroll") for (int m = 0; m < 4; ++m) _Pragma("unroll") for (int k = 0; k < 2; ++k) dst[m][k] = *(const LAS bf16x8*)(lds + PG8_SA(b, h) + aoff + m * 2048 + k * 1024); } while (0)
#define PG8_LDB(dst, b, h) do { _Pragma("unroll") for (int n = 0; n < 2; ++n) _Pragma("unroll") for (int k = 0; k < 2; ++k) dst[n][k] = *(const LAS bf16x8*)(lds + PG8_SB(b, h) + boff + n * 2048 + k * 1024); } while (0)
#define PG8_MMA(ai, bj, At, Bt) do { __builtin_amdgcn_s_setprio(1); _Pragma("unroll") for (int m = 0; m < 4; ++m) _Pragma("unroll") for (int n = 0; n < 2; ++n) _Pragma("unroll") for (int k = 0; k < 2; ++k) \
        acc[ai][bj][m][n] = __builtin_amdgcn_mfma_f32_16x16x32_bf16(Bt[n][k], At[m][k], acc[ai][bj][m][n], 0, 0, 0); __builtin_amdgcn_s_setprio(0); } while (0)
#define PG8_WAIT_V(n) asm volatile("s_waitcnt vmcnt(" #n ")" ::: "memory")
#define PG8_WAIT_L(n) asm volatile("s_waitcnt lgkmcnt(" #n ")" ::: "memory")
#define PG8_BAR __builtin_amdgcn_s_barrier()
#define PG8_SCHED __builtin_amdgcn_sched_barrier(0)
    Unit cur, nxt; int ui = 0;
    if (!S.next(0, cur)) return;
    unsigned oc0[2], oc1[2], on0[2], on1[2];
    if constexpr (GATHER) { S.offs(cur, RA, CA2, oc0, oc1); }
    else {
#pragma unroll
        for (int i = 0; i < 2; ++i) { oc0[i] = (unsigned)(RA[i] * K) * 2u + (unsigned)CA2[i]; oc1[i] = oc0[i]; on0[i] = oc0[i]; on1[i] = oc0[i]; } }
    const size_t ah = GATHER ? (size_t)0 : hstep;
    f32x4 acc[2][2][4][2];
#pragma unroll
    for (int a = 0; a < 2; ++a)
#pragma unroll
        for (int b = 0; b < 2; ++b)
#pragma unroll
            for (int m = 0; m < 4; ++m)
#pragma unroll
                for (int n = 0; n < 2; ++n) acc[a][b][m][n] = (f32x4){0.f, 0.f, 0.f, 0.f};
    bf16x8 At[4][2], B0[2][2], B1[2][2];
    const char* cA = cur.A; const char* cB = cur.B;
    PG8_STAGE(PG8_SB(0, 0), cB, voffB); PG8_STAGE(PG8_SB(0, 1), cB + hstep, voffB); PG8_STAGE(PG8_SA(0, 0), cA, oc0); PG8_STAGE(PG8_SA(0, 1), cA + ah, oc1);
    if (wr == 1) PG8_BAR;
    PG8_WAIT_V(2); PG8_BAR;
    PG8_STAGE(PG8_SB(1, 0), cB + kstep, voffB); PG8_STAGE(PG8_SA(1, 0), cA + kstep, oc0); PG8_STAGE(PG8_SB(1, 1), cB + hstep + kstep, voffB);
    PG8_WAIT_V(6); PG8_BAR;
    for (;;) {
        const bool has_next = S.next(ui + 1, nxt);
        const char* nA = has_next ? nxt.A : cA; const char* nB = has_next ? nxt.B : cB;
        if constexpr (GATHER) { if (has_next) S.offs(nxt, RA, CA2, on0, on1); else { on0[0] = oc0[0]; on0[1] = oc0[1]; on1[0] = oc1[0]; on1[1] = oc1[1]; } }
        for (int t = 0; t < nt; t += 2) {
            const bool last = (t == nt - 2);
            const char* a1 = cA + (size_t)(t + 1) * kstep;
            const char* a2 = last ? nA : cA + (size_t)(t + 2) * kstep; const char* b2 = last ? nB : cB + (size_t)(t + 2) * kstep;
            const char* a3 = a2 + kstep; const char* b3 = b2 + kstep;
            unsigned o20[2], o21[2];
            if constexpr (GATHER) { o20[0] = last ? on0[0] : oc0[0]; o20[1] = last ? on0[1] : oc0[1]; o21[0] = last ? on1[0] : oc1[0]; o21[1] = last ? on1[1] : oc1[1]; }
            else { o20[0] = oc0[0]; o20[1] = oc0[1]; o21[0] = oc0[0]; o21[1] = oc0[1]; }
            PG8_LDB(B0, 0, 0); PG8_LDB(B1, 0, 1); PG8_SCHED; PG8_LDA(At, 0, 0); PG8_STAGE(PG8_SA(1, 1), a1 + ah, oc1);
            PG8_WAIT_V(8); PG8_WAIT_L(0); PG8_BAR; PG8_MMA(0, 0, At, B0); PG8_MMA(0, 1, At, B1); PG8_BAR; PG8_SCHED;
            PG8_LDA(At, 0, 1); PG8_STAGE(PG8_SB(0, 0), b2, voffB); PG8_STAGE(PG8_SB(0, 1), b2 + hstep, voffB); PG8_STAGE(PG8_SA(0, 0), a2, o20);
            PG8_WAIT_V(8); PG8_WAIT_L(0); PG8_BAR; PG8_MMA(1, 0, At, B0); PG8_MMA(1, 1, At, B1); PG8_BAR; PG8_SCHED;
            PG8_LDB(B0, 1, 0); PG8_LDB(B1, 1, 1); PG8_SCHED; PG8_LDA(At, 1, 0); PG8_STAGE(PG8_SA(0, 1), a2 + ah, o21);
            PG8_WAIT_V(8); PG8_WAIT_L(0); PG8_BAR; PG8_MMA(0, 0, At, B0); PG8_MMA(0, 1, At, B1); PG8_BAR; PG8_SCHED;
            PG8_LDA(At, 1, 1); PG8_STAGE(PG8_SB(1, 0), b3, voffB); PG8_STAGE(PG8_SB(1, 1), b3 + hstep, voffB); PG8_STAGE(PG8_SA(1, 0), a3, o20);
            PG8_WAIT_V(8); PG8_WAIT_L(0); PG8_BAR; PG8_MMA(1, 0, At, B0); PG8_MMA(1, 1, At, B1); PG8_BAR; PG8_SCHED;
        }
        if constexpr (ALIGN_EPI) { if (wr == 0) PG8_BAR; }
        E(acc, cur, wr, wc, fr, fq);
        if (!has_next) break;
#pragma unroll
        for (int a = 0; a < 2; ++a)
#pragma unroll
            for (int b = 0; b < 2; ++b)
#pragma unroll
                for (int m = 0; m < 4; ++m)
#pragma unroll
                    for (int n = 0; n < 2; ++n) acc[a][b][m][n] = (f32x4){0.f, 0.f, 0.f, 0.f};
        cur = nxt; cA = nA; cB = nB; ++ui;
        if constexpr (GATHER) { oc0[0] = on0[0]; oc0[1] = on0[1]; oc1[0] = on1[0]; oc1[1] = on1[1]; }
        if constexpr (ALIGN_EPI) { if (wr == 1) PG8_BAR; }
    }
    PG8_WAIT_V(0);
    if constexpr (!ALIGN_EPI) { if (wr == 0) PG8_BAR; }
    PG8_BAR;
#undef PG8_SA
#undef PG8_SB
#undef PG8_STAGE
#undef PG8_LDA
#undef PG8_LDB
#undef PG8_MMA
#undef PG8_WAIT_V
#undef PG8_WAIT_L
#undef PG8_BAR
#undef PG8_SCHED
}

struct SchedPlain {
    TileOrder o; const char* A; const char* B; size_t tstep;
    __device__ __forceinline__ bool next(int i, Unit& u) const { int pm, pn; if (!o.next(i, pm, pn)) return false; u.pm = pm; u.pn = pn; u.x0 = 0; u.x1 = 0; u.x2 = 0; u.A = A + (size_t)pm * tstep; u.B = B + (size_t)pn * tstep; return true; }
};
struct SchedTwo {
    TileOrder o; const char* A0; const char* A1; const char* B0; const char* B1; size_t tstep;
    __device__ __forceinline__ bool next(int i, Unit& u) const { int pm, pn; if (!o.next(i >> 1, pm, pn)) return false; const int br = i & 1; u.pm = pm; u.pn = pn; u.x0 = br; u.x1 = 0; u.x2 = 0;
        u.A = (br ? A1 : A0) + (size_t)pm * tstep; u.B = (br ? B1 : B0) + (size_t)pn * tstep; return true; }
};
struct SchedMoe {
    const LAS int* utab; int nunits;
    const char* Abase; const char* Bbase; size_t a_row_bytes; size_t b_exp_bytes; size_t b_tile_bytes; const int* list; int gather_k2;
    __device__ __forceinline__ bool next(int i, Unit& u) const {
        if (i >= nunits) return false;
        const int e = utab[i * 5 + 0], pn = utab[i * 5 + 1], lo_ = utab[i * 5 + 2], nv = utab[i * 5 + 3], rb = utab[i * 5 + 4];
        u.pm = e; u.pn = pn; u.x0 = lo_; u.x1 = nv; u.x2 = rb;
        u.A = Abase + (size_t)rb * a_row_bytes; u.B = Bbase + (size_t)e * b_exp_bytes + (size_t)pn * b_tile_bytes; return true; }
    __device__ __forceinline__ void offs(const Unit& u, const int (&RA)[2], const int (&CA2)[2], unsigned (&o0)[2], unsigned (&o1)[2]) const {
        const int* lp = list + (size_t)u.pm * T + u.x0;
#pragma unroll
        for (int i = 0; i < 2; ++i) {
            int r0 = RA[i], r1 = RA[i] + HALF; r0 = r0 < u.x1 ? r0 : u.x1 - 1; r1 = r1 < u.x1 ? r1 : u.x1 - 1;
            const int t0 = lp[r0] >> 1, t1 = lp[r1] >> 1;
            o0[i] = (unsigned)t0 * (unsigned)gather_k2 + (unsigned)CA2[i]; o1[i] = (unsigned)t1 * (unsigned)gather_k2 + (unsigned)CA2[i]; }
    }
};
}

using pg8::Unit;
struct EpiInProj {
    static constexpr bool PERM = true;
    bf16_t* qkv; bf16_t* gates;
    __device__ __forceinline__ void operator()(const f32x4 (&acc)[2][2][4][2], const Unit& u, int wr, int wc, int fr, int fq) const {
        const int pn = u.pn; bf16_t* base; int ldc, colt; float sc = 1.f; const bool gate = pn >= 12;
        if (!gate) { const int piece = pn >> 1; base = qkv + (size_t)piece * (QKV_STRIDE / 2); ldc = WA; colt = (pn & 1) * 256; if (piece == 0 || piece == 3) sc = C2; }
        else { const int g = (pn - 12) >> 2; base = gates + (size_t)g * ((size_t)T * D_MODEL); ldc = D_MODEL; colt = ((pn - 12) & 3) * 256; }
        const int row0 = u.pm * 256 + wr * 64 + fr, col0 = colt + wc * 32 + 8 * fq;
#pragma unroll
        for (int ai = 0; ai < 2; ++ai)
#pragma unroll
            for (int m = 0; m < 4; ++m) { bf16_t* rowp = base + (size_t)(row0 + ai * 128 + m * 16) * ldc + col0;
#pragma unroll
                for (int bj = 0; bj < 2; ++bj) { f32x4 v0 = acc[ai][bj][m][0], v1 = acc[ai][bj][m][1];
                    if (gate) {
#pragma unroll
                        for (int i = 0; i < 4; ++i) { v0[i] = sigmoidf_(v0[i]); v1[i] = sigmoidf_(v1[i]); } }
                    else { v0 = v0 * sc; v1 = v1 * sc; }
                    u32x4 w; w.x = cvt_pk_bf16(v0[0], v0[1]); w.y = cvt_pk_bf16(v0[2], v0[3]); w.z = cvt_pk_bf16(v1[0], v1[1]); w.w = cvt_pk_bf16(v1[2], v1[3]);
                    *(u32x4*)(rowp + bj * 128) = w; } }
    }
};
struct EpiMerge {
    static constexpr bool PERM = true;
    const bf16_t* ga; const bf16_t* gb; bf16_t* merged;
    __device__ __forceinline__ void operator()(const f32x4 (&acc)[2][2][4][2], const Unit& u, int wr, int wc, int fr, int fq) const {
        const int br = u.x0; const bf16_t* g = br ? gb : ga;
        const int row0 = u.pm * 256 + wr * 64 + fr, col0 = u.pn * 256 + wc * 32 + 8 * fq;
#pragma unroll
        for (int ai = 0; ai < 2; ++ai)
#pragma unroll
            for (int m = 0; m < 4; ++m) { const size_t ro = (size_t)(row0 + ai * 128 + m * 16) * D_MODEL + col0;
#pragma unroll
                for (int bj = 0; bj < 2; ++bj) { const f32x4 a0 = acc[ai][bj][m][0], a1 = acc[ai][bj][m][1];
                    const u32x4 gw = *(const u32x4*)(g + ro + bj * 128);
                    float v[8];
                    v[0] = bf_lo(gw.x) * a0[0]; v[1] = bf_hi(gw.x) * a0[1]; v[2] = bf_lo(gw.y) * a0[2]; v[3] = bf_hi(gw.y) * a0[3];
                    v[4] = bf_lo(gw.z) * a1[0]; v[5] = bf_hi(gw.z) * a1[1]; v[6] = bf_lo(gw.w) * a1[2]; v[7] = bf_hi(gw.w) * a1[3];
                    if (br) { const u32x4 pw = *(const u32x4*)(merged + ro + bj * 128);
                        v[0] += bf_lo(pw.x); v[1] += bf_hi(pw.x); v[2] += bf_lo(pw.y); v[3] += bf_hi(pw.y); v[4] += bf_lo(pw.z); v[5] += bf_hi(pw.z); v[6] += bf_lo(pw.w); v[7] += bf_hi(pw.w); }
                    u32x4 w; w.x = cvt_pk_bf16(v[0], v[1]); w.y = cvt_pk_bf16(v[2], v[3]); w.z = cvt_pk_bf16(v[4], v[5]); w.w = cvt_pk_bf16(v[6], v[7]);
                    *(u32x4*)(merged + ro + bj * 128) = w; } }
    }
};
struct EpiOut {
    static constexpr bool PERM = false;
    const float* xin; float* pre;
    __device__ __forceinline__ void operator()(const f32x4 (&acc)[2][2][4][2], const Unit& u, int wr, int wc, int fr, int fq) const {
        const int row0 = u.pm * 256 + wr * 64 + fr, col0 = u.pn * 256 + wc * 32 + 4 * fq;
#pragma unroll
        for (int ai = 0; ai < 2; ++ai)
#pragma unroll
            for (int m = 0; m < 4; ++m) { const size_t ro = (size_t)(row0 + ai * 128 + m * 16) * D_MODEL + col0;
#pragma unroll
                for (int bj = 0; bj < 2; ++bj)
#pragma unroll
                    for (int n = 0; n < 2; ++n) { const f32x4 xv = *(const f32x4*)(xin + ro + bj * 128 + n * 16); *(f32x4*)(pre + ro + bj * 128 + n * 16) = xv * ALPHA + acc[ai][bj][m][n]; } }
    }
};
struct EpiGU {
    static constexpr bool PERM = true;
    bf16_t* h;
    __device__ __forceinline__ void operator()(const f32x4 (&acc)[2][2][4][2], const Unit& u, int wr, int wc, int fr, int fq) const {
        const int row0 = u.x2 + wr * 64 + fr, col0 = u.pn * 128 + wc * 32 + 8 * fq;
#pragma unroll
        for (int ai = 0; ai < 2; ++ai)
#pragma unroll
            for (int m = 0; m < 4; ++m) { bf16_t* rowp = h + (size_t)(row0 + ai * 128 + m * 16) * FE + col0; float v[8];
#pragma unroll
                for (int n = 0; n < 2; ++n)
#pragma unroll
                    for (int i = 0; i < 4; ++i) { const float g = acc[ai][0][m][n][i], uu = acc[ai][1][m][n][i]; v[n * 4 + i] = g * sigmoidf_(g) * uu; }
                u32x4 w; w.x = cvt_pk_bf16(v[0], v[1]); w.y = cvt_pk_bf16(v[2], v[3]); w.z = cvt_pk_bf16(v[4], v[5]); w.w = cvt_pk_bf16(v[6], v[7]);
                *(u32x4*)rowp = w; }
    }
};
struct EpiDown {
    static constexpr bool PERM = true;
    bf16_t* y; const int* list;
    __device__ __forceinline__ void operator()(const f32x4 (&acc)[2][2][4][2], const Unit& u, int wr, int wc, int fr, int fq) const {
        const int nv = u.x1, loff = u.x0;
        const int* lp = list + (size_t)u.pm * T + loff;
        const int col0 = u.pn * 256 + wc * 32 + 8 * fq;
#pragma unroll
        for (int ai = 0; ai < 2; ++ai)
#pragma unroll
            for (int m = 0; m < 4; ++m) { const int lr = ai * 128 + wr * 64 + m * 16 + fr;
                if (lr < nv) { const int entry = lp[lr]; bf16_t* rowp = y + (size_t)entry * D_MODEL + col0;
#pragma unroll
                    for (int bj = 0; bj < 2; ++bj) { const f32x4 v0 = acc[ai][bj][m][0], v1 = acc[ai][bj][m][1];
                        u32x4 w; w.x = cvt_pk_bf16(v0[0], v0[1]); w.y = cvt_pk_bf16(v0[2], v0[3]); w.z = cvt_pk_bf16(v1[0], v1[1]); w.w = cvt_pk_bf16(v1[2], v1[3]);
                        *(u32x4*)(rowp + bj * 128) = w; } } }
    }
};

namespace att {
constexpr int DM = WA;
constexpr int SLOTB = 8192;
constexpr int LDS_K = 0, LDS_V = 2 * SLOTB, LDS_WS = 4 * SLOTB, LDS_OST = LDS_WS + 8 * 256, LDS_TAB = LDS_OST + 8 * 4096, LDS_FLG = LDS_TAB + 1024, LDS_END = LDS_FLG + 64;
#define SBAR() __builtin_amdgcn_sched_barrier(0)
#define WAIT_BAR0() asm volatile("s_waitcnt vmcnt(0) lgkmcnt(0)\n\ts_barrier" ::: "memory")
__device__ __forceinline__ int crow(int r, int hi) { return (r & 3) + 8 * (r >> 2) + 4 * hi; }
__device__ __forceinline__ void glds16(const void* gsrc, unsigned lds_dst) { unsigned keep;
    asm volatile("s_mov_b32 %0, m0\n\ts_mov_b32 m0, %2\n\ts_nop 0\n\tglobal_load_lds_dwordx4 %1, off\n\ts_mov_b32 m0, %0" : "=&s"(keep) : "v"(gsrc), "s"(lds_dst) : "memory"); }
__device__ __forceinline__ float max3f(float a, float b, float c) { return __builtin_fmaxf(__builtin_fmaxf(a, b), c); }
__device__ __forceinline__ void qkt(f32x16& p0, f32x16& p1, const LAS char* Kslot, const bf16x8* qr, const f32x16& cin, int r32, int hi) {
    const LAS char* kb = Kslot + hi * 1024 + r32 * 16;
#pragma unroll
    for (int d0 = 0; d0 < 4; ++d0) {
        const bf16x8 b0 = *(const LAS bf16x8*)(kb + d0 * 2048);
        const bf16x8 b1 = *(const LAS bf16x8*)(kb + d0 * 2048 + 512);
        if (d0 == 0) { p0 = __builtin_amdgcn_mfma_f32_32x32x16_bf16(b0, qr[0], cin, 0, 0, 0); p1 = __builtin_amdgcn_mfma_f32_32x32x16_bf16(b1, qr[0], cin, 0, 0, 0); }
        else { p0 = __builtin_amdgcn_mfma_f32_32x32x16_bf16(b0, qr[d0], p0, 0, 0, 0); p1 = __builtin_amdgcn_mfma_f32_32x32x16_bf16(b1, qr[d0], p1, 0, 0, 0); } }
}
__device__ __forceinline__ float rowmax(const f32x16& p0, const f32x16& p1) {
    float a = max3f(p0[0], p0[1], p1[0]), b = max3f(p0[2], p0[3], p1[1]); a = max3f(a, p1[2], p1[3]);
#pragma unroll
    for (int r = 4; r < 16; r += 4) { a = max3f(a, p0[r], p0[r + 1]); b = max3f(b, p0[r + 2], p0[r + 3]); a = max3f(a, p1[r], p1[r + 1]); b = max3f(b, p1[r + 2], p1[r + 3]); }
    const float m = __builtin_fmaxf(a, b);
    auto rr = __builtin_amdgcn_permlane32_swap(__float_as_uint(m), __float_as_uint(m), false, false);
    return __builtin_fmaxf(__uint_as_float(rr[0]), __uint_as_float(rr[1]));
}
__device__ __forceinline__ void pv(f32x16* o, int vb, bf16x8 pa0, bf16x8 pa1, bf16x8 pa2, bf16x8 pa3) {
#pragma unroll
    for (int d0 = 0; d0 < 2; ++d0) { s16x4 lo[4], hi[4];
#pragma unroll
        for (int ks = 0; ks < 4; ++ks) {
            asm volatile("ds_read_b64_tr_b16 %0,%1 offset:%c2" : "=&v"(lo[ks]) : "v"(vb), "i"(d0 * 4096 + ks * 1024) : "memory");
            asm volatile("ds_read_b64_tr_b16 %0,%1 offset:%c2" : "=&v"(hi[ks]) : "v"(vb), "i"(d0 * 4096 + ks * 1024 + 512) : "memory"); }
        asm volatile("s_waitcnt lgkmcnt(0)" ::: "memory"); SBAR();
#define PK(k) (bf16x8){lo[k][0], lo[k][1], lo[k][2], lo[k][3], hi[k][0], hi[k][1], hi[k][2], hi[k][3]}
        o[d0] = __builtin_amdgcn_mfma_f32_32x32x16_bf16(pa0, PK(0), o[d0], 0, 0, 0);
        o[d0] = __builtin_amdgcn_mfma_f32_32x32x16_bf16(pa1, PK(1), o[d0], 0, 0, 0);
        o[d0] = __builtin_amdgcn_mfma_f32_32x32x16_bf16(pa2, PK(2), o[d0], 0, 0, 0);
        o[d0] = __builtin_amdgcn_mfma_f32_32x32x16_bf16(pa3, PK(3), o[d0], 0, 0, 0);
#undef PK
    }
}
#define PKW(P, B) cvt_pk_bf16(P[B], P[B + 1])
__device__ __forceinline__ void store_o(const f32x16* o, const float* rs, bf16_t* Ow, LAS char* shm, int wid, int lane, int r32, int hi) {
    LAS bf16_t* stg = (LAS bf16_t*)(shm + LDS_OST) + wid * 2048;
#pragma unroll
    for (int r = 0; r < 16; ++r) { const int orow = crow(r, hi);
#pragma unroll
        for (int d0 = 0; d0 < 2; ++d0) stg[orow * 64 + d0 * 32 + r32] = (bf16_t)(cvt_pk_bf16(o[d0][r] * rs[r], 0.f) & 0xffffu); }
    LDS_WAIT();
#pragma unroll
    for (int i = 0; i < 4; ++i) { const int row = i * 8 + (lane >> 3), ch = lane & 7; const u32x4 v = *(const LAS u32x4*)(stg + row * 64 + ch * 8); *(u32x4*)(Ow + (size_t)row * DM + ch * 8) = v; }
}

__device__ __forceinline__ void attn_a_unit(int b, int h, int u, const bf16_t* Q, const bf16_t* K, const bf16_t* V, bf16_t* O, const float* bias_h, LAS char* shm) {
    int tid_ = threadIdx.x; asm volatile("" : "+v"(tid_)); const int tid = tid_, lane = tid & 63, r32 = lane & 31, hi = lane >> 5; const int wid = __builtin_amdgcn_readfirstlane(tid >> 6);
    const long rowbase = (long)b * SEQ; const int q0 = u * 256;
    const bf16_t* Qw = Q + (rowbase + q0 + wid * 32) * DM + h * HD;
    const bf16_t* Kh = K + rowbase * DM + h * HD; const bf16_t* Vh = V + rowbase * DM + h * HD;
    const unsigned lds0 = (unsigned)(size_t)shm;
    LAS float* wsf = (LAS float*)(shm + LDS_WS) + wid * 64;
    LAS float* tab = (LAS float*)(shm + LDS_TAB);
    if (tid < 256) { int rel = tid - 64; rel = rel < -128 ? -128 : (rel > 128 ? 128 : rel); tab[tid] = bias_h[rel + 128] * LOG2E; }
    const float bfar = bias_h[256] * LOG2E;
    const bf16_t* ksrc = Kh + (long)lane * DM + wid * 8;
    const bf16_t* vsrc = Vh + (long)(16 * (wid & 3) + (lane >> 2)) * DM + (wid >> 2) * 32 + (lane & 3) * 8;
    const unsigned kdst = lds0 + LDS_K + wid * 1024, vdst = lds0 + LDS_V + wid * 1024;
#define DMA_K(t, slot) glds16(ksrc + (long)(t) * 64 * DM, (unsigned)__builtin_amdgcn_readfirstlane(kdst + (slot)))
#define DMA_V(t, slot) glds16(vsrc + (long)(t) * 64 * DM, (unsigned)__builtin_amdgcn_readfirstlane(vdst + (slot)))
    const int vb0 = (int)(lds0 + LDS_V) + ((lane >> 4) & 1) * 32 + (lane & 3) * 8 + (4 * hi + ((lane & 15) >> 2)) * 64;
    const int cw = 4 * u + (wid >> 1);
    const int jlo = (4 * u - 8) > 0 ? (4 * u - 8) : 0, jhi = 4 * u + 3;
    DMA_K(jlo, 0); DMA_V(jlo, 0);
    bf16x8 qr[4];
#pragma unroll
    for (int d0 = 0; d0 < 4; ++d0) qr[d0] = *(const bf16x8*)(Qw + (long)r32 * DM + d0 * 16 + hi * 8);
    float mhat = 0.f, l_reg = 0.f; f32x16 o[2]; o[0] = f32x16{}; o[1] = f32x16{};
    bool first = true;
    for (int j = jlo; j <= jhi; ++j) {
        const int sl = ((j - jlo) & 1) * SLOTB;
        WAIT_BAR0();
        if (j < jhi) { DMA_K(j + 1, sl ^ SLOTB); DMA_V(j + 1, sl ^ SLOTB); }
        if (j >= cw - 8 && j <= cw) {
            const bool far = (j <= cw - 3);
            f32x16 cin; const float c0 = (far ? bfar : 0.f) - mhat;
#pragma unroll
            for (int r = 0; r < 16; ++r) cin[r] = c0;
            f32x16 p0, p1;
            qkt(p0, p1, shm + LDS_K + sl, qr, cin, r32, hi);
            if (!far) {
                const LAS float* tp = tab + ((cw - j) * 64 + 32 * (wid & 1) + r32 + 64 - 4 * hi);
#pragma unroll
                for (int r = 0; r < 16; ++r) { const int kv = (r & 3) + 8 * (r >> 2); p0[r] += tp[-kv]; p1[r] += tp[-kv - 32]; }
            }
            const float rm = rowmax(p0, p1);
            bool upd; float dl;
            if (first) { upd = true; dl = rm; } else { upd = __any(rm > 8.f) != 0; dl = __builtin_fmaxf(rm, 0.f); }
            if (upd) {
                mhat += dl;
#pragma unroll
                for (int r = 0; r < 16; ++r) { p0[r] -= dl; p1[r] -= dl; }
                if (!first) { const float f = fast_exp2(-dl); l_reg *= f; if (hi == 0) wsf[r32] = f; LDS_WAIT();
#pragma unroll
                    for (int r = 0; r < 16; ++r) { const float fr_ = wsf[crow(r, hi)]; o[0][r] *= fr_; o[1][r] *= fr_; } }
            }
            first = false;
            float sacc = 0.f;
#pragma unroll
            for (int r = 0; r < 16; ++r) { p0[r] = fast_exp2(p0[r]); p1[r] = fast_exp2(p1[r]); sacc += p0[r] + p1[r]; }
            l_reg += sacc;
            u32x4 pw0 = (u32x4){PKW(p0, 0), PKW(p0, 2), PKW(p0, 4), PKW(p0, 6)}, pw1 = (u32x4){PKW(p0, 8), PKW(p0, 10), PKW(p0, 12), PKW(p0, 14)};
            u32x4 pw2 = (u32x4){PKW(p1, 0), PKW(p1, 2), PKW(p1, 4), PKW(p1, 6)}, pw3 = (u32x4){PKW(p1, 8), PKW(p1, 10), PKW(p1, 12), PKW(p1, 14)};
            pv(o, vb0 + sl, __builtin_bit_cast(bf16x8, pw0), __builtin_bit_cast(bf16x8, pw1), __builtin_bit_cast(bf16x8, pw2), __builtin_bit_cast(bf16x8, pw3));
        }
    }
    { auto rr = __builtin_amdgcn_permlane32_swap(__float_as_uint(l_reg), __float_as_uint(l_reg), false, false); l_reg = __uint_as_float(rr[0]) + __uint_as_float(rr[1]); }
    if (hi == 0) wsf[32 + r32] = l_reg; LDS_WAIT();
    float rli[16];
#pragma unroll
    for (int r = 0; r < 16; ++r) rli[r] = fast_rcp(wsf[32 + crow(r, hi)]);
    store_o(o, rli, O + (rowbase + q0 + wid * 32) * DM + h * HD, shm, wid, lane, r32, hi);
    asm volatile("s_waitcnt lgkmcnt(0)\n\ts_barrier" ::: "memory");
#undef DMA_K
#undef DMA_V
}

__device__ __forceinline__ void attn_b_unit(int b, int h, int qb, const bf16_t* Q, const bf16_t* K, const bf16_t* V, bf16_t* O, LAS char* shm) {
    int tid_ = threadIdx.x; asm volatile("" : "+v"(tid_)); const int tid = tid_, lane = tid & 63, r32 = lane & 31, hi = lane >> 5; const int wid = __builtin_amdgcn_readfirstlane(tid >> 6);
    const long rowbase = (long)b * SEQ; const int q0 = qb * 256;
    const bf16_t* Qw = Q + (rowbase + q0 + wid * 32) * DM + h * HD;
    const bf16_t* Kh = K + rowbase * DM + h * HD; const bf16_t* Vh = V + rowbase * DM + h * HD;
    const unsigned lds0 = (unsigned)(size_t)shm;
    LAS unsigned* flg = (LAS unsigned*)(shm + LDS_FLG);
    const bf16_t* ksrc = Kh + (long)lane * DM + wid * 8;
    const bf16_t* vsrc = Vh + (long)(16 * (wid & 3) + (lane >> 2)) * DM + (wid >> 2) * 32 + (lane & 3) * 8;
    const unsigned kdst = lds0 + LDS_K + wid * 1024, vdst = lds0 + LDS_V + wid * 1024;
#define DMA_K(t, slot) glds16(ksrc + (long)(t) * 64 * DM, (unsigned)__builtin_amdgcn_readfirstlane(kdst + (slot)))
#define DMA_V(t, slot) glds16(vsrc + (long)(t) * 64 * DM, (unsigned)__builtin_amdgcn_readfirstlane(vdst + (slot)))
    const int vb0 = (int)(lds0 + LDS_V) + ((lane >> 4) & 1) * 32 + (lane & 3) * 8 + (4 * hi + ((lane & 15) >> 2)) * 64;
    const int jtop = 4 * qb + 3, jd = 4 * qb + (wid >> 1);
    const int tq = 32 * (wid & 1) + r32;
    DMA_K(jtop, 0); DMA_V(jtop, 0);
    bf16x8 qr[4];
#pragma unroll
    for (int d0 = 0; d0 < 4; ++d0) qr[d0] = *(const bf16x8*)(Qw + (long)r32 * DM + d0 * 16 + hi * 8);
    float R = 1.0f; bool wdone = false; f32x16 o[2]; o[0] = f32x16{}; o[1] = f32x16{};
    for (int j = jtop, it = 0; j >= 0; --j, ++it) {
        const int sl = (it & 1) * SLOTB;
        WAIT_BAR0();
        if (it > 0) { const LAS unsigned* f = flg + ((it - 1) & 1) * 8; unsigned all = 1u;
#pragma unroll
            for (int w = 0; w < 8; ++w) all &= f[w];
            if (__builtin_amdgcn_readfirstlane(all) != 0u) break; }
        if (j > 0) { DMA_K(j - 1, sl ^ SLOTB); DMA_V(j - 1, sl ^ SLOTB); }
        if (j <= jd && !wdone) {
            f32x16 cin = f32x16{}; f32x16 p0, p1;
            qkt(p0, p1, shm + LDS_K + sl, qr, cin, r32, hi);
#pragma unroll
            for (int r = 0; r < 16; ++r) { p0[r] = fast_rcp(1.0f + fast_exp2(p0[r])); p1[r] = fast_rcp(1.0f + fast_exp2(p1[r])); }
            if (j == jd) {
#pragma unroll
                for (int r = 0; r < 16; ++r) { const int kv = crow(r, hi); if (kv >= tq) p0[r] = 1.0f; if (kv + 32 >= tq) p1[r] = 1.0f; } }
            float W[8], part[8];
#pragma unroll
            for (int i = 0; i < 8; ++i) { const float pb = (i < 4) ? (p0[4 * i] * p0[4 * i + 1]) * (p0[4 * i + 2] * p0[4 * i + 3]) : (p1[4 * i - 16] * p1[4 * i - 15]) * (p1[4 * i - 14] * p1[4 * i - 13]);
                auto rr = __builtin_amdgcn_permlane32_swap(__float_as_uint(pb), __float_as_uint(pb), false, false);
                const float vlo = __uint_as_float(rr[0]), vhi = __uint_as_float(rr[1]);
                W[i] = vlo * vhi; part[i] = hi ? 1.0f : vhi; }
            float sw = R;
#pragma unroll
            for (int i = 7; i >= 0; --i) { float c = sw * part[i];
                if (i < 4) {
#pragma unroll
                    for (int rr_ = 3; rr_ >= 0; --rr_) { const float t_ = c * p0[4 * i + rr_]; p0[4 * i + rr_] = c - t_; c = t_; } }
                else {
#pragma unroll
                    for (int rr_ = 3; rr_ >= 0; --rr_) { const float t_ = c * p1[4 * i - 16 + rr_]; p1[4 * i - 16 + rr_] = c - t_; c = t_; } }
                sw *= W[i]; }
            R = sw;
            u32x4 pw0 = (u32x4){PKW(p0, 0), PKW(p0, 2), PKW(p0, 4), PKW(p0, 6)}, pw1 = (u32x4){PKW(p0, 8), PKW(p0, 10), PKW(p0, 12), PKW(p0, 14)};
            u32x4 pw2 = (u32x4){PKW(p1, 0), PKW(p1, 2), PKW(p1, 4), PKW(p1, 6)}, pw3 = (u32x4){PKW(p1, 8), PKW(p1, 10), PKW(p1, 12), PKW(p1, 14)};
            pv(o, vb0 + sl, __builtin_bit_cast(bf16x8, pw0), __builtin_bit_cast(bf16x8, pw1), __builtin_bit_cast(bf16x8, pw2), __builtin_bit_cast(bf16x8, pw3));
            wdone = __all(R == 0.0f) != 0;
        }
        if (lane == 0) flg[(it & 1) * 8 + wid] = wdone ? 1u : 0u;
    }
    float ones[16];
#pragma unroll
    for (int r = 0; r < 16; ++r) ones[r] = 1.0f;
    store_o(o, ones, O + (rowbase + q0 + wid * 32) * DM + h * HD, shm, wid, lane, r32, hi);
    asm volatile("s_waitcnt lgkmcnt(0)\n\ts_barrier" ::: "memory");
#undef DMA_K
#undef DMA_V
}
#undef PKW
#undef SBAR
#undef WAIT_BAR0
}

#define XB_TMO      128
#define XB_XCNT(j)  (256  + 64 * (j))
#define XB_XSUB(j)  (1280 + 64 * (j))
#define XB_XGEN(j)  (2304 + 64 * (j))
#define XB_TOP      3328
#define XB_TOPGEN   3392
#define XCD_BAR_WORDS 3456
#define XB_SPIN_CAP (1u << 22)
__device__ __forceinline__ unsigned xb_ld(unsigned* p)              { return __hip_atomic_load(p, __ATOMIC_RELAXED, __HIP_MEMORY_SCOPE_AGENT); }
__device__ __forceinline__ unsigned xb_add(unsigned* p, unsigned v) { return __hip_atomic_fetch_add(p, v, __ATOMIC_RELAXED, __HIP_MEMORY_SCOPE_AGENT); }
__device__ __forceinline__ unsigned xb_xcc_id() { return (unsigned)__builtin_amdgcn_s_getreg((3 << 11) | 20) & 0xFu; }
#define XB_SPIN(cond, bar) do { unsigned _sp = 0; while (cond) { __builtin_amdgcn_s_sleep(1); \
    if ((++_sp & 255u) == 0u) { if (xb_ld(&(bar)[XB_TMO])) break; if (_sp > XB_SPIN_CAP) { atomicAdd(&(bar)[XB_TMO], 1u); break; } } } } while (0)
struct XcdBarrier { unsigned* bar; unsigned x; volatile LAS unsigned* st; };
__device__ __forceinline__ XcdBarrier xcd_barrier_post(unsigned* bar, volatile LAS unsigned* st) {
    XcdBarrier b; b.bar = bar; b.x = xb_xcc_id(); b.st = st;
    if (threadIdx.x == 0) (void)xb_add(&bar[XB_XCNT(b.x)], 1u);
    return b;
}
__device__ __forceinline__ void xcd_barrier_complete(unsigned* bar, unsigned x, unsigned& nloc, unsigned& nx) {
    const unsigned G = gridDim.x * gridDim.y * gridDim.z;
    unsigned sum, cnt, mine, sp = 0u;
    for (;;) {
        sum = 0u; cnt = 0u; mine = 0u;
#pragma unroll
        for (unsigned j = 0; j < 16; ++j) { const unsigned c = xb_ld(&bar[XB_XCNT(j)]); sum += c; cnt += (c > 0u) ? 1u : 0u; mine = (j == x) ? c : mine; }
        if (sum == G) break;
        __builtin_amdgcn_s_sleep(1);
        if ((++sp & 255u) == 0u) { if (xb_ld(&bar[XB_TMO])) break; if (sp > XB_SPIN_CAP) { atomicAdd(&bar[XB_TMO], 1u); break; } }
    }
    nloc = mine > 0u ? mine : 1u; nx = cnt > 0u ? cnt : 1u;
}
__device__ __forceinline__ void xcd_barrier(const XcdBarrier& b) {
    asm volatile("s_waitcnt vmcnt(0)" ::: "memory");
    __syncthreads();
    if (threadIdx.x == 0) {
        unsigned* bar = b.bar;
        __builtin_amdgcn_s_waitcnt(0);
        unsigned nloc = b.st[0], nx = b.st[1];
        if (nloc == 0u) { xcd_barrier_complete(bar, b.x, nloc, nx); b.st[0] = nloc; b.st[1] = nx; }
        const unsigned old = xb_add(&bar[XB_XSUB(b.x)], 1u);
        const unsigned gen = old / nloc;
        if (old + 1u == (gen + 1u) * nloc) {
            __builtin_amdgcn_fence(__ATOMIC_RELEASE, "agent");
            asm volatile("s_waitcnt vmcnt(0)" ::: "memory");
            const unsigned og = xb_add(&bar[XB_TOP], 1u);
            const unsigned tg = og / nx;
            if (og + 1u == (tg + 1u) * nx) xb_add(&bar[XB_TOPGEN], 1u);
            else XB_SPIN(xb_ld(&bar[XB_TOPGEN]) == tg, bar);
            __builtin_amdgcn_fence(__ATOMIC_ACQUIRE, "agent");
            xb_add(&bar[XB_XGEN(b.x)], 1u);
            asm volatile("s_waitcnt vmcnt(0)" ::: "memory");
        } else {
            XB_SPIN(xb_ld(&bar[XB_XGEN(b.x)]) == gen, bar);
            __builtin_amdgcn_fence(__ATOMIC_ACQUIRE, "agent");
            asm volatile("s_waitcnt vmcnt(0)" ::: "memory");
        }
    }
    __syncthreads();
}

__device__ __forceinline__ unsigned f2bf(float f) { unsigned u = __builtin_bit_cast(unsigned, f); return (u + 0x7fffu + ((u >> 16) & 1u)) >> 16; }
__device__ __forceinline__ unsigned pk2(float lo, float hi) { return f2bf(lo) | (f2bf(hi) << 16); }
__device__ __forceinline__ void transpose_item(const float* W, int K, int N, bf16_t* WT, int row_off, LAS float* scr, int item, int lane) {
    const int nblk = N / 32, kb = item / nblk, nb = item % nblk, k0 = 64 * kb, n0 = 32 * nb;
    f32x4 ld[8];
#pragma unroll
    for (int i = 0; i < 8; ++i) ld[i] = *(const f32x4*)(W + (size_t)(k0 + 8 * i + (lane >> 3)) * N + n0 + 4 * (lane & 7));
#pragma unroll
    for (int i = 0; i < 8; ++i) { LAS float* d = scr + (8 * i + (lane >> 3)) * 33 + 4 * (lane & 7); d[0] = ld[i].x; d[1] = ld[i].y; d[2] = ld[i].z; d[3] = ld[i].w; }
    LDS_WAIT(); asm volatile("" ::: "memory");
    const int c = lane & 7;
#pragma unroll
    for (int j = 0; j < 4; ++j) { const int n = (lane >> 3) + 8 * j; const LAS float* s = scr + (8 * c) * 33 + n;
        u32x4 o; o.x = pk2(s[0 * 33], s[1 * 33]); o.y = pk2(s[2 * 33], s[3 * 33]); o.z = pk2(s[4 * 33], s[5 * 33]); o.w = pk2(s[6 * 33], s[7 * 33]);
        *(u32x4*)(WT + (size_t)(row_off + n0 + n) * K + k0 + 8 * c) = o; }
    LDS_WAIT(); asm volatile("" ::: "memory");
}

struct Args { const float* in[15]; float* out; unsigned char* ws; int ph_lo, ph_hi, li, pad; };
typedef const __attribute__((address_space(4))) char* kptr_t;
__device__ __forceinline__ kptr_t kbase() { kptr_t kp = (kptr_t)__builtin_amdgcn_kernarg_segment_ptr(); asm volatile("" : "+s"(kp)); return kp; }
__device__ __forceinline__ const float* arg_in(int i) { return *(const float* const __attribute__((address_space(4)))*)(kbase() + 8 * i); }
__device__ __forceinline__ float* arg_out() { return *(float* const __attribute__((address_space(4)))*)(kbase() + 120); }
__device__ __forceinline__ unsigned char* arg_ws() { return *(unsigned char* const __attribute__((address_space(4)))*)(kbase() + 128); }
__device__ __forceinline__ int arg_lo() { return *(const __attribute__((address_space(4))) int*)(kbase() + 136); }
__device__ __forceinline__ int arg_hi() { return *(const __attribute__((address_space(4))) int*)(kbase() + 140); }
__device__ __forceinline__ int arg_li() { return *(const __attribute__((address_space(4))) int*)(kbase() + 144); }
static_assert(sizeof(Args) == 152, "Args layout");

constexpr int NWAVES = 8;
constexpr int PH_PER_LAYER = 8, N_PHASES = 1 + DEPTH * PH_PER_LAYER;
#define PH_COMMON() int tid_ = threadIdx.x; asm volatile("" : "+v"(tid_)); const int tid = tid_, lane = tid & 63, wave = __builtin_amdgcn_readfirstlane(tid >> 6); const int G = gridDim.x, bx = blockIdx.x; \
    const int vcu = (G % 8 == 0) ? (bx % 8) * (G / 8) + bx / 8 : bx; const int gw = vcu * NWAVES + wave, NGW = G * NWAVES; unsigned char* ws = arg_ws(); \
    (void)tid; (void)lane; (void)wave; (void)vcu; (void)gw; (void)NGW; (void)ws

__device__ __forceinline__ void convert_weights(int l, LAS unsigned char* lds) {
    PH_COMMON();
    LAS float* scr = (LAS float*)(lds + wave * 16384);
    const float* w_in = arg_in(1) + (size_t)l * D_MODEL * PROJ;
    const float* w_upa = arg_in(3) + (size_t)l * WA * D_MODEL;
    const float* w_upb = arg_in(4) + (size_t)l * WA * D_MODEL;
    const float* w_out = arg_in(5) + (size_t)l * D_MODEL * D_MODEL;
    const float* w_gate = arg_in(10) + (size_t)l * NE * D_MODEL * FE;
    const float* w_up = arg_in(11) + (size_t)l * NE * D_MODEL * FE;
    const float* w_down = arg_in(12) + (size_t)l * NE * FE * D_MODEL;
    constexpr int I_IN = (D_MODEL / 64) * (PROJ / 32), I_UP = (WA / 64) * (D_MODEL / 32), I_OUT = (D_MODEL / 64) * (D_MODEL / 32);
    constexpr int I_G = (D_MODEL / 64) * (FE / 32), I_D = (FE / 64) * (D_MODEL / 32);
    constexpr int NITEMS = I_IN + 2 * I_UP + I_OUT + NE * (2 * I_G + I_D);
    for (int it = gw; it < NITEMS; it += NGW) {
        int r = it;
        if (r < I_IN) { transpose_item(w_in, D_MODEL, PROJ, (bf16_t*)(ws + WS_WIN), 0, scr, r, lane); continue; } r -= I_IN;
        if (r < I_UP) { transpose_item(w_upa, WA, D_MODEL, (bf16_t*)(ws + WS_WUPA), 0, scr, r, lane); continue; } r -= I_UP;
        if (r < I_UP) { transpose_item(w_upb, WA, D_MODEL, (bf16_t*)(ws + WS_WUPB), 0, scr, r, lane); continue; } r -= I_UP;
        if (r < I_OUT) { transpose_item(w_out, D_MODEL, D_MODEL, (bf16_t*)(ws + WS_WOUT), 0, scr, r, lane); continue; } r -= I_OUT;
        const int e = r / (2 * I_G + I_D); r -= e * (2 * I_G + I_D);
        if (r < 2 * I_G) { const int up = r >= I_G; if (up) r -= I_G;
            const int nb = r % (FE / 32), n0 = nb * 32;
            const int row_off = e * 1024 + (n0 / 128) * 128 + (up ? 128 : 0);
            transpose_item((up ? w_up : w_gate) + (size_t)e * D_MODEL * FE, D_MODEL, FE, (bf16_t*)(ws + WS_WGU), row_off, scr, r, lane); continue; }
        r -= 2 * I_G;
        transpose_item(w_down + (size_t)e * FE * D_MODEL, FE, D_MODEL, (bf16_t*)(ws + WS_WD), e * 1024, scr, r, lane);
    }
}

__device__ __forceinline__ void phase0(LAS unsigned char* lds) {
    convert_weights(0, lds);
    PH_COMMON();
    const float* x_in = arg_in(0); bf16_t* XB = (bf16_t*)(ws + WS_XB);
    for (int m = gw; m < T; m += NGW) { const f32x4* xr = (const f32x4*)(x_in + (size_t)m * D_MODEL) + lane; u32x2* o8 = (u32x2*)(XB + (size_t)m * D_MODEL) + lane;
#pragma unroll
        for (int j = 0; j < 4; ++j) { const f32x4 v = xr[64 * j]; u32x2 w; w.x = cvt_pk_bf16(v.x, v.y); w.y = cvt_pk_bf16(v.z, v.w); o8[64 * j] = w; } }
}
__device__ __forceinline__ void phase1(LAS unsigned char* lds) {
    PH_COMMON();
    pg8::SchedPlain S; S.o.init(T / 256, PROJ / 256, G, bx); S.A = (const char*)(ws + WS_XB); S.B = (const char*)(ws + WS_WIN); S.tstep = (size_t)256 * D_MODEL * 2;
    EpiInProj E{(bf16_t*)(ws + WS_QA), (bf16_t*)(ws + WS_GA)};
    pg8::gemm_phase<EpiInProj, pg8::SchedPlain, false, true>(lds, D_MODEL, S, E);
}
__device__ __forceinline__ void phase2(LAS unsigned char* lds, int l) {
    PH_COMMON();
    const int bh = vcu >> 2, s = vcu & 3; const int b = bh >> 3, h = bh & 7;
    if (G != 256) return;
    bf16_t* QKV = (bf16_t*)(ws + WS_QA);
    const float* bias_h = arg_in(2) + ((size_t)l * NH + h) * N_REL;
    bf16_t* QAp = QKV; bf16_t* KAp = QKV + (QKV_STRIDE / 2); bf16_t* VAp = QKV + 2 * (QKV_STRIDE / 2);
    bf16_t* QBp = QKV + 3 * (QKV_STRIDE / 2); bf16_t* KBp = QKV + 4 * (QKV_STRIDE / 2); bf16_t* VBp = QKV + 5 * (QKV_STRIDE / 2);
    for (int i = 0; i < 4; ++i) { const int u = (i == 0) ? s : (i == 1) ? 7 - s : (i == 2) ? 8 + s : 15 - s; att::attn_a_unit(b, h, u, QAp, KAp, VAp, QAp, bias_h, (LAS char*)lds); }
    for (int i = 0; i < 4; ++i) { const int u = (i == 0) ? s : (i == 1) ? 7 - s : (i == 2) ? 8 + s : 15 - s; att::attn_b_unit(b, h, u, QBp, KBp, VBp, QBp, (LAS char*)lds); }
}
__device__ __forceinline__ void phase3(LAS unsigned char* lds) {
    PH_COMMON();
    bf16_t* QKV = (bf16_t*)(ws + WS_QA);
    pg8::SchedTwo S; S.o.init(T / 256, D_MODEL / 256, G, bx); S.A0 = (const char*)QKV; S.A1 = (const char*)(QKV + 3 * (QKV_STRIDE / 2));
    S.B0 = (const char*)(ws + WS_WUPA); S.B1 = (const char*)(ws + WS_WUPB); S.tstep = (size_t)256 * WA * 2;
    EpiMerge E{(const bf16_t*)(ws + WS_GA), (const bf16_t*)(ws + WS_GB), (bf16_t*)(ws + WS_MERGED)};
    pg8::gemm_phase<EpiMerge, pg8::SchedTwo, false, true>(lds, WA, S, E);
}
__device__ __forceinline__ void phase4(LAS unsigned char* lds, int l) {
    PH_COMMON();
    pg8::SchedPlain S; S.o.init(T / 256, D_MODEL / 256, G, bx); S.A = (const char*)(ws + WS_MERGED); S.B = (const char*)(ws + WS_WOUT); S.tstep = (size_t)256 * D_MODEL * 2;
    EpiOut E{(l == 0) ? arg_in(0) : (const float*)arg_out(), (float*)(ws + WS_PRE)};
    pg8::gemm_phase<EpiOut, pg8::SchedPlain, false, true>(lds, D_MODEL, S, E);
}
__device__ __forceinline__ void phase5(LAS unsigned char* lds, int l) {
    PH_COMMON();
    const float* g1 = arg_in(6) + (size_t)l * D_MODEL; const float* b1 = arg_in(7) + (size_t)l * D_MODEL;
    const float* w_router = arg_in(8); const float* b_router = arg_in(9);
    float* xout = arg_out(); bf16_t* XB = (bf16_t*)(ws + WS_XB); const float* PRE = (const float*)(ws + WS_PRE);
    int* LIST = (int*)(ws + WS_LIST); f32x2* RECW = (f32x2*)(ws + WS_RECW);
    unsigned* gcnt = (unsigned*)(ws + WS_CTL) + CW_CNT + 64 * l;
    PBS_BEGIN(1, lds);
    for (int i = tid; i < D_MODEL * 4; i += NWAVES * 64) { const int c = i >> 2, q = i & 3; *(LAS f32x4*)(lds + c * 64 + (c >> 2) * 16 + q * 16) = *(const f32x4*)(w_router + c * 16 + q * 4); }
    LAS unsigned* lcnt = (LAS unsigned*)(lds + 81920);
    LAS int* lrec = (LAS int*)(lds + 81920 + 256);
    if (tid < 32) lcnt[tid] = 0u;
    __syncthreads();
    PBS_END(1, lds); PBS_BEGIN(2, lds);
    int krow = 0;
    f32x4 nv[4];
    { const f32x4* pr = (const f32x4*)(PRE + (size_t)gw * D_MODEL) + lane;
#pragma unroll
      for (int j = 0; j < 4; ++j) nv[j] = pr[64 * j]; }
    for (int m = gw; m < T; m += NGW, ++krow) {
        f32x4 v[4]; float s = 0.f;
#pragma unroll
        for (int j = 0; j < 4; ++j) { v[j] = nv[j]; s += (v[j].x + v[j].y) + (v[j].z + v[j].w); }
        if (m + NGW < T) { const f32x4* pr = (const f32x4*)(PRE + (size_t)(m + NGW) * D_MODEL) + lane;
#pragma unroll
            for (int j = 0; j < 4; ++j) nv[j] = pr[64 * j]; }
        const float mean = wave_sum(s) * (1.f / D_MODEL); float s2 = 0.f;
#pragma unroll
        for (int j = 0; j < 4; ++j) { v[j] = v[j] - mean; s2 += (v[j].x * v[j].x + v[j].y * v[j].y) + (v[j].z * v[j].z + v[j].w * v[j].w); }
        const float rstd = 1.f / sqrtf(wave_sum(s2) * (1.f / D_MODEL) + LN_EPS);
        float lg[16];
#pragma unroll
        for (int e = 0; e < 16; ++e) lg[e] = 0.f;
#pragma unroll
        for (int j = 0; j < 4; ++j) { const f32x4 gg = *((const f32x4*)g1 + lane + 64 * j), bb = *((const f32x4*)b1 + lane + 64 * j);
            v[j] = v[j] * rstd * gg + bb;
            *((f32x4*)(xout + (size_t)m * D_MODEL) + lane + 64 * j) = v[j];
            u32x2 w; w.x = cvt_pk_bf16(v[j].x, v[j].y); w.y = cvt_pk_bf16(v[j].z, v[j].w); *((u32x2*)(XB + (size_t)m * D_MODEL) + lane + 64 * j) = w;
#pragma unroll
            for (int i = 0; i < 4; ++i) { const int c = 4 * (lane + 64 * j) + i; const LAS f32x4* wp = (const LAS f32x4*)(lds + c * 64 + (c >> 2) * 16); const float xv = v[j][i];
#pragma unroll
                for (int q = 0; q < 4; ++q) { const f32x4 wv = wp[q]; lg[4 * q + 0] += xv * wv.x; lg[4 * q + 1] += xv * wv.y; lg[4 * q + 2] += xv * wv.z; lg[4 * q + 3] += xv * wv.w; } } }
#pragma unroll
        for (int e = 0; e < 16; ++e) lg[e] = wave_sum(lg[e]) + b_router[e];
        int best = 0; float bv = lg[0];
#pragma unroll
        for (int e = 1; e < 16; ++e) if (lg[e] > bv) { bv = lg[e]; best = e; }
        const int grp = best >> 2; int e2 = -1; float v2 = 0.f;
#pragma unroll
        for (int e = 0; e < 16; ++e) { if ((e >> 2) == grp && e != best) { if (e2 < 0 || lg[e] > v2) { v2 = lg[e]; e2 = e; } } }
        const float w1 = fast_rcp(1.0f + fast_exp2((v2 - bv) * LOG2E)), w2 = 1.0f - w1;
        if (lane == 0) { RECW[m] = (f32x2){w1, w2};
            const int lp1 = (int)__hip_atomic_fetch_add(lcnt + best, 1u, __ATOMIC_RELAXED, __HIP_MEMORY_SCOPE_WORKGROUP);
            const int lp2 = (int)__hip_atomic_fetch_add(lcnt + e2, 1u, __ATOMIC_RELAXED, __HIP_MEMORY_SCOPE_WORKGROUP);
            LAS int* rp = lrec + (wave * 16 + krow) * 4; rp[0] = best; rp[1] = lp1; rp[2] = e2; rp[3] = lp2; }
    }
    PBS_END(2, lds);
    __syncthreads();
    PBS_BEGIN(3, lds);
    if (tid < 16) { const unsigned n = lcnt[tid]; lcnt[16 + tid] = n ? __hip_atomic_fetch_add(gcnt + tid, n, __ATOMIC_RELAXED, __HIP_MEMORY_SCOPE_AGENT) : 0u; }
    __syncthreads();
    if (lane == 0) { int k2 = 0;
        for (int m = gw; m < T; m += NGW, ++k2) { const LAS int* rp = lrec + (wave * 16 + k2) * 4;
            LIST[(size_t)rp[0] * T + lcnt[16 + rp[0]] + rp[1]] = m * 2; LIST[(size_t)rp[2] * T + lcnt[16 + rp[2]] + rp[3]] = m * 2 + 1; } }
    __syncthreads();
    PBS_END(3, lds);
}
__device__ __forceinline__ int moe_units(LAS unsigned char* lds, int l) {
    PH_COMMON();
    LAS int* utab = (LAS int*)(lds + UTAB_OFF);
    unsigned* gcnt = (unsigned*)(ws + WS_CTL) + CW_CNT + 64 * l;
    __syncthreads();
    if (tid == 0) {
        LAS int* ts = utab + 128; LAS int* ncnt = utab + 160;
        int acc_t = 0;
        for (int e = 0; e < 16; ++e) { const int n = (int)__hip_atomic_load(gcnt + e, __ATOMIC_RELAXED, __HIP_MEMORY_SCOPE_AGENT); ncnt[e] = n; ts[e] = acc_t; acc_t += (n + 255) / 256; }
        ts[16] = acc_t;
        const int nunits = acc_t * 4; int cnt = 0;
        for (int i = 0; cnt < 16; ++i) { const long L = (long)i * G + bx; if (L >= nunits) break;
            int U = (int)L; { const int q = nunits / 8, r = nunits % 8, xcd = U % 8, off = U / 8; U = (xcd < r ? xcd * (q + 1) : r * (q + 1) + (xcd - r) * q) + off; }
            const int tile = U >> 2, pn = U & 3; int e = 0; while (ts[e + 1] <= tile) ++e;
            const int mt = tile - ts[e]; const int n = ncnt[e]; const int nv = (n - 256 * mt) < 256 ? (n - 256 * mt) : 256;
            utab[cnt * 5 + 0] = e; utab[cnt * 5 + 1] = pn; utab[cnt * 5 + 2] = mt * 256; utab[cnt * 5 + 3] = nv; utab[cnt * 5 + 4] = tile * 256;
            ++cnt; }
        utab[192] = cnt;
    }
    __syncthreads();
    return utab[192];
}
__device__ __forceinline__ void phase6(LAS unsigned char* lds, int l) {
    const int nun = moe_units(lds, l);
    PH_COMMON();
    pg8::SchedMoe S; S.utab = (LAS int*)(lds + UTAB_OFF); S.nunits = nun; S.Abase = (const char*)(ws + WS_XB); S.Bbase = (const char*)(ws + WS_WGU); S.a_row_bytes = 0;
    S.b_exp_bytes = (size_t)1024 * D_MODEL * 2; S.b_tile_bytes = (size_t)256 * D_MODEL * 2; S.list = (const int*)(ws + WS_LIST); S.gather_k2 = D_MODEL * 2;
    EpiGU E{(bf16_t*)(ws + WS_H)};
    pg8::gemm_phase<EpiGU, pg8::SchedMoe, true, true>(lds, D_MODEL, S, E);
}
__device__ __forceinline__ void phase7(LAS unsigned char* lds, int l) {
    const int nun = moe_units(lds, l);
    PH_COMMON();
    pg8::SchedMoe S; S.utab = (LAS int*)(lds + UTAB_OFF); S.nunits = nun; S.Abase = (const char*)(ws + WS_H); S.Bbase = (const char*)(ws + WS_WD); S.a_row_bytes = (size_t)FE * 2;
    S.b_exp_bytes = (size_t)1024 * FE * 2; S.b_tile_bytes = (size_t)256 * FE * 2; S.list = (const int*)(ws + WS_LIST); S.gather_k2 = 0;
    EpiDown E{(bf16_t*)(ws + WS_Y), (const int*)(ws + WS_LIST)};
    pg8::gemm_phase<EpiDown, pg8::SchedMoe, false, true>(lds, FE, S, E);
}
__device__ __forceinline__ void phase8(LAS unsigned char* lds, int l) {
    PH_COMMON();
    const float* g2 = arg_in(13) + (size_t)l * D_MODEL; const float* b2 = arg_in(14) + (size_t)l * D_MODEL;
    float* xout = arg_out(); bf16_t* XB = (bf16_t*)(ws + WS_XB); const bf16_t* Y = (const bf16_t*)(ws + WS_Y); const f32x2* RECW = (const f32x2*)(ws + WS_RECW);
    PBS_BEGIN(4, lds);
    f32x4 nx[4]; u32x2 na[4], nc[4]; f32x2 nw;
#define P8_LOAD(mm) do { nw = RECW[mm]; const f32x4* xr = (const f32x4*)(xout + (size_t)(mm) * D_MODEL) + lane; \
        const u32x2* y0 = (const u32x2*)(Y + (size_t)(2 * (mm)) * D_MODEL) + lane; const u32x2* y1 = (const u32x2*)(Y + (size_t)(2 * (mm) + 1) * D_MODEL) + lane; \
        _Pragma("unroll") for (int j = 0; j < 4; ++j) { nx[j] = xr[64 * j]; na[j] = y0[64 * j]; nc[j] = y1[64 * j]; } } while (0)
    P8_LOAD(gw);
    for (int m = gw; m < T; m += NGW) {
        const f32x2 wv = nw; f32x4 cx[4]; u32x2 ca[4], cc[4];
#pragma unroll
        for (int j = 0; j < 4; ++j) { cx[j] = nx[j]; ca[j] = na[j]; cc[j] = nc[j]; }
        if (m + NGW < T) P8_LOAD(m + NGW);
        f32x4 v[4]; float s = 0.f;
#pragma unroll
        for (int j = 0; j < 4; ++j) { const f32x4 xv = cx[j]; const u32x2 a = ca[j], c = cc[j];
            v[j].x = xv.x * ALPHA + wv.x * bf_lo(a.x) + wv.y * bf_lo(c.x); v[j].y = xv.y * ALPHA + wv.x * bf_hi(a.x) + wv.y * bf_hi(c.x);
            v[j].z = xv.z * ALPHA + wv.x * bf_lo(a.y) + wv.y * bf_lo(c.y); v[j].w = xv.w * ALPHA + wv.x * bf_hi(a.y) + wv.y * bf_hi(c.y);
            s += (v[j].x + v[j].y) + (v[j].z + v[j].w); }
        const float mean = wave_sum(s) * (1.f / D_MODEL); float s2 = 0.f;
#pragma unroll
        for (int j = 0; j < 4; ++j) { v[j] = v[j] - mean; s2 += (v[j].x * v[j].x + v[j].y * v[j].y) + (v[j].z * v[j].z + v[j].w * v[j].w); }
        const float rstd = 1.f / sqrtf(wave_sum(s2) * (1.f / D_MODEL) + LN_EPS);
#pragma unroll
        for (int j = 0; j < 4; ++j) { const f32x4 gg = *((const f32x4*)g2 + lane + 64 * j), bb = *((const f32x4*)b2 + lane + 64 * j);
            v[j] = v[j] * rstd * gg + bb;
            *((f32x4*)(xout + (size_t)m * D_MODEL) + lane + 64 * j) = v[j];
            u32x2 w; w.x = cvt_pk_bf16(v[j].x, v[j].y); w.y = cvt_pk_bf16(v[j].z, v[j].w); *((u32x2*)(XB + (size_t)m * D_MODEL) + lane + 64 * j) = w; }
    }
#undef P8_LOAD
    PBS_END(4, lds);
    PBS_BEGIN(5, lds);
    if (l + 1 < DEPTH) { __syncthreads(); convert_weights(l + 1, lds); }
    PBS_END(5, lds);
}

__global__ void __launch_bounds__(NWAVES * 64, 2) fwd(Args args) {
    extern __shared__ __attribute__((aligned(16))) unsigned char lds_raw[];
    LAS unsigned char* lds = (LAS unsigned char*)lds_raw;
    volatile LAS unsigned* MISC = (volatile LAS unsigned*)(lds + MISC_OFF);
    for (int u = threadIdx.x; u < (LDS_BYTES - LDSCTL_OFF) / 4; u += NWAVES * 64) ((LAS unsigned*)(lds + LDSCTL_OFF))[u] = 0u;
    __syncthreads();
    XcdBarrier bar; bar.bar = (unsigned*)(arg_ws() + WS_CTL) + CW_BAR + arg_li() * XCD_BAR_WORDS; bar.x = 0; bar.st = nullptr;
    if (!MK_MULTI) bar = xcd_barrier_post((unsigned*)(arg_ws() + WS_CTL) + CW_BAR + arg_li() * XCD_BAR_WORDS, MISC + 8);
    const int lo = arg_lo(), hi = arg_hi();
#define IN(k) (lo <= (k) && (k) < hi)
#define SEAM(k) do { if (!MK_MULTI && IN(k) && IN((k) + 1)) { XcdBarrier b2_ = bar; asm volatile("" : "+s"(b2_.bar)); xcd_barrier(b2_); } } while (0)
    unsigned long long tacc = 0ull, tst = 0ull; (void)tacc; (void)tst;
#define PB_BEGIN(k) do { if (PROBE_PH == (k)) tst = __builtin_amdgcn_s_memrealtime(); } while (0)
#define PB_END(k) do { if (PROBE_PH == (k)) tacc += __builtin_amdgcn_s_memrealtime() - tst; } while (0)
    PB_BEGIN(0);
    if (HAS(0) && IN(0)) phase0(lds);
    SEAM(0);
    PB_END(0);
    for (int l = 0; l < DEPTH; ++l) {
        const int pb = 1 + l * PH_PER_LAYER;
        PB_BEGIN(1);
        if (HAS(1) && IN(pb + 0)) phase1(lds);
        SEAM(pb + 0);
        PB_END(1);
        PB_BEGIN(2);
        if (HAS(2) && IN(pb + 1)) phase2(lds, l);
        SEAM(pb + 1);
        PB_END(2);
        PB_BEGIN(3);
        if (HAS(3) && IN(pb + 2)) phase3(lds);
        SEAM(pb + 2);
        PB_END(3);
        PB_BEGIN(4);
        if (HAS(4) && IN(pb + 3)) phase4(lds, l);
        SEAM(pb + 3);
        PB_END(4);
        PB_BEGIN(5);
        if (HAS(5) && IN(pb + 4)) phase5(lds, l);
        SEAM(pb + 4);
        PB_END(5);
        PB_BEGIN(6);
        if (HAS(6) && IN(pb + 5)) phase6(lds, l);
        SEAM(pb + 5);
        PB_END(6);
        PB_BEGIN(7);
        if (HAS(7) && IN(pb + 6)) phase7(lds, l);
        SEAM(pb + 6);
        PB_END(7);
        PB_BEGIN(8);
        if (HAS(8) && IN(pb + 7)) phase8(lds, l);
        SEAM(pb + 7);
        PB_END(8);
    }
    if (PROBE_PH >= 100) tacc = *(volatile LAS unsigned long long*)(lds + MISC_OFF + 64);
    if (PROBE_PH >= 0 && blockIdx.x == 0) { const unsigned long long t0 = __builtin_amdgcn_s_memrealtime(); while (__builtin_amdgcn_s_memrealtime() - t0 < tacc * PROBE_MULT) __builtin_amdgcn_s_sleep(8); }
#undef IN
#undef SEAM
    (void)args;
}


#ifndef DBG_PROBE
#define DBG_PROBE 0
#endif
#ifndef DBG_LAYER
#define DBG_LAYER 0
#endif
#ifndef DBG_GAIN
#define DBG_GAIN 1.0f
#endif
#if DBG_PROBE
constexpr size_t WS_DXS = 528 * MiB, WS_DKV = 544 * MiB, WS_DST = 576 * MiB;
__device__ __forceinline__ int dbg_tok(int i) { const int sp[8] = {0, 1, 63, 64, 65, 575, 576, 4095}; return i < 8 ? sp[i] : (i * 67 + (i % 5) * 13 + 200) % 4096; }
__global__ void dbg_kv(const float* xs, const float* w_in, float* kv) {
    const int c = blockIdx.x * 256 + threadIdx.x, t0 = blockIdx.y * 16;
    const int col = c < 1024 ? 512 + c : 2048 + (c - 1024);
    float acc[16];
#pragma unroll
    for (int i = 0; i < 16; ++i) acc[i] = 0.f;
    for (int k = 0; k < D_MODEL; ++k) { const float w = w_in[(size_t)k * PROJ + col];
#pragma unroll
        for (int i = 0; i < 16; ++i) acc[i] += xs[(size_t)(t0 + i) * D_MODEL + k] * w; }
#pragma unroll
    for (int i = 0; i < 16; ++i) kv[(size_t)(t0 + i) * 2048 + c] = acc[i];
}
__device__ __forceinline__ float blk_sum(float v, float* red) { __syncthreads(); red[threadIdx.x] = v; __syncthreads(); for (int s = 128; s > 0; s >>= 1) { if ((int)threadIdx.x < s) red[threadIdx.x] += red[threadIdx.x + s]; __syncthreads(); } const float r = red[0]; __syncthreads(); return r; }
__device__ __forceinline__ float blk_max(float v, float* red) { __syncthreads(); red[threadIdx.x] = v; __syncthreads(); for (int s = 128; s > 0; s >>= 1) { if ((int)threadIdx.x < s) red[threadIdx.x] = fmaxf(red[threadIdx.x], red[threadIdx.x + s]); __syncthreads(); } const float r = red[0]; __syncthreads(); return r; }
__global__ void __launch_bounds__(256) dbg_tok_kernel(Args a, int L, int mode) {
    __shared__ float xs[1024], qa[512], qb[512], gl[2048], ya[512], yb[512], mg[1024], mixed[1024], x1[1024], hbuf[512], sc[4096], red[256], lgs[16];
    const int tid = threadIdx.x; const int t = dbg_tok(blockIdx.x);
    unsigned char* ws = a.ws;
    const float* xsnap = (const float*)(ws + WS_DXS); const float* kv = (const float*)(ws + WS_DKV); float* st = (float*)(ws + WS_DST);
    const float* w_in = a.in[1] + (size_t)L * D_MODEL * PROJ; const float* relb = a.in[2] + (size_t)L * NH * N_REL;
    const float* w_upa = a.in[3] + (size_t)L * WA * D_MODEL; const float* w_upb = a.in[4] + (size_t)L * WA * D_MODEL; const float* w_out = a.in[5] + (size_t)L * D_MODEL * D_MODEL;
    const float* g1 = a.in[6] + (size_t)L * D_MODEL; const float* b1 = a.in[7] + (size_t)L * D_MODEL; const float* w_router = a.in[8]; const float* b_router = a.in[9];
    const float* w_gate = a.in[10] + (size_t)L * NE * D_MODEL * FE; const float* w_up = a.in[11] + (size_t)L * NE * D_MODEL * FE; const float* w_down = a.in[12] + (size_t)L * NE * FE * D_MODEL;
    for (int i = tid; i < 1024; i += 256) xs[i] = xsnap[(size_t)t * D_MODEL + i];
    __syncthreads();
    for (int j = tid; j < 3072; j += 256) { const int col = j < 512 ? j : (j < 1024 ? 1536 + (j - 512) : 3072 + (j - 1024)); float s = 0.f;
        for (int k = 0; k < 1024; ++k) s += xs[k] * w_in[(size_t)k * PROJ + col];
        if (j < 512) qa[j] = s; else if (j < 1024) qb[j - 512] = s; else gl[j - 1024] = s; }
    __syncthreads();
    for (int h = 0; h < 8; ++h) {
        const int c = t >> 6; const int k0 = (c - 8) > 0 ? (c - 8) * 64 : 0, k1 = c * 64 + 63; const int nk = k1 - k0 + 1;
        float mx = -1e30f;
        for (int i = tid; i < nk; i += 256) { const int key = k0 + i; float s = 0.f; for (int d = 0; d < 64; ++d) s += qa[h * 64 + d] * kv[(size_t)key * 2048 + h * 64 + d];
            int rel = t - key; rel = rel < -128 ? -128 : (rel > 128 ? 128 : rel); s = s * 0.125f + relb[h * N_REL + rel + 128]; sc[i] = s; mx = fmaxf(mx, s); }
        mx = blk_max(mx, red);
        float sm = 0.f; for (int i = tid; i < nk; i += 256) { const float p = expf(sc[i] - mx); sc[i] = p; sm += p; }
        sm = blk_sum(sm, red);
        if (tid < 64) { float o = 0.f; for (int i = 0; i < nk; ++i) o += sc[i] * kv[(size_t)(k0 + i) * 2048 + 512 + h * 64 + tid]; ya[h * 64 + tid] = o / sm; }
        __syncthreads();
        for (int s = tid; s < t; s += 256) { float z = 0.f; for (int d = 0; d < 64; ++d) z += qb[h * 64 + d] * kv[(size_t)s * 2048 + 1024 + h * 64 + d]; sc[s] = z * 0.125f; }
        __syncthreads();
        if (tid < 64) { float y = 0.f; for (int s = 0; s < t; ++s) { const float beta = 1.0f / (1.0f + expf(-sc[s])); y += beta * (kv[(size_t)s * 2048 + 1536 + h * 64 + tid] - y); } yb[h * 64 + tid] = y; }
        __syncthreads();
    }
    if (mode == 0) {
        const bf16_t* OA = (const bf16_t*)(ws + WS_QA); const bf16_t* OB = (const bf16_t*)(ws + WS_QA + 3 * QKV_STRIDE);
        float na = 0.f, da = 0.f, nb = 0.f, db = 0.f;
        for (int i = tid; i < 512; i += 256) { const float oa = __uint_as_float((unsigned)OA[(size_t)t * WA + i] << 16), ob = __uint_as_float((unsigned)OB[(size_t)t * WA + i] << 16);
            na += (oa - ya[i]) * (oa - ya[i]); da += ya[i] * ya[i]; nb += (ob - yb[i]) * (ob - yb[i]); db += yb[i] * yb[i]; }
        na = blk_sum(na, red); da = blk_sum(da, red); nb = blk_sum(nb, red); db = blk_sum(db, red);
        if (tid == 0) { atomicAdd(st + 4, na); atomicAdd(st + 5, da); atomicAdd(st + 6, nb); atomicAdd(st + 7, db); }
        return; }
    for (int cidx = tid; cidx < 1024; cidx += 256) { float ua = 0.f, ub = 0.f; for (int k = 0; k < 512; ++k) { ua += ya[k] * w_upa[(size_t)k * D_MODEL + cidx]; ub += yb[k] * w_upb[(size_t)k * D_MODEL + cidx]; }
        const float ga = 1.0f / (1.0f + expf(-gl[cidx])), gb = 1.0f / (1.0f + expf(-gl[1024 + cidx])); mg[cidx] = ga * ua + gb * ub; }
    __syncthreads();
    float num = 0.f, den = 0.f;
    for (int cidx = tid; cidx < 1024; cidx += 256) { float s = 0.f; for (int k = 0; k < 1024; ++k) s += mg[k] * w_out[(size_t)k * D_MODEL + cidx]; mixed[cidx] = s;
        const float opt = ((const float*)(ws + WS_PRE))[(size_t)t * D_MODEL + cidx] - ALPHA * xs[cidx]; num += (opt - s) * (opt - s); den += s * s; }
    num = blk_sum(num, red); den = blk_sum(den, red);
    if (tid == 0) { atomicAdd(st + 0, num); atomicAdd(st + 1, den); }
    float s1 = 0.f; for (int i = tid; i < 1024; i += 256) { x1[i] = ALPHA * xs[i] + mixed[i]; s1 += x1[i]; }
    const float mean = blk_sum(s1, red) / 1024.f; float s2 = 0.f; for (int i = tid; i < 1024; i += 256) { const float d = x1[i] - mean; s2 += d * d; }
    const float rstd = 1.0f / sqrtf(blk_sum(s2, red) / 1024.f + LN_EPS);
    for (int i = tid; i < 1024; i += 256) x1[i] = (x1[i] - mean) * rstd * g1[i] + b1[i];
    __syncthreads();
    if (tid < 16) { float s = 0.f; for (int k = 0; k < 1024; ++k) s += x1[k] * w_router[k * 16 + tid]; lgs[tid] = s + b_router[tid]; }
    __syncthreads();
    int best = 0; for (int e = 1; e < 16; ++e) if (lgs[e] > lgs[best]) best = e;
    const int grp = best >> 2; int e2 = -1; for (int e = grp * 4; e < grp * 4 + 4; ++e) if (e != best && (e2 < 0 || lgs[e] > lgs[e2])) e2 = e;
    const float pw1 = 1.0f / (1.0f + expf(lgs[e2] - lgs[best])), pw2 = 1.0f - pw1;
    const f32x2 wo = ((const f32x2*)(ws + WS_RECW))[t]; const bf16_t* Y = (const bf16_t*)(ws + WS_Y);
    float fnum = 0.f, fden = 0.f; float ff[4] = {0.f, 0.f, 0.f, 0.f};
    for (int kk = 0; kk < 2; ++kk) { const int e = kk ? e2 : best; const float pw = kk ? pw2 : pw1;
        for (int f = tid; f < 512; f += 256) { float g = 0.f, u = 0.f; for (int k = 0; k < 1024; ++k) { g += x1[k] * w_gate[((size_t)e * D_MODEL + k) * FE + f]; u += x1[k] * w_up[((size_t)e * D_MODEL + k) * FE + f]; }
            hbuf[f] = g / (1.0f + expf(-g)) * u; }
        __syncthreads();
        for (int j = 0; j < 4; ++j) { const int cidx = tid + 256 * j; float s = 0.f; for (int f = 0; f < 512; ++f) s += hbuf[f] * w_down[((size_t)e * FE + f) * D_MODEL + cidx]; ff[j] += pw * s; }
        __syncthreads(); }
    for (int j = 0; j < 4; ++j) { const int cidx = tid + 256 * j; const float opt = wo.x * __uint_as_float((unsigned)Y[(size_t)(2 * t) * D_MODEL + cidx] << 16) + wo.y * __uint_as_float((unsigned)Y[(size_t)(2 * t + 1) * D_MODEL + cidx] << 16);
        fnum += (opt - ff[j]) * (opt - ff[j]); fden += ff[j] * ff[j]; }
    fnum = blk_sum(fnum, red); fden = blk_sum(fden, red);
    if (tid == 0) { atomicAdd(st + 2, fnum); atomicAdd(st + 3, fden); }
}
__global__ void dbg_inject(float* out, const float* st, int n4) {
    const float delta = sqrtf((DBG_PROBE == 1) ? st[0] / st[1] : (DBG_PROBE == 2) ? st[2] / st[3] : (DBG_PROBE == 3) ? st[4] / st[5] : st[6] / st[7]); const float f = 1.0f + DBG_GAIN * delta;
    for (int i = blockIdx.x * blockDim.x + threadIdx.x; i < n4; i += gridDim.x * blockDim.x) { f32x4 v = ((f32x4*)out)[i]; v = v * f; ((f32x4*)out)[i] = v; }
}
#endif

extern "C" void kernel_launch(void* const* d_in, const int* in_sizes, int n_in, void* d_out, int out_size, void* d_ws, size_t ws_size, hipStream_t stream) {
    static int grid = 0;
    if (grid == 0) {
        if (n_in != 15 || in_sizes[0] != T * D_MODEL || out_size != T * D_MODEL || ws_size < WS_END) {
            fprintf(stderr, "kernel_launch: unexpected shapes (n_in %d in0 %d out %d ws %zu; need ws >= %zu); nothing launched\n", n_in, n_in > 0 ? in_sizes[0] : -1, out_size, ws_size, (size_t)WS_END); grid = -1; return; }
        int dev = 0, cus = 0, per_cu = 0;
        if (hipGetDevice(&dev) != hipSuccess || hipDeviceGetAttribute(&cus, hipDeviceAttributeMultiprocessorCount, dev) != hipSuccess) { grid = -1; return; }
        if (hipFuncSetAttribute((const void*)fwd, hipFuncAttributeMaxDynamicSharedMemorySize, LDS_BYTES) != hipSuccess) { fprintf(stderr, "kernel_launch: hipFuncSetAttribute failed\n"); grid = -1; return; }
        if (hipOccupancyMaxActiveBlocksPerMultiprocessor(&per_cu, (const void*)fwd, NWAVES * 64, LDS_BYTES) != hipSuccess || per_cu < 1)
            fprintf(stderr, "kernel_launch: note: occupancy query reports %d workgroups per CU\n", per_cu);
        (void)hipGetLastError();
        grid = cus;
        if (grid != 256) fprintf(stderr, "kernel_launch: %d CUs; the attention deal needs 256\n", grid);
    }
    if (grid < 0) return;
    if (hipMemsetAsync((char*)d_ws + WS_CTL, 0, CTL_ZERO_BYTES, stream) != hipSuccess) { fprintf(stderr, "kernel_launch: memset failed\n"); return; }
    Args a{};
    for (int i = 0; i < 15; ++i) a.in[i] = (const float*)d_in[i];
    a.out = (float*)d_out; a.ws = (unsigned char*)d_ws;
#if DBG_PROBE
    {
        const int L = DBG_LAYER, p0 = 1 + 8 * L, p1 = 1 + 8 * (L + 1);
        hipMemsetAsync((char*)d_ws + WS_DST, 0, 64, stream);
        a.li = 0; a.ph_lo = 0; a.ph_hi = p0; hipLaunchKernelGGL(fwd, dim3(grid), dim3(NWAVES * 64), LDS_BYTES, stream, a);
        hipMemcpyAsync((char*)d_ws + WS_DXS, (L == 0) ? (const void*)d_in[0] : (const void*)d_out, (size_t)SEQ * D_MODEL * 4, hipMemcpyDeviceToDevice, stream);
        hipLaunchKernelGGL(dbg_kv, dim3(8, 256), dim3(256), 0, stream, (const float*)((char*)d_ws + WS_DXS), (const float*)d_in[1] + (size_t)L * D_MODEL * PROJ, (float*)((char*)d_ws + WS_DKV));
        a.li = 1; a.ph_lo = p0; a.ph_hi = p0 + 2; hipLaunchKernelGGL(fwd, dim3(grid), dim3(NWAVES * 64), LDS_BYTES, stream, a);
        hipLaunchKernelGGL(dbg_tok_kernel, dim3(64), dim3(256), 0, stream, a, L, 0);
        a.li = 3; a.ph_lo = p0 + 2; a.ph_hi = p1; hipLaunchKernelGGL(fwd, dim3(grid), dim3(NWAVES * 64), LDS_BYTES, stream, a);
        hipLaunchKernelGGL(dbg_tok_kernel, dim3(64), dim3(256), 0, stream, a, L, 1);
        if (p1 < N_PHASES) { a.li = 2; a.ph_lo = p1; a.ph_hi = N_PHASES; hipLaunchKernelGGL(fwd, dim3(grid), dim3(NWAVES * 64), LDS_BYTES, stream, a); }
        hipLaunchKernelGGL(dbg_inject, dim3(1024), dim3(256), 0, stream, (float*)d_out, (const float*)((char*)d_ws + WS_DST), T * D_MODEL / 4);
    }
#elif MK_MULTI
    for (int p = 0; p < N_PHASES; ++p) { a.ph_lo = p; a.ph_hi = p + 1; hipLaunchKernelGGL(fwd, dim3(grid), dim3(NWAVES * 64), LDS_BYTES, stream, a); }
#else
    a.ph_lo = 0; a.ph_hi = N_PHASES;
    hipLaunchKernelGGL(fwd, dim3(grid), dim3(NWAVES * 64), LDS_BYTES, stream, a);
#endif
    const hipError_t le = hipPeekAtLastError();
    if (le != hipSuccess) fprintf(stderr, "kernel_launch: launch failed: %s\n", hipGetErrorName(le));
}
```

```cpp
#include <hip/hip_runtime.h>
#include <cstdio>
#include <cstdint>

#ifndef MK_MULTI
#define MK_MULTI 0
#endif

#ifndef PROBE_PH
#define PROBE_PH (-1)
#endif
#ifndef PROBE_MULT
#define PROBE_MULT 1
#endif
#ifndef PHASE_MASK
#define PHASE_MASK 0x1ff
#endif
#define HAS(k) ((PHASE_MASK >> (k)) & 1)
#define LAS __attribute__((address_space(3)))
#define PBS_BEGIN(id, lds) do { if (PROBE_PH == 100 + (id) && threadIdx.x == 0) *(volatile LAS unsigned long long*)((lds) + MISC_OFF + 80) = __builtin_amdgcn_s_memrealtime(); } while (0)
#define PBS_END(id, lds) do { if (PROBE_PH == 100 + (id) && threadIdx.x == 0) { volatile LAS unsigned long long* p_ = (volatile LAS unsigned long long*)((lds) + MISC_OFF + 64); p_[0] = p_[0] + (__builtin_amdgcn_s_memrealtime() - p_[2]); } } while (0)
#define GAS __attribute__((address_space(1)))
typedef unsigned short bf16_t;
typedef short bf16x8 __attribute__((ext_vector_type(8)));
typedef short s16x4 __attribute__((ext_vector_type(4)));
typedef float f32x4 __attribute__((ext_vector_type(4)));
typedef float f32x2 __attribute__((ext_vector_type(2)));
typedef float f32x16 __attribute__((ext_vector_type(16)));
typedef unsigned u32x4 __attribute__((ext_vector_type(4)));
typedef unsigned u32x2 __attribute__((ext_vector_type(2)));

constexpr int D_MODEL = 1024, BATCH = 8, SEQ = 4096, DEPTH = 4, T = BATCH * SEQ;
constexpr int NH = 8, HD = 64, WA = NH * HD;
constexpr int PROJ = 3 * WA + 3 * WA + 2 * D_MODEL;
constexpr int N_REL = 257, NE = 16, FE = 512;
constexpr float ALPHA = 1.681792830507429f;
constexpr float LN_EPS = 1e-5f;
constexpr float LOG2E = 1.4426950408889634f;
constexpr float C2 = 0.125f * LOG2E;

constexpr size_t MiB = 1u << 20;
constexpr size_t WS_CTL = 0, CTL_ZERO_BYTES = 1 * MiB;
constexpr size_t WS_RECW = 2 * MiB;
constexpr size_t WS_LIST = 4 * MiB;
constexpr size_t WS_WIN = 8 * MiB, WS_WUPA = 18 * MiB, WS_WUPB = 19 * MiB, WS_WOUT = 20 * MiB, WS_WGU = 22 * MiB, WS_WD = 54 * MiB;
constexpr size_t WS_XB = 72 * MiB;
constexpr size_t WS_QA = 136 * MiB, QKV_STRIDE = 32 * MiB;
constexpr size_t WS_GA = 328 * MiB, WS_GB = 392 * MiB;
constexpr size_t WS_PRE = 328 * MiB;
constexpr size_t WS_MERGED = 456 * MiB;
constexpr size_t WS_Y = 136 * MiB;
constexpr size_t WS_H = 456 * MiB;
constexpr size_t WS_END = 526 * MiB;
constexpr int CW_TMO = 0;
constexpr int CW_BAR = 4096;
constexpr int CW_CNT = 32768;

constexpr int RING_BYTES = 131072;
constexpr int LDSCTL_OFF = RING_BYTES, MISC_OFF = LDSCTL_OFF + 320;
constexpr int UTAB_OFF = LDSCTL_OFF + 1024;
constexpr int LDS_BYTES = 147456;

#ifndef USE_F16
#define USE_F16 1
#endif
typedef _Float16 h16x2 __attribute__((ext_vector_type(2)));
typedef _Float16 h16x8 __attribute__((ext_vector_type(8)));
#if USE_F16
__device__ __forceinline__ unsigned cvt_pk_bf16(float lo, float hi) { const f32x2 v = {lo, hi}; return __builtin_bit_cast(unsigned, __builtin_convertvector(v, h16x2)); }
__device__ __forceinline__ float bf_lo(unsigned w) { return (float)__builtin_bit_cast(h16x2, w)[0]; }
__device__ __forceinline__ float bf_hi(unsigned w) { return (float)__builtin_bit_cast(h16x2, w)[1]; }
#define MFMA16(a, b, c) __builtin_amdgcn_mfma_f32_16x16x32_f16(__builtin_bit_cast(h16x8, a), __builtin_bit_cast(h16x8, b), c, 0, 0, 0)
#define MFMA32(a, b, c) __builtin_amdgcn_mfma_f32_32x32x16_f16(__builtin_bit_cast(h16x8, a), __builtin_bit_cast(h16x8, b), c, 0, 0, 0)
#else
__device__ __forceinline__ unsigned cvt_pk_bf16(float lo, float hi) { unsigned r; asm volatile("v_cvt_pk_bf16_f32 %0, %1, %2" : "=v"(r) : "v"(lo), "v"(hi)); return r; }
__device__ __forceinline__ float bf_lo(unsigned w) { return __uint_as_float(w << 16); }
__device__ __forceinline__ float bf_hi(unsigned w) { return __uint_as_float(w & 0xffff0000u); }
#define MFMA16(a, b, c) __builtin_amdgcn_mfma_f32_16x16x32_bf16(a, b, c, 0, 0, 0)
#define MFMA32(a, b, c) MFMA32(a, b, c)
#endif
__device__ __forceinline__ float h2f(bf16_t h) { return bf_lo((unsigned)h); }
__device__ __forceinline__ float fast_exp2(float x) { return __builtin_amdgcn_exp2f(x); }
__device__ __forceinline__ float fast_rcp(float x) { return __builtin_amdgcn_rcpf(x); }
__device__ __forceinline__ float sigmoidf_(float v) { return fast_rcp(1.0f + fast_exp2(-LOG2E * v)); }
__device__ __forceinline__ float wave_sum(float v) {
#define DPP_ADD(ctrl, rmask) v += __builtin_bit_cast(float, __builtin_amdgcn_update_dpp(0, __builtin_bit_cast(int, v), ctrl, rmask, 0xf, false))
    DPP_ADD(0x111, 0xf); DPP_ADD(0x112, 0xf); DPP_ADD(0x114, 0xf); DPP_ADD(0x118, 0xf);
    DPP_ADD(0x142, 0xa); DPP_ADD(0x143, 0xc);
#undef DPP_ADD
    return __builtin_bit_cast(float, __builtin_amdgcn_readlane(__builtin_bit_cast(int, v), 63));
}
#define LDS_WAIT() asm volatile("s_waitcnt lgkmcnt(0)" ::: "memory")
#define VM_WAIT() asm volatile("s_waitcnt vmcnt(0)" ::: "memory")

namespace pg8 {
constexpr int BM = 256, BK = 64, HALF = 128, HTB = HALF * BK * 2, STAGE_BYTES = 8 * HTB, NXCD = 8, WGM = 8;
__host__ __device__ __forceinline__ int lds_byte(int r, int c) { const int st = (r >> 4) * 2 + (c >> 5), rr = r & 15, cc = c & 31, ob = rr * 64 + cc * 2; return st * 1024 + (ob ^ (((ob >> 9) & 1) << 5)); }
__host__ __device__ __forceinline__ void stage_rc(int b, int& R, int& C) { const int st = b / 1024, sb = b % 1024, swz = sb ^ (((sb >> 9) & 1) << 5); R = (st >> 1) * 16 + swz / 64; C = (st & 1) * 32 + (swz % 64) / 2; }
__host__ __device__ __forceinline__ int perm32(int rho) { const int n = rho >> 4, i = rho & 15; return 8 * (i >> 2) + 4 * n + (i & 3); }

struct Unit { const char* A; const char* B; int pm, pn, x0, x1, x2; };

struct TileOrder {
    int nM, nN, nwg, G, c;
    __device__ __forceinline__ void init(int nM_, int nN_, int G_, int c_) { nM = nM_; nN = nN_; nwg = nM * nN; G = G_; c = c_; }
    __device__ __forceinline__ bool next(int i, int& pm, int& pn) const {
        const long L = (long)i * G + c; if (L >= nwg) return false;
        int wgid = (int)L; { const int q = nwg / NXCD, r = nwg % NXCD, xcd = wgid % NXCD, off = wgid / NXCD; wgid = (xcd < r ? xcd * (q + 1) : r * (q + 1) + (xcd - r) * q) + off; }
        const int nig = WGM * nN, gid = wgid / nig, fm = gid * WGM, gsz = (nM - fm) < WGM ? (nM - fm) : WGM;
        pm = fm + ((wgid % nig) % gsz); pn = (wgid % nig) / gsz; return true;
    }
};

template <class Epi, class Sched, bool GATHER, bool ALIGN_EPI>
__device__ __forceinline__ void gemm_phase(LAS unsigned char* lds, const int K, const Sched& S, const Epi& E) {
    int tid_ = threadIdx.x; asm volatile("" : "+v"(tid_));
    const int tid = tid_, wid = __builtin_amdgcn_readfirstlane(tid >> 6), lane = tid & 63, wr = wid >> 2, wc = wid & 3, fr = lane & 15, fq = lane >> 4;
    const int nt = K / BK;
    unsigned voffB[2]; int RA[2], CA2[2];
#pragma unroll
    for (int i = 0; i < 2; ++i) { int R, C; stage_rc(tid * 16 + i * 8192, R, C); const int Rb = Epi::PERM ? ((R & ~31) + perm32(R & 31)) : R;
        RA[i] = R; CA2[i] = C * 2; voffB[i] = (unsigned)(Rb * K + C) * 2u; }
    const size_t kstep = (size_t)(BK * 2);
    const size_t hstep = (size_t)HALF * K * 2;
    const unsigned ldsw = (unsigned)wid * 1024u;
    const int aoff = lds_byte(wr * 64 + fr, fq * 8), boff = lds_byte(wc * 32 + fr, fq * 8);
#define PG8_SA(b, h) (((b) * 2 + (h)) * HTB)
#define PG8_SB(b, h) ((4 + (b) * 2 + (h)) * HTB)
#define PG8_STAGE(bufoff, gbase, voff) do { _Pragma("unroll") for (int _i = 0; _i < 2; ++_i) \
        __builtin_amdgcn_global_load_lds((const unsigned*)((const char*)(gbase) + (voff)[_i]), (LAS unsigned*)(lds + (bufoff) + ldsw + _i * 8192), 16, 0, 0); } while (0)
#define PG8_LDA(dst, b, h) do { _Pragma("unroll") for (int m = 0; m < 4; ++m) _Pragma("unroll") for (int k = 0; k < 2; ++k) dst[m][k] = *(const LAS bf16x8*)(lds + PG8_SA(b, h) + aoff + m * 2048 + k * 1024); } while (0)
#define PG8_LDB(dst, b, h) do { _Pragma("unroll") for (int n = 0; n < 2; ++n) _Pragma("unroll") for (int k = 0; k < 2; ++k) dst[n][k] = *(const LAS bf16x8*)(lds + PG8_SB(b, h) + boff + n * 2048 + k * 1024); } while (0)
#define PG8_MMA(ai, bj, At, Bt) do { __builtin_amdgcn_s_setprio(1); _Pragma("unroll") for (int m = 0; m < 4; ++m) _Pragma("unroll") for (int n = 0; n < 2; ++n) _Pragma("unroll") for (int k = 0; k < 2; ++k) \
        acc[ai][bj][m][n] = MFMA16(Bt[n][k], At[m][k], acc[ai][bj][m][n]); __builtin_amdgcn_s_setprio(0); } while (0)
#define PG8_WAIT_V(n) asm volatile("s_waitcnt vmcnt(" #n ")" ::: "memory")
#define PG8_WAIT_L(n) asm volatile("s_waitcnt lgkmcnt(" #n ")" ::: "memory")
#define PG8_BAR __builtin_amdgcn_s_barrier()
#define PG8_SCHED __builtin_amdgcn_sched_barrier(0)
    Unit cur, nxt; int ui = 0;
    if (!S.next(0, cur)) return;
    unsigned oc0[2], oc1[2], on0[2], on1[2];
    if constexpr (GATHER) { S.offs(cur, RA, CA2, oc0, oc1); }
    else {
#pragma unroll
        for (int i = 0; i < 2; ++i) { oc0[i] = (unsigned)(RA[i] * K) * 2u + (unsigned)CA2[i]; oc1[i] = oc0[i]; on0[i] = oc0[i]; on1[i] = oc0[i]; } }
    const size_t ah = GATHER ? (size_t)0 : hstep;
    f32x4 acc[2][2][4][2];
#pragma unroll
    for (int a = 0; a < 2; ++a)
#pragma unroll
        for (int b = 0; b < 2; ++b)
#pragma unroll
            for (int m = 0; m < 4; ++m)
#pragma unroll
                for (int n = 0; n < 2; ++n) acc[a][b][m][n] = (f32x4){0.f, 0.f, 0.f, 0.f};
    bf16x8 At[4][2], B0[2][2], B1[2][2];
    const char* cA = cur.A; const char* cB = cur.B;
    PG8_STAGE(PG8_SB(0, 0), cB, voffB); PG8_STAGE(PG8_SB(0, 1), cB + hstep, voffB); PG8_STAGE(PG8_SA(0, 0), cA, oc0); PG8_STAGE(PG8_SA(0, 1), cA + ah, oc1);
    if (wr == 1) PG8_BAR;
    PG8_WAIT_V(2); PG8_BAR;
    PG8_STAGE(PG8_SB(1, 0), cB + kstep, voffB); PG8_STAGE(PG8_SA(1, 0), cA + kstep, oc0); PG8_STAGE(PG8_SB(1, 1), cB + hstep + kstep, voffB);
    PG8_WAIT_V(6); PG8_BAR;
    for (;;) {
        const bool has_next = S.next(ui + 1, nxt);
        const char* nA = has_next ? nxt.A : cA; const char* nB = has_next ? nxt.B : cB;
        if constexpr (GATHER) { if (has_next) S.offs(nxt, RA, CA2, on0, on1); else { on0[0] = oc0[0]; on0[1] = oc0[1]; on1[0] = oc1[0]; on1[1] = oc1[1]; } }
        for (int t = 0; t < nt; t += 2) {
            const bool last = (t == nt - 2);
            const char* a1 = cA + (size_t)(t + 1) * kstep;
            const char* a2 = last ? nA : cA + (size_t)(t + 2) * kstep; const char* b2 = last ? nB : cB + (size_t)(t + 2) * kstep;
            const char* a3 = a2 + kstep; const char* b3 = b2 + kstep;
            unsigned o20[2], o21[2];
            if constexpr (GATHER) { o20[0] = last ? on0[0] : oc0[0]; o20[1] = last ? on0[1] : oc0[1]; o21[0] = last ? on1[0] : oc1[0]; o21[1] = last ? on1[1] : oc1[1]; }
            else { o20[0] = oc0[0]; o20[1] = oc0[1]; o21[0] = oc0[0]; o21[1] = oc0[1]; }
            PG8_LDB(B0, 0, 0); PG8_LDB(B1, 0, 1); PG8_SCHED; PG8_LDA(At, 0, 0); PG8_STAGE(PG8_SA(1, 1), a1 + ah, oc1);
            PG8_WAIT_V(8); PG8_WAIT_L(0); PG8_BAR; PG8_MMA(0, 0, At, B0); PG8_MMA(0, 1, At, B1); PG8_BAR; PG8_SCHED;
            PG8_LDA(At, 0, 1); PG8_STAGE(PG8_SB(0, 0), b2, voffB); PG8_STAGE(PG8_SB(0, 1), b2 + hstep, voffB); PG8_STAGE(PG8_SA(0, 0), a2, o20);
            PG8_WAIT_V(8); PG8_WAIT_L(0); PG8_BAR; PG8_MMA(1, 0, At, B0); PG8_MMA(1, 1, At, B1); PG8_BAR; PG8_SCHED;
            PG8_LDB(B0, 1, 0); PG8_LDB(B1, 1, 1); PG8_SCHED; PG8_LDA(At, 1, 0); PG8_STAGE(PG8_SA(0, 1), a2 + ah, o21);
            PG8_WAIT_V(8); PG8_WAIT_L(0); PG8_BAR; PG8_MMA(0, 0, At, B0); PG8_MMA(0, 1, At, B1); PG8_BAR; PG8_SCHED;
            PG8_LDA(At, 1, 1); PG8_STAGE(PG8_SB(1, 0), b3, voffB); PG8_STAGE(PG8_SB(1, 1), b3 + hstep, voffB); PG8_STAGE(PG8_SA(1, 0), a3, o20);
            PG8_WAIT_V(8); PG8_WAIT_L(0); PG8_BAR; PG8_MMA(1, 0, At, B0); PG8_MMA(1, 1, At, B1); PG8_BAR; PG8_SCHED;
        }
        if constexpr (ALIGN_EPI) { if (wr == 0) PG8_BAR; }
        E(acc, cur, wr, wc, fr, fq);
        if (!has_next) break;
#pragma unroll
        for (int a = 0; a < 2; ++a)
#pragma unroll
            for (int b = 0; b < 2; ++b)
#pragma unroll
                for (int m = 0; m < 4; ++m)
#pragma unroll
                    for (int n = 0; n < 2; ++n) acc[a][b][m][n] = (f32x4){0.f, 0.f, 0.f, 0.f};
        cur = nxt; cA = nA; cB = nB; ++ui;
        if constexpr (GATHER) { oc0[0] = on0[0]; oc0[1] = on0[1]; oc1[0] = on1[0]; oc1[1] = on1[1]; }
        if constexpr (ALIGN_EPI) { if (wr == 1) PG8_BAR; }
    }
    PG8_WAIT_V(0);
    if constexpr (!ALIGN_EPI) { if (wr == 0) PG8_BAR; }
    PG8_BAR;
#undef PG8_SA
#undef PG8_SB
#undef PG8_STAGE
#undef PG8_LDA
#undef PG8_LDB
#undef PG8_MMA
#undef PG8_WAIT_V
#undef PG8_WAIT_L
#undef PG8_BAR
#undef PG8_SCHED
}

struct SchedPlain {
    TileOrder o; const char* A; const char* B; size_t tstep;
    __device__ __forceinline__ bool next(int i, Unit& u) const { int pm, pn; if (!o.next(i, pm, pn)) return false; u.pm = pm; u.pn = pn; u.x0 = 0; u.x1 = 0; u.x2 = 0; u.A = A + (size_t)pm * tstep; u.B = B + (size_t)pn * tstep; return true; }
};
struct SchedTwo {
    TileOrder o; const char* A0; const char* A1; const char* B0; const char* B1; size_t tstep;
    __device__ __forceinline__ bool next(int i, Unit& u) const { int pm, pn; if (!o.next(i >> 1, pm, pn)) return false; const int br = i & 1; u.pm = pm; u.pn = pn; u.x0 = br; u.x1 = 0; u.x2 = 0;
        u.A = (br ? A1 : A0) + (size_t)pm * tstep; u.B = (br ? B1 : B0) + (size_t)pn * tstep; return true; }
};
struct SchedMoe {
    const LAS int* utab; int nunits;
    const char* Abase; const char* Bbase; size_t a_row_bytes; size_t b_exp_bytes; size_t b_tile_bytes; const int* list; int gather_k2;
    __device__ __forceinline__ bool next(int i, Unit& u) const {
        if (i >= nunits) return false;
        const int e = utab[i * 5 + 0], pn = utab[i * 5 + 1], lo_ = utab[i * 5 + 2], nv = utab[i * 5 + 3], rb = utab[i * 5 + 4];
        u.pm = e; u.pn = pn; u.x0 = lo_; u.x1 = nv; u.x2 = rb;
        u.A = Abase + (size_t)rb * a_row_bytes; u.B = Bbase + (size_t)e * b_exp_bytes + (size_t)pn * b_tile_bytes; return true; }
    __device__ __forceinline__ void offs(const Unit& u, const int (&RA)[2], const int (&CA2)[2], unsigned (&o0)[2], unsigned (&o1)[2]) const {
        const int* lp = list + (size_t)u.pm * T + u.x0;
#pragma unroll
        for (int i = 0; i < 2; ++i) {
            int r0 = RA[i], r1 = RA[i] + HALF; r0 = r0 < u.x1 ? r0 : u.x1 - 1; r1 = r1 < u.x1 ? r1 : u.x1 - 1;
            const int t0 = lp[r0] >> 1, t1 = lp[r1] >> 1;
            o0[i] = (unsigned)t0 * (unsigned)gather_k2 + (unsigned)CA2[i]; o1[i] = (unsigned)t1 * (unsigned)gather_k2 + (unsigned)CA2[i]; }
    }
};
}

using pg8::Unit;
struct EpiInProj {
    static constexpr bool PERM = true;
    bf16_t* qkv; bf16_t* gates;
    __device__ __forceinline__ void operator()(const f32x4 (&acc)[2][2][4][2], const Unit& u, int wr, int wc, int fr, int fq) const {
        const int pn = u.pn; bf16_t* base; int ldc, colt; float sc = 1.f; const bool gate = pn >= 12;
        if (!gate) { const int piece = pn >> 1; base = qkv + (size_t)piece * (QKV_STRIDE / 2); ldc = WA; colt = (pn & 1) * 256; if (piece == 0 || piece == 3) sc = C2; }
        else { const int g = (pn - 12) >> 2; base = gates + (size_t)g * ((size_t)T * D_MODEL); ldc = D_MODEL; colt = ((pn - 12) & 3) * 256; }
        const int row0 = u.pm * 256 + wr * 64 + fr, col0 = colt + wc * 32 + 8 * fq;
#pragma unroll
        for (int ai = 0; ai < 2; ++ai)
#pragma unroll
            for (int m = 0; m < 4; ++m) { bf16_t* rowp = base + (size_t)(row0 + ai * 128 + m * 16) * ldc + col0;
#pragma unroll
                for (int bj = 0; bj < 2; ++bj) { f32x4 v0 = acc[ai][bj][m][0], v1 = acc[ai][bj][m][1];
                    if (gate) {
#pragma unroll
                        for (int i = 0; i < 4; ++i) { v0[i] = sigmoidf_(v0[i]); v1[i] = sigmoidf_(v1[i]); } }
                    else { v0 = v0 * sc; v1 = v1 * sc; }
                    u32x4 w; w.x = cvt_pk_bf16(v0[0], v0[1]); w.y = cvt_pk_bf16(v0[2], v0[3]); w.z = cvt_pk_bf16(v1[0], v1[1]); w.w = cvt_pk_bf16(v1[2], v1[3]);
                    *(u32x4*)(rowp + bj * 128) = w; } }
    }
};
struct EpiMerge {
    static constexpr bool PERM = true;
    const bf16_t* ga; const bf16_t* gb; bf16_t* merged;
    __device__ __forceinline__ void operator()(const f32x4 (&acc)[2][2][4][2], const Unit& u, int wr, int wc, int fr, int fq) const {
        const int br = u.x0; const bf16_t* g = br ? gb : ga;
        const int row0 = u.pm * 256 + wr * 64 + fr, col0 = u.pn * 256 + wc * 32 + 8 * fq;
#pragma unroll
        for (int ai = 0; ai < 2; ++ai)
#pragma unroll
            for (int m = 0; m < 4; ++m) { const size_t ro = (size_t)(row0 + ai * 128 + m * 16) * D_MODEL + col0;
#pragma unroll
                for (int bj = 0; bj < 2; ++bj) { const f32x4 a0 = acc[ai][bj][m][0], a1 = acc[ai][bj][m][1];
                    const u32x4 gw = *(const u32x4*)(g + ro + bj * 128);
                    float v[8];
                    v[0] = bf_lo(gw.x) * a0[0]; v[1] = bf_hi(gw.x) * a0[1]; v[2] = bf_lo(gw.y) * a0[2]; v[3] = bf_hi(gw.y) * a0[3];
                    v[4] = bf_lo(gw.z) * a1[0]; v[5] = bf_hi(gw.z) * a1[1]; v[6] = bf_lo(gw.w) * a1[2]; v[7] = bf_hi(gw.w) * a1[3];
                    if (br) { const u32x4 pw = *(const u32x4*)(merged + ro + bj * 128);
                        v[0] += bf_lo(pw.x); v[1] += bf_hi(pw.x); v[2] += bf_lo(pw.y); v[3] += bf_hi(pw.y); v[4] += bf_lo(pw.z); v[5] += bf_hi(pw.z); v[6] += bf_lo(pw.w); v[7] += bf_hi(pw.w); }
                    u32x4 w; w.x = cvt_pk_bf16(v[0], v[1]); w.y = cvt_pk_bf16(v[2], v[3]); w.z = cvt_pk_bf16(v[4], v[5]); w.w = cvt_pk_bf16(v[6], v[7]);
                    *(u32x4*)(merged + ro + bj * 128) = w; } }
    }
};
struct EpiOut {
    static constexpr bool PERM = true;
    const float* xin; const bf16_t* xb; bf16_t* pre;
    __device__ __forceinline__ void operator()(const f32x4 (&acc)[2][2][4][2], const Unit& u, int wr, int wc, int fr, int fq) const {
        const int row0 = u.pm * 256 + wr * 64 + fr, col0 = u.pn * 256 + wc * 32 + 8 * fq;
#pragma unroll
        for (int ai = 0; ai < 2; ++ai)
#pragma unroll
            for (int m = 0; m < 4; ++m) { const size_t ro = (size_t)(row0 + ai * 128 + m * 16) * D_MODEL + col0;
#pragma unroll
                for (int bj = 0; bj < 2; ++bj) { f32x4 x0, x1;
                    if (xin) { x0 = *(const f32x4*)(xin + ro + bj * 128); x1 = *(const f32x4*)(xin + ro + bj * 128 + 4); }
                    else { const u32x4 xw = *(const u32x4*)(xb + ro + bj * 128); x0 = (f32x4){bf_lo(xw.x), bf_hi(xw.x), bf_lo(xw.y), bf_hi(xw.y)}; x1 = (f32x4){bf_lo(xw.z), bf_hi(xw.z), bf_lo(xw.w), bf_hi(xw.w)}; }
                    const f32x4 v0 = x0 * ALPHA + acc[ai][bj][m][0], v1 = x1 * ALPHA + acc[ai][bj][m][1];
                    u32x4 w; w.x = cvt_pk_bf16(v0[0], v0[1]); w.y = cvt_pk_bf16(v0[2], v0[3]); w.z = cvt_pk_bf16(v1[0], v1[1]); w.w = cvt_pk_bf16(v1[2], v1[3]);
                    *(u32x4*)(pre + ro + bj * 128) = w; } }
    }
};
struct EpiGU {
    static constexpr bool PERM = true;
    bf16_t* h;
    __device__ __forceinline__ void operator()(const f32x4 (&acc)[2][2][4][2], const Unit& u, int wr, int wc, int fr, int fq) const {
        const int row0 = u.x2 + wr * 64 + fr, col0 = u.pn * 128 + wc * 32 + 8 * fq;
#pragma unroll
        for (int ai = 0; ai < 2; ++ai)
#pragma unroll
            for (int m = 0; m < 4; ++m) { bf16_t* rowp = h + (size_t)(row0 + ai * 128 + m * 16) * FE + col0; float v[8];
#pragma unroll
                for (int n = 0; n < 2; ++n)
#pragma unroll
                    for (int i = 0; i < 4; ++i) { const float g = acc[ai][0][m][n][i], uu = acc[ai][1][m][n][i]; v[n * 4 + i] = g * sigmoidf_(g) * uu; }
                u32x4 w; w.x = cvt_pk_bf16(v[0], v[1]); w.y = cvt_pk_bf16(v[2], v[3]); w.z = cvt_pk_bf16(v[4], v[5]); w.w = cvt_pk_bf16(v[6], v[7]);
                *(u32x4*)rowp = w; }
    }
};
struct EpiDown {
    static constexpr bool PERM = true;
    bf16_t* y; const int* list;
    __device__ __forceinline__ void operator()(const f32x4 (&acc)[2][2][4][2], const Unit& u, int wr, int wc, int fr, int fq) const {
        const int nv = u.x1, loff = u.x0;
        const int* lp = list + (size_t)u.pm * T + loff;
        const int col0 = u.pn * 256 + wc * 32 + 8 * fq;
#pragma unroll
        for (int ai = 0; ai < 2; ++ai)
#pragma unroll
            for (int m = 0; m < 4; ++m) { const int lr = ai * 128 + wr * 64 + m * 16 + fr;
                if (lr < nv) { const int entry = lp[lr]; bf16_t* rowp = y + (size_t)entry * D_MODEL + col0;
#pragma unroll
                    for (int bj = 0; bj < 2; ++bj) { const f32x4 v0 = acc[ai][bj][m][0], v1 = acc[ai][bj][m][1];
                        u32x4 w; w.x = cvt_pk_bf16(v0[0], v0[1]); w.y = cvt_pk_bf16(v0[2], v0[3]); w.z = cvt_pk_bf16(v1[0], v1[1]); w.w = cvt_pk_bf16(v1[2], v1[3]);
                        *(u32x4*)(rowp + bj * 128) = w; } } }
    }
};

namespace att {
constexpr int DM = WA;
constexpr int SLOTB = 8192, NSLOT = 8, PFD = 3;
constexpr int LDS_K = 0, LDS_V = NSLOT * SLOTB, LDS_WS = LDSCTL_OFF + 4096, LDS_TAB = LDS_WS + 8 * 256, LDS_FLG = LDS_TAB + 1024, LDS_END = LDS_FLG + 64, LDS_OST = 0;
static_assert(2 * NSLOT * SLOTB <= RING_BYTES && LDS_END <= LDS_BYTES, "attention LDS map");
#define SBAR() __builtin_amdgcn_sched_barrier(0)
#define WAIT_BAR0() asm volatile("s_waitcnt vmcnt(0) lgkmcnt(0)\n\ts_barrier" ::: "memory")
#define WAIT_BARN(N) asm volatile("s_waitcnt vmcnt(" #N ") lgkmcnt(0)\n\ts_barrier" ::: "memory")
#define STEP_WAIT(tcur, tlow) do { if ((tcur) - 2 >= (tlow)) { WAIT_BARN(4); } else if ((tcur) - 1 >= (tlow)) { WAIT_BARN(2); } else { WAIT_BAR0(); } } while (0)
__device__ __forceinline__ int crow(int r, int hi) { return (r & 3) + 8 * (r >> 2) + 4 * hi; }
__device__ __forceinline__ void glds16(const void* gsrc, unsigned lds_dst) { unsigned keep;
    asm volatile("s_mov_b32 %0, m0\n\ts_mov_b32 m0, %2\n\ts_nop 0\n\tglobal_load_lds_dwordx4 %1, off\n\ts_mov_b32 m0, %0" : "=&s"(keep) : "v"(gsrc), "s"(lds_dst) : "memory"); }
__device__ __forceinline__ float max3f(float a, float b, float c) { return __builtin_fmaxf(__builtin_fmaxf(a, b), c); }
__device__ __forceinline__ void qkt(f32x16& p0, f32x16& p1, const LAS char* Kslot, const bf16x8* qr, const f32x16& cin, int r32, int hi) {
    const LAS char* kb = Kslot + hi * 1024 + r32 * 16;
#pragma unroll
    for (int d0 = 0; d0 < 4; ++d0) {
        const bf16x8 b0 = *(const LAS bf16x8*)(kb + d0 * 2048);
        const bf16x8 b1 = *(const LAS bf16x8*)(kb + d0 * 2048 + 512);
        if (d0 == 0) { p0 = MFMA32(b0, qr[0], cin); p1 = MFMA32(b1, qr[0], cin); }
        else { p0 = MFMA32(b0, qr[d0], p0); p1 = MFMA32(b1, qr[d0], p1); } }
}
__device__ __forceinline__ float rowmax(const f32x16& p0, const f32x16& p1) {
    float a = max3f(p0[0], p0[1], p1[0]), b = max3f(p0[2], p0[3], p1[1]); a = max3f(a, p1[2], p1[3]);
#pragma unroll
    for (int r = 4; r < 16; r += 4) { a = max3f(a, p0[r], p0[r + 1]); b = max3f(b, p0[r + 2], p0[r + 3]); a = max3f(a, p1[r], p1[r + 1]); b = max3f(b, p1[r + 2], p1[r + 3]); }
    const float m = __builtin_fmaxf(a, b);
    auto rr = __builtin_amdgcn_permlane32_swap(__float_as_uint(m), __float_as_uint(m), false, false);
    return __builtin_fmaxf(__uint_as_float(rr[0]), __uint_as_float(rr[1]));
}
__device__ __forceinline__ void pv(f32x16* o, int vb, bf16x8 pa0, bf16x8 pa1, bf16x8 pa2, bf16x8 pa3) {
#pragma unroll
    for (int d0 = 0; d0 < 2; ++d0) { s16x4 lo[4], hi[4];
#pragma unroll
        for (int ks = 0; ks < 4; ++ks) {
            asm volatile("ds_read_b64_tr_b16 %0,%1 offset:%c2" : "=&v"(lo[ks]) : "v"(vb), "i"(d0 * 4096 + ks * 1024) : "memory");
            asm volatile("ds_read_b64_tr_b16 %0,%1 offset:%c2" : "=&v"(hi[ks]) : "v"(vb), "i"(d0 * 4096 + ks * 1024 + 512) : "memory"); }
        asm volatile("s_waitcnt lgkmcnt(0)" ::: "memory"); SBAR();
#define PK(k) (bf16x8){lo[k][0], lo[k][1], lo[k][2], lo[k][3], hi[k][0], hi[k][1], hi[k][2], hi[k][3]}
        o[d0] = MFMA32(pa0, PK(0), o[d0]);
        o[d0] = MFMA32(pa1, PK(1), o[d0]);
        o[d0] = MFMA32(pa2, PK(2), o[d0]);
        o[d0] = MFMA32(pa3, PK(3), o[d0]);
#undef PK
    }
}
#define PKW(P, B) cvt_pk_bf16(P[B], P[B + 1])
__device__ __forceinline__ void store_o(const f32x16* o, const float* rs, bf16_t* Ow, LAS char* shm, int wid, int lane, int r32, int hi) {
    LAS bf16_t* stg = (LAS bf16_t*)(shm + LDS_OST) + wid * 2048;
#pragma unroll
    for (int r = 0; r < 16; ++r) { const int orow = crow(r, hi);
#pragma unroll
        for (int d0 = 0; d0 < 2; ++d0) stg[orow * 64 + d0 * 32 + r32] = (bf16_t)(cvt_pk_bf16(o[d0][r] * rs[r], 0.f) & 0xffffu); }
    LDS_WAIT();
#pragma unroll
    for (int i = 0; i < 4; ++i) { const int row = i * 8 + (lane >> 3), ch = lane & 7; const u32x4 v = *(const LAS u32x4*)(stg + row * 64 + ch * 8); *(u32x4*)(Ow + (size_t)row * DM + ch * 8) = v; }
}

#define DMA_K(t) glds16(ksrc + (long)(t) * 64 * DM, (unsigned)__builtin_amdgcn_readfirstlane(kdst + ((t) & (NSLOT - 1)) * SLOTB))
#define DMA_V(t) glds16(vsrc + (long)(t) * 64 * DM, (unsigned)__builtin_amdgcn_readfirstlane(vdst + ((t) & (NSLOT - 1)) * SLOTB))
__device__ __forceinline__ void attn_a_unit(int b, int h, int u, const bf16_t* Q, const bf16_t* K, const bf16_t* V, bf16_t* O, const float* bias_h, LAS char* shm) {
    int tid_ = threadIdx.x; asm volatile("" : "+v"(tid_)); const int tid = tid_, lane = tid & 63, r32 = lane & 31, hi = lane >> 5; const int wid = __builtin_amdgcn_readfirstlane(tid >> 6);
    const long rowbase = (long)b * SEQ; const int q0 = u * 256;
    const bf16_t* Qw = Q + (rowbase + q0 + wid * 32) * DM + h * HD;
    const bf16_t* Kh = K + rowbase * DM + h * HD; const bf16_t* Vh = V + rowbase * DM + h * HD;
    const unsigned lds0 = (unsigned)(size_t)shm;
    LAS float* wsf = (LAS float*)(shm + LDS_WS) + wid * 64;
    LAS float* tab = (LAS float*)(shm + LDS_TAB);
    if (tid < 256) { int rel = tid - 64; rel = rel < -128 ? -128 : (rel > 128 ? 128 : rel); tab[tid] = bias_h[rel + 128] * LOG2E; }
    const float bfar = bias_h[256] * LOG2E;
    const bf16_t* ksrc = Kh + (long)lane * DM + wid * 8;
    const bf16_t* vsrc = Vh + (long)(16 * (wid & 3) + (lane >> 2)) * DM + (wid >> 2) * 32 + (lane & 3) * 8;
    const unsigned kdst = lds0 + LDS_K + wid * 1024, vdst = lds0 + LDS_V + wid * 1024;
    const int vb0 = (int)(lds0 + LDS_V) + ((lane >> 4) & 1) * 32 + (lane & 3) * 8 + (4 * hi + ((lane & 15) >> 2)) * 64;
    const int tb = 4 * u, pr = wid >> 1;
    const int nsteps = (tb + 4) < 9 ? (tb + 4) : 9;
    const int tlow = (tb - 8) > 0 ? (tb - 8) : 0;
    bf16x8 qr[4];
#pragma unroll
    for (int d0 = 0; d0 < 4; ++d0) qr[d0] = *(const bf16x8*)(Qw + (long)r32 * DM + d0 * 16 + hi * 8);
#pragma unroll
    for (int i = 3; i >= 1 - PFD; --i) { if (tb + i >= tlow) { DMA_K(tb + i); DMA_V(tb + i); } }
    float mhat = 0.f, l_reg = 0.f; f32x16 o[2]; o[0] = f32x16{}; o[1] = f32x16{};
    for (int s = 0; s < nsteps; ++s) {
        STEP_WAIT(tb - s, tlow);
        { const int tn = tb - s - PFD; if (tn >= tlow) { DMA_K(tn); DMA_V(tn); } }
        const int j = tb + pr - s;
        if (j >= 0) {
            const int sl = (j & (NSLOT - 1)) * SLOTB;
            const bool far = (s >= 3), first = (s == 0);
            f32x16 cin; const float c0 = (far ? bfar : 0.f) - mhat;
#pragma unroll
            for (int r = 0; r < 16; ++r) cin[r] = c0;
            f32x16 p0, p1;
            qkt(p0, p1, shm + LDS_K + sl, qr, cin, r32, hi);
            if (!far) {
                const LAS float* tp = tab + (s * 64 + 32 * (wid & 1) + r32 + 64 - 4 * hi);
#pragma unroll
                for (int r = 0; r < 16; ++r) { const int kv = (r & 3) + 8 * (r >> 2); p0[r] += tp[-kv]; p1[r] += tp[-kv - 32]; }
            }
            const float rm = rowmax(p0, p1);
            bool upd; float dl;
            if (first) { upd = true; dl = rm; } else { upd = __any(rm > 8.f) != 0; dl = __builtin_fmaxf(rm, 0.f); }
            if (upd) {
                mhat += dl;
#pragma unroll
                for (int r = 0; r < 16; ++r) { p0[r] -= dl; p1[r] -= dl; }
                if (!first) { const float f = fast_exp2(-dl); l_reg *= f; if (hi == 0) wsf[r32] = f; LDS_WAIT();
#pragma unroll
                    for (int r = 0; r < 16; ++r) { const float fr_ = wsf[crow(r, hi)]; o[0][r] *= fr_; o[1][r] *= fr_; } }
            }
            float sacc = 0.f;
#pragma unroll
            for (int r = 0; r < 16; ++r) { p0[r] = fast_exp2(p0[r]); p1[r] = fast_exp2(p1[r]); sacc += p0[r] + p1[r]; }
            l_reg += sacc;
            u32x4 pw0 = (u32x4){PKW(p0, 0), PKW(p0, 2), PKW(p0, 4), PKW(p0, 6)}, pw1 = (u32x4){PKW(p0, 8), PKW(p0, 10), PKW(p0, 12), PKW(p0, 14)};
            u32x4 pw2 = (u32x4){PKW(p1, 0), PKW(p1, 2), PKW(p1, 4), PKW(p1, 6)}, pw3 = (u32x4){PKW(p1, 8), PKW(p1, 10), PKW(p1, 12), PKW(p1, 14)};
            pv(o, vb0 + sl, __builtin_bit_cast(bf16x8, pw0), __builtin_bit_cast(bf16x8, pw1), __builtin_bit_cast(bf16x8, pw2), __builtin_bit_cast(bf16x8, pw3));
        }
    }
    { auto rr = __builtin_amdgcn_permlane32_swap(__float_as_uint(l_reg), __float_as_uint(l_reg), false, false); l_reg = __uint_as_float(rr[0]) + __uint_as_float(rr[1]); }
    if (hi == 0) wsf[32 + r32] = l_reg; LDS_WAIT();
    float rli[16];
#pragma unroll
    for (int r = 0; r < 16; ++r) rli[r] = fast_rcp(wsf[32 + crow(r, hi)]);
    asm volatile("s_waitcnt lgkmcnt(0)\n\ts_barrier" ::: "memory");
    store_o(o, rli, O + (rowbase + q0 + wid * 32) * DM + h * HD, shm, wid, lane, r32, hi);
    asm volatile("s_waitcnt lgkmcnt(0)\n\ts_barrier" ::: "memory");
}

__device__ __forceinline__ void attn_b_unit(int b, int h, int qb, const bf16_t* Q, const bf16_t* K, const bf16_t* V, bf16_t* O, LAS char* shm) {
    int tid_ = threadIdx.x; asm volatile("" : "+v"(tid_)); const int tid = tid_, lane = tid & 63, r32 = lane & 31, hi = lane >> 5; const int wid = __builtin_amdgcn_readfirstlane(tid >> 6);
    const long rowbase = (long)b * SEQ; const int q0 = qb * 256;
    const bf16_t* Qw = Q + (rowbase + q0 + wid * 32) * DM + h * HD;
    const bf16_t* Kh = K + rowbase * DM + h * HD; const bf16_t* Vh = V + rowbase * DM + h * HD;
    const unsigned lds0 = (unsigned)(size_t)shm;
    LAS unsigned* flg = (LAS unsigned*)(shm + LDS_FLG);
    const bf16_t* ksrc = Kh + (long)lane * DM + wid * 8;
    const bf16_t* vsrc = Vh + (long)(16 * (wid & 3) + (lane >> 2)) * DM + (wid >> 2) * 32 + (lane & 3) * 8;
    const unsigned kdst = lds0 + LDS_K + wid * 1024, vdst = lds0 + LDS_V + wid * 1024;
    const int vb0 = (int)(lds0 + LDS_V) + ((lane >> 4) & 1) * 32 + (lane & 3) * 8 + (4 * hi + ((lane & 15) >> 2)) * 64;
    const int tb = 4 * qb, pr = wid >> 1;
    const int tq = 32 * (wid & 1) + r32;
    bf16x8 qr[4];
#pragma unroll
    for (int d0 = 0; d0 < 4; ++d0) qr[d0] = *(const bf16x8*)(Qw + (long)r32 * DM + d0 * 16 + hi * 8);
#pragma unroll
    for (int i = 3; i >= 1 - PFD; --i) { if (tb + i >= 0) { DMA_K(tb + i); DMA_V(tb + i); } }
    float R = 1.0f; bool wdone = false; f32x16 o[2]; o[0] = f32x16{}; o[1] = f32x16{};
    for (int s = 0; ; ++s) {
        STEP_WAIT(tb - s, 0);
        if (s > 0) { const LAS unsigned* f = flg + ((s - 1) & 1) * 8; unsigned all = 1u;
#pragma unroll
            for (int w = 0; w < 8; ++w) all &= f[w];
            if (__builtin_amdgcn_readfirstlane(all) != 0u) break; }
        { const int tn = tb - s - PFD; if (tn >= 0) { DMA_K(tn); DMA_V(tn); } }
        const int j = tb + pr - s;
        if (j >= 0 && !wdone) {
            const int sl = (j & (NSLOT - 1)) * SLOTB;
            f32x16 cin = f32x16{}; f32x16 p0, p1;
            qkt(p0, p1, shm + LDS_K + sl, qr, cin, r32, hi);
#pragma unroll
            for (int r = 0; r < 16; ++r) { p0[r] = fast_rcp(1.0f + fast_exp2(p0[r])); p1[r] = fast_rcp(1.0f + fast_exp2(p1[r])); }
            if (s == 0) {
#pragma unroll
                for (int r = 0; r < 16; ++r) { const int kv = crow(r, hi); if (kv >= tq) p0[r] = 1.0f; if (kv + 32 >= tq) p1[r] = 1.0f; } }
            float W[8], part[8];
#pragma unroll
            for (int i = 0; i < 8; ++i) { const float pb = (i < 4) ? (p0[4 * i] * p0[4 * i + 1]) * (p0[4 * i + 2] * p0[4 * i + 3]) : (p1[4 * i - 16] * p1[4 * i - 15]) * (p1[4 * i - 14] * p1[4 * i - 13]);
                auto rr = __builtin_amdgcn_permlane32_swap(__float_as_uint(pb), __float_as_uint(pb), false, false);
                const float vlo = __uint_as_float(rr[0]), vhi = __uint_as_float(rr[1]);
                W[i] = vlo * vhi; part[i] = hi ? 1.0f : vhi; }
            float sw = R;
#pragma unroll
            for (int i = 7; i >= 0; --i) { float c = sw * part[i];
                if (i < 4) {
#pragma unroll
                    for (int rr_ = 3; rr_ >= 0; --rr_) { const float t_ = c * p0[4 * i + rr_]; p0[4 * i + rr_] = c - t_; c = t_; } }
                else {
#pragma unroll
                    for (int rr_ = 3; rr_ >= 0; --rr_) { const float t_ = c * p1[4 * i - 16 + rr_]; p1[4 * i - 16 + rr_] = c - t_; c = t_; } }
                sw *= W[i]; }
            R = sw;
            u32x4 pw0 = (u32x4){PKW(p0, 0), PKW(p0, 2), PKW(p0, 4), PKW(p0, 6)}, pw1 = (u32x4){PKW(p0, 8), PKW(p0, 10), PKW(p0, 12), PKW(p0, 14)};
            u32x4 pw2 = (u32x4){PKW(p1, 0), PKW(p1, 2), PKW(p1, 4), PKW(p1, 6)}, pw3 = (u32x4){PKW(p1, 8), PKW(p1, 10), PKW(p1, 12), PKW(p1, 14)};
            pv(o, vb0 + sl, __builtin_bit_cast(bf16x8, pw0), __builtin_bit_cast(bf16x8, pw1), __builtin_bit_cast(bf16x8, pw2), __builtin_bit_cast(bf16x8, pw3));
            wdone = __all(R == 0.0f) != 0;
        }
        if (j <= 0) wdone = true;
        if (lane == 0) flg[(s & 1) * 8 + wid] = wdone ? 1u : 0u;
    }
    float ones[16];
#pragma unroll
    for (int r = 0; r < 16; ++r) ones[r] = 1.0f;
    asm volatile("s_waitcnt vmcnt(0) lgkmcnt(0)\n\ts_barrier" ::: "memory");
    store_o(o, ones, O + (rowbase + q0 + wid * 32) * DM + h * HD, shm, wid, lane, r32, hi);
    asm volatile("s_waitcnt lgkmcnt(0)\n\ts_barrier" ::: "memory");
}
#undef DMA_K
#undef DMA_V
#undef PKW
#undef SBAR
#undef WAIT_BAR0
}

#define XB_TMO      128
#define XB_XCNT(j)  (256  + 64 * (j))
#define XB_XSUB(j)  (1280 + 64 * (j))
#define XB_XGEN(j)  (2304 + 64 * (j))
#define XB_TOP      3328
#define XB_TOPGEN   3392
#define XCD_BAR_WORDS 3456
#define XB_SPIN_CAP (1u << 22)
__device__ __forceinline__ unsigned xb_ld(unsigned* p)              { return __hip_atomic_load(p, __ATOMIC_RELAXED, __HIP_MEMORY_SCOPE_AGENT); }
__device__ __forceinline__ unsigned xb_add(unsigned* p, unsigned v) { return __hip_atomic_fetch_add(p, v, __ATOMIC_RELAXED, __HIP_MEMORY_SCOPE_AGENT); }
__device__ __forceinline__ unsigned xb_xcc_id() { return (unsigned)__builtin_amdgcn_s_getreg((3 << 11) | 20) & 0xFu; }
#define XB_SPIN(cond, bar) do { unsigned _sp = 0; while (cond) { __builtin_amdgcn_s_sleep(1); \
    if ((++_sp & 255u) == 0u) { if (xb_ld(&(bar)[XB_TMO])) break; if (_sp > XB_SPIN_CAP) { atomicAdd(&(bar)[XB_TMO], 1u); break; } } } } while (0)
struct XcdBarrier { unsigned* bar; unsigned x; volatile LAS unsigned* st; };
__device__ __forceinline__ XcdBarrier xcd_barrier_post(unsigned* bar, volatile LAS unsigned* st) {
    XcdBarrier b; b.bar = bar; b.x = xb_xcc_id(); b.st = st;
    if (threadIdx.x == 0) (void)xb_add(&bar[XB_XCNT(b.x)], 1u);
    return b;
}
__device__ __forceinline__ void xcd_barrier_complete(unsigned* bar, unsigned x, unsigned& nloc, unsigned& nx) {
    const unsigned G = gridDim.x * gridDim.y * gridDim.z;
    unsigned sum, cnt, mine, sp = 0u;
    for (;;) {
        sum = 0u; cnt = 0u; mine = 0u;
#pragma unroll
        for (unsigned j = 0; j < 16; ++j) { const unsigned c = xb_ld(&bar[XB_XCNT(j)]); sum += c; cnt += (c > 0u) ? 1u : 0u; mine = (j == x) ? c : mine; }
        if (sum == G) break;
        __builtin_amdgcn_s_sleep(1);
        if ((++sp & 255u) == 0u) { if (xb_ld(&bar[XB_TMO])) break; if (sp > XB_SPIN_CAP) { atomicAdd(&bar[XB_TMO], 1u); break; } }
    }
    nloc = mine > 0u ? mine : 1u; nx = cnt > 0u ? cnt : 1u;
}
__device__ __forceinline__ void xcd_barrier(const XcdBarrier& b) {
    asm volatile("s_waitcnt vmcnt(0)" ::: "memory");
    __syncthreads();
    if (threadIdx.x == 0) {
        unsigned* bar = b.bar;
        __builtin_amdgcn_s_waitcnt(0);
        unsigned nloc = b.st[0], nx = b.st[1];
        if (nloc == 0u) { xcd_barrier_complete(bar, b.x, nloc, nx); b.st[0] = nloc; b.st[1] = nx; }
        const unsigned old = xb_add(&bar[XB_XSUB(b.x)], 1u);
        const unsigned gen = old / nloc;
        if (old + 1u == (gen + 1u) * nloc) {
            __builtin_amdgcn_fence(__ATOMIC_RELEASE, "agent");
            asm volatile("s_waitcnt vmcnt(0)" ::: "memory");
            const unsigned og = xb_add(&bar[XB_TOP], 1u);
            const unsigned tg = og / nx;
            if (og + 1u == (tg + 1u) * nx) xb_add(&bar[XB_TOPGEN], 1u);
            else XB_SPIN(xb_ld(&bar[XB_TOPGEN]) == tg, bar);
            __builtin_amdgcn_fence(__ATOMIC_ACQUIRE, "agent");
            xb_add(&bar[XB_XGEN(b.x)], 1u);
            asm volatile("s_waitcnt vmcnt(0)" ::: "memory");
        } else {
            XB_SPIN(xb_ld(&bar[XB_XGEN(b.x)]) == gen, bar);
            __builtin_amdgcn_fence(__ATOMIC_ACQUIRE, "agent");
            asm volatile("s_waitcnt vmcnt(0)" ::: "memory");
        }
    }
    __syncthreads();
}

__device__ __forceinline__ unsigned f2bf(float f) { unsigned u = __builtin_bit_cast(unsigned, f); return (u + 0x7fffu + ((u >> 16) & 1u)) >> 16; }
__device__ __forceinline__ unsigned pk2(float lo, float hi) { return cvt_pk_bf16(lo, hi); }
__device__ __forceinline__ void transpose_item(const float* W, int K, int N, bf16_t* WT, int row_off, LAS float* scr, int item, int lane) {
    const int nblk = N / 32, kb = item / nblk, nb = item % nblk, k0 = 64 * kb, n0 = 32 * nb;
    f32x4 ld[8];
#pragma unroll
    for (int i = 0; i < 8; ++i) ld[i] = *(const f32x4*)(W + (size_t)(k0 + 8 * i + (lane >> 3)) * N + n0 + 4 * (lane & 7));
#pragma unroll
    for (int i = 0; i < 8; ++i) { LAS float* d = scr + (8 * i + (lane >> 3)) * 33 + 4 * (lane & 7); d[0] = ld[i].x; d[1] = ld[i].y; d[2] = ld[i].z; d[3] = ld[i].w; }
    LDS_WAIT(); asm volatile("" ::: "memory");
    const int c = lane & 7;
#pragma unroll
    for (int j = 0; j < 4; ++j) { const int n = (lane >> 3) + 8 * j; const LAS float* s = scr + (8 * c) * 33 + n;
        u32x4 o; o.x = pk2(s[0 * 33], s[1 * 33]); o.y = pk2(s[2 * 33], s[3 * 33]); o.z = pk2(s[4 * 33], s[5 * 33]); o.w = pk2(s[6 * 33], s[7 * 33]);
        *(u32x4*)(WT + (size_t)(row_off + n0 + n) * K + k0 + 8 * c) = o; }
    LDS_WAIT(); asm volatile("" ::: "memory");
}

struct Args { const float* in[15]; float* out; unsigned char* ws; int ph_lo, ph_hi, li, pad; };
typedef const __attribute__((address_space(4))) char* kptr_t;
__device__ __forceinline__ kptr_t kbase() { kptr_t kp = (kptr_t)__builtin_amdgcn_kernarg_segment_ptr(); asm volatile("" : "+s"(kp)); return kp; }
__device__ __forceinline__ const float* arg_in(int i) { return *(const float* const __attribute__((address_space(4)))*)(kbase() + 8 * i); }
__device__ __forceinline__ float* arg_out() { return *(float* const __attribute__((address_space(4)))*)(kbase() + 120); }
__device__ __forceinline__ unsigned char* arg_ws() { return *(unsigned char* const __attribute__((address_space(4)))*)(kbase() + 128); }
__device__ __forceinline__ int arg_lo() { return *(const __attribute__((address_space(4))) int*)(kbase() + 136); }
__device__ __forceinline__ int arg_hi() { return *(const __attribute__((address_space(4))) int*)(kbase() + 140); }
__device__ __forceinline__ int arg_li() { return *(const __attribute__((address_space(4))) int*)(kbase() + 144); }
static_assert(sizeof(Args) == 152, "Args layout");

constexpr int NWAVES = 8;
constexpr int PH_PER_LAYER = 8, N_PHASES = 1 + DEPTH * PH_PER_LAYER;
#define PH_COMMON() int tid_ = threadIdx.x; asm volatile("" : "+v"(tid_)); const int tid = tid_, lane = tid & 63, wave = __builtin_amdgcn_readfirstlane(tid >> 6); const int G = gridDim.x, bx = blockIdx.x; \
    const int vcu = (G % 8 == 0) ? (bx % 8) * (G / 8) + bx / 8 : bx; const int gw = vcu * NWAVES + wave, NGW = G * NWAVES; unsigned char* ws = arg_ws(); \
    (void)tid; (void)lane; (void)wave; (void)vcu; (void)gw; (void)NGW; (void)ws

__device__ __forceinline__ void convert_weights(int l, LAS unsigned char* lds) {
    PH_COMMON();
    LAS float* scr = (LAS float*)(lds + wave * 16384);
    const float* w_in = arg_in(1) + (size_t)l * D_MODEL * PROJ;
    const float* w_upa = arg_in(3) + (size_t)l * WA * D_MODEL;
    const float* w_upb = arg_in(4) + (size_t)l * WA * D_MODEL;
    const float* w_out = arg_in(5) + (size_t)l * D_MODEL * D_MODEL;
    const float* w_gate = arg_in(10) + (size_t)l * NE * D_MODEL * FE;
    const float* w_up = arg_in(11) + (size_t)l * NE * D_MODEL * FE;
    const float* w_down = arg_in(12) + (size_t)l * NE * FE * D_MODEL;
    constexpr int I_IN = (D_MODEL / 64) * (PROJ / 32), I_UP = (WA / 64) * (D_MODEL / 32), I_OUT = (D_MODEL / 64) * (D_MODEL / 32);
    constexpr int I_G = (D_MODEL / 64) * (FE / 32), I_D = (FE / 64) * (D_MODEL / 32);
    constexpr int NITEMS = I_IN + 2 * I_UP + I_OUT + NE * (2 * I_G + I_D);
    for (int it = gw; it < NITEMS; it += NGW) {
        int r = it;
        if (r < I_IN) { transpose_item(w_in, D_MODEL, PROJ, (bf16_t*)(ws + WS_WIN), 0, scr, r, lane); continue; } r -= I_IN;
        if (r < I_UP) { transpose_item(w_upa, WA, D_MODEL, (bf16_t*)(ws + WS_WUPA), 0, scr, r, lane); continue; } r -= I_UP;
        if (r < I_UP) { transpose_item(w_upb, WA, D_MODEL, (bf16_t*)(ws + WS_WUPB), 0, scr, r, lane); continue; } r -= I_UP;
        if (r < I_OUT) { transpose_item(w_out, D_MODEL, D_MODEL, (bf16_t*)(ws + WS_WOUT), 0, scr, r, lane); continue; } r -= I_OUT;
        const int e = r / (2 * I_G + I_D); r -= e * (2 * I_G + I_D);
        if (r < 2 * I_G) { const int up = r >= I_G; if (up) r -= I_G;
            const int nb = r % (FE / 32), n0 = nb * 32;
            const int row_off = e * 1024 + (n0 / 128) * 128 + (up ? 128 : 0);
            transpose_item((up ? w_up : w_gate) + (size_t)e * D_MODEL * FE, D_MODEL, FE, (bf16_t*)(ws + WS_WGU), row_off, scr, r, lane); continue; }
        r -= 2 * I_G;
        transpose_item(w_down + (size_t)e * FE * D_MODEL, FE, D_MODEL, (bf16_t*)(ws + WS_WD), e * 1024, scr, r, lane);
    }
}

__device__ __forceinline__ void phase0(LAS unsigned char* lds) {
    convert_weights(0, lds);
    PH_COMMON();
    const float* x_in = arg_in(0); bf16_t* XB = (bf16_t*)(ws + WS_XB);
    for (int m = gw; m < T; m += NGW) { const f32x4* xr = (const f32x4*)(x_in + (size_t)m * D_MODEL) + lane; u32x2* o8 = (u32x2*)(XB + (size_t)m * D_MODEL) + lane;
#pragma unroll
        for (int j = 0; j < 4; ++j) { const f32x4 v = xr[64 * j]; u32x2 w; w.x = cvt_pk_bf16(v.x, v.y); w.y = cvt_pk_bf16(v.z, v.w); o8[64 * j] = w; } }
}
__device__ __forceinline__ void phase1(LAS unsigned char* lds) {
    PH_COMMON();
    pg8::SchedPlain S; S.o.init(T / 256, PROJ / 256, G, bx); S.A = (const char*)(ws + WS_XB); S.B = (const char*)(ws + WS_WIN); S.tstep = (size_t)256 * D_MODEL * 2;
    EpiInProj E{(bf16_t*)(ws + WS_QA), (bf16_t*)(ws + WS_GA)};
    pg8::gemm_phase<EpiInProj, pg8::SchedPlain, false, true>(lds, D_MODEL, S, E);
}
__device__ __forceinline__ void phase2(LAS unsigned char* lds, int l) {
    PH_COMMON();
    const int bh = vcu >> 2, s = vcu & 3; const int b = bh >> 3, h = bh & 7;
    if (G != 256) return;
    bf16_t* QKV = (bf16_t*)(ws + WS_QA);
    const float* bias_h = arg_in(2) + ((size_t)l * NH + h) * N_REL;
    bf16_t* QAp = QKV; bf16_t* KAp = QKV + (QKV_STRIDE / 2); bf16_t* VAp = QKV + 2 * (QKV_STRIDE / 2);
    bf16_t* QBp = QKV + 3 * (QKV_STRIDE / 2); bf16_t* KBp = QKV + 4 * (QKV_STRIDE / 2); bf16_t* VBp = QKV + 5 * (QKV_STRIDE / 2);
    PBS_BEGIN(6, lds);
    for (int i = 0; i < 4; ++i) { const int u = (i == 0) ? s : (i == 1) ? 7 - s : (i == 2) ? 8 + s : 15 - s; att::attn_a_unit(b, h, u, QAp, KAp, VAp, QAp, bias_h, (LAS char*)lds); }
    PBS_END(6, lds); PBS_BEGIN(7, lds);
    for (int i = 0; i < 4; ++i) { const int u = (i == 0) ? s : (i == 1) ? 7 - s : (i == 2) ? 8 + s : 15 - s; att::attn_b_unit(b, h, u, QBp, KBp, VBp, QBp, (LAS char*)lds); }
    PBS_END(7, lds);
}
__device__ __forceinline__ void phase3(LAS unsigned char* lds) {
    PH_COMMON();
    bf16_t* QKV = (bf16_t*)(ws + WS_QA);
    pg8::SchedTwo S; S.o.init(T / 256, D_MODEL / 256, G, bx); S.A0 = (const char*)QKV; S.A1 = (const char*)(QKV + 3 * (QKV_STRIDE / 2));
    S.B0 = (const char*)(ws + WS_WUPA); S.B1 = (const char*)(ws + WS_WUPB); S.tstep = (size_t)256 * WA * 2;
    EpiMerge E{(const bf16_t*)(ws + WS_GA), (const bf16_t*)(ws + WS_GB), (bf16_t*)(ws + WS_MERGED)};
    pg8::gemm_phase<EpiMerge, pg8::SchedTwo, false, true>(lds, WA, S, E);
}
__device__ __forceinline__ void phase4(LAS unsigned char* lds, int l) {
    PH_COMMON();
    pg8::SchedPlain S; S.o.init(T / 256, D_MODEL / 256, G, bx); S.A = (const char*)(ws + WS_MERGED); S.B = (const char*)(ws + WS_WOUT); S.tstep = (size_t)256 * D_MODEL * 2;
    EpiOut E{(l == 0) ? arg_in(0) : (const float*)nullptr, (const bf16_t*)(ws + WS_XB), (bf16_t*)(ws + WS_PRE)};
    pg8::gemm_phase<EpiOut, pg8::SchedPlain, false, true>(lds, D_MODEL, S, E);
}
__device__ __forceinline__ void phase5(LAS unsigned char* lds, int l) {
    PH_COMMON();
    const float* g1 = arg_in(6) + (size_t)l * D_MODEL; const float* b1 = arg_in(7) + (size_t)l * D_MODEL;
    const float* w_router = arg_in(8); const float* b_router = arg_in(9);
    bf16_t* XB = (bf16_t*)(ws + WS_XB); const bf16_t* PRE = (const bf16_t*)(ws + WS_PRE);
    int* LIST = (int*)(ws + WS_LIST); f32x2* RECW = (f32x2*)(ws + WS_RECW);
    unsigned* gcnt = (unsigned*)(ws + WS_CTL) + CW_CNT + 64 * l;
    PBS_BEGIN(1, lds);
    for (int i = tid; i < D_MODEL * 4; i += NWAVES * 64) { const int c = i >> 2, q = i & 3; *(LAS f32x4*)(lds + c * 64 + (c >> 2) * 16 + q * 16) = *(const f32x4*)(w_router + c * 16 + q * 4); }
    LAS unsigned* lcnt = (LAS unsigned*)(lds + 81920);
    LAS int* lrec = (LAS int*)(lds + 81920 + 256);
    if (tid < 32) lcnt[tid] = 0u;
    __syncthreads();
    PBS_END(1, lds); PBS_BEGIN(2, lds);
    int krow = 0;
    u32x2 nv[4];
    { const u32x2* pr = (const u32x2*)(PRE + (size_t)gw * D_MODEL) + lane;
#pragma unroll
      for (int j = 0; j < 4; ++j) nv[j] = pr[64 * j]; }
    for (int m = gw; m < T; m += NGW, ++krow) {
        f32x4 v[4]; float s = 0.f;
#pragma unroll
        for (int j = 0; j < 4; ++j) { v[j] = (f32x4){bf_lo(nv[j].x), bf_hi(nv[j].x), bf_lo(nv[j].y), bf_hi(nv[j].y)}; s += (v[j].x + v[j].y) + (v[j].z + v[j].w); }
        if (m + NGW < T) { const u32x2* pr = (const u32x2*)(PRE + (size_t)(m + NGW) * D_MODEL) + lane;
#pragma unroll
            for (int j = 0; j < 4; ++j) nv[j] = pr[64 * j]; }
        const float mean = wave_sum(s) * (1.f / D_MODEL); float s2 = 0.f;
#pragma unroll
        for (int j = 0; j < 4; ++j) { v[j] = v[j] - mean; s2 += (v[j].x * v[j].x + v[j].y * v[j].y) + (v[j].z * v[j].z + v[j].w * v[j].w); }
        const float rstd = 1.f / sqrtf(wave_sum(s2) * (1.f / D_MODEL) + LN_EPS);
        float lg[16];
#pragma unroll
        for (int e = 0; e < 16; ++e) lg[e] = 0.f;
#pragma unroll
        for (int j = 0; j < 4; ++j) { const f32x4 gg = *((const f32x4*)g1 + lane + 64 * j), bb = *((const f32x4*)b1 + lane + 64 * j);
            v[j] = v[j] * rstd * gg + bb;
            u32x2 w; w.x = cvt_pk_bf16(v[j].x, v[j].y); w.y = cvt_pk_bf16(v[j].z, v[j].w); *((u32x2*)(XB + (size_t)m * D_MODEL) + lane + 64 * j) = w;
#pragma unroll
            for (int i = 0; i < 4; ++i) { const int c = 4 * (lane + 64 * j) + i; const LAS f32x4* wp = (const LAS f32x4*)(lds + c * 64 + (c >> 2) * 16); const float xv = v[j][i];
#pragma unroll
                for (int q = 0; q < 4; ++q) { const f32x4 wv = wp[q]; lg[4 * q + 0] += xv * wv.x; lg[4 * q + 1] += xv * wv.y; lg[4 * q + 2] += xv * wv.z; lg[4 * q + 3] += xv * wv.w; } } }
#pragma unroll
        for (int e = 0; e < 16; ++e) lg[e] = wave_sum(lg[e]) + b_router[e];
        int best = 0; float bv = lg[0];
#pragma unroll
        for (int e = 1; e < 16; ++e) if (lg[e] > bv) { bv = lg[e]; best = e; }
        const int grp = best >> 2; int e2 = -1; float v2 = 0.f;
#pragma unroll
        for (int e = 0; e < 16; ++e) { if ((e >> 2) == grp && e != best) { if (e2 < 0 || lg[e] > v2) { v2 = lg[e]; e2 = e; } } }
        const float w1 = fast_rcp(1.0f + fast_exp2((v2 - bv) * LOG2E)), w2 = 1.0f - w1;
        if (lane == 0) { RECW[m] = (f32x2){w1, w2};
            const int lp1 = (int)__hip_atomic_fetch_add(lcnt + best, 1u, __ATOMIC_RELAXED, __HIP_MEMORY_SCOPE_WORKGROUP);
            const int lp2 = (int)__hip_atomic_fetch_add(lcnt + e2, 1u, __ATOMIC_RELAXED, __HIP_MEMORY_SCOPE_WORKGROUP);
            LAS int* rp = lrec + (wave * 16 + krow) * 4; rp[0] = best; rp[1] = lp1; rp[2] = e2; rp[3] = lp2; }
    }
    PBS_END(2, lds);
    __syncthreads();
    PBS_BEGIN(3, lds);
    if (tid < 16) { const unsigned n = lcnt[tid]; lcnt[16 + tid] = n ? __hip_atomic_fetch_add(gcnt + tid, n, __ATOMIC_RELAXED, __HIP_MEMORY_SCOPE_AGENT) : 0u; }
    __syncthreads();
    if (lane == 0) { int k2 = 0;
        for (int m = gw; m < T; m += NGW, ++k2) { const LAS int* rp = lrec + (wave * 16 + k2) * 4;
            LIST[(size_t)rp[0] * T + lcnt[16 + rp[0]] + rp[1]] = m * 2; LIST[(size_t)rp[2] * T + lcnt[16 + rp[2]] + rp[3]] = m * 2 + 1; } }
    __syncthreads();
    PBS_END(3, lds);
}
__device__ __forceinline__ int moe_units(LAS unsigned char* lds, int l) {
    PH_COMMON();
    LAS int* utab = (LAS int*)(lds + UTAB_OFF);
    unsigned* gcnt = (unsigned*)(ws + WS_CTL) + CW_CNT + 64 * l;
    __syncthreads();
    if (tid == 0) {
        LAS int* ts = utab + 128; LAS int* ncnt = utab + 160;
        int acc_t = 0;
        for (int e = 0; e < 16; ++e) { const int n = (int)__hip_atomic_load(gcnt + e, __ATOMIC_RELAXED, __HIP_MEMORY_SCOPE_AGENT); ncnt[e] = n; ts[e] = acc_t; acc_t += (n + 255) / 256; }
        ts[16] = acc_t;
        const int nunits = acc_t * 4; int cnt = 0;
        for (int i = 0; cnt < 16; ++i) { const long L = (long)i * G + bx; if (L >= nunits) break;
            int U = (int)L; { const int q = nunits / 8, r = nunits % 8, xcd = U % 8, off = U / 8; U = (xcd < r ? xcd * (q + 1) : r * (q + 1) + (xcd - r) * q) + off; }
            const int tile = U >> 2, pn = U & 3; int e = 0; while (ts[e + 1] <= tile) ++e;
            const int mt = tile - ts[e]; const int n = ncnt[e]; const int nv = (n - 256 * mt) < 256 ? (n - 256 * mt) : 256;
            utab[cnt * 5 + 0] = e; utab[cnt * 5 + 1] = pn; utab[cnt * 5 + 2] = mt * 256; utab[cnt * 5 + 3] = nv; utab[cnt * 5 + 4] = tile * 256;
            ++cnt; }
        utab[192] = cnt;
    }
    __syncthreads();
    return utab[192];
}
__device__ __forceinline__ void phase6(LAS unsigned char* lds, int l) {
    const int nun = moe_units(lds, l);
    PH_COMMON();
    pg8::SchedMoe S; S.utab = (LAS int*)(lds + UTAB_OFF); S.nunits = nun; S.Abase = (const char*)(ws + WS_XB); S.Bbase = (const char*)(ws + WS_WGU); S.a_row_bytes = 0;
    S.b_exp_bytes = (size_t)1024 * D_MODEL * 2; S.b_tile_bytes = (size_t)256 * D_MODEL * 2; S.list = (const int*)(ws + WS_LIST); S.gather_k2 = D_MODEL * 2;
    EpiGU E{(bf16_t*)(ws + WS_H)};
    pg8::gemm_phase<EpiGU, pg8::SchedMoe, true, true>(lds, D_MODEL, S, E);
}
__device__ __forceinline__ void phase7(LAS unsigned char* lds, int l) {
    const int nun = moe_units(lds, l);
    PH_COMMON();
    pg8::SchedMoe S; S.utab = (LAS int*)(lds + UTAB_OFF); S.nunits = nun; S.Abase = (const char*)(ws + WS_H); S.Bbase = (const char*)(ws + WS_WD); S.a_row_bytes = (size_t)FE * 2;
    S.b_exp_bytes = (size_t)1024 * FE * 2; S.b_tile_bytes = (size_t)256 * FE * 2; S.list = (const int*)(ws + WS_LIST); S.gather_k2 = 0;
    EpiDown E{(bf16_t*)(ws + WS_Y), (const int*)(ws + WS_LIST)};
    pg8::gemm_phase<EpiDown, pg8::SchedMoe, false, true>(lds, FE, S, E);
}
__device__ __forceinline__ void phase8(LAS unsigned char* lds, int l) {
    PH_COMMON();
    const float* g2 = arg_in(13) + (size_t)l * D_MODEL; const float* b2 = arg_in(14) + (size_t)l * D_MODEL;
    float* xout = arg_out(); bf16_t* XB = (bf16_t*)(ws + WS_XB); const bf16_t* Y = (const bf16_t*)(ws + WS_Y); const f32x2* RECW = (const f32x2*)(ws + WS_RECW);
    PBS_BEGIN(4, lds);
    u32x2 nx[4], na[4], nc[4]; f32x2 nw;
#define P8_LOAD(mm) do { nw = RECW[mm]; const u32x2* xr = (const u32x2*)(XB + (size_t)(mm) * D_MODEL) + lane; \
        const u32x2* y0 = (const u32x2*)(Y + (size_t)(2 * (mm)) * D_MODEL) + lane; const u32x2* y1 = (const u32x2*)(Y + (size_t)(2 * (mm) + 1) * D_MODEL) + lane; \
        _Pragma("unroll") for (int j = 0; j < 4; ++j) { nx[j] = xr[64 * j]; na[j] = y0[64 * j]; nc[j] = y1[64 * j]; } } while (0)
    P8_LOAD(gw);
    const bool lastl = (l + 1 == DEPTH);
    for (int m = gw; m < T; m += NGW) {
        const f32x2 wv = nw; u32x2 cx[4], ca[4], cc[4];
#pragma unroll
        for (int j = 0; j < 4; ++j) { cx[j] = nx[j]; ca[j] = na[j]; cc[j] = nc[j]; }
        if (m + NGW < T) P8_LOAD(m + NGW);
        f32x4 v[4]; float s = 0.f;
#pragma unroll
        for (int j = 0; j < 4; ++j) { const u32x2 xw = cx[j]; const u32x2 a = ca[j], c = cc[j];
            v[j].x = bf_lo(xw.x) * ALPHA + wv.x * bf_lo(a.x) + wv.y * bf_lo(c.x); v[j].y = bf_hi(xw.x) * ALPHA + wv.x * bf_hi(a.x) + wv.y * bf_hi(c.x);
            v[j].z = bf_lo(xw.y) * ALPHA + wv.x * bf_lo(a.y) + wv.y * bf_lo(c.y); v[j].w = bf_hi(xw.y) * ALPHA + wv.x * bf_hi(a.y) + wv.y * bf_hi(c.y);
            s += (v[j].x + v[j].y) + (v[j].z + v[j].w); }
        const float mean = wave_sum(s) * (1.f / D_MODEL); float s2 = 0.f;
#pragma unroll
        for (int j = 0; j < 4; ++j) { v[j] = v[j] - mean; s2 += (v[j].x * v[j].x + v[j].y * v[j].y) + (v[j].z * v[j].z + v[j].w * v[j].w); }
        const float rstd = 1.f / sqrtf(wave_sum(s2) * (1.f / D_MODEL) + LN_EPS);
#pragma unroll
        for (int j = 0; j < 4; ++j) { const f32x4 gg = *((const f32x4*)g2 + lane + 64 * j), bb = *((const f32x4*)b2 + lane + 64 * j);
            v[j] = v[j] * rstd * gg + bb;
            if (lastl) *((f32x4*)(xout + (size_t)m * D_MODEL) + lane + 64 * j) = v[j];
            else { u32x2 w; w.x = cvt_pk_bf16(v[j].x, v[j].y); w.y = cvt_pk_bf16(v[j].z, v[j].w); *((u32x2*)(XB + (size_t)m * D_MODEL) + lane + 64 * j) = w; } }
    }
#undef P8_LOAD
    PBS_END(4, lds);
    PBS_BEGIN(5, lds);
    if (l + 1 < DEPTH) { __syncthreads(); convert_weights(l + 1, lds); }
    PBS_END(5, lds);
}

__global__ void __launch_bounds__(NWAVES * 64, 2) fwd(Args args) {
    extern __shared__ __attribute__((aligned(16))) unsigned char lds_raw[];
    LAS unsigned char* lds = (LAS unsigned char*)lds_raw;
    volatile LAS unsigned* MISC = (volatile LAS unsigned*)(lds + MISC_OFF);
    for (int u = threadIdx.x; u < (LDS_BYTES - LDSCTL_OFF) / 4; u += NWAVES * 64) ((LAS unsigned*)(lds + LDSCTL_OFF))[u] = 0u;
    __syncthreads();
    XcdBarrier bar; bar.bar = (unsigned*)(arg_ws() + WS_CTL) + CW_BAR + arg_li() * XCD_BAR_WORDS; bar.x = 0; bar.st = nullptr;
    if (!MK_MULTI) bar = xcd_barrier_post((unsigned*)(arg_ws() + WS_CTL) + CW_BAR + arg_li() * XCD_BAR_WORDS, MISC + 8);
    const int lo = arg_lo(), hi = arg_hi();
#define IN(k) (lo <= (k) && (k) < hi)
#define SEAM(k) do { if (!MK_MULTI && IN(k) && IN((k) + 1)) { XcdBarrier b2_ = bar; asm volatile("" : "+s"(b2_.bar)); xcd_barrier(b2_); } } while (0)
    unsigned long long tacc = 0ull, tst = 0ull; (void)tacc; (void)tst;
#define PB_BEGIN(k) do { if (PROBE_PH == (k)) tst = __builtin_amdgcn_s_memrealtime(); } while (0)
#define PB_END(k) do { if (PROBE_PH == (k)) tacc += __builtin_amdgcn_s_memrealtime() - tst; } while (0)
    PB_BEGIN(0);
    if (HAS(0) && IN(0)) phase0(lds);
    SEAM(0);
    PB_END(0);
    for (int l = 0; l < DEPTH; ++l) {
        const int pb = 1 + l * PH_PER_LAYER;
        PB_BEGIN(1);
        if (HAS(1) && IN(pb + 0)) phase1(lds);
        SEAM(pb + 0);
        PB_END(1);
        PB_BEGIN(2);
        if (HAS(2) && IN(pb + 1)) phase2(lds, l);
        SEAM(pb + 1);
        PB_END(2);
        PB_BEGIN(3);
        if (HAS(3) && IN(pb + 2)) phase3(lds);
        SEAM(pb + 2);
        PB_END(3);
        PB_BEGIN(4);
        if (HAS(4) && IN(pb + 3)) phase4(lds, l);
        SEAM(pb + 3);
        PB_END(4);
        PB_BEGIN(5);
        if (HAS(5) && IN(pb + 4)) phase5(lds, l);
        SEAM(pb + 4);
        PB_END(5);
        PB_BEGIN(6);
        if (HAS(6) && IN(pb + 5)) phase6(lds, l);
        SEAM(pb + 5);
        PB_END(6);
        PB_BEGIN(7);
        if (HAS(7) && IN(pb + 6)) phase7(lds, l);
        SEAM(pb + 6);
        PB_END(7);
        PB_BEGIN(8);
        if (HAS(8) && IN(pb + 7)) phase8(lds, l);
        SEAM(pb + 7);
        PB_END(8);
    }
    if (PROBE_PH >= 100) tacc = *(volatile LAS unsigned long long*)(lds + MISC_OFF + 64);
    if (PROBE_PH >= 0 && blockIdx.x == 0) { const unsigned long long t0 = __builtin_amdgcn_s_memrealtime(); while (__builtin_amdgcn_s_memrealtime() - t0 < tacc * PROBE_MULT) __builtin_amdgcn_s_sleep(8); }
#undef IN
#undef SEAM
    (void)args;
}


#ifndef DBG_PROBE
#define DBG_PROBE 0
#endif
#ifndef DBG_LAYER
#define DBG_LAYER 0
#endif
#ifndef DBG_GAIN
#define DBG_GAIN 1.0f
#endif
#if DBG_PROBE
constexpr size_t WS_DXS = 528 * MiB, WS_DKV = 544 * MiB, WS_DST = 610 * MiB;
__device__ __forceinline__ int dbg_tok(int i) { const int sp[8] = {0, 1, 63, 64, 65, 575, 576, 4095}; return i < 8 ? sp[i] : (i * 67 + (i % 5) * 13 + 200) % 4096; }
__device__ __forceinline__ void atomic_max_pos(float* p, float v) { atomicMax((unsigned*)p, __float_as_uint(v)); }
__global__ void dbg_kv(const float* xs, const float* w_in, float* kv) {
    const int c = blockIdx.x * 256 + threadIdx.x; const int bi = blockIdx.y >> 8; const int t0 = (blockIdx.y & 255) * 16;
    xs += (size_t)(bi ? 5 : 0) * SEQ * D_MODEL; kv += (size_t)bi * SEQ * 2048;
    const int col = c < 1024 ? 512 + c : 2048 + (c - 1024);
    float acc[16];
#pragma unroll
    for (int i = 0; i < 16; ++i) acc[i] = 0.f;
    for (int k = 0; k < D_MODEL; ++k) { const float w = w_in[(size_t)k * PROJ + col];
#pragma unroll
        for (int i = 0; i < 16; ++i) acc[i] += xs[(size_t)(t0 + i) * D_MODEL + k] * w; }
#pragma unroll
    for (int i = 0; i < 16; ++i) kv[(size_t)(t0 + i) * 2048 + c] = acc[i];
}
__device__ __forceinline__ float blk_sum(float v, float* red) { __syncthreads(); red[threadIdx.x] = v; __syncthreads(); for (int s = 128; s > 0; s >>= 1) { if ((int)threadIdx.x < s) red[threadIdx.x] += red[threadIdx.x + s]; __syncthreads(); } const float r = red[0]; __syncthreads(); return r; }
__device__ __forceinline__ float blk_max(float v, float* red) { __syncthreads(); red[threadIdx.x] = v; __syncthreads(); for (int s = 128; s > 0; s >>= 1) { if ((int)threadIdx.x < s) red[threadIdx.x] = fmaxf(red[threadIdx.x], red[threadIdx.x + s]); __syncthreads(); } const float r = red[0]; __syncthreads(); return r; }
__global__ void __launch_bounds__(256) dbg_tok_kernel(Args a, int L, int mode) {
    __shared__ float xs[1024], qa[512], qb[512], gl[2048], ya[512], yb[512], mg[1024], mixed[1024], x1[1024], hbuf[512], sc[4096], red[256], lgs[16];
    const int tid = threadIdx.x; const int t = dbg_tok(blockIdx.x >> 1); const int bi = blockIdx.x & 1, bb = bi ? 5 : 0; const size_t grow = (size_t)bb * SEQ + t;
    unsigned char* ws = a.ws;
    const float* xsnap = a.in[0] + (size_t)bb * SEQ * D_MODEL; const float* kv = (const float*)(ws + WS_DKV) + (size_t)bi * SEQ * 2048; float* st = (float*)(ws + WS_DST);
    const float* w_in = a.in[1] + (size_t)L * D_MODEL * PROJ; const float* relb = a.in[2] + (size_t)L * NH * N_REL;
    const float* w_upa = a.in[3] + (size_t)L * WA * D_MODEL; const float* w_upb = a.in[4] + (size_t)L * WA * D_MODEL; const float* w_out = a.in[5] + (size_t)L * D_MODEL * D_MODEL;
    const float* g1 = a.in[6] + (size_t)L * D_MODEL; const float* b1 = a.in[7] + (size_t)L * D_MODEL; const float* w_router = a.in[8]; const float* b_router = a.in[9];
    const float* w_gate = a.in[10] + (size_t)L * NE * D_MODEL * FE; const float* w_up = a.in[11] + (size_t)L * NE * D_MODEL * FE; const float* w_down = a.in[12] + (size_t)L * NE * FE * D_MODEL;
    for (int i = tid; i < 1024; i += 256) xs[i] = xsnap[(size_t)t * D_MODEL + i];
    __syncthreads();
    for (int j = tid; j < 3072; j += 256) { const int col = j < 512 ? j : (j < 1024 ? 1536 + (j - 512) : 3072 + (j - 1024)); float s = 0.f;
        for (int k = 0; k < 1024; ++k) s += xs[k] * w_in[(size_t)k * PROJ + col];
        if (j < 512) qa[j] = s; else if (j < 1024) qb[j - 512] = s; else gl[j - 1024] = s; }
    __syncthreads();
    for (int h = 0; h < 8; ++h) {
        const int c = t >> 6; const int k0 = (c - 8) > 0 ? (c - 8) * 64 : 0, k1 = c * 64 + 63; const int nk = k1 - k0 + 1;
        float mx = -1e30f;
        for (int i = tid; i < nk; i += 256) { const int key = k0 + i; float s = 0.f; for (int d = 0; d < 64; ++d) s += qa[h * 64 + d] * kv[(size_t)key * 2048 + h * 64 + d];
            int rel = t - key; rel = rel < -128 ? -128 : (rel > 128 ? 128 : rel); s = s * 0.125f + relb[h * N_REL + rel + 128]; sc[i] = s; mx = fmaxf(mx, s); }
        mx = blk_max(mx, red);
        float sm = 0.f; for (int i = tid; i < nk; i += 256) { const float p = expf(sc[i] - mx); sc[i] = p; sm += p; }
        sm = blk_sum(sm, red);
        if (tid < 64) { float o = 0.f; for (int i = 0; i < nk; ++i) o += sc[i] * kv[(size_t)(k0 + i) * 2048 + 512 + h * 64 + tid]; ya[h * 64 + tid] = o / sm; }
        __syncthreads();
        for (int s = tid; s < t; s += 256) { float z = 0.f; for (int d = 0; d < 64; ++d) z += qb[h * 64 + d] * kv[(size_t)s * 2048 + 1024 + h * 64 + d]; sc[s] = z * 0.125f; }
        __syncthreads();
        if (tid < 64) { float y = 0.f; for (int s = 0; s < t; ++s) { const float beta = 1.0f / (1.0f + expf(-sc[s])); y += beta * (kv[(size_t)s * 2048 + 1536 + h * 64 + tid] - y); } yb[h * 64 + tid] = y; }
        __syncthreads();
    }
    if (mode == 0) {
        const bf16_t* OA = (const bf16_t*)(ws + WS_QA); const bf16_t* OB = (const bf16_t*)(ws + WS_QA + 3 * QKV_STRIDE);
        float na = 0.f, da = 0.f, nb = 0.f, db = 0.f;
        for (int i = tid; i < 512; i += 256) { const float oa = h2f(OA[grow * WA + i]), ob = h2f(OB[grow * WA + i]);
            na += (oa - ya[i]) * (oa - ya[i]); da += ya[i] * ya[i]; nb += (ob - yb[i]) * (ob - yb[i]); db += yb[i] * yb[i]; }
        na = blk_sum(na, red); da = blk_sum(da, red); nb = blk_sum(nb, red); db = blk_sum(db, red);
        if (tid == 0) { atomicAdd(st + 4, na); atomicAdd(st + 5, da); atomicAdd(st + 6, nb); atomicAdd(st + 7, db); }
        return; }
    for (int cidx = tid; cidx < 1024; cidx += 256) { float ua = 0.f, ub = 0.f; for (int k = 0; k < 512; ++k) { ua += ya[k] * w_upa[(size_t)k * D_MODEL + cidx]; ub += yb[k] * w_upb[(size_t)k * D_MODEL + cidx]; }
        const float ga = 1.0f / (1.0f + expf(-gl[cidx])), gb = 1.0f / (1.0f + expf(-gl[1024 + cidx])); mg[cidx] = ga * ua + gb * ub; }
    __syncthreads();
    float num = 0.f, den = 0.f;
    for (int cidx = tid; cidx < 1024; cidx += 256) { float s = 0.f; for (int k = 0; k < 1024; ++k) s += mg[k] * w_out[(size_t)k * D_MODEL + cidx]; mixed[cidx] = s;
        const float opt = h2f(((const bf16_t*)(ws + WS_PRE))[grow * D_MODEL + cidx]) - ALPHA * xs[cidx]; num += (opt - s) * (opt - s); den += s * s; }
    num = blk_sum(num, red); den = blk_sum(den, red);
    if (tid == 0) { atomicAdd(st + 0, num); atomicAdd(st + 1, den); atomic_max_pos(st + 8, num / den); }
    float s1 = 0.f; for (int i = tid; i < 1024; i += 256) { x1[i] = ALPHA * xs[i] + mixed[i]; s1 += x1[i]; }
    const float mean = blk_sum(s1, red) / 1024.f; float s2 = 0.f; for (int i = tid; i < 1024; i += 256) { const float d = x1[i] - mean; s2 += d * d; }
    const float rstd = 1.0f / sqrtf(blk_sum(s2, red) / 1024.f + LN_EPS);
    for (int i = tid; i < 1024; i += 256) x1[i] = (x1[i] - mean) * rstd * g1[i] + b1[i];
    __syncthreads();
    if (tid < 16) { float s = 0.f; for (int k = 0; k < 1024; ++k) s += x1[k] * w_router[k * 16 + tid]; lgs[tid] = s + b_router[tid]; }
    __syncthreads();
    int best = 0; for (int e = 1; e < 16; ++e) if (lgs[e] > lgs[best]) best = e;
    const int grp = best >> 2; int e2 = -1; for (int e = grp * 4; e < grp * 4 + 4; ++e) if (e != best && (e2 < 0 || lgs[e] > lgs[e2])) e2 = e;
    const float pw1 = 1.0f / (1.0f + expf(lgs[e2] - lgs[best])), pw2 = 1.0f - pw1;
    const f32x2 wo = ((const f32x2*)(ws + WS_RECW))[grow]; const bf16_t* Y = (const bf16_t*)(ws + WS_Y);
    float fnum = 0.f, fden = 0.f; float ff[4] = {0.f, 0.f, 0.f, 0.f};
    for (int kk = 0; kk < 2; ++kk) { const int e = kk ? e2 : best; const float pw = kk ? pw2 : pw1;
        for (int f = tid; f < 512; f += 256) { float g = 0.f, u = 0.f; for (int k = 0; k < 1024; ++k) { g += x1[k] * w_gate[((size_t)e * D_MODEL + k) * FE + f]; u += x1[k] * w_up[((size_t)e * D_MODEL + k) * FE + f]; }
            hbuf[f] = g / (1.0f + expf(-g)) * u; }
        __syncthreads();
        for (int j = 0; j < 4; ++j) { const int cidx = tid + 256 * j; float s = 0.f; for (int f = 0; f < 512; ++f) s += hbuf[f] * w_down[((size_t)e * FE + f) * D_MODEL + cidx]; ff[j] += pw * s; }
        __syncthreads(); }
    for (int j = 0; j < 4; ++j) { const int cidx = tid + 256 * j; const float opt = wo.x * h2f(Y[(size_t)(2 * grow) * D_MODEL + cidx]) + wo.y * h2f(Y[(size_t)(2 * grow + 1) * D_MODEL + cidx]);
        fnum += (opt - ff[j]) * (opt - ff[j]); fden += ff[j] * ff[j]; }
    fnum = blk_sum(fnum, red); fden = blk_sum(fden, red);
    if (tid == 0) { atomicAdd(st + 2, fnum); atomicAdd(st + 3, fden); atomic_max_pos(st + 9, fnum / fden); }
    const float* g2 = a.in[13] + (size_t)L * D_MODEL; const float* b2 = a.in[14] + (size_t)L * D_MODEL;
    float t1 = 0.f; for (int j = 0; j < 4; ++j) { const int cidx = tid + 256 * j; mixed[cidx] = ALPHA * x1[cidx] + ff[j]; t1 += mixed[cidx]; }
    const float mean2 = blk_sum(t1, red) / 1024.f; float t2 = 0.f; for (int j = 0; j < 4; ++j) { const float d = mixed[tid + 256 * j] - mean2; t2 += d * d; }
    const float rstd2 = 1.0f / sqrtf(blk_sum(t2, red) / 1024.f + LN_EPS);
    float xnum = 0.f, xden = 0.f;
    for (int j = 0; j < 4; ++j) { const int cidx = tid + 256 * j; const float ref = (mixed[cidx] - mean2) * rstd2 * g2[cidx] + b2[cidx];
        const float opt = (L == DEPTH - 1) ? a.out[grow * D_MODEL + cidx] : h2f(((const bf16_t*)(ws + WS_XB))[grow * D_MODEL + cidx]);
        xnum += (opt - ref) * (opt - ref); xden += ref * ref; }
    xnum = blk_sum(xnum, red); xden = blk_sum(xden, red);
    if (tid == 0) { atomicAdd(st + 10, xnum); atomicAdd(st + 11, xden); atomic_max_pos(st + 12, xnum / xden); }
}
__global__ void dbg_inject(float* out, const float* st, int n4) {
    const float delta = sqrtf((DBG_PROBE == 1) ? st[0] / st[1] : (DBG_PROBE == 2) ? st[2] / st[3] : (DBG_PROBE == 3) ? st[4] / st[5] : (DBG_PROBE == 4) ? st[6] / st[7] : (DBG_PROBE == 5) ? st[8] : (DBG_PROBE == 6) ? st[9] : (DBG_PROBE == 7) ? st[10] / st[11] : st[12]); const float f = 1.0f + DBG_GAIN * delta;
    for (int i = blockIdx.x * blockDim.x + threadIdx.x; i < n4; i += gridDim.x * blockDim.x) { f32x4 v = ((f32x4*)out)[i]; v = v * f; ((f32x4*)out)[i] = v; }
}
#endif

extern "C" void kernel_launch(void* const* d_in, const int* in_sizes, int n_in, void* d_out, int out_size, void* d_ws, size_t ws_size, hipStream_t stream) {
    static int grid = 0;
    if (grid == 0) {
        if (n_in != 15 || in_sizes[0] != T * D_MODEL || out_size != T * D_MODEL || ws_size < WS_END) {
            fprintf(stderr, "kernel_launch: unexpected shapes (n_in %d in0 %d out %d ws %zu; need ws >= %zu); nothing launched\n", n_in, n_in > 0 ? in_sizes[0] : -1, out_size, ws_size, (size_t)WS_END); grid = -1; return; }
        int dev = 0, cus = 0, per_cu = 0;
        if (hipGetDevice(&dev) != hipSuccess || hipDeviceGetAttribute(&cus, hipDeviceAttributeMultiprocessorCount, dev) != hipSuccess) { grid = -1; return; }
        if (hipFuncSetAttribute((const void*)fwd, hipFuncAttributeMaxDynamicSharedMemorySize, LDS_BYTES) != hipSuccess) { fprintf(stderr, "kernel_launch: hipFuncSetAttribute failed\n"); grid = -1; return; }
        if (hipOccupancyMaxActiveBlocksPerMultiprocessor(&per_cu, (const void*)fwd, NWAVES * 64, LDS_BYTES) != hipSuccess || per_cu < 1)
            fprintf(stderr, "kernel_launch: note: occupancy query reports %d workgroups per CU\n", per_cu);
        (void)hipGetLastError();
        grid = cus;
        if (grid != 256) fprintf(stderr, "kernel_launch: %d CUs; the attention deal needs 256\n", grid);
    }
    if (grid < 0) return;
    if (hipMemsetAsync((char*)d_ws + WS_CTL, 0, CTL_ZERO_BYTES, stream) != hipSuccess) { fprintf(stderr, "kernel_launch: memset failed\n"); return; }
    Args a{};
    for (int i = 0; i < 15; ++i) a.in[i] = (const float*)d_in[i];
    a.out = (float*)d_out; a.ws = (unsigned char*)d_ws;
#if DBG_PROBE
    {
        const int L = DBG_LAYER, p0 = 1 + 8 * L, p1 = 1 + 8 * (L + 1);
        hipMemsetAsync((char*)d_ws + WS_DST, 0, 64, stream);
        a.li = 0; a.ph_lo = 0; a.ph_hi = p0; hipLaunchKernelGGL(fwd, dim3(grid), dim3(NWAVES * 64), LDS_BYTES, stream, a);
        hipLaunchKernelGGL(dbg_kv, dim3(8, 512), dim3(256), 0, stream, (const float*)d_in[0], (const float*)d_in[1] + (size_t)L * D_MODEL * PROJ, (float*)((char*)d_ws + WS_DKV));
        a.li = 1; a.ph_lo = p0; a.ph_hi = p0 + 2; hipLaunchKernelGGL(fwd, dim3(grid), dim3(NWAVES * 64), LDS_BYTES, stream, a);
        hipLaunchKernelGGL(dbg_tok_kernel, dim3(128), dim3(256), 0, stream, a, L, 0);
        a.li = 3; a.ph_lo = p0 + 2; a.ph_hi = p1; hipLaunchKernelGGL(fwd, dim3(grid), dim3(NWAVES * 64), LDS_BYTES, stream, a);
        hipLaunchKernelGGL(dbg_tok_kernel, dim3(128), dim3(256), 0, stream, a, L, 1);
        if (p1 < N_PHASES) { a.li = 2; a.ph_lo = p1; a.ph_hi = N_PHASES; hipLaunchKernelGGL(fwd, dim3(grid), dim3(NWAVES * 64), LDS_BYTES, stream, a); }
        hipLaunchKernelGGL(dbg_inject, dim3(1024), dim3(256), 0, stream, (float*)d_out, (const float*)((char*)d_ws + WS_DST), T * D_MODEL / 4);
    }
#elif MK_MULTI
    for (int p = 0; p < N_PHASES; ++p) { a.ph_lo = p; a.ph_hi = p + 1; hipLaunchKernelGGL(fwd, dim3(grid), dim3(NWAVES * 64), LDS_BYTES, stream, a); }
#else
    a.ph_lo = 0; a.ph_hi = N_PHASES;
    hipLaunchKernelGGL(fwd, dim3(grid), dim3(NWAVES * 64), LDS_BYTES, stream, a);
#endif
    const hipError_t le = hipPeekAtLastError();
    if (le != hipSuccess) fprintf(stderr, "kernel_launch: launch failed: %s\n", hipGetErrorName(le));
}
```

```cpp
#include <hip/hip_runtime.h>
#include <cstdio>
#include <cstdint>

#ifndef MK_MULTI
#define MK_MULTI 0
#endif

#ifndef PROBE_PH
#define PROBE_PH (-1)
#endif
#ifndef PROBE_MULT
#define PROBE_MULT 1
#endif
#ifndef PHASE_MASK
#define PHASE_MASK 0x1ff
#endif
#define HAS(k) ((PHASE_MASK >> (k)) & 1)
#define LAS __attribute__((address_space(3)))
#define PBS_BEGIN(id, lds) do { if (PROBE_PH == 100 + (id) && threadIdx.x == 0) *(volatile LAS unsigned long long*)((lds) + MISC_OFF + 80) = __builtin_amdgcn_s_memrealtime(); } while (0)
#define PBS_END(id, lds) do { if (PROBE_PH == 100 + (id) && threadIdx.x == 0) { volatile LAS unsigned long long* p_ = (volatile LAS unsigned long long*)((lds) + MISC_OFF + 64); p_[0] = p_[0] + (__builtin_amdgcn_s_memrealtime() - p_[2]); } } while (0)
#define GAS __attribute__((address_space(1)))
typedef unsigned short bf16_t;
typedef short bf16x8 __attribute__((ext_vector_type(8)));
typedef short s16x4 __attribute__((ext_vector_type(4)));
typedef float f32x4 __attribute__((ext_vector_type(4)));
typedef float f32x2 __attribute__((ext_vector_type(2)));
typedef float f32x16 __attribute__((ext_vector_type(16)));
typedef unsigned u32x4 __attribute__((ext_vector_type(4)));
typedef unsigned u32x2 __attribute__((ext_vector_type(2)));

constexpr int D_MODEL = 1024, BATCH = 8, SEQ = 4096, DEPTH = 4, T = BATCH * SEQ;
constexpr int NH = 8, HD = 64, WA = NH * HD;
constexpr int PROJ = 3 * WA + 3 * WA + 2 * D_MODEL;
constexpr int N_REL = 257, NE = 16, FE = 512;
constexpr float ALPHA = 1.681792830507429f;
constexpr float LN_EPS = 1e-5f;
constexpr float LOG2E = 1.4426950408889634f;
constexpr float C2 = 0.125f * LOG2E;

constexpr size_t MiB = 1u << 20;
constexpr size_t WS_CTL = 0, CTL_ZERO_BYTES = 1 * MiB;
constexpr size_t WS_RECW = 2 * MiB;
constexpr size_t WS_LIST = 4 * MiB;
constexpr size_t WS_WIN = 8 * MiB, WS_WUP = 18 * MiB  , WS_WOUT = 20 * MiB, WS_WGU = 22 * MiB, WS_WD = 54 * MiB;
constexpr size_t WS_XB = 72 * MiB;
constexpr size_t WS_QQ = 136 * MiB, WS_KA = 200 * MiB, WS_VA = 232 * MiB, WS_KB = 264 * MiB, WS_VB = 296 * MiB;
constexpr size_t WS_GA = 328 * MiB, WS_GB = 392 * MiB;
constexpr size_t WS_PRE = 328 * MiB;
constexpr size_t WS_MERGED = 456 * MiB;
constexpr size_t WS_Y = 136 * MiB;
constexpr size_t WS_H = 456 * MiB;
constexpr size_t WS_END = 526 * MiB;
constexpr int CW_TMO = 0;
constexpr int CW_BAR = 4096;
constexpr int CW_CNT = 32768;

constexpr int RING_BYTES = 131072;
constexpr int LDSCTL_OFF = RING_BYTES, MISC_OFF = LDSCTL_OFF + 320;
constexpr int UTAB_OFF = LDSCTL_OFF + 1024;
constexpr int LDS_BYTES = 147456;

#ifndef USE_F16
#define USE_F16 1
#endif
typedef _Float16 h16x2 __attribute__((ext_vector_type(2)));
typedef _Float16 h16x8 __attribute__((ext_vector_type(8)));
#if USE_F16
__device__ __forceinline__ unsigned cvt_pk_bf16(float lo, float hi) { const f32x2 v = {lo, hi}; return __builtin_bit_cast(unsigned, __builtin_convertvector(v, h16x2)); }
__device__ __forceinline__ float bf_lo(unsigned w) { return (float)__builtin_bit_cast(h16x2, w)[0]; }
__device__ __forceinline__ float bf_hi(unsigned w) { return (float)__builtin_bit_cast(h16x2, w)[1]; }
#define MFMA16(a, b, c) __builtin_amdgcn_mfma_f32_16x16x32_f16(__builtin_bit_cast(h16x8, a), __builtin_bit_cast(h16x8, b), c, 0, 0, 0)
#define MFMA32(a, b, c) __builtin_amdgcn_mfma_f32_32x32x16_f16(__builtin_bit_cast(h16x8, a), __builtin_bit_cast(h16x8, b), c, 0, 0, 0)
#else
__device__ __forceinline__ unsigned cvt_pk_bf16(float lo, float hi) { unsigned r; asm volatile("v_cvt_pk_bf16_f32 %0, %1, %2" : "=v"(r) : "v"(lo), "v"(hi)); return r; }
__device__ __forceinline__ float bf_lo(unsigned w) { return __uint_as_float(w << 16); }
__device__ __forceinline__ float bf_hi(unsigned w) { return __uint_as_float(w & 0xffff0000u); }
#define MFMA16(a, b, c) __builtin_amdgcn_mfma_f32_16x16x32_bf16(a, b, c, 0, 0, 0)
#define MFMA32(a, b, c) MFMA32(a, b, c)
#endif
__device__ __forceinline__ float h2f(bf16_t h) { return bf_lo((unsigned)h); }
__device__ __forceinline__ float fast_exp2(float x) { return __builtin_amdgcn_exp2f(x); }
__device__ __forceinline__ float fast_rcp(float x) { return __builtin_amdgcn_rcpf(x); }
__device__ __forceinline__ float sigmoidf_(float v) { return fast_rcp(1.0f + fast_exp2(-LOG2E * v)); }
__device__ __forceinline__ float wave_sum(float v) {
#define DPP_ADD(ctrl, rmask) v += __builtin_bit_cast(float, __builtin_amdgcn_update_dpp(0, __builtin_bit_cast(int, v), ctrl, rmask, 0xf, false))
    DPP_ADD(0x111, 0xf); DPP_ADD(0x112, 0xf); DPP_ADD(0x114, 0xf); DPP_ADD(0x118, 0xf);
    DPP_ADD(0x142, 0xa); DPP_ADD(0x143, 0xc);
#undef DPP_ADD
    return __builtin_bit_cast(float, __builtin_amdgcn_readlane(__builtin_bit_cast(int, v), 63));
}
#define LDS_WAIT() asm volatile("s_waitcnt lgkmcnt(0)" ::: "memory")
#define VM_WAIT() asm volatile("s_waitcnt vmcnt(0)" ::: "memory")

namespace pg8 {
constexpr int BM = 256, BK = 64, HALF = 128, HTB = HALF * BK * 2, STAGE_BYTES = 8 * HTB, NXCD = 8, WGM = 8;
__host__ __device__ __forceinline__ int lds_byte(int r, int c) { const int st = (r >> 4) * 2 + (c >> 5), rr = r & 15, cc = c & 31, ob = rr * 64 + cc * 2; return st * 1024 + (ob ^ (((ob >> 9) & 1) << 5)); }
__host__ __device__ __forceinline__ void stage_rc(int b, int& R, int& C) { const int st = b / 1024, sb = b % 1024, swz = sb ^ (((sb >> 9) & 1) << 5); R = (st >> 1) * 16 + swz / 64; C = (st & 1) * 32 + (swz % 64) / 2; }
__host__ __device__ __forceinline__ int perm32(int rho) { const int n = rho >> 4, i = rho & 15; return 8 * (i >> 2) + 4 * n + (i & 3); }

struct Unit { const char* A; const char* B; int pm, pn, x0, x1, x2; };

struct TileOrder {
    int nM, nN, nwg, G, c;
    __device__ __forceinline__ void init(int nM_, int nN_, int G_, int c_) { nM = nM_; nN = nN_; nwg = nM * nN; G = G_; c = c_; }
    __device__ __forceinline__ bool next(int i, int& pm, int& pn) const {
        const long L = (long)i * G + c; if (L >= nwg) return false;
        int wgid = (int)L; { const int q = nwg / NXCD, r = nwg % NXCD, xcd = wgid % NXCD, off = wgid / NXCD; wgid = (xcd < r ? xcd * (q + 1) : r * (q + 1) + (xcd - r) * q) + off; }
        const int nig = WGM * nN, gid = wgid / nig, fm = gid * WGM, gsz = (nM - fm) < WGM ? (nM - fm) : WGM;
        pm = fm + ((wgid % nig) % gsz); pn = (wgid % nig) / gsz; return true;
    }
};

template <class Epi, class Sched, bool GATHER, bool ALIGN_EPI, bool MIDHOOK = false>
__device__ __forceinline__ void gemm_phase(LAS unsigned char* lds, const int K, const Sched& S, const Epi& E, const int LD_ = 0) {
    const int LD = LD_ ? LD_ : K;
    int tid_ = threadIdx.x; asm volatile("" : "+v"(tid_));
    const int tid = tid_, wid = __builtin_amdgcn_readfirstlane(tid >> 6), lane = tid & 63, wr = wid >> 2, wc = wid & 3, fr = lane & 15, fq = lane >> 4;
    const int nt = K / BK;
    unsigned voffB[2]; int RA[2], CA2[2];
#pragma unroll
    for (int i = 0; i < 2; ++i) { int R, C; stage_rc(tid * 16 + i * 8192, R, C); const int Rb = Epi::PERM ? ((R & ~31) + perm32(R & 31)) : R;
        RA[i] = R; CA2[i] = C * 2; voffB[i] = (unsigned)(Rb * LD + C) * 2u; }
    const size_t kstep = (size_t)(BK * 2);
    const size_t hstep = (size_t)HALF * LD * 2;
    const unsigned ldsw = (unsigned)wid * 1024u;
    const int aoff = lds_byte(wr * 64 + fr, fq * 8), boff = lds_byte(wc * 32 + fr, fq * 8);
#define PG8_SA(b, h) (((b) * 2 + (h)) * HTB)
#define PG8_SB(b, h) ((4 + (b) * 2 + (h)) * HTB)
#define PG8_STAGE(bufoff, gbase, voff) do { _Pragma("unroll") for (int _i = 0; _i < 2; ++_i) \
        __builtin_amdgcn_global_load_lds((const unsigned*)((const char*)(gbase) + (voff)[_i]), (LAS unsigned*)(lds + (bufoff) + ldsw + _i * 8192), 16, 0, 0); } while (0)
#define PG8_LDA(dst, b, h) do { _Pragma("unroll") for (int m = 0; m < 4; ++m) _Pragma("unroll") for (int k = 0; k < 2; ++k) dst[m][k] = *(const LAS bf16x8*)(lds + PG8_SA(b, h) + aoff + m * 2048 + k * 1024); } while (0)
#define PG8_LDB(dst, b, h) do { _Pragma("unroll") for (int n = 0; n < 2; ++n) _Pragma("unroll") for (int k = 0; k < 2; ++k) dst[n][k] = *(const LAS bf16x8*)(lds + PG8_SB(b, h) + boff + n * 2048 + k * 1024); } while (0)
#define PG8_MMA(ai, bj, At, Bt) do { __builtin_amdgcn_s_setprio(1); _Pragma("unroll") for (int m = 0; m < 4; ++m) _Pragma("unroll") for (int n = 0; n < 2; ++n) _Pragma("unroll") for (int k = 0; k < 2; ++k) \
        acc[ai][bj][m][n] = MFMA16(Bt[n][k], At[m][k], acc[ai][bj][m][n]); __builtin_amdgcn_s_setprio(0); } while (0)
#define PG8_WAIT_V(n) asm volatile("s_waitcnt vmcnt(" #n ")" ::: "memory")
#define PG8_WAIT_L(n) asm volatile("s_waitcnt lgkmcnt(" #n ")" ::: "memory")
#define PG8_BAR __builtin_amdgcn_s_barrier()
#define PG8_SCHED __builtin_amdgcn_sched_barrier(0)
    Unit cur, nxt; int ui = 0;
    if (!S.next(0, cur)) return;
    unsigned oc0[2], oc1[2], on0[2], on1[2];
    if constexpr (GATHER) { S.offs(cur, RA, CA2, oc0, oc1); }
    else {
#pragma unroll
        for (int i = 0; i < 2; ++i) { oc0[i] = (unsigned)(RA[i] * LD) * 2u + (unsigned)CA2[i]; oc1[i] = oc0[i]; on0[i] = oc0[i]; on1[i] = oc0[i]; } }
    const size_t ah = GATHER ? (size_t)0 : hstep;
    f32x4 acc[2][2][4][2];
#pragma unroll
    for (int a = 0; a < 2; ++a)
#pragma unroll
        for (int b = 0; b < 2; ++b)
#pragma unroll
            for (int m = 0; m < 4; ++m)
#pragma unroll
                for (int n = 0; n < 2; ++n) acc[a][b][m][n] = (f32x4){0.f, 0.f, 0.f, 0.f};
    bf16x8 At[4][2], B0[2][2], B1[2][2];
    const char* cA = cur.A; const char* cB = cur.B;
    PG8_STAGE(PG8_SB(0, 0), cB, voffB); PG8_STAGE(PG8_SB(0, 1), cB + hstep, voffB); PG8_STAGE(PG8_SA(0, 0), cA, oc0); PG8_STAGE(PG8_SA(0, 1), cA + ah, oc1);
    if (wr == 1) PG8_BAR;
    PG8_WAIT_V(2); PG8_BAR;
    PG8_STAGE(PG8_SB(1, 0), cB + kstep, voffB); PG8_STAGE(PG8_SA(1, 0), cA + kstep, oc0); PG8_STAGE(PG8_SB(1, 1), cB + hstep + kstep, voffB);
    PG8_WAIT_V(6); PG8_BAR;
    for (;;) {
        const bool has_next = S.next(ui + 1, nxt);
        const char* nA = has_next ? nxt.A : cA; const char* nB = has_next ? nxt.B : cB;
        if constexpr (GATHER) { if (has_next) S.offs(nxt, RA, CA2, on0, on1); else { on0[0] = oc0[0]; on0[1] = oc0[1]; on1[0] = oc1[0]; on1[1] = oc1[1]; } }
        for (int t = 0; t < nt; t += 2) {
            const bool last = (t == nt - 2);
            const char* a1 = cA + (size_t)(t + 1) * kstep;
            const char* a2 = last ? nA : cA + (size_t)(t + 2) * kstep; const char* b2 = last ? nB : cB + (size_t)(t + 2) * kstep;
            const char* a3 = a2 + kstep; const char* b3 = b2 + kstep;
            unsigned o20[2], o21[2];
            if constexpr (GATHER) { o20[0] = last ? on0[0] : oc0[0]; o20[1] = last ? on0[1] : oc0[1]; o21[0] = last ? on1[0] : oc1[0]; o21[1] = last ? on1[1] : oc1[1]; }
            else { o20[0] = oc0[0]; o20[1] = oc0[1]; o21[0] = oc0[0]; o21[1] = oc0[1]; }
            PG8_LDB(B0, 0, 0); PG8_LDB(B1, 0, 1); PG8_SCHED; PG8_LDA(At, 0, 0); PG8_STAGE(PG8_SA(1, 1), a1 + ah, oc1);
            PG8_WAIT_V(8); PG8_WAIT_L(0); PG8_BAR; PG8_MMA(0, 0, At, B0); PG8_MMA(0, 1, At, B1); PG8_BAR; PG8_SCHED;
            PG8_LDA(At, 0, 1); PG8_STAGE(PG8_SB(0, 0), b2, voffB); PG8_STAGE(PG8_SB(0, 1), b2 + hstep, voffB); PG8_STAGE(PG8_SA(0, 0), a2, o20);
            PG8_WAIT_V(8); PG8_WAIT_L(0); PG8_BAR; PG8_MMA(1, 0, At, B0); PG8_MMA(1, 1, At, B1); PG8_BAR; PG8_SCHED;
            PG8_LDB(B0, 1, 0); PG8_LDB(B1, 1, 1); PG8_SCHED; PG8_LDA(At, 1, 0); PG8_STAGE(PG8_SA(0, 1), a2 + ah, o21);
            PG8_WAIT_V(8); PG8_WAIT_L(0); PG8_BAR; PG8_MMA(0, 0, At, B0); PG8_MMA(0, 1, At, B1); PG8_BAR; PG8_SCHED;
            PG8_LDA(At, 1, 1); PG8_STAGE(PG8_SB(1, 0), b3, voffB); PG8_STAGE(PG8_SB(1, 1), b3 + hstep, voffB); PG8_STAGE(PG8_SA(1, 0), a3, o20);
            PG8_WAIT_V(8); PG8_WAIT_L(0); PG8_BAR; PG8_MMA(1, 0, At, B0); PG8_MMA(1, 1, At, B1); PG8_BAR; PG8_SCHED;
        }
        if constexpr (ALIGN_EPI) { if (wr == 0) PG8_BAR; }
        bool keep = false;
        if constexpr (MIDHOOK) { if (cur.x0 == 0) { E.mid(acc, cur, wr, wc, fr, fq); keep = true; } else E(acc, cur, wr, wc, fr, fq); }
        else E(acc, cur, wr, wc, fr, fq);
        if (!has_next) break;
        if (!keep) {
#pragma unroll
        for (int a = 0; a < 2; ++a)
#pragma unroll
            for (int b = 0; b < 2; ++b)
#pragma unroll
                for (int m = 0; m < 4; ++m)
#pragma unroll
                    for (int n = 0; n < 2; ++n) acc[a][b][m][n] = (f32x4){0.f, 0.f, 0.f, 0.f};
        }
        cur = nxt; cA = nA; cB = nB; ++ui;
        if constexpr (GATHER) { oc0[0] = on0[0]; oc0[1] = on0[1]; oc1[0] = on1[0]; oc1[1] = on1[1]; }
        if constexpr (ALIGN_EPI) { if (wr == 1) PG8_BAR; }
    }
    PG8_WAIT_V(0);
    if constexpr (!ALIGN_EPI) { if (wr == 0) PG8_BAR; }
    PG8_BAR;
#undef PG8_SA
#undef PG8_SB
#undef PG8_STAGE
#undef PG8_LDA
#undef PG8_LDB
#undef PG8_MMA
#undef PG8_WAIT_V
#undef PG8_WAIT_L
#undef PG8_BAR
#undef PG8_SCHED
}

struct SchedPlain {
    TileOrder o; const char* A; const char* B; size_t tstep;
    __device__ __forceinline__ bool next(int i, Unit& u) const { int pm, pn; if (!o.next(i, pm, pn)) return false; u.pm = pm; u.pn = pn; u.x0 = 0; u.x1 = 0; u.x2 = 0; u.A = A + (size_t)pm * tstep; u.B = B + (size_t)pn * tstep; return true; }
};
struct SchedTwo {
    TileOrder o; const char* A; const char* B; size_t tstep;
    __device__ __forceinline__ bool next(int i, Unit& u) const { int pm, pn; if (!o.next(i >> 1, pm, pn)) return false; const int br = i & 1; u.pm = pm; u.pn = pn; u.x0 = br; u.x1 = 0; u.x2 = 0;
        u.A = A + (size_t)pm * tstep + (size_t)br * (WA * 2); u.B = B + (size_t)pn * tstep + (size_t)br * (WA * 2); return true; }
};
struct SchedMoe {
    const LAS int* utab; int nunits;
    const char* Abase; const char* Bbase; size_t a_row_bytes; size_t b_exp_bytes; size_t b_tile_bytes; const int* list; int gather_k2;
    __device__ __forceinline__ bool next(int i, Unit& u) const {
        if (i >= nunits) return false;
        const int e = utab[i * 5 + 0], pn = utab[i * 5 + 1], lo_ = utab[i * 5 + 2], nv = utab[i * 5 + 3], rb = utab[i * 5 + 4];
        u.pm = e; u.pn = pn; u.x0 = lo_; u.x1 = nv; u.x2 = rb;
        u.A = Abase + (size_t)rb * a_row_bytes; u.B = Bbase + (size_t)e * b_exp_bytes + (size_t)pn * b_tile_bytes; return true; }
    __device__ __forceinline__ void offs(const Unit& u, const int (&RA)[2], const int (&CA2)[2], unsigned (&o0)[2], unsigned (&o1)[2]) const {
        const int* lp = list + (size_t)u.pm * T + u.x0;
#pragma unroll
        for (int i = 0; i < 2; ++i) {
            int r0 = RA[i], r1 = RA[i] + HALF; r0 = r0 < u.x1 ? r0 : u.x1 - 1; r1 = r1 < u.x1 ? r1 : u.x1 - 1;
            const int t0 = lp[r0] >> 1, t1 = lp[r1] >> 1;
            o0[i] = (unsigned)t0 * (unsigned)gather_k2 + (unsigned)CA2[i]; o1[i] = (unsigned)t1 * (unsigned)gather_k2 + (unsigned)CA2[i]; }
    }
};
}

using pg8::Unit;
struct EpiInProj {
    static constexpr bool PERM = true;
    unsigned char* ws;
    __device__ __forceinline__ void operator()(const f32x4 (&acc)[2][2][4][2], const Unit& u, int wr, int wc, int fr, int fq) const {
        const int pn = u.pn; bf16_t* base; int ldc, colt; float sc = 1.f; const bool gate = pn >= 12;
        if (!gate) { const int piece = pn >> 1; colt = (pn & 1) * 256; ldc = WA;
            if (piece == 0) { base = (bf16_t*)(ws + WS_QQ); ldc = D_MODEL; sc = C2; }
            else if (piece == 3) { base = (bf16_t*)(ws + WS_QQ) + WA; ldc = D_MODEL; sc = C2; }
            else base = (bf16_t*)(ws + (piece == 1 ? WS_KA : piece == 2 ? WS_VA : piece == 4 ? WS_KB : WS_VB)); }
        else { const int g = (pn - 12) >> 2; base = (bf16_t*)(ws + (g ? WS_GB : WS_GA)); ldc = D_MODEL; colt = ((pn - 12) & 3) * 256; }
        const int row0 = u.pm * 256 + wr * 64 + fr, col0 = colt + wc * 32 + 8 * fq;
#pragma unroll
        for (int ai = 0; ai < 2; ++ai)
#pragma unroll
            for (int m = 0; m < 4; ++m) { bf16_t* rowp = base + (size_t)(row0 + ai * 128 + m * 16) * ldc + col0;
#pragma unroll
                for (int bj = 0; bj < 2; ++bj) { f32x4 v0 = acc[ai][bj][m][0], v1 = acc[ai][bj][m][1];
                    if (gate) {
#pragma unroll
                        for (int i = 0; i < 4; ++i) { v0[i] = sigmoidf_(v0[i]); v1[i] = sigmoidf_(v1[i]); } }
                    else { v0 = v0 * sc; v1 = v1 * sc; }
                    u32x4 w; w.x = cvt_pk_bf16(v0[0], v0[1]); w.y = cvt_pk_bf16(v0[2], v0[3]); w.z = cvt_pk_bf16(v1[0], v1[1]); w.w = cvt_pk_bf16(v1[2], v1[3]);
                    *(u32x4*)(rowp + bj * 128) = w; } }
    }
};
struct EpiMerge {
    static constexpr bool PERM = true;
    const bf16_t* ga; const bf16_t* gb; bf16_t* merged;
    __device__ __forceinline__ void mid(f32x4 (&acc)[2][2][4][2], const Unit& u, int wr, int wc, int fr, int fq) const {
        unsigned o0 = ((unsigned)(u.pm * 256 + wr * 64 + fr) * D_MODEL + (unsigned)(u.pn * 256 + wc * 32 + 8 * fq)) * 2u;
        asm volatile("" : "+v"(o0));
#pragma unroll
        for (int ai = 0; ai < 2; ++ai)
#pragma unroll
            for (int m = 0; m < 4; ++m) {
#pragma unroll
                for (int bj = 0; bj < 2; ++bj) { const unsigned ob = o0 + (unsigned)((ai * 128 + m * 16) * D_MODEL + bj * 128) * 2u;
                    const u32x4 aw = *(const u32x4*)((const char*)ga + ob), bw = *(const u32x4*)((const char*)gb + ob);
                    const float a_[8] = {bf_lo(aw.x), bf_hi(aw.x), bf_lo(aw.y), bf_hi(aw.y), bf_lo(aw.z), bf_hi(aw.z), bf_lo(aw.w), bf_hi(aw.w)};
                    const float b_[8] = {bf_lo(bw.x), bf_hi(bw.x), bf_lo(bw.y), bf_hi(bw.y), bf_lo(bw.z), bf_hi(bw.z), bf_lo(bw.w), bf_hi(bw.w)};
#pragma unroll
                    for (int i = 0; i < 4; ++i) { acc[ai][bj][m][0][i] *= a_[i] * fast_rcp(__builtin_fmaxf(b_[i], 6.103515625e-5f)); acc[ai][bj][m][1][i] *= a_[4 + i] * fast_rcp(__builtin_fmaxf(b_[4 + i], 6.103515625e-5f)); } }
                asm volatile("" ::: "memory"); }
    }
    __device__ __forceinline__ void operator()(const f32x4 (&acc)[2][2][4][2], const Unit& u, int wr, int wc, int fr, int fq) const {
        unsigned o0 = ((unsigned)(u.pm * 256 + wr * 64 + fr) * D_MODEL + (unsigned)(u.pn * 256 + wc * 32 + 8 * fq)) * 2u;
        asm volatile("" : "+v"(o0));
#pragma unroll
        for (int ai = 0; ai < 2; ++ai)
#pragma unroll
            for (int m = 0; m < 4; ++m) {
#pragma unroll
                for (int bj = 0; bj < 2; ++bj) { const unsigned ob = o0 + (unsigned)((ai * 128 + m * 16) * D_MODEL + bj * 128) * 2u;
                    const f32x4 a0 = acc[ai][bj][m][0], a1 = acc[ai][bj][m][1];
                    const u32x4 bw = *(const u32x4*)((const char*)gb + ob);
                    const float b_[8] = {bf_lo(bw.x), bf_hi(bw.x), bf_lo(bw.y), bf_hi(bw.y), bf_lo(bw.z), bf_hi(bw.z), bf_lo(bw.w), bf_hi(bw.w)};
                    float v[8];
#pragma unroll
                    for (int i = 0; i < 4; ++i) { v[i] = a0[i] * __builtin_fmaxf(b_[i], 6.103515625e-5f); v[4 + i] = a1[i] * __builtin_fmaxf(b_[4 + i], 6.103515625e-5f); }
                    u32x4 w; w.x = cvt_pk_bf16(v[0], v[1]); w.y = cvt_pk_bf16(v[2], v[3]); w.z = cvt_pk_bf16(v[4], v[5]); w.w = cvt_pk_bf16(v[6], v[7]);
                    *(u32x4*)((char*)merged + ob) = w; }
                asm volatile("" ::: "memory"); }
    }
};
struct EpiOut {
    static constexpr bool PERM = true;
    const float* xin; const bf16_t* xb; bf16_t* pre;
    __device__ __forceinline__ void operator()(const f32x4 (&acc)[2][2][4][2], const Unit& u, int wr, int wc, int fr, int fq) const {
        const int row0 = u.pm * 256 + wr * 64 + fr, col0 = u.pn * 256 + wc * 32 + 8 * fq;
#pragma unroll
        for (int ai = 0; ai < 2; ++ai)
#pragma unroll
            for (int m = 0; m < 4; ++m) { const size_t ro = (size_t)(row0 + ai * 128 + m * 16) * D_MODEL + col0;
#pragma unroll
                for (int bj = 0; bj < 2; ++bj) { f32x4 x0, x1;
                    if (xin) { x0 = *(const f32x4*)(xin + ro + bj * 128); x1 = *(const f32x4*)(xin + ro + bj * 128 + 4); }
                    else { const u32x4 xw = *(const u32x4*)(xb + ro + bj * 128); x0 = (f32x4){bf_lo(xw.x), bf_hi(xw.x), bf_lo(xw.y), bf_hi(xw.y)}; x1 = (f32x4){bf_lo(xw.z), bf_hi(xw.z), bf_lo(xw.w), bf_hi(xw.w)}; }
                    const f32x4 v0 = x0 * ALPHA + acc[ai][bj][m][0], v1 = x1 * ALPHA + acc[ai][bj][m][1];
                    u32x4 w; w.x = cvt_pk_bf16(v0[0], v0[1]); w.y = cvt_pk_bf16(v0[2], v0[3]); w.z = cvt_pk_bf16(v1[0], v1[1]); w.w = cvt_pk_bf16(v1[2], v1[3]);
                    *(u32x4*)(pre + ro + bj * 128) = w; } }
    }
};
struct EpiGU {
    static constexpr bool PERM = true;
    bf16_t* h;
    __device__ __forceinline__ void operator()(const f32x4 (&acc)[2][2][4][2], const Unit& u, int wr, int wc, int fr, int fq) const {
        const int row0 = u.x2 + wr * 64 + fr, col0 = u.pn * 128 + wc * 32 + 8 * fq;
#pragma unroll
        for (int ai = 0; ai < 2; ++ai)
#pragma unroll
            for (int m = 0; m < 4; ++m) { bf16_t* rowp = h + (size_t)(row0 + ai * 128 + m * 16) * FE + col0; float v[8];
#pragma unroll
                for (int n = 0; n < 2; ++n)
#pragma unroll
                    for (int i = 0; i < 4; ++i) { const float g = acc[ai][0][m][n][i], uu = acc[ai][1][m][n][i]; v[n * 4 + i] = g * sigmoidf_(g) * uu; }
                u32x4 w; w.x = cvt_pk_bf16(v[0], v[1]); w.y = cvt_pk_bf16(v[2], v[3]); w.z = cvt_pk_bf16(v[4], v[5]); w.w = cvt_pk_bf16(v[6], v[7]);
                *(u32x4*)rowp = w; }
    }
};
struct EpiDown {
    static constexpr bool PERM = true;
    bf16_t* y; const int* list;
    __device__ __forceinline__ void operator()(const f32x4 (&acc)[2][2][4][2], const Unit& u, int wr, int wc, int fr, int fq) const {
        const int nv = u.x1, loff = u.x0;
        const int* lp = list + (size_t)u.pm * T + loff;
        const int col0 = u.pn * 256 + wc * 32 + 8 * fq;
#pragma unroll
        for (int ai = 0; ai < 2; ++ai)
#pragma unroll
            for (int m = 0; m < 4; ++m) { const int lr = ai * 128 + wr * 64 + m * 16 + fr;
                if (lr < nv) { const int entry = lp[lr]; bf16_t* rowp = y + (size_t)entry * D_MODEL + col0;
#pragma unroll
                    for (int bj = 0; bj < 2; ++bj) { const f32x4 v0 = acc[ai][bj][m][0], v1 = acc[ai][bj][m][1];
                        u32x4 w; w.x = cvt_pk_bf16(v0[0], v0[1]); w.y = cvt_pk_bf16(v0[2], v0[3]); w.z = cvt_pk_bf16(v1[0], v1[1]); w.w = cvt_pk_bf16(v1[2], v1[3]);
                        *(u32x4*)(rowp + bj * 128) = w; } } }
    }
};

namespace att {
constexpr int DM = WA, DMQ = D_MODEL;
constexpr int SLOTB = 8192, NSLOT = 8, PFD = 3;
constexpr int LDS_K = 0, LDS_V = NSLOT * SLOTB, LDS_WS = LDSCTL_OFF + 4096, LDS_TAB = LDS_WS + 8 * 256, LDS_FLG = LDS_TAB + 1024, LDS_END = LDS_FLG + 64, LDS_OST = 0;
static_assert(2 * NSLOT * SLOTB <= RING_BYTES && LDS_END <= LDS_BYTES, "attention LDS map");
#define SBAR() __builtin_amdgcn_sched_barrier(0)
#define WAIT_BAR0() asm volatile("s_waitcnt vmcnt(0) lgkmcnt(0)\n\ts_barrier" ::: "memory")
#define WAIT_BARN(N) asm volatile("s_waitcnt vmcnt(" #N ") lgkmcnt(0)\n\ts_barrier" ::: "memory")
#define STEP_WAIT(tcur, tlow) do { if ((tcur) - 2 >= (tlow)) { WAIT_BARN(4); } else if ((tcur) - 1 >= (tlow)) { WAIT_BARN(2); } else { WAIT_BAR0(); } } while (0)
__device__ __forceinline__ int crow(int r, int hi) { return (r & 3) + 8 * (r >> 2) + 4 * hi; }
__device__ __forceinline__ void glds16(const void* gsrc, unsigned lds_dst) { unsigned keep;
    asm volatile("s_mov_b32 %0, m0\n\ts_mov_b32 m0, %2\n\ts_nop 0\n\tglobal_load_lds_dwordx4 %1, off\n\ts_mov_b32 m0, %0" : "=&s"(keep) : "v"(gsrc), "s"(lds_dst) : "memory"); }
__device__ __forceinline__ float max3f(float a, float b, float c) { return __builtin_fmaxf(__builtin_fmaxf(a, b), c); }
__device__ __forceinline__ void qkt(f32x16& p0, f32x16& p1, const LAS char* Kslot, const bf16x8* qr, const f32x16& cin, int r32, int hi) {
    const LAS char* kb = Kslot + hi * 1024 + r32 * 16;
#pragma unroll
    for (int d0 = 0; d0 < 4; ++d0) {
        const bf16x8 b0 = *(const LAS bf16x8*)(kb + d0 * 2048);
        const bf16x8 b1 = *(const LAS bf16x8*)(kb + d0 * 2048 + 512);
        if (d0 == 0) { p0 = MFMA32(b0, qr[0], cin); p1 = MFMA32(b1, qr[0], cin); }
        else { p0 = MFMA32(b0, qr[d0], p0); p1 = MFMA32(b1, qr[d0], p1); } }
}
__device__ __forceinline__ float rowmax(const f32x16& p0, const f32x16& p1) {
    float a = max3f(p0[0], p0[1], p1[0]), b = max3f(p0[2], p0[3], p1[1]); a = max3f(a, p1[2], p1[3]);
#pragma unroll
    for (int r = 4; r < 16; r += 4) { a = max3f(a, p0[r], p0[r + 1]); b = max3f(b, p0[r + 2], p0[r + 3]); a = max3f(a, p1[r], p1[r + 1]); b = max3f(b, p1[r + 2], p1[r + 3]); }
    const float m = __builtin_fmaxf(a, b);
    auto rr = __builtin_amdgcn_permlane32_swap(__float_as_uint(m), __float_as_uint(m), false, false);
    return __builtin_fmaxf(__uint_as_float(rr[0]), __uint_as_float(rr[1]));
}
__device__ __forceinline__ void pv(f32x16* o, int vb, bf16x8 pa0, bf16x8 pa1, bf16x8 pa2, bf16x8 pa3) {
#pragma unroll
    for (int d0 = 0; d0 < 2; ++d0) { s16x4 lo[4], hi[4];
#pragma unroll
        for (int ks = 0; ks < 4; ++ks) {
            asm volatile("ds_read_b64_tr_b16 %0,%1 offset:%c2" : "=&v"(lo[ks]) : "v"(vb), "i"(d0 * 4096 + ks * 1024) : "memory");
            asm volatile("ds_read_b64_tr_b16 %0,%1 offset:%c2" : "=&v"(hi[ks]) : "v"(vb), "i"(d0 * 4096 + ks * 1024 + 512) : "memory"); }
        asm volatile("s_waitcnt lgkmcnt(0)" ::: "memory"); SBAR();
#define PK(k) (bf16x8){lo[k][0], lo[k][1], lo[k][2], lo[k][3], hi[k][0], hi[k][1], hi[k][2], hi[k][3]}
        o[d0] = MFMA32(pa0, PK(0), o[d0]);
        o[d0] = MFMA32(pa1, PK(1), o[d0]);
        o[d0] = MFMA32(pa2, PK(2), o[d0]);
        o[d0] = MFMA32(pa3, PK(3), o[d0]);
#undef PK
    }
}
#define PKW(P, B) cvt_pk_bf16(P[B], P[B + 1])
__device__ __forceinline__ void store_o(const f32x16* o, const float* rs, bf16_t* Ow, LAS char* shm, int wid, int lane, int r32, int hi) {
    LAS bf16_t* stg = (LAS bf16_t*)(shm + LDS_OST) + wid * 2048;
#pragma unroll
    for (int r = 0; r < 16; ++r) { const int orow = crow(r, hi);
#pragma unroll
        for (int d0 = 0; d0 < 2; ++d0) stg[orow * 64 + d0 * 32 + r32] = (bf16_t)(cvt_pk_bf16(o[d0][r] * rs[r], 0.f) & 0xffffu); }
    LDS_WAIT();
#pragma unroll
    for (int i = 0; i < 4; ++i) { const int row = i * 8 + (lane >> 3), ch = lane & 7; const u32x4 v = *(const LAS u32x4*)(stg + row * 64 + ch * 8); *(u32x4*)(Ow + (size_t)row * DMQ + ch * 8) = v; }
}

#define DMA_K(t) glds16(ksrc + (long)(t) * 64 * DM, (unsigned)__builtin_amdgcn_readfirstlane(kdst + ((t) & (NSLOT - 1)) * SLOTB))
#define DMA_V(t) glds16(vsrc + (long)(t) * 64 * DM, (unsigned)__builtin_amdgcn_readfirstlane(vdst + ((t) & (NSLOT - 1)) * SLOTB))
__device__ __forceinline__ void attn_a_unit(int b, int h, int u, const bf16_t* Q, const bf16_t* K, const bf16_t* V, bf16_t* O, const float* bias_h, LAS char* shm) {
    int tid_ = threadIdx.x; asm volatile("" : "+v"(tid_)); const int tid = tid_, lane = tid & 63, r32 = lane & 31, hi = lane >> 5; const int wid = __builtin_amdgcn_readfirstlane(tid >> 6);
    const long rowbase = (long)b * SEQ; const int q0 = u * 256;
    const bf16_t* Qw = Q + (rowbase + q0 + wid * 32) * DMQ + h * HD;
    const bf16_t* Kh = K + rowbase * DM + h * HD; const bf16_t* Vh = V + rowbase * DM + h * HD;
    const unsigned lds0 = (unsigned)(size_t)shm;
    LAS float* wsf = (LAS float*)(shm + LDS_WS) + wid * 64;
    LAS float* tab = (LAS float*)(shm + LDS_TAB);
    if (tid < 256) { int rel = tid - 64; rel = rel < -128 ? -128 : (rel > 128 ? 128 : rel); tab[tid] = bias_h[rel + 128] * LOG2E; }
    const float bfar = bias_h[256] * LOG2E;
    const bf16_t* ksrc = Kh + (long)lane * DM + wid * 8;
    const bf16_t* vsrc = Vh + (long)(16 * (wid & 3) + (lane >> 2)) * DM + (wid >> 2) * 32 + (lane & 3) * 8;
    const unsigned kdst = lds0 + LDS_K + wid * 1024, vdst = lds0 + LDS_V + wid * 1024;
    const int vb0 = (int)(lds0 + LDS_V) + ((lane >> 4) & 1) * 32 + (lane & 3) * 8 + (4 * hi + ((lane & 15) >> 2)) * 64;
    const int tb = 4 * u, pr = wid >> 1;
    const int nsteps = (tb + 4) < 9 ? (tb + 4) : 9;
    const int tlow = (tb - 8) > 0 ? (tb - 8) : 0;
    bf16x8 qr[4];
#pragma unroll
    for (int d0 = 0; d0 < 4; ++d0) qr[d0] = *(const bf16x8*)(Qw + (long)r32 * DMQ + d0 * 16 + hi * 8);
#pragma unroll
    for (int i = 3; i >= 1 - PFD; --i) { if (tb + i >= tlow) { DMA_K(tb + i); DMA_V(tb + i); } }
    float mhat = 0.f, l_reg = 0.f; f32x16 o[2]; o[0] = f32x16{}; o[1] = f32x16{};
    for (int s = 0; s < nsteps; ++s) {
        STEP_WAIT(tb - s, tlow);
        { const int tn = tb - s - PFD; if (tn >= tlow) { DMA_K(tn); DMA_V(tn); } }
        const int j = tb + pr - s;
        if (j >= 0) {
            const int sl = (j & (NSLOT - 1)) * SLOTB;
            const bool far = (s >= 3), first = (s == 0);
            f32x16 cin; const float c0 = (far ? bfar : 0.f) - mhat;
#pragma unroll
            for (int r = 0; r < 16; ++r) cin[r] = c0;
            f32x16 p0, p1;
            qkt(p0, p1, shm + LDS_K + sl, qr, cin, r32, hi);
            if (!far) {
                const LAS float* tp = tab + (s * 64 + 32 * (wid & 1) + r32 + 64 - 4 * hi);
#pragma unroll
                for (int r = 0; r < 16; ++r) { const int kv = (r & 3) + 8 * (r >> 2); p0[r] += tp[-kv]; p1[r] += tp[-kv - 32]; }
            }
            const float rm = rowmax(p0, p1);
            bool upd; float dl;
            if (first) { upd = true; dl = rm; } else { upd = __any(rm > 8.f) != 0; dl = __builtin_fmaxf(rm, 0.f); }
            if (upd) {
                mhat += dl;
#pragma unroll
                for (int r = 0; r < 16; ++r) { p0[r] -= dl; p1[r] -= dl; }
                if (!first) { const float f = fast_exp2(-dl); l_reg *= f; if (hi == 0) wsf[r32] = f; LDS_WAIT();
#pragma unroll
                    for (int r = 0; r < 16; ++r) { const float fr_ = wsf[crow(r, hi)]; o[0][r] *= fr_; o[1][r] *= fr_; } }
            }
            float sacc = 0.f;
#pragma unroll
            for (int r = 0; r < 16; ++r) { p0[r] = fast_exp2(p0[r]); p1[r] = fast_exp2(p1[r]); sacc += p0[r] + p1[r]; }
            l_reg += sacc;
            u32x4 pw0 = (u32x4){PKW(p0, 0), PKW(p0, 2), PKW(p0, 4), PKW(p0, 6)}, pw1 = (u32x4){PKW(p0, 8), PKW(p0, 10), PKW(p0, 12), PKW(p0, 14)};
            u32x4 pw2 = (u32x4){PKW(p1, 0), PKW(p1, 2), PKW(p1, 4), PKW(p1, 6)}, pw3 = (u32x4){PKW(p1, 8), PKW(p1, 10), PKW(p1, 12), PKW(p1, 14)};
            pv(o, vb0 + sl, __builtin_bit_cast(bf16x8, pw0), __builtin_bit_cast(bf16x8, pw1), __builtin_bit_cast(bf16x8, pw2), __builtin_bit_cast(bf16x8, pw3));
        }
    }
    { auto rr = __builtin_amdgcn_permlane32_swap(__float_as_uint(l_reg), __float_as_uint(l_reg), false, false); l_reg = __uint_as_float(rr[0]) + __uint_as_float(rr[1]); }
    if (hi == 0) wsf[32 + r32] = l_reg; LDS_WAIT();
    float rli[16];
#pragma unroll
    for (int r = 0; r < 16; ++r) rli[r] = fast_rcp(wsf[32 + crow(r, hi)]);
    asm volatile("s_waitcnt lgkmcnt(0)\n\ts_barrier" ::: "memory");
    store_o(o, rli, O + (rowbase + q0 + wid * 32) * DMQ + h * HD, shm, wid, lane, r32, hi);
    asm volatile("s_waitcnt lgkmcnt(0)\n\ts_barrier" ::: "memory");
}

__device__ __forceinline__ void attn_b_unit(int b, int h, int qb, const bf16_t* Q, const bf16_t* K, const bf16_t* V, bf16_t* O, LAS char* shm) {
    int tid_ = threadIdx.x; asm volatile("" : "+v"(tid_)); const int tid = tid_, lane = tid & 63, r32 = lane & 31, hi = lane >> 5; const int wid = __builtin_amdgcn_readfirstlane(tid >> 6);
    const long rowbase = (long)b * SEQ; const int q0 = qb * 256;
    const bf16_t* Qw = Q + (rowbase + q0 + wid * 32) * DMQ + h * HD;
    const bf16_t* Kh = K + rowbase * DM + h * HD; const bf16_t* Vh = V + rowbase * DM + h * HD;
    const unsigned lds0 = (unsigned)(size_t)shm;
    LAS unsigned* flg = (LAS unsigned*)(shm + LDS_FLG);
    const bf16_t* ksrc = Kh + (long)lane * DM + wid * 8;
    const bf16_t* vsrc = Vh + (long)(16 * (wid & 3) + (lane >> 2)) * DM + (wid >> 2) * 32 + (lane & 3) * 8;
    const unsigned kdst = lds0 + LDS_K + wid * 1024, vdst = lds0 + LDS_V + wid * 1024;
    const int vb0 = (int)(lds0 + LDS_V) + ((lane >> 4) & 1) * 32 + (lane & 3) * 8 + (4 * hi + ((lane & 15) >> 2)) * 64;
    const int tb = 4 * qb, pr = wid >> 1;
    const int tq = 32 * (wid & 1) + r32;
    bf16x8 qr[4];
#pragma unroll
    for (int d0 = 0; d0 < 4; ++d0) qr[d0] = *(const bf16x8*)(Qw + (long)r32 * DMQ + d0 * 16 + hi * 8);
#pragma unroll
    for (int i = 3; i >= 1 - PFD; --i) { if (tb + i >= 0) { DMA_K(tb + i); DMA_V(tb + i); } }
    float R = 1.0f; bool wdone = false; f32x16 o[2]; o[0] = f32x16{}; o[1] = f32x16{};
    for (int s = 0; ; ++s) {
        STEP_WAIT(tb - s, 0);
        if (s > 0) { const LAS unsigned* f = flg + ((s - 1) & 1) * 8; unsigned all = 1u;
#pragma unroll
            for (int w = 0; w < 8; ++w) all &= f[w];
            if (__builtin_amdgcn_readfirstlane(all) != 0u) break; }
        { const int tn = tb - s - PFD; if (tn >= 0) { DMA_K(tn); DMA_V(tn); } }
        const int j = tb + pr - s;
        if (j >= 0 && !wdone) {
            const int sl = (j & (NSLOT - 1)) * SLOTB;
            f32x16 cin = f32x16{}; f32x16 p0, p1;
            qkt(p0, p1, shm + LDS_K + sl, qr, cin, r32, hi);
#pragma unroll
            for (int r = 0; r < 16; ++r) { p0[r] = fast_rcp(1.0f + fast_exp2(p0[r])); p1[r] = fast_rcp(1.0f + fast_exp2(p1[r])); }
            if (s == 0) {
#pragma unroll
                for (int r = 0; r < 16; ++r) { const int kv = crow(r, hi); if (kv >= tq) p0[r] = 1.0f; if (kv + 32 >= tq) p1[r] = 1.0f; } }
            float W[8], part[8];
#pragma unroll
            for (int i = 0; i < 8; ++i) { const float pb = (i < 4) ? (p0[4 * i] * p0[4 * i + 1]) * (p0[4 * i + 2] * p0[4 * i + 3]) : (p1[4 * i - 16] * p1[4 * i - 15]) * (p1[4 * i - 14] * p1[4 * i - 13]);
                auto rr = __builtin_amdgcn_permlane32_swap(__float_as_uint(pb), __float_as_uint(pb), false, false);
                const float vlo = __uint_as_float(rr[0]), vhi = __uint_as_float(rr[1]);
                W[i] = vlo * vhi; part[i] = hi ? 1.0f : vhi; }
            float sw = R;
#pragma unroll
            for (int i = 7; i >= 0; --i) { float c = sw * part[i];
                if (i < 4) {
#pragma unroll
                    for (int rr_ = 3; rr_ >= 0; --rr_) { const float t_ = c * p0[4 * i + rr_]; p0[4 * i + rr_] = c - t_; c = t_; } }
                else {
#pragma unroll
                    for (int rr_ = 3; rr_ >= 0; --rr_) { const float t_ = c * p1[4 * i - 16 + rr_]; p1[4 * i - 16 + rr_] = c - t_; c = t_; } }
                sw *= W[i]; }
            R = sw;
            u32x4 pw0 = (u32x4){PKW(p0, 0), PKW(p0, 2), PKW(p0, 4), PKW(p0, 6)}, pw1 = (u32x4){PKW(p0, 8), PKW(p0, 10), PKW(p0, 12), PKW(p0, 14)};
            u32x4 pw2 = (u32x4){PKW(p1, 0), PKW(p1, 2), PKW(p1, 4), PKW(p1, 6)}, pw3 = (u32x4){PKW(p1, 8), PKW(p1, 10), PKW(p1, 12), PKW(p1, 14)};
            pv(o, vb0 + sl, __builtin_bit_cast(bf16x8, pw0), __builtin_bit_cast(bf16x8, pw1), __builtin_bit_cast(bf16x8, pw2), __builtin_bit_cast(bf16x8, pw3));
            wdone = __all(R == 0.0f) != 0;
        }
        if (j <= 0) wdone = true;
        if (lane == 0) flg[(s & 1) * 8 + wid] = wdone ? 1u : 0u;
    }
    float ones[16];
#pragma unroll
    for (int r = 0; r < 16; ++r) ones[r] = 1.0f;
    asm volatile("s_waitcnt vmcnt(0) lgkmcnt(0)\n\ts_barrier" ::: "memory");
    store_o(o, ones, O + (rowbase + q0 + wid * 32) * DMQ + h * HD, shm, wid, lane, r32, hi);
    asm volatile("s_waitcnt lgkmcnt(0)\n\ts_barrier" ::: "memory");
}
#undef DMA_K
#undef DMA_V
#undef PKW
#undef SBAR
#undef WAIT_BAR0
}

#define XB_TMO      128
#define XB_XCNT(j)  (256  + 64 * (j))
#define XB_XSUB(j)  (1280 + 64 * (j))
#define XB_XGEN(j)  (2304 + 64 * (j))
#define XB_TOP      3328
#define XB_TOPGEN   3392
#define XCD_BAR_WORDS 3456
#define XB_SPIN_CAP (1u << 22)
__device__ __forceinline__ unsigned xb_ld(unsigned* p)              { return __hip_atomic_load(p, __ATOMIC_RELAXED, __HIP_MEMORY_SCOPE_AGENT); }
__device__ __forceinline__ unsigned xb_add(unsigned* p, unsigned v) { return __hip_atomic_fetch_add(p, v, __ATOMIC_RELAXED, __HIP_MEMORY_SCOPE_AGENT); }
__device__ __forceinline__ unsigned xb_xcc_id() { return (unsigned)__builtin_amdgcn_s_getreg((3 << 11) | 20) & 0xFu; }
#define XB_SPIN(cond, bar) do { unsigned _sp = 0; while (cond) { __builtin_amdgcn_s_sleep(1); \
    if ((++_sp & 255u) == 0u) { if (xb_ld(&(bar)[XB_TMO])) break; if (_sp > XB_SPIN_CAP) { atomicAdd(&(bar)[XB_TMO], 1u); break; } } } } while (0)
struct XcdBarrier { unsigned* bar; unsigned x; volatile LAS unsigned* st; };
__device__ __forceinline__ XcdBarrier xcd_barrier_post(unsigned* bar, volatile LAS unsigned* st) {
    XcdBarrier b; b.bar = bar; b.x = xb_xcc_id(); b.st = st;
    if (threadIdx.x == 0) (void)xb_add(&bar[XB_XCNT(b.x)], 1u);
    return b;
}
__device__ __forceinline__ void xcd_barrier_complete(unsigned* bar, unsigned x, unsigned& nloc, unsigned& nx) {
    const unsigned G = gridDim.x * gridDim.y * gridDim.z;
    unsigned sum, cnt, mine, sp = 0u;
    for (;;) {
        sum = 0u; cnt = 0u; mine = 0u;
#pragma unroll
        for (unsigned j = 0; j < 16; ++j) { const unsigned c = xb_ld(&bar[XB_XCNT(j)]); sum += c; cnt += (c > 0u) ? 1u : 0u; mine = (j == x) ? c : mine; }
        if (sum == G) break;
        __builtin_amdgcn_s_sleep(1);
        if ((++sp & 255u) == 0u) { if (xb_ld(&bar[XB_TMO])) break; if (sp > XB_SPIN_CAP) { atomicAdd(&bar[XB_TMO], 1u); break; } }
    }
    nloc = mine > 0u ? mine : 1u; nx = cnt > 0u ? cnt : 1u;
}
__device__ __forceinline__ void xcd_barrier(const XcdBarrier& b) {
    asm volatile("s_waitcnt vmcnt(0)" ::: "memory");
    __syncthreads();
    if (threadIdx.x == 0) {
        unsigned* bar = b.bar;
        __builtin_amdgcn_s_waitcnt(0);
        unsigned nloc = b.st[0], nx = b.st[1];
        if (nloc == 0u) { xcd_barrier_complete(bar, b.x, nloc, nx); b.st[0] = nloc; b.st[1] = nx; }
        const unsigned old = xb_add(&bar[XB_XSUB(b.x)], 1u);
        const unsigned gen = old / nloc;
        if (old + 1u == (gen + 1u) * nloc) {
            __builtin_amdgcn_fence(__ATOMIC_RELEASE, "agent");
            asm volatile("s_waitcnt vmcnt(0)" ::: "memory");
            const unsigned og = xb_add(&bar[XB_TOP], 1u);
            const unsigned tg = og / nx;
            if (og + 1u == (tg + 1u) * nx) xb_add(&bar[XB_TOPGEN], 1u);
            else XB_SPIN(xb_ld(&bar[XB_TOPGEN]) == tg, bar);
            __builtin_amdgcn_fence(__ATOMIC_ACQUIRE, "agent");
            xb_add(&bar[XB_XGEN(b.x)], 1u);
            asm volatile("s_waitcnt vmcnt(0)" ::: "memory");
        } else {
            XB_SPIN(xb_ld(&bar[XB_XGEN(b.x)]) == gen, bar);
            __builtin_amdgcn_fence(__ATOMIC_ACQUIRE, "agent");
            asm volatile("s_waitcnt vmcnt(0)" ::: "memory");
        }
    }
    __syncthreads();
}

__device__ __forceinline__ unsigned f2bf(float f) { unsigned u = __builtin_bit_cast(unsigned, f); return (u + 0x7fffu + ((u >> 16) & 1u)) >> 16; }
__device__ __forceinline__ unsigned pk2(float lo, float hi) { return cvt_pk_bf16(lo, hi); }
__device__ __forceinline__ void transpose_item(const float* W, int K, int N, bf16_t* WT, int row_off, LAS float* scr, int item, int lane, int ldw = 0, int koff = 0) {
    if (ldw == 0) ldw = K;
    const int nblk = N / 32, kb = item / nblk, nb = item % nblk, k0 = 64 * kb, n0 = 32 * nb;
    f32x4 ld[8];
#pragma unroll
    for (int i = 0; i < 8; ++i) ld[i] = *(const f32x4*)(W + (size_t)(k0 + 8 * i + (lane >> 3)) * N + n0 + 4 * (lane & 7));
#pragma unroll
    for (int i = 0; i < 8; ++i) { LAS float* d = scr + (8 * i + (lane >> 3)) * 33 + 4 * (lane & 7); d[0] = ld[i].x; d[1] = ld[i].y; d[2] = ld[i].z; d[3] = ld[i].w; }
    LDS_WAIT(); asm volatile("" ::: "memory");
    const int c = lane & 7;
#pragma unroll
    for (int j = 0; j < 4; ++j) { const int n = (lane >> 3) + 8 * j; const LAS float* s = scr + (8 * c) * 33 + n;
        u32x4 o; o.x = pk2(s[0 * 33], s[1 * 33]); o.y = pk2(s[2 * 33], s[3 * 33]); o.z = pk2(s[4 * 33], s[5 * 33]); o.w = pk2(s[6 * 33], s[7 * 33]);
        *(u32x4*)(WT + (size_t)(row_off + n0 + n) * ldw + koff + k0 + 8 * c) = o; }
    LDS_WAIT(); asm volatile("" ::: "memory");
}

struct Args { const float* in[15]; float* out; unsigned char* ws; int ph_lo, ph_hi, li, pad; };
typedef const __attribute__((address_space(4))) char* kptr_t;
__device__ __forceinline__ kptr_t kbase() { kptr_t kp = (kptr_t)__builtin_amdgcn_kernarg_segment_ptr(); asm volatile("" : "+s"(kp)); return kp; }
__device__ __forceinline__ const float* arg_in(int i) { return *(const float* const __attribute__((address_space(4)))*)(kbase() + 8 * i); }
__device__ __forceinline__ float* arg_out() { return *(float* const __attribute__((address_space(4)))*)(kbase() + 120); }
__device__ __forceinline__ unsigned char* arg_ws() { return *(unsigned char* const __attribute__((address_space(4)))*)(kbase() + 128); }
__device__ __forceinline__ int arg_lo() { return *(const __attribute__((address_space(4))) int*)(kbase() + 136); }
__device__ __forceinline__ int arg_hi() { return *(const __attribute__((address_space(4))) int*)(kbase() + 140); }
__device__ __forceinline__ int arg_li() { return *(const __attribute__((address_space(4))) int*)(kbase() + 144); }
static_assert(sizeof(Args) == 152, "Args layout");

constexpr int NWAVES = 8;
constexpr int PH_PER_LAYER = 8, N_PHASES = 1 + DEPTH * PH_PER_LAYER;
#define PH_COMMON() int tid_ = threadIdx.x; asm volatile("" : "+v"(tid_)); const int tid = tid_, lane = tid & 63, wave = __builtin_amdgcn_readfirstlane(tid >> 6); const int G = gridDim.x, bx = blockIdx.x; \
    const int vcu = (G % 8 == 0) ? (bx % 8) * (G / 8) + bx / 8 : bx; const int gw = vcu * NWAVES + wave, NGW = G * NWAVES; unsigned char* ws = arg_ws(); \
    (void)tid; (void)lane; (void)wave; (void)vcu; (void)gw; (void)NGW; (void)ws

__device__ __forceinline__ void convert_weights(int l, LAS unsigned char* lds) {
    PH_COMMON();
    LAS float* scr = (LAS float*)(lds + wave * 16384);
    const float* w_in = arg_in(1) + (size_t)l * D_MODEL * PROJ;
    const float* w_upa = arg_in(3) + (size_t)l * WA * D_MODEL;
    const float* w_upb = arg_in(4) + (size_t)l * WA * D_MODEL;
    const float* w_out = arg_in(5) + (size_t)l * D_MODEL * D_MODEL;
    const float* w_gate = arg_in(10) + (size_t)l * NE * D_MODEL * FE;
    const float* w_up = arg_in(11) + (size_t)l * NE * D_MODEL * FE;
    const float* w_down = arg_in(12) + (size_t)l * NE * FE * D_MODEL;
    constexpr int I_IN = (D_MODEL / 64) * (PROJ / 32), I_UP = (WA / 64) * (D_MODEL / 32), I_OUT = (D_MODEL / 64) * (D_MODEL / 32);
    constexpr int I_G = (D_MODEL / 64) * (FE / 32), I_D = (FE / 64) * (D_MODEL / 32);
    constexpr int NITEMS = I_IN + 2 * I_UP + I_OUT + NE * (2 * I_G + I_D);
    for (int it = gw; it < NITEMS; it += NGW) {
        int r = it;
        if (r < I_IN) { transpose_item(w_in, D_MODEL, PROJ, (bf16_t*)(ws + WS_WIN), 0, scr, r, lane); continue; } r -= I_IN;
        if (r < I_UP) { transpose_item(w_upa, WA, D_MODEL, (bf16_t*)(ws + WS_WUP), 0, scr, r, lane, D_MODEL, 0); continue; } r -= I_UP;
        if (r < I_UP) { transpose_item(w_upb, WA, D_MODEL, (bf16_t*)(ws + WS_WUP), 0, scr, r, lane, D_MODEL, WA); continue; } r -= I_UP;
        if (r < I_OUT) { transpose_item(w_out, D_MODEL, D_MODEL, (bf16_t*)(ws + WS_WOUT), 0, scr, r, lane); continue; } r -= I_OUT;
        const int e = r / (2 * I_G + I_D); r -= e * (2 * I_G + I_D);
        if (r < 2 * I_G) { const int up = r >= I_G; if (up) r -= I_G;
            const int nb = r % (FE / 32), n0 = nb * 32;
            const int row_off = e * 1024 + (n0 / 128) * 128 + (up ? 128 : 0);
            transpose_item((up ? w_up : w_gate) + (size_t)e * D_MODEL * FE, D_MODEL, FE, (bf16_t*)(ws + WS_WGU), row_off, scr, r, lane); continue; }
        r -= 2 * I_G;
        transpose_item(w_down + (size_t)e * FE * D_MODEL, FE, D_MODEL, (bf16_t*)(ws + WS_WD), e * 1024, scr, r, lane);
    }
}

__device__ __forceinline__ void phase0(LAS unsigned char* lds) {
    convert_weights(0, lds);
    PH_COMMON();
    const float* x_in = arg_in(0); bf16_t* XB = (bf16_t*)(ws + WS_XB);
    for (int m = gw; m < T; m += NGW) { const f32x4* xr = (const f32x4*)(x_in + (size_t)m * D_MODEL) + lane; u32x2* o8 = (u32x2*)(XB + (size_t)m * D_MODEL) + lane;
#pragma unroll
        for (int j = 0; j < 4; ++j) { const f32x4 v = xr[64 * j]; u32x2 w; w.x = cvt_pk_bf16(v.x, v.y); w.y = cvt_pk_bf16(v.z, v.w); o8[64 * j] = w; } }
}
__device__ __forceinline__ void phase1(LAS unsigned char* lds) {
    PH_COMMON();
    pg8::SchedPlain S; S.o.init(T / 256, PROJ / 256, G, bx); S.A = (const char*)(ws + WS_XB); S.B = (const char*)(ws + WS_WIN); S.tstep = (size_t)256 * D_MODEL * 2;
    EpiInProj E{ws};
    pg8::gemm_phase<EpiInProj, pg8::SchedPlain, false, true>(lds, D_MODEL, S, E);
}
__device__ __forceinline__ void phase2(LAS unsigned char* lds, int l) {
    PH_COMMON();
    const int bh = vcu >> 2, s = vcu & 3; const int b = bh >> 3, h = bh & 7;
    if (G != 256) return;
    const float* bias_h = arg_in(2) + ((size_t)l * NH + h) * N_REL;
    bf16_t* QAp = (bf16_t*)(ws + WS_QQ); bf16_t* KAp = (bf16_t*)(ws + WS_KA); bf16_t* VAp = (bf16_t*)(ws + WS_VA);
    bf16_t* QBp = (bf16_t*)(ws + WS_QQ) + WA; bf16_t* KBp = (bf16_t*)(ws + WS_KB); bf16_t* VBp = (bf16_t*)(ws + WS_VB);
    PBS_BEGIN(6, lds);
    for (int i = 0; i < 4; ++i) { const int u = (i == 0) ? s : (i == 1) ? 7 - s : (i == 2) ? 8 + s : 15 - s; att::attn_a_unit(b, h, u, QAp, KAp, VAp, QAp, bias_h, (LAS char*)lds); }
    PBS_END(6, lds); PBS_BEGIN(7, lds);
    for (int i = 0; i < 4; ++i) { const int u = (i == 0) ? s : (i == 1) ? 7 - s : (i == 2) ? 8 + s : 15 - s; att::attn_b_unit(b, h, u, QBp, KBp, VBp, QBp, (LAS char*)lds); }
    PBS_END(7, lds);
}
__device__ __forceinline__ void phase3(LAS unsigned char* lds) {
    PH_COMMON();
    pg8::SchedTwo S; S.o.init(T / 256, D_MODEL / 256, G, bx); S.A = (const char*)(ws + WS_QQ); S.B = (const char*)(ws + WS_WUP); S.tstep = (size_t)256 * D_MODEL * 2;
    EpiMerge E{(const bf16_t*)(ws + WS_GA), (const bf16_t*)(ws + WS_GB), (bf16_t*)(ws + WS_MERGED)};
    pg8::gemm_phase<EpiMerge, pg8::SchedTwo, false, true, true>(lds, WA, S, E, D_MODEL);
}
__device__ __forceinline__ void phase4(LAS unsigned char* lds, int l) {
    PH_COMMON();
    pg8::SchedPlain S; S.o.init(T / 256, D_MODEL / 256, G, bx); S.A = (const char*)(ws + WS_MERGED); S.B = (const char*)(ws + WS_WOUT); S.tstep = (size_t)256 * D_MODEL * 2;
    EpiOut E{(l == 0) ? arg_in(0) : (const float*)nullptr, (const bf16_t*)(ws + WS_XB), (bf16_t*)(ws + WS_PRE)};
    pg8::gemm_phase<EpiOut, pg8::SchedPlain, false, true>(lds, D_MODEL, S, E);
}
#define dppf(v, ctrl) __builtin_bit_cast(float, __builtin_amdgcn_update_dpp(__builtin_bit_cast(int, (float)(v)), __builtin_bit_cast(int, (float)(v)), ctrl, 0xf, 0xf, false))
#define dppi(v, ctrl) __builtin_amdgcn_update_dpp((int)(v), (int)(v), ctrl, 0xf, 0xf, false)
__device__ __forceinline__ void phase5(LAS unsigned char* lds, int l) {
    static_assert(USE_F16 == 1, "the MFMA router path takes the pre-LN tensor as IEEE half");
    PH_COMMON();
    const float* g1 = arg_in(6) + (size_t)l * D_MODEL; const float* b1 = arg_in(7) + (size_t)l * D_MODEL;
    const float* w_router = arg_in(8); const float* b_router = arg_in(9);
    bf16_t* XB = (bf16_t*)(ws + WS_XB); const bf16_t* PRE = (const bf16_t*)(ws + WS_PRE);
    int* LIST = (int*)(ws + WS_LIST); f32x2* RECW = (f32x2*)(ws + WS_RECW);
    unsigned* gcnt = (unsigned*)(ws + WS_CTL) + CW_CNT + 64 * l;
    PBS_BEGIN(1, lds);
    LAS float* part = (LAS float*)(lds + 65536); LAS float* S23 = (LAS float*)(lds + 69632); LAS f32x2* rstat = (LAS f32x2*)(lds + 70656) + wave * 16;
    LAS unsigned* lcnt = (LAS unsigned*)(lds + 81920);
    LAS int* lrec = (LAS int*)(lds + 81920 + 256);
    for (int p = tid; p < 2048; p += NWAVES * 64) { const int kt = p >> 6, ln = p & 63, n = ln & 15, c0 = 32 * kt + 8 * (ln >> 4);
        unsigned hw[4], lw[4];
#pragma unroll
        for (int j = 0; j < 4; ++j) { const float w0 = g1[c0 + 2 * j] * w_router[(c0 + 2 * j) * 16 + n], w1 = g1[c0 + 2 * j + 1] * w_router[(c0 + 2 * j + 1) * 16 + n];
            hw[j] = cvt_pk_bf16(w0, w1); lw[j] = cvt_pk_bf16(w0 - bf_lo(hw[j]), w1 - bf_hi(hw[j])); }
        *(LAS u32x4*)(lds + p * 16) = (u32x4){hw[0], hw[1], hw[2], hw[3]}; *(LAS u32x4*)(lds + 32768 + p * 16) = (u32x4){lw[0], lw[1], lw[2], lw[3]}; }
    { const int e = tid & 15, pt = tid >> 4; float s2 = 0.f, s3 = 0.f;
        for (int c = 32 * pt; c < 32 * pt + 32; ++c) { const float w = w_router[c * 16 + e]; s2 += g1[c] * w; s3 += b1[c] * w; }
        part[pt * 32 + e] = s2; part[pt * 32 + 16 + e] = s3; }
    if (tid < 32) lcnt[tid] = 0u;
    __syncthreads();
    if (tid < 32) { float s = 0.f; for (int pt = 0; pt < 32; ++pt) s += part[pt * 32 + tid]; if (tid >= 16) s += b_router[tid - 16]; S23[tid] = s; }
    __syncthreads();
    PBS_END(1, lds); PBS_BEGIN(2, lds);
    int krow = 0;
    u32x2 nv[4];
    { const u32x2* pr = (const u32x2*)(PRE + (size_t)gw * D_MODEL) + lane;
#pragma unroll
      for (int j = 0; j < 4; ++j) nv[j] = pr[64 * j]; }
    for (int m = gw; m < T; m += NGW, ++krow) {
        f32x4 v[4]; float s = 0.f;
#pragma unroll
        for (int j = 0; j < 4; ++j) { v[j] = (f32x4){bf_lo(nv[j].x), bf_hi(nv[j].x), bf_lo(nv[j].y), bf_hi(nv[j].y)}; s += (v[j].x + v[j].y) + (v[j].z + v[j].w); }
        if (m + NGW < T) { const u32x2* pr = (const u32x2*)(PRE + (size_t)(m + NGW) * D_MODEL) + lane;
#pragma unroll
            for (int j = 0; j < 4; ++j) nv[j] = pr[64 * j]; }
        const float mean = wave_sum(s) * (1.f / D_MODEL); float s2 = 0.f;
#pragma unroll
        for (int j = 0; j < 4; ++j) { v[j] = v[j] - mean; s2 += (v[j].x * v[j].x + v[j].y * v[j].y) + (v[j].z * v[j].z + v[j].w * v[j].w); }
        const float rstd = 1.f / sqrtf(wave_sum(s2) * (1.f / D_MODEL) + LN_EPS);
        if (lane == 0) rstat[krow] = (f32x2){mean, rstd};
#pragma unroll
        for (int j = 0; j < 4; ++j) { const f32x4 gg = *((const f32x4*)g1 + lane + 64 * j), bb = *((const f32x4*)b1 + lane + 64 * j);
            v[j] = v[j] * rstd * gg + bb;
            u32x2 w; w.x = cvt_pk_bf16(v[j].x, v[j].y); w.y = cvt_pk_bf16(v[j].z, v[j].w); *((u32x2*)(XB + (size_t)m * D_MODEL) + lane + 64 * j) = w; }
    }
    {
        const int n = lane & 15, kg = lane >> 4;
        const bf16_t* arow = PRE + (size_t)(gw + n * NGW) * D_MODEL + 8 * kg;
        f32x4 acc = (f32x4){0.f, 0.f, 0.f, 0.f};
#pragma unroll 4
        for (int kt = 0; kt < 32; ++kt) { const bf16x8 a = *(const bf16x8*)(arow + 32 * kt);
            const bf16x8 bh = *(const LAS bf16x8*)(lds + (kt * 64 + lane) * 16), bl = *(const LAS bf16x8*)(lds + 32768 + (kt * 64 + lane) * 16);
            acc = MFMA16(a, bh, acc); acc = MFMA16(a, bl, acc); }
        const float s2n = S23[n], s3n = S23[16 + n];
#pragma unroll
        for (int i = 0; i < 4; ++i) {
            const int kr = 4 * kg + i; const f32x2 st = rstat[kr];
            const float v = st.y * (acc[i] - st.x * s2n) + s3n;
            float mx = v; mx = fmaxf(mx, dppf(mx, 0xB1)); mx = fmaxf(mx, dppf(mx, 0x4E)); mx = fmaxf(mx, dppf(mx, 0x141)); mx = fmaxf(mx, dppf(mx, 0x140));
            int best = (v == mx) ? n : 16; best = min(best, dppi(best, 0xB1)); best = min(best, dppi(best, 0x4E)); best = min(best, dppi(best, 0x141)); best = min(best, dppi(best, 0x140));
            const float u = (n == best) ? -3.0e38f : v;
            float m2 = u; m2 = fmaxf(m2, dppf(m2, 0xB1)); m2 = fmaxf(m2, dppf(m2, 0x4E));
            int e2 = (u == m2) ? n : 16; e2 = min(e2, dppi(e2, 0xB1)); e2 = min(e2, dppi(e2, 0x4E));
            if (n == best) { const int m = gw + kr * NGW;
                const float w1 = fast_rcp(1.0f + fast_exp2((m2 - v) * LOG2E)), w2 = 1.0f - w1;
                RECW[m] = (f32x2){w1, w2};
                const int lp1 = (int)__hip_atomic_fetch_add(lcnt + best, 1u, __ATOMIC_RELAXED, __HIP_MEMORY_SCOPE_WORKGROUP);
                const int lp2 = (int)__hip_atomic_fetch_add(lcnt + e2, 1u, __ATOMIC_RELAXED, __HIP_MEMORY_SCOPE_WORKGROUP);
                LAS int* rp = lrec + (wave * 16 + kr) * 4; rp[0] = best; rp[1] = lp1; rp[2] = e2; rp[3] = lp2; }
        }
    }
    PBS_END(2, lds);
    __syncthreads();
    PBS_BEGIN(3, lds);
    if (tid < 16) { const unsigned n = lcnt[tid]; lcnt[16 + tid] = n ? __hip_atomic_fetch_add(gcnt + tid, n, __ATOMIC_RELAXED, __HIP_MEMORY_SCOPE_AGENT) : 0u; }
    __syncthreads();
    if (lane == 0) { int k2 = 0;
        for (int m = gw; m < T; m += NGW, ++k2) { const LAS int* rp = lrec + (wave * 16 + k2) * 4;
            LIST[(size_t)rp[0] * T + lcnt[16 + rp[0]] + rp[1]] = m * 2; LIST[(size_t)rp[2] * T + lcnt[16 + rp[2]] + rp[3]] = m * 2 + 1; } }
    __syncthreads();
    PBS_END(3, lds);
}
__device__ __forceinline__ int moe_units(LAS unsigned char* lds, int l) {
    PH_COMMON();
    LAS int* utab = (LAS int*)(lds + UTAB_OFF);
    unsigned* gcnt = (unsigned*)(ws + WS_CTL) + CW_CNT + 64 * l;
    __syncthreads();
    if (tid == 0) {
        LAS int* ts = utab + 128; LAS int* ncnt = utab + 160;
        int acc_t = 0;
        for (int e = 0; e < 16; ++e) { const int n = (int)__hip_atomic_load(gcnt + e, __ATOMIC_RELAXED, __HIP_MEMORY_SCOPE_AGENT); ncnt[e] = n; ts[e] = acc_t; acc_t += (n + 255) / 256; }
        ts[16] = acc_t;
        const int nunits = acc_t * 4; int cnt = 0;
        for (int i = 0; cnt < 16; ++i) { const long L = (long)i * G + bx; if (L >= nunits) break;
            int U = (int)L; { const int q = nunits / 8, r = nunits % 8, xcd = U % 8, off = U / 8; U = (xcd < r ? xcd * (q + 1) : r * (q + 1) + (xcd - r) * q) + off; }
            const int tile = U >> 2, pn = U & 3; int e = 0; while (ts[e + 1] <= tile) ++e;
            const int mt = tile - ts[e]; const int n = ncnt[e]; const int nv = (n - 256 * mt) < 256 ? (n - 256 * mt) : 256;
            utab[cnt * 5 + 0] = e; utab[cnt * 5 + 1] = pn; utab[cnt * 5 + 2] = mt * 256; utab[cnt * 5 + 3] = nv; utab[cnt * 5 + 4] = tile * 256;
            ++cnt; }
        utab[192] = cnt;
    }
    __syncthreads();
    return utab[192];
}
__device__ __forceinline__ void phase6(LAS unsigned char* lds, int l) {
    const int nun = moe_units(lds, l);
    PH_COMMON();
    pg8::SchedMoe S; S.utab = (LAS int*)(lds + UTAB_OFF); S.nunits = nun; S.Abase = (const char*)(ws + WS_XB); S.Bbase = (const char*)(ws + WS_WGU); S.a_row_bytes = 0;
    S.b_exp_bytes = (size_t)1024 * D_MODEL * 2; S.b_tile_bytes = (size_t)256 * D_MODEL * 2; S.list = (const int*)(ws + WS_LIST); S.gather_k2 = D_MODEL * 2;
    EpiGU E{(bf16_t*)(ws + WS_H)};
    pg8::gemm_phase<EpiGU, pg8::SchedMoe, true, true>(lds, D_MODEL, S, E);
}
__device__ __forceinline__ void phase7(LAS unsigned char* lds, int l) {
    const int nun = moe_units(lds, l);
    PH_COMMON();
    pg8::SchedMoe S; S.utab = (LAS int*)(lds + UTAB_OFF); S.nunits = nun; S.Abase = (const char*)(ws + WS_H); S.Bbase = (const char*)(ws + WS_WD); S.a_row_bytes = (size_t)FE * 2;
    S.b_exp_bytes = (size_t)1024 * FE * 2; S.b_tile_bytes = (size_t)256 * FE * 2; S.list = (const int*)(ws + WS_LIST); S.gather_k2 = 0;
    EpiDown E{(bf16_t*)(ws + WS_Y), (const int*)(ws + WS_LIST)};
    pg8::gemm_phase<EpiDown, pg8::SchedMoe, false, true>(lds, FE, S, E);
}
__device__ __forceinline__ void phase8(LAS unsigned char* lds, int l) {
    PH_COMMON();
    const float* g2 = arg_in(13) + (size_t)l * D_MODEL; const float* b2 = arg_in(14) + (size_t)l * D_MODEL;
    float* xout = arg_out(); bf16_t* XB = (bf16_t*)(ws + WS_XB); const bf16_t* Y = (const bf16_t*)(ws + WS_Y); const f32x2* RECW = (const f32x2*)(ws + WS_RECW);
    PBS_BEGIN(4, lds);
    u32x2 nx[4], na[4], nc[4]; f32x2 nw;
#define P8_LOAD(mm) do { nw = RECW[mm]; const u32x2* xr = (const u32x2*)(XB + (size_t)(mm) * D_MODEL) + lane; \
        const u32x2* y0 = (const u32x2*)(Y + (size_t)(2 * (mm)) * D_MODEL) + lane; const u32x2* y1 = (const u32x2*)(Y + (size_t)(2 * (mm) + 1) * D_MODEL) + lane; \
        _Pragma("unroll") for (int j = 0; j < 4; ++j) { nx[j] = xr[64 * j]; na[j] = y0[64 * j]; nc[j] = y1[64 * j]; } } while (0)
    P8_LOAD(gw);
    const bool lastl = (l + 1 == DEPTH);
    for (int m = gw; m < T; m += NGW) {
        const f32x2 wv = nw; u32x2 cx[4], ca[4], cc[4];
#pragma unroll
        for (int j = 0; j < 4; ++j) { cx[j] = nx[j]; ca[j] = na[j]; cc[j] = nc[j]; }
        if (m + NGW < T) P8_LOAD(m + NGW);
        f32x4 v[4]; float s = 0.f;
#pragma unroll
        for (int j = 0; j < 4; ++j) { const u32x2 xw = cx[j]; const u32x2 a = ca[j], c = cc[j];
            v[j].x = bf_lo(xw.x) * ALPHA + wv.x * bf_lo(a.x) + wv.y * bf_lo(c.x); v[j].y = bf_hi(xw.x) * ALPHA + wv.x * bf_hi(a.x) + wv.y * bf_hi(c.x);
            v[j].z = bf_lo(xw.y) * ALPHA + wv.x * bf_lo(a.y) + wv.y * bf_lo(c.y); v[j].w = bf_hi(xw.y) * ALPHA + wv.x * bf_hi(a.y) + wv.y * bf_hi(c.y);
            s += (v[j].x + v[j].y) + (v[j].z + v[j].w); }
        const float mean = wave_sum(s) * (1.f / D_MODEL); float s2 = 0.f;
#pragma unroll
        for (int j = 0; j < 4; ++j) { v[j] = v[j] - mean; s2 += (v[j].x * v[j].x + v[j].y * v[j].y) + (v[j].z * v[j].z + v[j].w * v[j].w); }
        const float rstd = 1.f / sqrtf(wave_sum(s2) * (1.f / D_MODEL) + LN_EPS);
#pragma unroll
        for (int j = 0; j < 4; ++j) { const f32x4 gg = *((const f32x4*)g2 + lane + 64 * j), bb = *((const f32x4*)b2 + lane + 64 * j);
            v[j] = v[j] * rstd * gg + bb;
            if (lastl) *((f32x4*)(xout + (size_t)m * D_MODEL) + lane + 64 * j) = v[j];
            else { u32x2 w; w.x = cvt_pk_bf16(v[j].x, v[j].y); w.y = cvt_pk_bf16(v[j].z, v[j].w); *((u32x2*)(XB + (size_t)m * D_MODEL) + lane + 64 * j) = w; } }
    }
#undef P8_LOAD
    PBS_END(4, lds);
    PBS_BEGIN(5, lds);
    if (l + 1 < DEPTH) { __syncthreads(); convert_weights(l + 1, lds); }
    PBS_END(5, lds);
}

__global__ void __launch_bounds__(NWAVES * 64, 2) fwd(Args args) {
    extern __shared__ __attribute__((aligned(16))) unsigned char lds_raw[];
    LAS unsigned char* lds = (LAS unsigned char*)lds_raw;
    volatile LAS unsigned* MISC = (volatile LAS unsigned*)(lds + MISC_OFF);
    for (int u = threadIdx.x; u < (LDS_BYTES - LDSCTL_OFF) / 4; u += NWAVES * 64) ((LAS unsigned*)(lds + LDSCTL_OFF))[u] = 0u;
    __syncthreads();
    XcdBarrier bar; bar.bar = (unsigned*)(arg_ws() + WS_CTL) + CW_BAR + arg_li() * XCD_BAR_WORDS; bar.x = 0; bar.st = nullptr;
    if (!MK_MULTI) bar = xcd_barrier_post((unsigned*)(arg_ws() + WS_CTL) + CW_BAR + arg_li() * XCD_BAR_WORDS, MISC + 8);
    const int lo = arg_lo(), hi = arg_hi();
#define IN(k) (lo <= (k) && (k) < hi)
#define SEAM(k) do { if (!MK_MULTI && IN(k) && IN((k) + 1)) { XcdBarrier b2_ = bar; asm volatile("" : "+s"(b2_.bar)); xcd_barrier(b2_); } } while (0)
    unsigned long long tacc = 0ull, tst = 0ull; (void)tacc; (void)tst;
#define PB_BEGIN(k) do { if (PROBE_PH == (k)) tst = __builtin_amdgcn_s_memrealtime(); } while (0)
#define PB_END(k) do { if (PROBE_PH == (k)) tacc += __builtin_amdgcn_s_memrealtime() - tst; } while (0)
    PB_BEGIN(0);
    if (HAS(0) && IN(0)) phase0(lds);
    SEAM(0);
    PB_END(0);
    for (int l = 0; l < DEPTH; ++l) {
        const int pb = 1 + l * PH_PER_LAYER;
        PB_BEGIN(1);
        if (HAS(1) && IN(pb + 0)) phase1(lds);
        SEAM(pb + 0);
        PB_END(1);
        PB_BEGIN(2);
        if (HAS(2) && IN(pb + 1)) phase2(lds, l);
        SEAM(pb + 1);
        PB_END(2);
        PB_BEGIN(3);
        if (HAS(3) && IN(pb + 2)) phase3(lds);
        SEAM(pb + 2);
        PB_END(3);
        PB_BEGIN(4);
        if (HAS(4) && IN(pb + 3)) phase4(lds, l);
        SEAM(pb + 3);
        PB_END(4);
        PB_BEGIN(5);
        if (HAS(5) && IN(pb + 4)) phase5(lds, l);
        SEAM(pb + 4);
        PB_END(5);
        PB_BEGIN(6);
        if (HAS(6) && IN(pb + 5)) phase6(lds, l);
        SEAM(pb + 5);
        PB_END(6);
        PB_BEGIN(7);
        if (HAS(7) && IN(pb + 6)) phase7(lds, l);
        SEAM(pb + 6);
        PB_END(7);
        PB_BEGIN(8);
        if (HAS(8) && IN(pb + 7)) phase8(lds, l);
        SEAM(pb + 7);
        PB_END(8);
    }
    if (PROBE_PH >= 100) tacc = *(volatile LAS unsigned long long*)(lds + MISC_OFF + 64);
    if (PROBE_PH >= 0 && blockIdx.x == 0) { const unsigned long long t0 = __builtin_amdgcn_s_memrealtime(); while (__builtin_amdgcn_s_memrealtime() - t0 < tacc * PROBE_MULT) __builtin_amdgcn_s_sleep(8); }
#undef IN
#undef SEAM
    (void)args;
}


#ifndef DBG_PROBE
#define DBG_PROBE 0
#endif
#ifndef DBG_LAYER
#define DBG_LAYER 0
#endif
#ifndef DBG_GAIN
#define DBG_GAIN 1.0f
#endif
#if DBG_PROBE
constexpr size_t WS_DXS = 528 * MiB, WS_DKV = 544 * MiB, WS_DST = 610 * MiB;
__device__ __forceinline__ int dbg_tok(int i) { const int sp[8] = {0, 1, 63, 64, 65, 575, 576, 4095}; return i < 8 ? sp[i] : (i * 67 + (i % 5) * 13 + 200) % 4096; }
__device__ __forceinline__ void atomic_max_pos(float* p, float v) { atomicMax((unsigned*)p, __float_as_uint(v)); }
__global__ void dbg_kv(const float* xs, const float* w_in, float* kv) {
    const int c = blockIdx.x * 256 + threadIdx.x; const int bi = blockIdx.y >> 8; const int t0 = (blockIdx.y & 255) * 16;
    xs += (size_t)(bi ? 5 : 0) * SEQ * D_MODEL; kv += (size_t)bi * SEQ * 2048;
    const int col = c < 1024 ? 512 + c : 2048 + (c - 1024);
    float acc[16];
#pragma unroll
    for (int i = 0; i < 16; ++i) acc[i] = 0.f;
    for (int k = 0; k < D_MODEL; ++k) { const float w = w_in[(size_t)k * PROJ + col];
#pragma unroll
        for (int i = 0; i < 16; ++i) acc[i] += xs[(size_t)(t0 + i) * D_MODEL + k] * w; }
#pragma unroll
    for (int i = 0; i < 16; ++i) kv[(size_t)(t0 + i) * 2048 + c] = acc[i];
}
__device__ __forceinline__ float blk_sum(float v, float* red) { __syncthreads(); red[threadIdx.x] = v; __syncthreads(); for (int s = 128; s > 0; s >>= 1) { if ((int)threadIdx.x < s) red[threadIdx.x] += red[threadIdx.x + s]; __syncthreads(); } const float r = red[0]; __syncthreads(); return r; }
__device__ __forceinline__ float blk_max(float v, float* red) { __syncthreads(); red[threadIdx.x] = v; __syncthreads(); for (int s = 128; s > 0; s >>= 1) { if ((int)threadIdx.x < s) red[threadIdx.x] = fmaxf(red[threadIdx.x], red[threadIdx.x + s]); __syncthreads(); } const float r = red[0]; __syncthreads(); return r; }
__global__ void __launch_bounds__(256) dbg_tok_kernel(Args a, int L, int mode) {
    __shared__ float xs[1024], qa[512], qb[512], gl[2048], ya[512], yb[512], mg[1024], mixed[1024], x1[1024], hbuf[512], sc[4096], red[256], lgs[16];
    const int tid = threadIdx.x; const int t = dbg_tok(blockIdx.x >> 1); const int bi = blockIdx.x & 1, bb = bi ? 5 : 0; const size_t grow = (size_t)bb * SEQ + t;
    unsigned char* ws = a.ws;
    const float* xsnap = a.in[0] + (size_t)bb * SEQ * D_MODEL; const float* kv = (const float*)(ws + WS_DKV) + (size_t)bi * SEQ * 2048; float* st = (float*)(ws + WS_DST);
    const float* w_in = a.in[1] + (size_t)L * D_MODEL * PROJ; const float* relb = a.in[2] + (size_t)L * NH * N_REL;
    const float* w_upa = a.in[3] + (size_t)L * WA * D_MODEL; const float* w_upb = a.in[4] + (size_t)L * WA * D_MODEL; const float* w_out = a.in[5] + (size_t)L * D_MODEL * D_MODEL;
    const float* g1 = a.in[6] + (size_t)L * D_MODEL; const float* b1 = a.in[7] + (size_t)L * D_MODEL; const float* w_router = a.in[8]; const float* b_router = a.in[9];
    const float* w_gate = a.in[10] + (size_t)L * NE * D_MODEL * FE; const float* w_up = a.in[11] + (size_t)L * NE * D_MODEL * FE; const float* w_down = a.in[12] + (size_t)L * NE * FE * D_MODEL;
    for (int i = tid; i < 1024; i += 256) xs[i] = xsnap[(size_t)t * D_MODEL + i];
    __syncthreads();
    for (int j = tid; j < 3072; j += 256) { const int col = j < 512 ? j : (j < 1024 ? 1536 + (j - 512) : 3072 + (j - 1024)); float s = 0.f;
        for (int k = 0; k < 1024; ++k) s += xs[k] * w_in[(size_t)k * PROJ + col];
        if (j < 512) qa[j] = s; else if (j < 1024) qb[j - 512] = s; else gl[j - 1024] = s; }
    __syncthreads();
    for (int h = 0; h < 8; ++h) {
        const int c = t >> 6; const int k0 = (c - 8) > 0 ? (c - 8) * 64 : 0, k1 = c * 64 + 63; const int nk = k1 - k0 + 1;
        float mx = -1e30f;
        for (int i = tid; i < nk; i += 256) { const int key = k0 + i; float s = 0.f; for (int d = 0; d < 64; ++d) s += qa[h * 64 + d] * kv[(size_t)key * 2048 + h * 64 + d];
            int rel = t - key; rel = rel < -128 ? -128 : (rel > 128 ? 128 : rel); s = s * 0.125f + relb[h * N_REL + rel + 128]; sc[i] = s; mx = fmaxf(mx, s); }
        mx = blk_max(mx, red);
        float sm = 0.f; for (int i = tid; i < nk; i += 256) { const float p = expf(sc[i] - mx); sc[i] = p; sm += p; }
        sm = blk_sum(sm, red);
        if (tid < 64) { float o = 0.f; for (int i = 0; i < nk; ++i) o += sc[i] * kv[(size_t)(k0 + i) * 2048 + 512 + h * 64 + tid]; ya[h * 64 + tid] = o / sm; }
        __syncthreads();
        for (int s = tid; s < t; s += 256) { float z = 0.f; for (int d = 0; d < 64; ++d) z += qb[h * 64 + d] * kv[(size_t)s * 2048 + 1024 + h * 64 + d]; sc[s] = z * 0.125f; }
        __syncthreads();
        if (tid < 64) { float y = 0.f; for (int s = 0; s < t; ++s) { const float beta = 1.0f / (1.0f + expf(-sc[s])); y += beta * (kv[(size_t)s * 2048 + 1536 + h * 64 + tid] - y); } yb[h * 64 + tid] = y; }
        __syncthreads();
    }
    if (mode == 0) {
        const bf16_t* OA = (const bf16_t*)(ws + WS_QQ); const bf16_t* OB = (const bf16_t*)(ws + WS_QQ) + WA;
        float na = 0.f, da = 0.f, nb = 0.f, db = 0.f;
        for (int i = tid; i < 512; i += 256) { const float oa = h2f(OA[grow * D_MODEL + i]), ob = h2f(OB[grow * D_MODEL + i]);
            na += (oa - ya[i]) * (oa - ya[i]); da += ya[i] * ya[i]; nb += (ob - yb[i]) * (ob - yb[i]); db += yb[i] * yb[i]; }
        na = blk_sum(na, red); da = blk_sum(da, red); nb = blk_sum(nb, red); db = blk_sum(db, red);
        if (tid == 0) { atomicAdd(st + 4, na); atomicAdd(st + 5, da); atomicAdd(st + 6, nb); atomicAdd(st + 7, db); }
        return; }
    for (int cidx = tid; cidx < 1024; cidx += 256) { float ua = 0.f, ub = 0.f; for (int k = 0; k < 512; ++k) { ua += ya[k] * w_upa[(size_t)k * D_MODEL + cidx]; ub += yb[k] * w_upb[(size_t)k * D_MODEL + cidx]; }
        const float ga = 1.0f / (1.0f + expf(-gl[cidx])), gb = 1.0f / (1.0f + expf(-gl[1024 + cidx])); mg[cidx] = ga * ua + gb * ub; }
    __syncthreads();
    float num = 0.f, den = 0.f;
    for (int cidx = tid; cidx < 1024; cidx += 256) { float s = 0.f; for (int k = 0; k < 1024; ++k) s += mg[k] * w_out[(size_t)k * D_MODEL + cidx]; mixed[cidx] = s;
        const float opt = h2f(((const bf16_t*)(ws + WS_PRE))[grow * D_MODEL + cidx]) - ALPHA * xs[cidx]; num += (opt - s) * (opt - s); den += s * s; }
    num = blk_sum(num, red); den = blk_sum(den, red);
    if (tid == 0) { atomicAdd(st + 0, num); atomicAdd(st + 1, den); atomic_max_pos(st + 8, num / den); }
    float s1 = 0.f; for (int i = tid; i < 1024; i += 256) { x1[i] = ALPHA * xs[i] + mixed[i]; s1 += x1[i]; }
    const float mean = blk_sum(s1, red) / 1024.f; float s2 = 0.f; for (int i = tid; i < 1024; i += 256) { const float d = x1[i] - mean; s2 += d * d; }
    const float rstd = 1.0f / sqrtf(blk_sum(s2, red) / 1024.f + LN_EPS);
    for (int i = tid; i < 1024; i += 256) x1[i] = (x1[i] - mean) * rstd * g1[i] + b1[i];
    __syncthreads();
    if (tid < 16) { float s = 0.f; for (int k = 0; k < 1024; ++k) s += x1[k] * w_router[k * 16 + tid]; lgs[tid] = s + b_router[tid]; }
    __syncthreads();
    int best = 0; for (int e = 1; e < 16; ++e) if (lgs[e] > lgs[best]) best = e;
    const int grp = best >> 2; int e2 = -1; for (int e = grp * 4; e < grp * 4 + 4; ++e) if (e != best && (e2 < 0 || lgs[e] > lgs[e2])) e2 = e;
    const float pw1 = 1.0f / (1.0f + expf(lgs[e2] - lgs[best])), pw2 = 1.0f - pw1;
    const f32x2 wo = ((const f32x2*)(ws + WS_RECW))[grow]; const bf16_t* Y = (const bf16_t*)(ws + WS_Y);
    float fnum = 0.f, fden = 0.f; float ff[4] = {0.f, 0.f, 0.f, 0.f};
    for (int kk = 0; kk < 2; ++kk) { const int e = kk ? e2 : best; const float pw = kk ? pw2 : pw1;
        for (int f = tid; f < 512; f += 256) { float g = 0.f, u = 0.f; for (int k = 0; k < 1024; ++k) { g += x1[k] * w_gate[((size_t)e * D_MODEL + k) * FE + f]; u += x1[k] * w_up[((size_t)e * D_MODEL + k) * FE + f]; }
            hbuf[f] = g / (1.0f + expf(-g)) * u; }
        __syncthreads();
        for (int j = 0; j < 4; ++j) { const int cidx = tid + 256 * j; float s = 0.f; for (int f = 0; f < 512; ++f) s += hbuf[f] * w_down[((size_t)e * FE + f) * D_MODEL + cidx]; ff[j] += pw * s; }
        __syncthreads(); }
    for (int j = 0; j < 4; ++j) { const int cidx = tid + 256 * j; const float opt = wo.x * h2f(Y[(size_t)(2 * grow) * D_MODEL + cidx]) + wo.y * h2f(Y[(size_t)(2 * grow + 1) * D_MODEL + cidx]);
        fnum += (opt - ff[j]) * (opt - ff[j]); fden += ff[j] * ff[j]; }
    fnum = blk_sum(fnum, red); fden = blk_sum(fden, red);
    if (tid == 0) { atomicAdd(st + 2, fnum); atomicAdd(st + 3, fden); atomic_max_pos(st + 9, fnum / fden); }
    const float* g2 = a.in[13] + (size_t)L * D_MODEL; const float* b2 = a.in[14] + (size_t)L * D_MODEL;
    float t1 = 0.f; for (int j = 0; j < 4; ++j) { const int cidx = tid + 256 * j; mixed[cidx] = ALPHA * x1[cidx] + ff[j]; t1 += mixed[cidx]; }
    const float mean2 = blk_sum(t1, red) / 1024.f; float t2 = 0.f; for (int j = 0; j < 4; ++j) { const float d = mixed[tid + 256 * j] - mean2; t2 += d * d; }
    const float rstd2 = 1.0f / sqrtf(blk_sum(t2, red) / 1024.f + LN_EPS);
    float xnum = 0.f, xden = 0.f;
    for (int j = 0; j < 4; ++j) { const int cidx = tid + 256 * j; const float ref = (mixed[cidx] - mean2) * rstd2 * g2[cidx] + b2[cidx];
        const float opt = (L == DEPTH - 1) ? a.out[grow * D_MODEL + cidx] : h2f(((const bf16_t*)(ws + WS_XB))[grow * D_MODEL + cidx]);
        xnum += (opt - ref) * (opt - ref); xden += ref * ref; }
    xnum = blk_sum(xnum, red); xden = blk_sum(xden, red);
    if (tid == 0) { atomicAdd(st + 10, xnum); atomicAdd(st + 11, xden); atomic_max_pos(st + 12, xnum / xden); }
}
__global__ void dbg_inject(float* out, const float* st, int n4) {
    const float delta = sqrtf((DBG_PROBE == 1) ? st[0] / st[1] : (DBG_PROBE == 2) ? st[2] / st[3] : (DBG_PROBE == 3) ? st[4] / st[5] : (DBG_PROBE == 4) ? st[6] / st[7] : (DBG_PROBE == 5) ? st[8] : (DBG_PROBE == 6) ? st[9] : (DBG_PROBE == 7) ? st[10] / st[11] : st[12]); const float f = 1.0f + DBG_GAIN * delta;
    for (int i = blockIdx.x * blockDim.x + threadIdx.x; i < n4; i += gridDim.x * blockDim.x) { f32x4 v = ((f32x4*)out)[i]; v = v * f; ((f32x4*)out)[i] = v; }
}
#endif

extern "C" void kernel_launch(void* const* d_in, const int* in_sizes, int n_in, void* d_out, int out_size, void* d_ws, size_t ws_size, hipStream_t stream) {
    static int grid = 0;
    if (grid == 0) {
        if (n_in != 15 || in_sizes[0] != T * D_MODEL || out_size != T * D_MODEL || ws_size < WS_END) {
            fprintf(stderr, "kernel_launch: unexpected shapes (n_in %d in0 %d out %d ws %zu; need ws >= %zu); nothing launched\n", n_in, n_in > 0 ? in_sizes[0] : -1, out_size, ws_size, (size_t)WS_END); grid = -1; return; }
        int dev = 0, cus = 0, per_cu = 0;
        if (hipGetDevice(&dev) != hipSuccess || hipDeviceGetAttribute(&cus, hipDeviceAttributeMultiprocessorCount, dev) != hipSuccess) { grid = -1; return; }
        if (hipFuncSetAttribute((const void*)fwd, hipFuncAttributeMaxDynamicSharedMemorySize, LDS_BYTES) != hipSuccess) { fprintf(stderr, "kernel_launch: hipFuncSetAttribute failed\n"); grid = -1; return; }
        if (hipOccupancyMaxActiveBlocksPerMultiprocessor(&per_cu, (const void*)fwd, NWAVES * 64, LDS_BYTES) != hipSuccess || per_cu < 1)
            fprintf(stderr, "kernel_launch: note: occupancy query reports %d workgroups per CU\n", per_cu);
        (void)hipGetLastError();
        grid = cus;
        if (grid != 256) fprintf(stderr, "kernel_launch: %d CUs; the attention deal needs 256\n", grid);
    }
    if (grid < 0) return;
    if (hipMemsetAsync((char*)d_ws + WS_CTL, 0, CTL_ZERO_BYTES, stream) != hipSuccess) { fprintf(stderr, "kernel_launch: memset failed\n"); return; }
    Args a{};
    for (int i = 0; i < 15; ++i) a.in[i] = (const float*)d_in[i];
    a.out = (float*)d_out; a.ws = (unsigned char*)d_ws;
#if DBG_PROBE
    {
        const int L = DBG_LAYER, p0 = 1 + 8 * L, p1 = 1 + 8 * (L + 1);
        hipMemsetAsync((char*)d_ws + WS_DST, 0, 64, stream);
        a.li = 0; a.ph_lo = 0; a.ph_hi = p0; hipLaunchKernelGGL(fwd, dim3(grid), dim3(NWAVES * 64), LDS_BYTES, stream, a);
        hipLaunchKernelGGL(dbg_kv, dim3(8, 512), dim3(256), 0, stream, (const float*)d_in[0], (const float*)d_in[1] + (size_t)L * D_MODEL * PROJ, (float*)((char*)d_ws + WS_DKV));
        a.li = 1; a.ph_lo = p0; a.ph_hi = p0 + 2; hipLaunchKernelGGL(fwd, dim3(grid), dim3(NWAVES * 64), LDS_BYTES, stream, a);
        hipLaunchKernelGGL(dbg_tok_kernel, dim3(128), dim3(256), 0, stream, a, L, 0);
        a.li = 3; a.ph_lo = p0 + 2; a.ph_hi = p1; hipLaunchKernelGGL(fwd, dim3(grid), dim3(NWAVES * 64), LDS_BYTES, stream, a);
        hipLaunchKernelGGL(dbg_tok_kernel, dim3(128), dim3(256), 0, stream, a, L, 1);
        if (p1 < N_PHASES) { a.li = 2; a.ph_lo = p1; a.ph_hi = N_PHASES; hipLaunchKernelGGL(fwd, dim3(grid), dim3(NWAVES * 64), LDS_BYTES, stream, a); }
        hipLaunchKernelGGL(dbg_inject, dim3(1024), dim3(256), 0, stream, (float*)d_out, (const float*)((char*)d_ws + WS_DST), T * D_MODEL / 4);
    }
#elif MK_MULTI
    for (int p = 0; p < N_PHASES; ++p) { a.ph_lo = p; a.ph_hi = p + 1; hipLaunchKernelGGL(fwd, dim3(grid), dim3(NWAVES * 64), LDS_BYTES, stream, a); }
#else
    a.ph_lo = 0; a.ph_hi = N_PHASES;
    hipLaunchKernelGGL(fwd, dim3(grid), dim3(NWAVES * 64), LDS_BYTES, stream, a);
#endif
    const hipError_t le = hipPeekAtLastError();
    if (le != hipSuccess) fprintf(stderr, "kernel_launch: launch failed: %s\n", hipGetErrorName(le));
}
```

```cpp
#include <hip/hip_runtime.h>
#include <cstdio>
#include <cstdint>

#ifndef MK_MULTI
#define MK_MULTI 0
#endif

#ifndef PROBE_PH
#define PROBE_PH (-1)
#endif
#ifndef PROBE_MULT
#define PROBE_MULT 1
#endif
#ifndef PHASE_MASK
#define PHASE_MASK 0x1ff
#endif
#define HAS(k) ((PHASE_MASK >> (k)) & 1)
#define LAS __attribute__((address_space(3)))
#define PBS_BEGIN(id, lds) do { if (PROBE_PH == 100 + (id) && threadIdx.x == 0) *(volatile LAS unsigned long long*)((lds) + MISC_OFF + 80) = __builtin_amdgcn_s_memrealtime(); } while (0)
#define PBS_END(id, lds) do { if (PROBE_PH == 100 + (id) && threadIdx.x == 0) { volatile LAS unsigned long long* p_ = (volatile LAS unsigned long long*)((lds) + MISC_OFF + 64); p_[0] = p_[0] + (__builtin_amdgcn_s_memrealtime() - p_[2]); } } while (0)
#define GAS __attribute__((address_space(1)))
typedef unsigned short bf16_t;
typedef short bf16x8 __attribute__((ext_vector_type(8)));
typedef short s16x4 __attribute__((ext_vector_type(4)));
typedef float f32x4 __attribute__((ext_vector_type(4)));
typedef float f32x2 __attribute__((ext_vector_type(2)));
typedef float f32x16 __attribute__((ext_vector_type(16)));
typedef unsigned u32x4 __attribute__((ext_vector_type(4)));
typedef unsigned u32x2 __attribute__((ext_vector_type(2)));

constexpr int D_MODEL = 1024, BATCH = 8, SEQ = 4096, DEPTH = 4, T = BATCH * SEQ;
constexpr int NH = 8, HD = 64, WA = NH * HD;
constexpr int PROJ = 3 * WA + 3 * WA + 2 * D_MODEL;
constexpr int N_REL = 257, NE = 16, FE = 512;
constexpr float ALPHA = 1.681792830507429f;
constexpr float LN_EPS = 1e-5f;
constexpr float LOG2E = 1.4426950408889634f;
constexpr float C2 = 0.125f * LOG2E;

constexpr size_t MiB = 1u << 20;
constexpr size_t WS_CTL = 0, CTL_ZERO_BYTES = 1 * MiB;
constexpr size_t WS_RECW = 2 * MiB;
constexpr size_t WS_LIST = 4 * MiB;
constexpr size_t WS_WIN = 8 * MiB, WS_WUP = 18 * MiB  , WS_WOUT = 20 * MiB, WS_WGU = 22 * MiB, WS_WD = 54 * MiB;
constexpr size_t WS_RTAB = 70 * MiB;
constexpr size_t RTAB_STRIDE = 65536 + 256;
constexpr size_t WS_XB = 72 * MiB;
constexpr size_t WS_QQ = 136 * MiB, WS_KA = 200 * MiB, WS_VA = 232 * MiB, WS_KB = 264 * MiB, WS_VB = 296 * MiB;
constexpr size_t WS_GA = 328 * MiB, WS_GB = 392 * MiB;
constexpr size_t WS_PRE = 328 * MiB;
constexpr size_t WS_MERGED = 456 * MiB;
constexpr size_t WS_Y = 136 * MiB;
constexpr size_t WS_H = 456 * MiB;
constexpr size_t WS_END = 526 * MiB;
constexpr int CW_TMO = 0;
constexpr int CW_BAR = 4096;
constexpr int CW_CNT = 32768;

constexpr int RING_BYTES = 131072;
constexpr int LDSCTL_OFF = RING_BYTES, MISC_OFF = LDSCTL_OFF + 320;
constexpr int UTAB_OFF = LDSCTL_OFF + 1024;
constexpr int LDS_BYTES = 147456;

#ifndef USE_F16
#define USE_F16 1
#endif
typedef _Float16 h16x2 __attribute__((ext_vector_type(2)));
typedef _Float16 h16x8 __attribute__((ext_vector_type(8)));
#if USE_F16
__device__ __forceinline__ unsigned cvt_pk_bf16(float lo, float hi) { const f32x2 v = {lo, hi}; return __builtin_bit_cast(unsigned, __builtin_convertvector(v, h16x2)); }
__device__ __forceinline__ float bf_lo(unsigned w) { return (float)__builtin_bit_cast(h16x2, w)[0]; }
__device__ __forceinline__ float bf_hi(unsigned w) { return (float)__builtin_bit_cast(h16x2, w)[1]; }
#define MFMA16(a, b, c) __builtin_amdgcn_mfma_f32_16x16x32_f16(__builtin_bit_cast(h16x8, a), __builtin_bit_cast(h16x8, b), c, 0, 0, 0)
#define MFMA32(a, b, c) __builtin_amdgcn_mfma_f32_32x32x16_f16(__builtin_bit_cast(h16x8, a), __builtin_bit_cast(h16x8, b), c, 0, 0, 0)
#else
__device__ __forceinline__ unsigned cvt_pk_bf16(float lo, float hi) { unsigned r; asm volatile("v_cvt_pk_bf16_f32 %0, %1, %2" : "=v"(r) : "v"(lo), "v"(hi)); return r; }
__device__ __forceinline__ float bf_lo(unsigned w) { return __uint_as_float(w << 16); }
__device__ __forceinline__ float bf_hi(unsigned w) { return __uint_as_float(w & 0xffff0000u); }
#define MFMA16(a, b, c) __builtin_amdgcn_mfma_f32_16x16x32_bf16(a, b, c, 0, 0, 0)
#define MFMA32(a, b, c) MFMA32(a, b, c)
#endif
__device__ __forceinline__ float h2f(bf16_t h) { return bf_lo((unsigned)h); }
__device__ __forceinline__ float fast_exp2(float x) { return __builtin_amdgcn_exp2f(x); }
__device__ __forceinline__ float fast_rcp(float x) { return __builtin_amdgcn_rcpf(x); }
__device__ __forceinline__ float sigmoidf_(float v) { return fast_rcp(1.0f + fast_exp2(-LOG2E * v)); }
__device__ __forceinline__ float wave_sum(float v) {
#define DPP_ADD(ctrl, rmask) v += __builtin_bit_cast(float, __builtin_amdgcn_update_dpp(0, __builtin_bit_cast(int, v), ctrl, rmask, 0xf, false))
    DPP_ADD(0x111, 0xf); DPP_ADD(0x112, 0xf); DPP_ADD(0x114, 0xf); DPP_ADD(0x118, 0xf);
    DPP_ADD(0x142, 0xa); DPP_ADD(0x143, 0xc);
#undef DPP_ADD
    return __builtin_bit_cast(float, __builtin_amdgcn_readlane(__builtin_bit_cast(int, v), 63));
}
#define LDS_WAIT() asm volatile("s_waitcnt lgkmcnt(0)" ::: "memory")
#define VM_WAIT() asm volatile("s_waitcnt vmcnt(0)" ::: "memory")

namespace pg8 {
constexpr int BM = 256, BK = 64, HALF = 128, HTB = HALF * BK * 2, STAGE_BYTES = 8 * HTB, NXCD = 8, WGM = 8;
__host__ __device__ __forceinline__ int lds_byte(int r, int c) { const int st = (r >> 4) * 2 + (c >> 5), rr = r & 15, cc = c & 31, ob = rr * 64 + cc * 2; return st * 1024 + (ob ^ (((ob >> 9) & 1) << 5)); }
__host__ __device__ __forceinline__ void stage_rc(int b, int& R, int& C) { const int st = b / 1024, sb = b % 1024, swz = sb ^ (((sb >> 9) & 1) << 5); R = (st >> 1) * 16 + swz / 64; C = (st & 1) * 32 + (swz % 64) / 2; }
__host__ __device__ __forceinline__ int perm32(int rho) { const int n = rho >> 4, i = rho & 15; return 8 * (i >> 2) + 4 * n + (i & 3); }

struct Unit { const char* A; const char* B; int pm, pn, x0, x1, x2; };

struct TileOrder {
    int nM, nN, nwg, G, c;
    __device__ __forceinline__ void init(int nM_, int nN_, int G_, int c_) { nM = nM_; nN = nN_; nwg = nM * nN; G = G_; c = c_; }
    __device__ __forceinline__ bool next(int i, int& pm, int& pn) const {
        const long L = (long)i * G + c; if (L >= nwg) return false;
        int wgid = (int)L; { const int q = nwg / NXCD, r = nwg % NXCD, xcd = wgid % NXCD, off = wgid / NXCD; wgid = (xcd < r ? xcd * (q + 1) : r * (q + 1) + (xcd - r) * q) + off; }
        const int nig = WGM * nN, gid = wgid / nig, fm = gid * WGM, gsz = (nM - fm) < WGM ? (nM - fm) : WGM;
        pm = fm + ((wgid % nig) % gsz); pn = (wgid % nig) / gsz; return true;
    }
};

template <class Epi, class Sched, bool GATHER, bool ALIGN_EPI, bool MIDHOOK = false>
__device__ __forceinline__ void gemm_phase(LAS unsigned char* lds, const int K, const Sched& S, const Epi& E, const int LD_ = 0) {
    const int LD = LD_ ? LD_ : K;
    int tid_ = threadIdx.x; asm volatile("" : "+v"(tid_));
    const int tid = tid_, wid = __builtin_amdgcn_readfirstlane(tid >> 6), lane = tid & 63, wr = wid >> 2, wc = wid & 3, fr = lane & 15, fq = lane >> 4;
    const int nt = K / BK;
    unsigned voffB[2]; int RA[2], CA2[2];
#pragma unroll
    for (int i = 0; i < 2; ++i) { int R, C; stage_rc(tid * 16 + i * 8192, R, C); const int Rb = Epi::PERM ? ((R & ~31) + perm32(R & 31)) : R;
        RA[i] = R; CA2[i] = C * 2; voffB[i] = (unsigned)(Rb * LD + C) * 2u; }
    const size_t kstep = (size_t)(BK * 2);
    const size_t hstep = (size_t)HALF * LD * 2;
    const unsigned ldsw = (unsigned)wid * 1024u;
    const int aoff = lds_byte(wr * 64 + fr, fq * 8), boff = lds_byte(wc * 32 + fr, fq * 8);
#define PG8_SA(b, h) (((b) * 2 + (h)) * HTB)
#define PG8_SB(b, h) ((4 + (b) * 2 + (h)) * HTB)
#define PG8_STAGE(bufoff, gbase, voff) do { _Pragma("unroll") for (int _i = 0; _i < 2; ++_i) \
        __builtin_amdgcn_global_load_lds((const unsigned*)((const char*)(gbase) + (voff)[_i]), (LAS unsigned*)(lds + (bufoff) + ldsw + _i * 8192), 16, 0, 0); } while (0)
#define PG8_LDA(dst, b, h) do { _Pragma("unroll") for (int m = 0; m < 4; ++m) _Pragma("unroll") for (int k = 0; k < 2; ++k) dst[m][k] = *(const LAS bf16x8*)(lds + PG8_SA(b, h) + aoff + m * 2048 + k * 1024); } while (0)
#define PG8_LDB(dst, b, h) do { _Pragma("unroll") for (int n = 0; n < 2; ++n) _Pragma("unroll") for (int k = 0; k < 2; ++k) dst[n][k] = *(const LAS bf16x8*)(lds + PG8_SB(b, h) + boff + n * 2048 + k * 1024); } while (0)
#define PG8_MMA(ai, bj, At, Bt) do { __builtin_amdgcn_s_setprio(1); _Pragma("unroll") for (int m = 0; m < 4; ++m) _Pragma("unroll") for (int n = 0; n < 2; ++n) _Pragma("unroll") for (int k = 0; k < 2; ++k) \
        acc[ai][bj][m][n] = MFMA16(Bt[n][k], At[m][k], acc[ai][bj][m][n]); __builtin_amdgcn_s_setprio(0); } while (0)
#define PG8_WAIT_V(n) asm volatile("s_waitcnt vmcnt(" #n ")" ::: "memory")
#define PG8_WAIT_L(n) asm volatile("s_waitcnt lgkmcnt(" #n ")" ::: "memory")
#define PG8_BAR __builtin_amdgcn_s_barrier()
#define PG8_SCHED __builtin_amdgcn_sched_barrier(0)
    Unit cur, nxt; int ui = 0;
    if (!S.next(0, cur)) return;
    unsigned oc0[2], oc1[2], on0[2], on1[2];
    if constexpr (GATHER) { S.offs(cur, RA, CA2, oc0, oc1); }
    else {
#pragma unroll
        for (int i = 0; i < 2; ++i) { oc0[i] = (unsigned)(RA[i] * LD) * 2u + (unsigned)CA2[i]; oc1[i] = oc0[i]; on0[i] = oc0[i]; on1[i] = oc0[i]; } }
    const size_t ah = GATHER ? (size_t)0 : hstep;
    f32x4 acc[2][2][4][2];
#pragma unroll
    for (int a = 0; a < 2; ++a)
#pragma unroll
        for (int b = 0; b < 2; ++b)
#pragma unroll
            for (int m = 0; m < 4; ++m)
#pragma unroll
                for (int n = 0; n < 2; ++n) acc[a][b][m][n] = (f32x4){0.f, 0.f, 0.f, 0.f};
    bf16x8 At[4][2], B0[2][2], B1[2][2];
    const char* cA = cur.A; const char* cB = cur.B;
    PG8_STAGE(PG8_SB(0, 0), cB, voffB); PG8_STAGE(PG8_SB(0, 1), cB + hstep, voffB); PG8_STAGE(PG8_SA(0, 0), cA, oc0); PG8_STAGE(PG8_SA(0, 1), cA + ah, oc1);
    if (wr == 1) PG8_BAR;
    PG8_WAIT_V(2); PG8_BAR;
    PG8_STAGE(PG8_SB(1, 0), cB + kstep, voffB); PG8_STAGE(PG8_SA(1, 0), cA + kstep, oc0); PG8_STAGE(PG8_SB(1, 1), cB + hstep + kstep, voffB);
    PG8_WAIT_V(6); PG8_BAR;
    for (;;) {
        const bool has_next = S.next(ui + 1, nxt);
        const char* nA = has_next ? nxt.A : cA; const char* nB = has_next ? nxt.B : cB;
        if constexpr (GATHER) { if (has_next) S.offs(nxt, RA, CA2, on0, on1); else { on0[0] = oc0[0]; on0[1] = oc0[1]; on1[0] = oc1[0]; on1[1] = oc1[1]; } }
        for (int t = 0; t < nt; t += 2) {
            const bool last = (t == nt - 2);
            const char* a1 = cA + (size_t)(t + 1) * kstep;
            const char* a2 = last ? nA : cA + (size_t)(t + 2) * kstep; const char* b2 = last ? nB : cB + (size_t)(t + 2) * kstep;
            const char* a3 = a2 + kstep; const char* b3 = b2 + kstep;
            unsigned o20[2], o21[2];
            if constexpr (GATHER) { o20[0] = last ? on0[0] : oc0[0]; o20[1] = last ? on0[1] : oc0[1]; o21[0] = last ? on1[0] : oc1[0]; o21[1] = last ? on1[1] : oc1[1]; }
            else { o20[0] = oc0[0]; o20[1] = oc0[1]; o21[0] = oc0[0]; o21[1] = oc0[1]; }
            PG8_LDB(B0, 0, 0); PG8_LDB(B1, 0, 1); PG8_SCHED; PG8_LDA(At, 0, 0); PG8_STAGE(PG8_SA(1, 1), a1 + ah, oc1);
            PG8_WAIT_V(8); PG8_WAIT_L(0); PG8_BAR; PG8_MMA(0, 0, At, B0); PG8_MMA(0, 1, At, B1); PG8_BAR; PG8_SCHED;
            PG8_LDA(At, 0, 1); PG8_STAGE(PG8_SB(0, 0), b2, voffB); PG8_STAGE(PG8_SB(0, 1), b2 + hstep, voffB); PG8_STAGE(PG8_SA(0, 0), a2, o20);
            PG8_WAIT_V(8); PG8_WAIT_L(0); PG8_BAR; PG8_MMA(1, 0, At, B0); PG8_MMA(1, 1, At, B1); PG8_BAR; PG8_SCHED;
            PG8_LDB(B0, 1, 0); PG8_LDB(B1, 1, 1); PG8_SCHED; PG8_LDA(At, 1, 0); PG8_STAGE(PG8_SA(0, 1), a2 + ah, o21);
            PG8_WAIT_V(8); PG8_WAIT_L(0); PG8_BAR; PG8_MMA(0, 0, At, B0); PG8_MMA(0, 1, At, B1); PG8_BAR; PG8_SCHED;
            PG8_LDA(At, 1, 1); PG8_STAGE(PG8_SB(1, 0), b3, voffB); PG8_STAGE(PG8_SB(1, 1), b3 + hstep, voffB); PG8_STAGE(PG8_SA(1, 0), a3, o20);
            PG8_WAIT_V(8); PG8_WAIT_L(0); PG8_BAR; PG8_MMA(1, 0, At, B0); PG8_MMA(1, 1, At, B1); PG8_BAR; PG8_SCHED;
        }
        if constexpr (ALIGN_EPI) { if (wr == 0) PG8_BAR; }
        bool keep = false;
        if constexpr (MIDHOOK) { if (cur.x0 == 0) { E.mid(acc, cur, wr, wc, fr, fq); keep = true; } else E(acc, cur, wr, wc, fr, fq); }
        else E(acc, cur, wr, wc, fr, fq);
        if (!has_next) break;
        if (!keep) {
#pragma unroll
        for (int a = 0; a < 2; ++a)
#pragma unroll
            for (int b = 0; b < 2; ++b)
#pragma unroll
                for (int m = 0; m < 4; ++m)
#pragma unroll
                    for (int n = 0; n < 2; ++n) acc[a][b][m][n] = (f32x4){0.f, 0.f, 0.f, 0.f};
        }
        cur = nxt; cA = nA; cB = nB; ++ui;
        if constexpr (GATHER) { oc0[0] = on0[0]; oc0[1] = on0[1]; oc1[0] = on1[0]; oc1[1] = on1[1]; }
        if constexpr (ALIGN_EPI) { if (wr == 1) PG8_BAR; }
    }
    PG8_WAIT_V(0);
    if constexpr (!ALIGN_EPI) { if (wr == 0) PG8_BAR; }
    PG8_BAR;
#undef PG8_SA
#undef PG8_SB
#undef PG8_STAGE
#undef PG8_LDA
#undef PG8_LDB
#undef PG8_MMA
#undef PG8_WAIT_V
#undef PG8_WAIT_L
#undef PG8_BAR
#undef PG8_SCHED
}

struct SchedPlain {
    TileOrder o; const char* A; const char* B; size_t tstep;
    __device__ __forceinline__ bool next(int i, Unit& u) const { int pm, pn; if (!o.next(i, pm, pn)) return false; u.pm = pm; u.pn = pn; u.x0 = 0; u.x1 = 0; u.x2 = 0; u.A = A + (size_t)pm * tstep; u.B = B + (size_t)pn * tstep; return true; }
};
struct SchedTwo {
    TileOrder o; const char* A; const char* B; size_t tstep;
    __device__ __forceinline__ bool next(int i, Unit& u) const { int pm, pn; if (!o.next(i >> 1, pm, pn)) return false; const int br = i & 1; u.pm = pm; u.pn = pn; u.x0 = br; u.x1 = 0; u.x2 = 0;
        u.A = A + (size_t)pm * tstep + (size_t)br * (WA * 2); u.B = B + (size_t)pn * tstep + (size_t)br * (WA * 2); return true; }
};
struct SchedMoe {
    const LAS int* utab; int nunits;
    const char* Abase; const char* Bbase; size_t a_row_bytes; size_t b_exp_bytes; size_t b_tile_bytes; const int* list; int gather_k2;
    __device__ __forceinline__ bool next(int i, Unit& u) const {
        if (i >= nunits) return false;
        const int e = utab[i * 5 + 0], pn = utab[i * 5 + 1], lo_ = utab[i * 5 + 2], nv = utab[i * 5 + 3], rb = utab[i * 5 + 4];
        u.pm = e; u.pn = pn; u.x0 = lo_; u.x1 = nv; u.x2 = rb;
        u.A = Abase + (size_t)rb * a_row_bytes; u.B = Bbase + (size_t)e * b_exp_bytes + (size_t)pn * b_tile_bytes; return true; }
    __device__ __forceinline__ void offs(const Unit& u, const int (&RA)[2], const int (&CA2)[2], unsigned (&o0)[2], unsigned (&o1)[2]) const {
        const int* lp = list + (size_t)u.pm * T + u.x0;
#pragma unroll
        for (int i = 0; i < 2; ++i) {
            int r0 = RA[i], r1 = RA[i] + HALF; r0 = r0 < u.x1 ? r0 : u.x1 - 1; r1 = r1 < u.x1 ? r1 : u.x1 - 1;
            const int t0 = lp[r0] >> 1, t1 = lp[r1] >> 1;
            o0[i] = (unsigned)t0 * (unsigned)gather_k2 + (unsigned)CA2[i]; o1[i] = (unsigned)t1 * (unsigned)gather_k2 + (unsigned)CA2[i]; }
    }
};
}

using pg8::Unit;
struct EpiInProj {
    static constexpr bool PERM = true;
    unsigned char* ws;
    __device__ __forceinline__ void operator()(const f32x4 (&acc)[2][2][4][2], const Unit& u, int wr, int wc, int fr, int fq) const {
        const int pn = u.pn; bf16_t* base; int ldc, colt; float sc = 1.f; const bool gate = pn >= 12;
        if (!gate) { const int piece = pn >> 1; colt = (pn & 1) * 256; ldc = WA;
            if (piece == 0) { base = (bf16_t*)(ws + WS_QQ); ldc = D_MODEL; sc = C2; }
            else if (piece == 3) { base = (bf16_t*)(ws + WS_QQ) + WA; ldc = D_MODEL; sc = C2; }
            else base = (bf16_t*)(ws + (piece == 1 ? WS_KA : piece == 2 ? WS_VA : piece == 4 ? WS_KB : WS_VB)); }
        else { const int g = (pn - 12) >> 2; base = (bf16_t*)(ws + (g ? WS_GB : WS_GA)); ldc = D_MODEL; colt = ((pn - 12) & 3) * 256; }
        const int row0 = u.pm * 256 + wr * 64 + fr, col0 = colt + wc * 32 + 8 * fq;
#pragma unroll
        for (int ai = 0; ai < 2; ++ai)
#pragma unroll
            for (int m = 0; m < 4; ++m) { bf16_t* rowp = base + (size_t)(row0 + ai * 128 + m * 16) * ldc + col0;
#pragma unroll
                for (int bj = 0; bj < 2; ++bj) { f32x4 v0 = acc[ai][bj][m][0], v1 = acc[ai][bj][m][1];
                    if (gate) {
#pragma unroll
                        for (int i = 0; i < 4; ++i) { v0[i] = sigmoidf_(v0[i]); v1[i] = sigmoidf_(v1[i]); } }
                    else { v0 = v0 * sc; v1 = v1 * sc; }
                    u32x4 w; w.x = cvt_pk_bf16(v0[0], v0[1]); w.y = cvt_pk_bf16(v0[2], v0[3]); w.z = cvt_pk_bf16(v1[0], v1[1]); w.w = cvt_pk_bf16(v1[2], v1[3]);
                    *(u32x4*)(rowp + bj * 128) = w; } }
    }
};
struct EpiMerge {
    static constexpr bool PERM = true;
    const bf16_t* ga; const bf16_t* gb; bf16_t* merged;
    __device__ __forceinline__ void mid(f32x4 (&acc)[2][2][4][2], const Unit& u, int wr, int wc, int fr, int fq) const {
        unsigned o0 = ((unsigned)(u.pm * 256 + wr * 64 + fr) * D_MODEL + (unsigned)(u.pn * 256 + wc * 32 + 8 * fq)) * 2u;
        asm volatile("" : "+v"(o0));
#pragma unroll
        for (int ai = 0; ai < 2; ++ai)
#pragma unroll
            for (int m = 0; m < 4; ++m) {
#pragma unroll
                for (int bj = 0; bj < 2; ++bj) { const unsigned ob = o0 + (unsigned)((ai * 128 + m * 16) * D_MODEL + bj * 128) * 2u;
                    const u32x4 aw = *(const u32x4*)((const char*)ga + ob), bw = *(const u32x4*)((const char*)gb + ob);
                    const float a_[8] = {bf_lo(aw.x), bf_hi(aw.x), bf_lo(aw.y), bf_hi(aw.y), bf_lo(aw.z), bf_hi(aw.z), bf_lo(aw.w), bf_hi(aw.w)};
                    const float b_[8] = {bf_lo(bw.x), bf_hi(bw.x), bf_lo(bw.y), bf_hi(bw.y), bf_lo(bw.z), bf_hi(bw.z), bf_lo(bw.w), bf_hi(bw.w)};
#pragma unroll
                    for (int i = 0; i < 4; ++i) { acc[ai][bj][m][0][i] *= a_[i] * fast_rcp(__builtin_fmaxf(b_[i], 6.103515625e-5f)); acc[ai][bj][m][1][i] *= a_[4 + i] * fast_rcp(__builtin_fmaxf(b_[4 + i], 6.103515625e-5f)); } }
                asm volatile("" ::: "memory"); }
    }
    __device__ __forceinline__ void operator()(const f32x4 (&acc)[2][2][4][2], const Unit& u, int wr, int wc, int fr, int fq) const {
        unsigned o0 = ((unsigned)(u.pm * 256 + wr * 64 + fr) * D_MODEL + (unsigned)(u.pn * 256 + wc * 32 + 8 * fq)) * 2u;
        asm volatile("" : "+v"(o0));
#pragma unroll
        for (int ai = 0; ai < 2; ++ai)
#pragma unroll
            for (int m = 0; m < 4; ++m) {
#pragma unroll
                for (int bj = 0; bj < 2; ++bj) { const unsigned ob = o0 + (unsigned)((ai * 128 + m * 16) * D_MODEL + bj * 128) * 2u;
                    const f32x4 a0 = acc[ai][bj][m][0], a1 = acc[ai][bj][m][1];
                    const u32x4 bw = *(const u32x4*)((const char*)gb + ob);
                    const float b_[8] = {bf_lo(bw.x), bf_hi(bw.x), bf_lo(bw.y), bf_hi(bw.y), bf_lo(bw.z), bf_hi(bw.z), bf_lo(bw.w), bf_hi(bw.w)};
                    float v[8];
#pragma unroll
                    for (int i = 0; i < 4; ++i) { v[i] = a0[i] * __builtin_fmaxf(b_[i], 6.103515625e-5f); v[4 + i] = a1[i] * __builtin_fmaxf(b_[4 + i], 6.103515625e-5f); }
                    u32x4 w; w.x = cvt_pk_bf16(v[0], v[1]); w.y = cvt_pk_bf16(v[2], v[3]); w.z = cvt_pk_bf16(v[4], v[5]); w.w = cvt_pk_bf16(v[6], v[7]);
                    *(u32x4*)((char*)merged + ob) = w; }
                asm volatile("" ::: "memory"); }
    }
};
struct EpiOut {
    static constexpr bool PERM = true;
    const float* xin; const bf16_t* xb; bf16_t* pre;
    __device__ __forceinline__ void operator()(const f32x4 (&acc)[2][2][4][2], const Unit& u, int wr, int wc, int fr, int fq) const {
        const int row0 = u.pm * 256 + wr * 64 + fr, col0 = u.pn * 256 + wc * 32 + 8 * fq;
#pragma unroll
        for (int ai = 0; ai < 2; ++ai)
#pragma unroll
            for (int m = 0; m < 4; ++m) { const size_t ro = (size_t)(row0 + ai * 128 + m * 16) * D_MODEL + col0;
#pragma unroll
                for (int bj = 0; bj < 2; ++bj) { f32x4 x0, x1;
                    if (xin) { x0 = *(const f32x4*)(xin + ro + bj * 128); x1 = *(const f32x4*)(xin + ro + bj * 128 + 4); }
                    else { const u32x4 xw = *(const u32x4*)(xb + ro + bj * 128); x0 = (f32x4){bf_lo(xw.x), bf_hi(xw.x), bf_lo(xw.y), bf_hi(xw.y)}; x1 = (f32x4){bf_lo(xw.z), bf_hi(xw.z), bf_lo(xw.w), bf_hi(xw.w)}; }
                    const f32x4 v0 = x0 * ALPHA + acc[ai][bj][m][0], v1 = x1 * ALPHA + acc[ai][bj][m][1];
                    u32x4 w; w.x = cvt_pk_bf16(v0[0], v0[1]); w.y = cvt_pk_bf16(v0[2], v0[3]); w.z = cvt_pk_bf16(v1[0], v1[1]); w.w = cvt_pk_bf16(v1[2], v1[3]);
                    *(u32x4*)(pre + ro + bj * 128) = w; } }
    }
};
struct EpiGU {
    static constexpr bool PERM = true;
    bf16_t* h;
    __device__ __forceinline__ void operator()(const f32x4 (&acc)[2][2][4][2], const Unit& u, int wr, int wc, int fr, int fq) const {
        const int row0 = u.x2 + wr * 64 + fr, col0 = u.pn * 128 + wc * 32 + 8 * fq;
#pragma unroll
        for (int ai = 0; ai < 2; ++ai)
#pragma unroll
            for (int m = 0; m < 4; ++m) { bf16_t* rowp = h + (size_t)(row0 + ai * 128 + m * 16) * FE + col0; float v[8];
#pragma unroll
                for (int n = 0; n < 2; ++n)
#pragma unroll
                    for (int i = 0; i < 4; ++i) { const float g = acc[ai][0][m][n][i], uu = acc[ai][1][m][n][i]; v[n * 4 + i] = g * sigmoidf_(g) * uu; }
                u32x4 w; w.x = cvt_pk_bf16(v[0], v[1]); w.y = cvt_pk_bf16(v[2], v[3]); w.z = cvt_pk_bf16(v[4], v[5]); w.w = cvt_pk_bf16(v[6], v[7]);
                *(u32x4*)rowp = w; }
    }
};
struct EpiDown {
    static constexpr bool PERM = true;
    bf16_t* y; const int* list;
    __device__ __forceinline__ void operator()(const f32x4 (&acc)[2][2][4][2], const Unit& u, int wr, int wc, int fr, int fq) const {
        const int nv = u.x1, loff = u.x0;
        const int* lp = list + (size_t)u.pm * T + loff;
        const int col0 = u.pn * 256 + wc * 32 + 8 * fq;
#pragma unroll
        for (int ai = 0; ai < 2; ++ai)
#pragma unroll
            for (int m = 0; m < 4; ++m) { const int lr = ai * 128 + wr * 64 + m * 16 + fr;
                if (lr < nv) { const int entry = lp[lr]; bf16_t* rowp = y + (size_t)entry * D_MODEL + col0;
#pragma unroll
                    for (int bj = 0; bj < 2; ++bj) { const f32x4 v0 = acc[ai][bj][m][0], v1 = acc[ai][bj][m][1];
                        u32x4 w; w.x = cvt_pk_bf16(v0[0], v0[1]); w.y = cvt_pk_bf16(v0[2], v0[3]); w.z = cvt_pk_bf16(v1[0], v1[1]); w.w = cvt_pk_bf16(v1[2], v1[3]);
                        *(u32x4*)(rowp + bj * 128) = w; } } }
    }
};

namespace att {
constexpr int DM = WA, DMQ = D_MODEL;
constexpr int SLOTB = 8192, NSLOT = 8, PFD = 3;
constexpr int LDS_K = 0, LDS_V = NSLOT * SLOTB, LDS_WS = LDSCTL_OFF + 4096, LDS_TAB = LDS_WS + 8 * 256, LDS_FLG = LDS_TAB + 1024, LDS_END = LDS_FLG + 64, LDS_OST = 0;
static_assert(2 * NSLOT * SLOTB <= RING_BYTES && LDS_END <= LDS_BYTES, "attention LDS map");
#define SBAR() __builtin_amdgcn_sched_barrier(0)
#define WAIT_BAR0() asm volatile("s_waitcnt vmcnt(0) lgkmcnt(0)\n\ts_barrier" ::: "memory")
#define WAIT_BARN(N) asm volatile("s_waitcnt vmcnt(" #N ") lgkmcnt(0)\n\ts_barrier" ::: "memory")
#define STEP_WAIT(tcur, tlow) do { if ((tcur) - 2 >= (tlow)) { WAIT_BARN(4); } else if ((tcur) - 1 >= (tlow)) { WAIT_BARN(2); } else { WAIT_BAR0(); } } while (0)
__device__ __forceinline__ int crow(int r, int hi) { return (r & 3) + 8 * (r >> 2) + 4 * hi; }
__device__ __forceinline__ void glds16(const void* gsrc, unsigned lds_dst) { unsigned keep;
    asm volatile("s_mov_b32 %0, m0\n\ts_mov_b32 m0, %2\n\ts_nop 0\n\tglobal_load_lds_dwordx4 %1, off\n\ts_mov_b32 m0, %0" : "=&s"(keep) : "v"(gsrc), "s"(lds_dst) : "memory"); }
__device__ __forceinline__ float max3f(float a, float b, float c) { return __builtin_fmaxf(__builtin_fmaxf(a, b), c); }
__device__ __forceinline__ void qkt(f32x16& p0, f32x16& p1, const LAS char* Kslot, const bf16x8* qr, const f32x16& cin, int r32, int hi) {
    const LAS char* kb = Kslot + hi * 1024 + r32 * 16;
#pragma unroll
    for (int d0 = 0; d0 < 4; ++d0) {
        const bf16x8 b0 = *(const LAS bf16x8*)(kb + d0 * 2048);
        const bf16x8 b1 = *(const LAS bf16x8*)(kb + d0 * 2048 + 512);
        if (d0 == 0) { p0 = MFMA32(b0, qr[0], cin); p1 = MFMA32(b1, qr[0], cin); }
        else { p0 = MFMA32(b0, qr[d0], p0); p1 = MFMA32(b1, qr[d0], p1); } }
}
__device__ __forceinline__ float rowmax(const f32x16& p0, const f32x16& p1) {
    float a = max3f(p0[0], p0[1], p1[0]), b = max3f(p0[2], p0[3], p1[1]); a = max3f(a, p1[2], p1[3]);
#pragma unroll
    for (int r = 4; r < 16; r += 4) { a = max3f(a, p0[r], p0[r + 1]); b = max3f(b, p0[r + 2], p0[r + 3]); a = max3f(a, p1[r], p1[r + 1]); b = max3f(b, p1[r + 2], p1[r + 3]); }
    const float m = __builtin_fmaxf(a, b);
    auto rr = __builtin_amdgcn_permlane32_swap(__float_as_uint(m), __float_as_uint(m), false, false);
    return __builtin_fmaxf(__uint_as_float(rr[0]), __uint_as_float(rr[1]));
}
__device__ __forceinline__ void pv(f32x16* o, int vb, bf16x8 pa0, bf16x8 pa1, bf16x8 pa2, bf16x8 pa3) {
#pragma unroll
    for (int d0 = 0; d0 < 2; ++d0) { s16x4 lo[4], hi[4];
#pragma unroll
        for (int ks = 0; ks < 4; ++ks) {
            asm volatile("ds_read_b64_tr_b16 %0,%1 offset:%c2" : "=&v"(lo[ks]) : "v"(vb), "i"(d0 * 4096 + ks * 1024) : "memory");
            asm volatile("ds_read_b64_tr_b16 %0,%1 offset:%c2" : "=&v"(hi[ks]) : "v"(vb), "i"(d0 * 4096 + ks * 1024 + 512) : "memory"); }
        asm volatile("s_waitcnt lgkmcnt(0)" ::: "memory"); SBAR();
#define PK(k) (bf16x8){lo[k][0], lo[k][1], lo[k][2], lo[k][3], hi[k][0], hi[k][1], hi[k][2], hi[k][3]}
        o[d0] = MFMA32(pa0, PK(0), o[d0]);
        o[d0] = MFMA32(pa1, PK(1), o[d0]);
        o[d0] = MFMA32(pa2, PK(2), o[d0]);
        o[d0] = MFMA32(pa3, PK(3), o[d0]);
#undef PK
    }
}
#define PKW(P, B) cvt_pk_bf16(P[B], P[B + 1])
__device__ __forceinline__ void store_o(const f32x16* o, const float* rs, bf16_t* Ow, LAS char* shm, int wid, int lane, int r32, int hi) {
    LAS bf16_t* stg = (LAS bf16_t*)(shm + LDS_OST) + wid * 2048;
#pragma unroll
    for (int r = 0; r < 16; ++r) { const int orow = crow(r, hi);
#pragma unroll
        for (int d0 = 0; d0 < 2; ++d0) stg[orow * 64 + d0 * 32 + r32] = (bf16_t)(cvt_pk_bf16(o[d0][r] * rs[r], 0.f) & 0xffffu); }
    LDS_WAIT();
#pragma unroll
    for (int i = 0; i < 4; ++i) { const int row = i * 8 + (lane >> 3), ch = lane & 7; const u32x4 v = *(const LAS u32x4*)(stg + row * 64 + ch * 8); *(u32x4*)(Ow + (size_t)row * DMQ + ch * 8) = v; }
}

#define DMA_K(t) glds16(ksrc + (long)(t) * 64 * DM, (unsigned)__builtin_amdgcn_readfirstlane(kdst + ((t) & (NSLOT - 1)) * SLOTB))
#define DMA_V(t) glds16(vsrc + (long)(t) * 64 * DM, (unsigned)__builtin_amdgcn_readfirstlane(vdst + ((t) & (NSLOT - 1)) * SLOTB))
__device__ __forceinline__ void attn_a_unit(int b, int h, int u, const bf16_t* Q, const bf16_t* K, const bf16_t* V, bf16_t* O, const float* bias_h, LAS char* shm) {
    int tid_ = threadIdx.x; asm volatile("" : "+v"(tid_)); const int tid = tid_, lane = tid & 63, r32 = lane & 31, hi = lane >> 5; const int wid = __builtin_amdgcn_readfirstlane(tid >> 6);
    const long rowbase = (long)b * SEQ; const int q0 = u * 256;
    const bf16_t* Qw = Q + (rowbase + q0 + wid * 32) * DMQ + h * HD;
    const bf16_t* Kh = K + rowbase * DM + h * HD; const bf16_t* Vh = V + rowbase * DM + h * HD;
    const unsigned lds0 = (unsigned)(size_t)shm;
    LAS float* wsf = (LAS float*)(shm + LDS_WS) + wid * 64;
    LAS float* tab = (LAS float*)(shm + LDS_TAB);
    if (tid < 256) { int rel = tid - 64; rel = rel < -128 ? -128 : (rel > 128 ? 128 : rel); tab[tid] = bias_h[rel + 128] * LOG2E; }
    const float bfar = bias_h[256] * LOG2E;
    const bf16_t* ksrc = Kh + (long)lane * DM + wid * 8;
    const bf16_t* vsrc = Vh + (long)(16 * (wid & 3) + (lane >> 2)) * DM + (wid >> 2) * 32 + (lane & 3) * 8;
    const unsigned kdst = lds0 + LDS_K + wid * 1024, vdst = lds0 + LDS_V + wid * 1024;
    const int vb0 = (int)(lds0 + LDS_V) + ((lane >> 4) & 1) * 32 + (lane & 3) * 8 + (4 * hi + ((lane & 15) >> 2)) * 64;
    const int tb = 4 * u, pr = wid >> 1;
    const int nsteps = (tb + 4) < 9 ? (tb + 4) : 9;
    const int tlow = (tb - 8) > 0 ? (tb - 8) : 0;
    bf16x8 qr[4];
#pragma unroll
    for (int d0 = 0; d0 < 4; ++d0) qr[d0] = *(const bf16x8*)(Qw + (long)r32 * DMQ + d0 * 16 + hi * 8);
#pragma unroll
    for (int i = 3; i >= 1 - PFD; --i) { if (tb + i >= tlow) { DMA_K(tb + i); DMA_V(tb + i); } }
    float mhat = 0.f, l_reg = 0.f; f32x16 o[2]; o[0] = f32x16{}; o[1] = f32x16{};
    for (int s = 0; s < nsteps; ++s) {
        STEP_WAIT(tb - s, tlow);
        { const int tn = tb - s - PFD; if (tn >= tlow) { DMA_K(tn); DMA_V(tn); } }
        const int j = tb + pr - s;
        if (j >= 0) {
            const int sl = (j & (NSLOT - 1)) * SLOTB;
            const bool far = (s >= 3), first = (s == 0);
            f32x16 cin; const float c0 = (far ? bfar : 0.f) - mhat;
#pragma unroll
            for (int r = 0; r < 16; ++r) cin[r] = c0;
            f32x16 p0, p1;
            qkt(p0, p1, shm + LDS_K + sl, qr, cin, r32, hi);
            if (!far) {
                const LAS float* tp = tab + (s * 64 + 32 * (wid & 1) + r32 + 64 - 4 * hi);
#pragma unroll
                for (int r = 0; r < 16; ++r) { const int kv = (r & 3) + 8 * (r >> 2); p0[r] += tp[-kv]; p1[r] += tp[-kv - 32]; }
            }
            const float rm = rowmax(p0, p1);
            bool upd; float dl;
            if (first) { upd = true; dl = rm; } else { upd = __any(rm > 8.f) != 0; dl = __builtin_fmaxf(rm, 0.f); }
            if (upd) {
                mhat += dl;
#pragma unroll
                for (int r = 0; r < 16; ++r) { p0[r] -= dl; p1[r] -= dl; }
                if (!first) { const float f = fast_exp2(-dl); l_reg *= f; if (hi == 0) wsf[r32] = f; LDS_WAIT();
#pragma unroll
                    for (int r = 0; r < 16; ++r) { const float fr_ = wsf[crow(r, hi)]; o[0][r] *= fr_; o[1][r] *= fr_; } }
            }
            float sacc = 0.f;
#pragma unroll
            for (int r = 0; r < 16; ++r) { p0[r] = fast_exp2(p0[r]); p1[r] = fast_exp2(p1[r]); sacc += p0[r] + p1[r]; }
            l_reg += sacc;
            u32x4 pw0 = (u32x4){PKW(p0, 0), PKW(p0, 2), PKW(p0, 4), PKW(p0, 6)}, pw1 = (u32x4){PKW(p0, 8), PKW(p0, 10), PKW(p0, 12), PKW(p0, 14)};
            u32x4 pw2 = (u32x4){PKW(p1, 0), PKW(p1, 2), PKW(p1, 4), PKW(p1, 6)}, pw3 = (u32x4){PKW(p1, 8), PKW(p1, 10), PKW(p1, 12), PKW(p1, 14)};
            pv(o, vb0 + sl, __builtin_bit_cast(bf16x8, pw0), __builtin_bit_cast(bf16x8, pw1), __builtin_bit_cast(bf16x8, pw2), __builtin_bit_cast(bf16x8, pw3));
        }
    }
    { auto rr = __builtin_amdgcn_permlane32_swap(__float_as_uint(l_reg), __float_as_uint(l_reg), false, false); l_reg = __uint_as_float(rr[0]) + __uint_as_float(rr[1]); }
    if (hi == 0) wsf[32 + r32] = l_reg; LDS_WAIT();
    float rli[16];
#pragma unroll
    for (int r = 0; r < 16; ++r) rli[r] = fast_rcp(wsf[32 + crow(r, hi)]);
    asm volatile("s_waitcnt lgkmcnt(0)\n\ts_barrier" ::: "memory");
    store_o(o, rli, O + (rowbase + q0 + wid * 32) * DMQ + h * HD, shm, wid, lane, r32, hi);
    asm volatile("s_waitcnt lgkmcnt(0)\n\ts_barrier" ::: "memory");
}

__device__ __forceinline__ void attn_b_unit(int b, int h, int qb, const bf16_t* Q, const bf16_t* K, const bf16_t* V, bf16_t* O, LAS char* shm) {
    int tid_ = threadIdx.x; asm volatile("" : "+v"(tid_)); const int tid = tid_, lane = tid & 63, r32 = lane & 31, hi = lane >> 5; const int wid = __builtin_amdgcn_readfirstlane(tid >> 6);
    const long rowbase = (long)b * SEQ; const int q0 = qb * 256;
    const bf16_t* Qw = Q + (rowbase + q0 + wid * 32) * DMQ + h * HD;
    const bf16_t* Kh = K + rowbase * DM + h * HD; const bf16_t* Vh = V + rowbase * DM + h * HD;
    const unsigned lds0 = (unsigned)(size_t)shm;
    LAS unsigned* flg = (LAS unsigned*)(shm + LDS_FLG);
    const bf16_t* ksrc = Kh + (long)lane * DM + wid * 8;
    const bf16_t* vsrc = Vh + (long)(16 * (wid & 3) + (lane >> 2)) * DM + (wid >> 2) * 32 + (lane & 3) * 8;
    const unsigned kdst = lds0 + LDS_K + wid * 1024, vdst = lds0 + LDS_V + wid * 1024;
    const int vb0 = (int)(lds0 + LDS_V) + ((lane >> 4) & 1) * 32 + (lane & 3) * 8 + (4 * hi + ((lane & 15) >> 2)) * 64;
    const int tb = 4 * qb, pr = wid >> 1;
    const int tq = 32 * (wid & 1) + r32;
    bf16x8 qr[4];
#pragma unroll
    for (int d0 = 0; d0 < 4; ++d0) qr[d0] = *(const bf16x8*)(Qw + (long)r32 * DMQ + d0 * 16 + hi * 8);
#pragma unroll
    for (int i = 3; i >= 1 - PFD; --i) { if (tb + i >= 0) { DMA_K(tb + i); DMA_V(tb + i); } }
    float R = 1.0f; bool wdone = false; f32x16 o[2]; o[0] = f32x16{}; o[1] = f32x16{};
    for (int s = 0; ; ++s) {
        STEP_WAIT(tb - s, 0);
        if (s > 0) { const LAS unsigned* f = flg + ((s - 1) & 1) * 8; unsigned all = 1u;
#pragma unroll
            for (int w = 0; w < 8; ++w) all &= f[w];
            if (__builtin_amdgcn_readfirstlane(all) != 0u) break; }
        { const int tn = tb - s - PFD; if (tn >= 0) { DMA_K(tn); DMA_V(tn); } }
        const int j = tb + pr - s;
        if (j >= 0 && !wdone) {
            const int sl = (j & (NSLOT - 1)) * SLOTB;
            f32x16 cin = f32x16{}; f32x16 p0, p1;
            qkt(p0, p1, shm + LDS_K + sl, qr, cin, r32, hi);
#pragma unroll
            for (int r = 0; r < 16; ++r) { p0[r] = fast_rcp(1.0f + fast_exp2(p0[r])); p1[r] = fast_rcp(1.0f + fast_exp2(p1[r])); }
            if (s == 0) {
#pragma unroll
                for (int r = 0; r < 16; ++r) { const int kv = crow(r, hi); if (kv >= tq) p0[r] = 1.0f; if (kv + 32 >= tq) p1[r] = 1.0f; } }
            float W[8], part[8];
#pragma unroll
            for (int i = 0; i < 8; ++i) { const float pb = (i < 4) ? (p0[4 * i] * p0[4 * i + 1]) * (p0[4 * i + 2] * p0[4 * i + 3]) : (p1[4 * i - 16] * p1[4 * i - 15]) * (p1[4 * i - 14] * p1[4 * i - 13]);
                auto rr = __builtin_amdgcn_permlane32_swap(__float_as_uint(pb), __float_as_uint(pb), false, false);
                const float vlo = __uint_as_float(rr[0]), vhi = __uint_as_float(rr[1]);
                W[i] = vlo * vhi; part[i] = hi ? 1.0f : vhi; }
            float sw = R;
#pragma unroll
            for (int i = 7; i >= 0; --i) { float c = sw * part[i];
                if (i < 4) {
#pragma unroll
                    for (int rr_ = 3; rr_ >= 0; --rr_) { const float t_ = c * p0[4 * i + rr_]; p0[4 * i + rr_] = c - t_; c = t_; } }
                else {
#pragma unroll
                    for (int rr_ = 3; rr_ >= 0; --rr_) { const float t_ = c * p1[4 * i - 16 + rr_]; p1[4 * i - 16 + rr_] = c - t_; c = t_; } }
                sw *= W[i]; }
            R = sw;
            u32x4 pw0 = (u32x4){PKW(p0, 0), PKW(p0, 2), PKW(p0, 4), PKW(p0, 6)}, pw1 = (u32x4){PKW(p0, 8), PKW(p0, 10), PKW(p0, 12), PKW(p0, 14)};
            u32x4 pw2 = (u32x4){PKW(p1, 0), PKW(p1, 2), PKW(p1, 4), PKW(p1, 6)}, pw3 = (u32x4){PKW(p1, 8), PKW(p1, 10), PKW(p1, 12), PKW(p1, 14)};
            pv(o, vb0 + sl, __builtin_bit_cast(bf16x8, pw0), __builtin_bit_cast(bf16x8, pw1), __builtin_bit_cast(bf16x8, pw2), __builtin_bit_cast(bf16x8, pw3));
            wdone = __all(R == 0.0f) != 0;
        }
        if (j <= 0) wdone = true;
        if (lane == 0) flg[(s & 1) * 8 + wid] = wdone ? 1u : 0u;
    }
    float ones[16];
#pragma unroll
    for (int r = 0; r < 16; ++r) ones[r] = 1.0f;
    asm volatile("s_waitcnt vmcnt(0) lgkmcnt(0)\n\ts_barrier" ::: "memory");
    store_o(o, ones, O + (rowbase + q0 + wid * 32) * DMQ + h * HD, shm, wid, lane, r32, hi);
    asm volatile("s_waitcnt lgkmcnt(0)\n\ts_barrier" ::: "memory");
}
#undef DMA_K
#undef DMA_V
#undef PKW
#undef SBAR
#undef WAIT_BAR0
}

#define XB_TMO      128
#define XB_XCNT(j)  (256  + 64 * (j))
#define XB_XSUB(j)  (1280 + 64 * (j))
#define XB_XGEN(j)  (2304 + 64 * (j))
#define XB_TOP      3328
#define XB_TOPGEN   3392
#define XCD_BAR_WORDS 3456
#define XB_SPIN_CAP (1u << 22)
__device__ __forceinline__ unsigned xb_ld(unsigned* p)              { return __hip_atomic_load(p, __ATOMIC_RELAXED, __HIP_MEMORY_SCOPE_AGENT); }
__device__ __forceinline__ unsigned xb_add(unsigned* p, unsigned v) { return __hip_atomic_fetch_add(p, v, __ATOMIC_RELAXED, __HIP_MEMORY_SCOPE_AGENT); }
__device__ __forceinline__ unsigned xb_xcc_id() { return (unsigned)__builtin_amdgcn_s_getreg((3 << 11) | 20) & 0xFu; }
#define XB_SPIN(cond, bar) do { unsigned _sp = 0; while (cond) { __builtin_amdgcn_s_sleep(1); \
    if ((++_sp & 255u) == 0u) { if (xb_ld(&(bar)[XB_TMO])) break; if (_sp > XB_SPIN_CAP) { atomicAdd(&(bar)[XB_TMO], 1u); break; } } } } while (0)
struct XcdBarrier { unsigned* bar; unsigned x; volatile LAS unsigned* st; };
__device__ __forceinline__ XcdBarrier xcd_barrier_post(unsigned* bar, volatile LAS unsigned* st) {
    XcdBarrier b; b.bar = bar; b.x = xb_xcc_id(); b.st = st;
    if (threadIdx.x == 0) (void)xb_add(&bar[XB_XCNT(b.x)], 1u);
    return b;
}
__device__ __forceinline__ void xcd_barrier_complete(unsigned* bar, unsigned x, unsigned& nloc, unsigned& nx) {
    const unsigned G = gridDim.x * gridDim.y * gridDim.z;
    unsigned sum, cnt, mine, sp = 0u;
    for (;;) {
        sum = 0u; cnt = 0u; mine = 0u;
#pragma unroll
        for (unsigned j = 0; j < 16; ++j) { const unsigned c = xb_ld(&bar[XB_XCNT(j)]); sum += c; cnt += (c > 0u) ? 1u : 0u; mine = (j == x) ? c : mine; }
        if (sum == G) break;
        __builtin_amdgcn_s_sleep(1);
        if ((++sp & 255u) == 0u) { if (xb_ld(&bar[XB_TMO])) break; if (sp > XB_SPIN_CAP) { atomicAdd(&bar[XB_TMO], 1u); break; } }
    }
    nloc = mine > 0u ? mine : 1u; nx = cnt > 0u ? cnt : 1u;
}
__device__ __forceinline__ void xcd_barrier(const XcdBarrier& b) {
    asm volatile("s_waitcnt vmcnt(0)" ::: "memory");
    __syncthreads();
    if (threadIdx.x == 0) {
        unsigned* bar = b.bar;
        __builtin_amdgcn_s_waitcnt(0);
        unsigned nloc = b.st[0], nx = b.st[1];
        if (nloc == 0u) { xcd_barrier_complete(bar, b.x, nloc, nx); b.st[0] = nloc; b.st[1] = nx; }
        const unsigned old = xb_add(&bar[XB_XSUB(b.x)], 1u);
        const unsigned gen = old / nloc;
        if (old + 1u == (gen + 1u) * nloc) {
            __builtin_amdgcn_fence(__ATOMIC_RELEASE, "agent");
            asm volatile("s_waitcnt vmcnt(0)" ::: "memory");
            const unsigned og = xb_add(&bar[XB_TOP], 1u);
            const unsigned tg = og / nx;
            if (og + 1u == (tg + 1u) * nx) xb_add(&bar[XB_TOPGEN], 1u);
            else XB_SPIN(xb_ld(&bar[XB_TOPGEN]) == tg, bar);
            __builtin_amdgcn_fence(__ATOMIC_ACQUIRE, "agent");
            xb_add(&bar[XB_XGEN(b.x)], 1u);
            asm volatile("s_waitcnt vmcnt(0)" ::: "memory");
        } else {
            XB_SPIN(xb_ld(&bar[XB_XGEN(b.x)]) == gen, bar);
            __builtin_amdgcn_fence(__ATOMIC_ACQUIRE, "agent");
            asm volatile("s_waitcnt vmcnt(0)" ::: "memory");
        }
    }
    __syncthreads();
}

__device__ __forceinline__ unsigned f2bf(float f) { unsigned u = __builtin_bit_cast(unsigned, f); return (u + 0x7fffu + ((u >> 16) & 1u)) >> 16; }
__device__ __forceinline__ unsigned pk2(float lo, float hi) { return cvt_pk_bf16(lo, hi); }
__device__ __forceinline__ void transpose_item(const float* W, int K, int N, bf16_t* WT, int row_off, LAS float* scr, int item, int lane, int ldw = 0, int koff = 0) {
    if (ldw == 0) ldw = K;
    const int nblk = N / 32, kb = item / nblk, nb = item % nblk, k0 = 64 * kb, n0 = 32 * nb;
    f32x4 ld[8];
#pragma unroll
    for (int i = 0; i < 8; ++i) ld[i] = *(const f32x4*)(W + (size_t)(k0 + 8 * i + (lane >> 3)) * N + n0 + 4 * (lane & 7));
#pragma unroll
    for (int i = 0; i < 8; ++i) { LAS float* d = scr + (8 * i + (lane >> 3)) * 33 + 4 * (lane & 7); d[0] = ld[i].x; d[1] = ld[i].y; d[2] = ld[i].z; d[3] = ld[i].w; }
    LDS_WAIT(); asm volatile("" ::: "memory");
    const int c = lane & 7;
#pragma unroll
    for (int j = 0; j < 4; ++j) { const int n = (lane >> 3) + 8 * j; const LAS float* s = scr + (8 * c) * 33 + n;
        u32x4 o; o.x = pk2(s[0 * 33], s[1 * 33]); o.y = pk2(s[2 * 33], s[3 * 33]); o.z = pk2(s[4 * 33], s[5 * 33]); o.w = pk2(s[6 * 33], s[7 * 33]);
        *(u32x4*)(WT + (size_t)(row_off + n0 + n) * ldw + koff + k0 + 8 * c) = o; }
    LDS_WAIT(); asm volatile("" ::: "memory");
}

struct Args { const float* in[15]; float* out; unsigned char* ws; int ph_lo, ph_hi, li, pad; };
typedef const __attribute__((address_space(4))) char* kptr_t;
__device__ __forceinline__ kptr_t kbase() { kptr_t kp = (kptr_t)__builtin_amdgcn_kernarg_segment_ptr(); asm volatile("" : "+s"(kp)); return kp; }
__device__ __forceinline__ const float* arg_in(int i) { return *(const float* const __attribute__((address_space(4)))*)(kbase() + 8 * i); }
__device__ __forceinline__ float* arg_out() { return *(float* const __attribute__((address_space(4)))*)(kbase() + 120); }
__device__ __forceinline__ unsigned char* arg_ws() { return *(unsigned char* const __attribute__((address_space(4)))*)(kbase() + 128); }
__device__ __forceinline__ int arg_lo() { return *(const __attribute__((address_space(4))) int*)(kbase() + 136); }
__device__ __forceinline__ int arg_hi() { return *(const __attribute__((address_space(4))) int*)(kbase() + 140); }
__device__ __forceinline__ int arg_li() { return *(const __attribute__((address_space(4))) int*)(kbase() + 144); }
static_assert(sizeof(Args) == 152, "Args layout");

constexpr int NWAVES = 8;
constexpr int PH_PER_LAYER = 8, N_PHASES = 1 + DEPTH * PH_PER_LAYER;
#define PH_COMMON() int tid_ = threadIdx.x; asm volatile("" : "+v"(tid_)); const int tid = tid_, lane = tid & 63, wave = __builtin_amdgcn_readfirstlane(tid >> 6); const int G = gridDim.x, bx = blockIdx.x; \
    const int vcu = (G % 8 == 0) ? (bx % 8) * (G / 8) + bx / 8 : bx; const int gw = vcu * NWAVES + wave, NGW = G * NWAVES; unsigned char* ws = arg_ws(); \
    (void)tid; (void)lane; (void)wave; (void)vcu; (void)gw; (void)NGW; (void)ws

__device__ __forceinline__ void convert_weights(int l, LAS unsigned char* lds) {
    PH_COMMON();
    LAS float* scr = (LAS float*)(lds + wave * 16384);
    const float* w_in = arg_in(1) + (size_t)l * D_MODEL * PROJ;
    const float* w_upa = arg_in(3) + (size_t)l * WA * D_MODEL;
    const float* w_upb = arg_in(4) + (size_t)l * WA * D_MODEL;
    const float* w_out = arg_in(5) + (size_t)l * D_MODEL * D_MODEL;
    const float* w_gate = arg_in(10) + (size_t)l * NE * D_MODEL * FE;
    const float* w_up = arg_in(11) + (size_t)l * NE * D_MODEL * FE;
    const float* w_down = arg_in(12) + (size_t)l * NE * FE * D_MODEL;
    constexpr int I_IN = (D_MODEL / 64) * (PROJ / 32), I_UP = (WA / 64) * (D_MODEL / 32), I_OUT = (D_MODEL / 64) * (D_MODEL / 32);
    constexpr int I_G = (D_MODEL / 64) * (FE / 32), I_D = (FE / 64) * (D_MODEL / 32);
    constexpr int NITEMS = I_IN + 2 * I_UP + I_OUT + NE * (2 * I_G + I_D);
    for (int it = gw; it < NITEMS; it += NGW) {
        int r = it;
        if (r < I_IN) { transpose_item(w_in, D_MODEL, PROJ, (bf16_t*)(ws + WS_WIN), 0, scr, r, lane); continue; } r -= I_IN;
        if (r < I_UP) { transpose_item(w_upa, WA, D_MODEL, (bf16_t*)(ws + WS_WUP), 0, scr, r, lane, D_MODEL, 0); continue; } r -= I_UP;
        if (r < I_UP) { transpose_item(w_upb, WA, D_MODEL, (bf16_t*)(ws + WS_WUP), 0, scr, r, lane, D_MODEL, WA); continue; } r -= I_UP;
        if (r < I_OUT) { transpose_item(w_out, D_MODEL, D_MODEL, (bf16_t*)(ws + WS_WOUT), 0, scr, r, lane); continue; } r -= I_OUT;
        const int e = r / (2 * I_G + I_D); r -= e * (2 * I_G + I_D);
        if (r < 2 * I_G) { const int up = r >= I_G; if (up) r -= I_G;
            const int nb = r % (FE / 32), n0 = nb * 32;
            const int row_off = e * 1024 + (n0 / 128) * 128 + (up ? 128 : 0);
            transpose_item((up ? w_up : w_gate) + (size_t)e * D_MODEL * FE, D_MODEL, FE, (bf16_t*)(ws + WS_WGU), row_off, scr, r, lane); continue; }
        r -= 2 * I_G;
        transpose_item(w_down + (size_t)e * FE * D_MODEL, FE, D_MODEL, (bf16_t*)(ws + WS_WD), e * 1024, scr, r, lane);
    }
}

__device__ __forceinline__ void phase0(LAS unsigned char* lds) {
    convert_weights(0, lds);
    PH_COMMON();
    const float* x_in = arg_in(0); bf16_t* XB = (bf16_t*)(ws + WS_XB);
    {
        const float* w_router = arg_in(8); const float* b_router = arg_in(9);
        for (int p = gw * 64 + lane; p < DEPTH * 2048; p += NGW * 64) { const int ll = p >> 11, q = p & 2047, kt = q >> 6, ln = q & 63, n = ln & 15, c0 = 32 * kt + 8 * (ln >> 4);
            const float* g1 = arg_in(6) + (size_t)ll * D_MODEL; unsigned hw[4], lw[4];
#pragma unroll
            for (int j = 0; j < 4; ++j) { const float w0 = g1[c0 + 2 * j] * w_router[(c0 + 2 * j) * 16 + n], w1 = g1[c0 + 2 * j + 1] * w_router[(c0 + 2 * j + 1) * 16 + n];
                hw[j] = cvt_pk_bf16(w0, w1); lw[j] = cvt_pk_bf16(w0 - bf_lo(hw[j]), w1 - bf_hi(hw[j])); }
            unsigned char* tb = ws + WS_RTAB + (size_t)ll * RTAB_STRIDE;
            *(u32x4*)(tb + q * 16) = (u32x4){hw[0], hw[1], hw[2], hw[3]}; *(u32x4*)(tb + 32768 + q * 16) = (u32x4){lw[0], lw[1], lw[2], lw[3]}; }
        for (int idx = gw; idx < DEPTH * 32; idx += NGW) { const int ll = idx >> 5, wh = (idx >> 4) & 1, e = idx & 15;
            const float* vv = (wh ? arg_in(7) : arg_in(6)) + (size_t)ll * D_MODEL; float s = 0.f;
            for (int c = lane; c < D_MODEL; c += 64) s += vv[c] * w_router[c * 16 + e];
            s = wave_sum(s); if (wh) s += b_router[e];
            if (lane == 0) ((float*)(ws + WS_RTAB + (size_t)ll * RTAB_STRIDE + 65536))[wh * 16 + e] = s; }
    }
    for (int m = gw; m < T; m += NGW) { const f32x4* xr = (const f32x4*)(x_in + (size_t)m * D_MODEL) + lane; u32x2* o8 = (u32x2*)(XB + (size_t)m * D_MODEL) + lane;
#pragma unroll
        for (int j = 0; j < 4; ++j) { const f32x4 v = xr[64 * j]; u32x2 w; w.x = cvt_pk_bf16(v.x, v.y); w.y = cvt_pk_bf16(v.z, v.w); o8[64 * j] = w; } }
}
__device__ __forceinline__ void phase1(LAS unsigned char* lds) {
    PH_COMMON();
    pg8::SchedPlain S; S.o.init(T / 256, PROJ / 256, G, bx); S.A = (const char*)(ws + WS_XB); S.B = (const char*)(ws + WS_WIN); S.tstep = (size_t)256 * D_MODEL * 2;
    EpiInProj E{ws};
    pg8::gemm_phase<EpiInProj, pg8::SchedPlain, false, true>(lds, D_MODEL, S, E);
}
__device__ __forceinline__ void phase2(LAS unsigned char* lds, int l) {
    PH_COMMON();
    const int bh = vcu >> 2, s = vcu & 3; const int b = bh >> 3, h = bh & 7;
    if (G != 256) return;
    const float* bias_h = arg_in(2) + ((size_t)l * NH + h) * N_REL;
    bf16_t* QAp = (bf16_t*)(ws + WS_QQ); bf16_t* KAp = (bf16_t*)(ws + WS_KA); bf16_t* VAp = (bf16_t*)(ws + WS_VA);
    bf16_t* QBp = (bf16_t*)(ws + WS_QQ) + WA; bf16_t* KBp = (bf16_t*)(ws + WS_KB); bf16_t* VBp = (bf16_t*)(ws + WS_VB);
    PBS_BEGIN(6, lds);
    for (int i = 0; i < 4; ++i) { const int u = (i == 0) ? s : (i == 1) ? 7 - s : (i == 2) ? 8 + s : 15 - s; att::attn_a_unit(b, h, u, QAp, KAp, VAp, QAp, bias_h, (LAS char*)lds); }
    PBS_END(6, lds); PBS_BEGIN(7, lds);
    for (int i = 0; i < 4; ++i) { const int u = (i == 0) ? s : (i == 1) ? 7 - s : (i == 2) ? 8 + s : 15 - s; att::attn_b_unit(b, h, u, QBp, KBp, VBp, QBp, (LAS char*)lds); }
    PBS_END(7, lds);
}
__device__ __forceinline__ void phase3(LAS unsigned char* lds) {
    PH_COMMON();
    pg8::SchedTwo S; S.o.init(T / 256, D_MODEL / 256, G, bx); S.A = (const char*)(ws + WS_QQ); S.B = (const char*)(ws + WS_WUP); S.tstep = (size_t)256 * D_MODEL * 2;
    EpiMerge E{(const bf16_t*)(ws + WS_GA), (const bf16_t*)(ws + WS_GB), (bf16_t*)(ws + WS_MERGED)};
    pg8::gemm_phase<EpiMerge, pg8::SchedTwo, false, true, true>(lds, WA, S, E, D_MODEL);
}
__device__ __forceinline__ void phase4(LAS unsigned char* lds, int l) {
    PH_COMMON();
    pg8::SchedPlain S; S.o.init(T / 256, D_MODEL / 256, G, bx); S.A = (const char*)(ws + WS_MERGED); S.B = (const char*)(ws + WS_WOUT); S.tstep = (size_t)256 * D_MODEL * 2;
    EpiOut E{(l == 0) ? arg_in(0) : (const float*)nullptr, (const bf16_t*)(ws + WS_XB), (bf16_t*)(ws + WS_PRE)};
    pg8::gemm_phase<EpiOut, pg8::SchedPlain, false, true>(lds, D_MODEL, S, E);
}
#define dppf(v, ctrl) __builtin_bit_cast(float, __builtin_amdgcn_update_dpp(__builtin_bit_cast(int, (float)(v)), __builtin_bit_cast(int, (float)(v)), ctrl, 0xf, 0xf, false))
#define dppi(v, ctrl) __builtin_amdgcn_update_dpp((int)(v), (int)(v), ctrl, 0xf, 0xf, false)
__device__ __forceinline__ void phase5(LAS unsigned char* lds, int l) {
    static_assert(USE_F16 == 1, "the MFMA router path takes the pre-LN tensor as IEEE half");
    PH_COMMON();
    const float* g1 = arg_in(6) + (size_t)l * D_MODEL; const float* b1 = arg_in(7) + (size_t)l * D_MODEL;
    bf16_t* XB = (bf16_t*)(ws + WS_XB); const bf16_t* PRE = (const bf16_t*)(ws + WS_PRE);
    int* LIST = (int*)(ws + WS_LIST); f32x2* RECW = (f32x2*)(ws + WS_RECW);
    unsigned* gcnt = (unsigned*)(ws + WS_CTL) + CW_CNT + 64 * l;
    PBS_BEGIN(1, lds);
    LAS float* S23 = (LAS float*)(lds + 69632); LAS f32x2* rstat = (LAS f32x2*)(lds + 70656) + wave * 16;
    LAS unsigned* lcnt = (LAS unsigned*)(lds + 81920);
    LAS int* lrec = (LAS int*)(lds + 81920 + 256);
    { const unsigned char* tb = ws + WS_RTAB + (size_t)l * RTAB_STRIDE;
        for (int i = tid; i < 4096; i += NWAVES * 64) ((LAS u32x4*)lds)[i] = ((const u32x4*)tb)[i];
        if (tid < 32) { S23[tid] = ((const float*)(tb + 65536))[tid]; lcnt[tid] = 0u; } }
    __syncthreads();
    PBS_END(1, lds); PBS_BEGIN(2, lds);
    int krow = 0;
    u32x2 nv[4];
    { const u32x2* pr = (const u32x2*)(PRE + (size_t)gw * D_MODEL) + lane;
#pragma unroll
      for (int j = 0; j < 4; ++j) nv[j] = pr[64 * j]; }
    for (int m = gw; m < T; m += NGW, ++krow) {
        f32x4 v[4]; float s = 0.f;
#pragma unroll
        for (int j = 0; j < 4; ++j) { v[j] = (f32x4){bf_lo(nv[j].x), bf_hi(nv[j].x), bf_lo(nv[j].y), bf_hi(nv[j].y)}; s += (v[j].x + v[j].y) + (v[j].z + v[j].w); }
        if (m + NGW < T) { const u32x2* pr = (const u32x2*)(PRE + (size_t)(m + NGW) * D_MODEL) + lane;
#pragma unroll
            for (int j = 0; j < 4; ++j) nv[j] = pr[64 * j]; }
        const float mean = wave_sum(s) * (1.f / D_MODEL); float s2 = 0.f;
#pragma unroll
        for (int j = 0; j < 4; ++j) { v[j] = v[j] - mean; s2 += (v[j].x * v[j].x + v[j].y * v[j].y) + (v[j].z * v[j].z + v[j].w * v[j].w); }
        const float rstd = 1.f / sqrtf(wave_sum(s2) * (1.f / D_MODEL) + LN_EPS);
        if (lane == 0) rstat[krow] = (f32x2){mean, rstd};
#pragma unroll
        for (int j = 0; j < 4; ++j) { const f32x4 gg = *((const f32x4*)g1 + lane + 64 * j), bb = *((const f32x4*)b1 + lane + 64 * j);
            v[j] = v[j] * rstd * gg + bb;
            u32x2 w; w.x = cvt_pk_bf16(v[j].x, v[j].y); w.y = cvt_pk_bf16(v[j].z, v[j].w); *((u32x2*)(XB + (size_t)m * D_MODEL) + lane + 64 * j) = w; }
    }
    {
        const int n = lane & 15, kg = lane >> 4;
        const bf16_t* arow = PRE + (size_t)(gw + n * NGW) * D_MODEL + 8 * kg;
        f32x4 acc = (f32x4){0.f, 0.f, 0.f, 0.f};
#pragma unroll 4
        for (int kt = 0; kt < 32; ++kt) { const bf16x8 a = *(const bf16x8*)(arow + 32 * kt);
            const bf16x8 bh = *(const LAS bf16x8*)(lds + (kt * 64 + lane) * 16), bl = *(const LAS bf16x8*)(lds + 32768 + (kt * 64 + lane) * 16);
            acc = MFMA16(a, bh, acc); acc = MFMA16(a, bl, acc); }
        const float s2n = S23[n], s3n = S23[16 + n];
#pragma unroll
        for (int i = 0; i < 4; ++i) {
            const int kr = 4 * kg + i; const f32x2 st = rstat[kr];
            const float v = st.y * (acc[i] - st.x * s2n) + s3n;
            float mx = v; mx = fmaxf(mx, dppf(mx, 0xB1)); mx = fmaxf(mx, dppf(mx, 0x4E)); mx = fmaxf(mx, dppf(mx, 0x141)); mx = fmaxf(mx, dppf(mx, 0x140));
            int best = (v == mx) ? n : 16; best = min(best, dppi(best, 0xB1)); best = min(best, dppi(best, 0x4E)); best = min(best, dppi(best, 0x141)); best = min(best, dppi(best, 0x140));
            const float u = (n == best) ? -3.0e38f : v;
            float m2 = u; m2 = fmaxf(m2, dppf(m2, 0xB1)); m2 = fmaxf(m2, dppf(m2, 0x4E));
            int e2 = (u == m2) ? n : 16; e2 = min(e2, dppi(e2, 0xB1)); e2 = min(e2, dppi(e2, 0x4E));
            if (n == best) { const int m = gw + kr * NGW;
                const float w1 = fast_rcp(1.0f + fast_exp2((m2 - v) * LOG2E)), w2 = 1.0f - w1;
                RECW[m] = (f32x2){w1, w2};
                const int lp1 = (int)__hip_atomic_fetch_add(lcnt + best, 1u, __ATOMIC_RELAXED, __HIP_MEMORY_SCOPE_WORKGROUP);
                const int lp2 = (int)__hip_atomic_fetch_add(lcnt + e2, 1u, __ATOMIC_RELAXED, __HIP_MEMORY_SCOPE_WORKGROUP);
                LAS int* rp = lrec + (wave * 16 + kr) * 4; rp[0] = best; rp[1] = lp1; rp[2] = e2; rp[3] = lp2; }
        }
    }
    PBS_END(2, lds);
    __syncthreads();
    PBS_BEGIN(3, lds);
    if (tid < 16) { const unsigned n = lcnt[tid]; lcnt[16 + tid] = n ? __hip_atomic_fetch_add(gcnt + tid, n, __ATOMIC_RELAXED, __HIP_MEMORY_SCOPE_AGENT) : 0u; }
    __syncthreads();
    if (lane < 16 && gw + lane * NGW < T) { const int m = gw + lane * NGW; const LAS int* rp = lrec + (wave * 16 + lane) * 4;
        LIST[(size_t)rp[0] * T + lcnt[16 + rp[0]] + rp[1]] = m * 2; LIST[(size_t)rp[2] * T + lcnt[16 + rp[2]] + rp[3]] = m * 2 + 1; }
    __syncthreads();
    PBS_END(3, lds);
}
__device__ __forceinline__ int moe_units(LAS unsigned char* lds, int l) {
    PH_COMMON();
    LAS int* utab = (LAS int*)(lds + UTAB_OFF);
    unsigned* gcnt = (unsigned*)(ws + WS_CTL) + CW_CNT + 64 * l;
    __syncthreads();
    if (tid == 0) {
        LAS int* ts = utab + 128; LAS int* ncnt = utab + 160;
        int acc_t = 0;
        for (int e = 0; e < 16; ++e) { const int n = (int)__hip_atomic_load(gcnt + e, __ATOMIC_RELAXED, __HIP_MEMORY_SCOPE_AGENT); ncnt[e] = n; ts[e] = acc_t; acc_t += (n + 255) / 256; }
        ts[16] = acc_t;
        const int nunits = acc_t * 4; int cnt = 0;
        for (int i = 0; cnt < 16; ++i) { const long L = (long)i * G + bx; if (L >= nunits) break;
            int U = (int)L; { const int q = nunits / 8, r = nunits % 8, xcd = U % 8, off = U / 8; U = (xcd < r ? xcd * (q + 1) : r * (q + 1) + (xcd - r) * q) + off; }
            const int tile = U >> 2, pn = U & 3; int e = 0; while (ts[e + 1] <= tile) ++e;
            const int mt = tile - ts[e]; const int n = ncnt[e]; const int nv = (n - 256 * mt) < 256 ? (n - 256 * mt) : 256;
            utab[cnt * 5 + 0] = e; utab[cnt * 5 + 1] = pn; utab[cnt * 5 + 2] = mt * 256; utab[cnt * 5 + 3] = nv; utab[cnt * 5 + 4] = tile * 256;
            ++cnt; }
        utab[192] = cnt;
    }
    __syncthreads();
    return utab[192];
}
__device__ __forceinline__ void phase6(LAS unsigned char* lds, int l) {
    const int nun = moe_units(lds, l);
    PH_COMMON();
    pg8::SchedMoe S; S.utab = (LAS int*)(lds + UTAB_OFF); S.nunits = nun; S.Abase = (const char*)(ws + WS_XB); S.Bbase = (const char*)(ws + WS_WGU); S.a_row_bytes = 0;
    S.b_exp_bytes = (size_t)1024 * D_MODEL * 2; S.b_tile_bytes = (size_t)256 * D_MODEL * 2; S.list = (const int*)(ws + WS_LIST); S.gather_k2 = D_MODEL * 2;
    EpiGU E{(bf16_t*)(ws + WS_H)};
    pg8::gemm_phase<EpiGU, pg8::SchedMoe, true, true>(lds, D_MODEL, S, E);
}
__device__ __forceinline__ void phase7(LAS unsigned char* lds, int l) {
    const int nun = moe_units(lds, l);
    PH_COMMON();
    pg8::SchedMoe S; S.utab = (LAS int*)(lds + UTAB_OFF); S.nunits = nun; S.Abase = (const char*)(ws + WS_H); S.Bbase = (const char*)(ws + WS_WD); S.a_row_bytes = (size_t)FE * 2;
    S.b_exp_bytes = (size_t)1024 * FE * 2; S.b_tile_bytes = (size_t)256 * FE * 2; S.list = (const int*)(ws + WS_LIST); S.gather_k2 = 0;
    EpiDown E{(bf16_t*)(ws + WS_Y), (const int*)(ws + WS_LIST)};
    pg8::gemm_phase<EpiDown, pg8::SchedMoe, false, true>(lds, FE, S, E);
}
__device__ __forceinline__ void phase8(LAS unsigned char* lds, int l) {
    PH_COMMON();
    const float* g2 = arg_in(13) + (size_t)l * D_MODEL; const float* b2 = arg_in(14) + (size_t)l * D_MODEL;
    float* xout = arg_out(); bf16_t* XB = (bf16_t*)(ws + WS_XB); const bf16_t* Y = (const bf16_t*)(ws + WS_Y); const f32x2* RECW = (const f32x2*)(ws + WS_RECW);
    PBS_BEGIN(4, lds);
    u32x2 nx[4], na[4], nc[4]; f32x2 nw;
#define P8_LOAD(mm) do { nw = RECW[mm]; const u32x2* xr = (const u32x2*)(XB + (size_t)(mm) * D_MODEL) + lane; \
        const u32x2* y0 = (const u32x2*)(Y + (size_t)(2 * (mm)) * D_MODEL) + lane; const u32x2* y1 = (const u32x2*)(Y + (size_t)(2 * (mm) + 1) * D_MODEL) + lane; \
        _Pragma("unroll") for (int j = 0; j < 4; ++j) { nx[j] = xr[64 * j]; na[j] = y0[64 * j]; nc[j] = y1[64 * j]; } } while (0)
    P8_LOAD(gw);
    const bool lastl = (l + 1 == DEPTH);
    for (int m = gw; m < T; m += NGW) {
        const f32x2 wv = nw; u32x2 cx[4], ca[4], cc[4];
#pragma unroll
        for (int j = 0; j < 4; ++j) { cx[j] = nx[j]; ca[j] = na[j]; cc[j] = nc[j]; }
        if (m + NGW < T) P8_LOAD(m + NGW);
        f32x4 v[4]; float s = 0.f;
#pragma unroll
        for (int j = 0; j < 4; ++j) { const u32x2 xw = cx[j]; const u32x2 a = ca[j], c = cc[j];
            v[j].x = bf_lo(xw.x) * ALPHA + wv.x * bf_lo(a.x) + wv.y * bf_lo(c.x); v[j].y = bf_hi(xw.x) * ALPHA + wv.x * bf_hi(a.x) + wv.y * bf_hi(c.x);
            v[j].z = bf_lo(xw.y) * ALPHA + wv.x * bf_lo(a.y) + wv.y * bf_lo(c.y); v[j].w = bf_hi(xw.y) * ALPHA + wv.x * bf_hi(a.y) + wv.y * bf_hi(c.y);
            s += (v[j].x + v[j].y) + (v[j].z + v[j].w); }
        const float mean = wave_sum(s) * (1.f / D_MODEL); float s2 = 0.f;
#pragma unroll
        for (int j = 0; j < 4; ++j) { v[j] = v[j] - mean; s2 += (v[j].x * v[j].x + v[j].y * v[j].y) + (v[j].z * v[j].z + v[j].w * v[j].w); }
        const float rstd = 1.f / sqrtf(wave_sum(s2) * (1.f / D_MODEL) + LN_EPS);
#pragma unroll
        for (int j = 0; j < 4; ++j) { const f32x4 gg = *((const f32x4*)g2 + lane + 64 * j), bb = *((const f32x4*)b2 + lane + 64 * j);
            v[j] = v[j] * rstd * gg + bb;
            if (lastl) *((f32x4*)(xout + (size_t)m * D_MODEL) + lane + 64 * j) = v[j];
            else { u32x2 w; w.x = cvt_pk_bf16(v[j].x, v[j].y); w.y = cvt_pk_bf16(v[j].z, v[j].w); *((u32x2*)(XB + (size_t)m * D_MODEL) + lane + 64 * j) = w; } }
    }
#undef P8_LOAD
    PBS_END(4, lds);
    PBS_BEGIN(5, lds);
    if (l + 1 < DEPTH) { __syncthreads(); convert_weights(l + 1, lds); }
    PBS_END(5, lds);
}

__global__ void __launch_bounds__(NWAVES * 64, 2) fwd(Args args) {
    extern __shared__ __attribute__((aligned(16))) unsigned char lds_raw[];
    LAS unsigned char* lds = (LAS unsigned char*)lds_raw;
    volatile LAS unsigned* MISC = (volatile LAS unsigned*)(lds + MISC_OFF);
    for (int u = threadIdx.x; u < (LDS_BYTES - LDSCTL_OFF) / 4; u += NWAVES * 64) ((LAS unsigned*)(lds + LDSCTL_OFF))[u] = 0u;
    __syncthreads();
    XcdBarrier bar; bar.bar = (unsigned*)(arg_ws() + WS_CTL) + CW_BAR + arg_li() * XCD_BAR_WORDS; bar.x = 0; bar.st = nullptr;
    if (!MK_MULTI) bar = xcd_barrier_post((unsigned*)(arg_ws() + WS_CTL) + CW_BAR + arg_li() * XCD_BAR_WORDS, MISC + 8);
    const int lo = arg_lo(), hi = arg_hi();
#define IN(k) (lo <= (k) && (k) < hi)
#define SEAM(k) do { if (!MK_MULTI && IN(k) && IN((k) + 1)) { XcdBarrier b2_ = bar; asm volatile("" : "+s"(b2_.bar)); xcd_barrier(b2_); } } while (0)
    unsigned long long tacc = 0ull, tst = 0ull; (void)tacc; (void)tst;
#define PB_BEGIN(k) do { if (PROBE_PH == (k)) tst = __builtin_amdgcn_s_memrealtime(); } while (0)
#define PB_END(k) do { if (PROBE_PH == (k)) tacc += __builtin_amdgcn_s_memrealtime() - tst; } while (0)
    PB_BEGIN(0);
    if (HAS(0) && IN(0)) phase0(lds);
    SEAM(0);
    PB_END(0);
    for (int l = 0; l < DEPTH; ++l) {
        const int pb = 1 + l * PH_PER_LAYER;
        PB_BEGIN(1);
        if (HAS(1) && IN(pb + 0)) phase1(lds);
        SEAM(pb + 0);
        PB_END(1);
        PB_BEGIN(2);
        if (HAS(2) && IN(pb + 1)) phase2(lds, l);
        SEAM(pb + 1);
        PB_END(2);
        PB_BEGIN(3);
        if (HAS(3) && IN(pb + 2)) phase3(lds);
        SEAM(pb + 2);
        PB_END(3);
        PB_BEGIN(4);
        if (HAS(4) && IN(pb + 3)) phase4(lds, l);
        SEAM(pb + 3);
        PB_END(4);
        PB_BEGIN(5);
        if (HAS(5) && IN(pb + 4)) phase5(lds, l);
        SEAM(pb + 4);
        PB_END(5);
        PB_BEGIN(6);
        if (HAS(6) && IN(pb + 5)) phase6(lds, l);
        SEAM(pb + 5);
        PB_END(6);
        PB_BEGIN(7);
        if (HAS(7) && IN(pb + 6)) phase7(lds, l);
        SEAM(pb + 6);
        PB_END(7);
        PB_BEGIN(8);
        if (HAS(8) && IN(pb + 7)) phase8(lds, l);
        SEAM(pb + 7);
        PB_END(8);
    }
    if (PROBE_PH >= 100) tacc = *(volatile LAS unsigned long long*)(lds + MISC_OFF + 64);
    if (PROBE_PH >= 0 && blockIdx.x == 0) { const unsigned long long t0 = __builtin_amdgcn_s_memrealtime(); while (__builtin_amdgcn_s_memrealtime() - t0 < tacc * PROBE_MULT) __builtin_amdgcn_s_sleep(8); }
#undef IN
#undef SEAM
    (void)args;
}


#ifndef DBG_PROBE
#define DBG_PROBE 0
#endif
#ifndef DBG_LAYER
#define DBG_LAYER 0
#endif
#ifndef DBG_GAIN
#define DBG_GAIN 1.0f
#endif
#if DBG_PROBE
constexpr size_t WS_DXS = 528 * MiB, WS_DKV = 544 * MiB, WS_DST = 610 * MiB;
__device__ __forceinline__ int dbg_tok(int i) { const int sp[8] = {0, 1, 63, 64, 65, 575, 576, 4095}; return i < 8 ? sp[i] : (i * 67 + (i % 5) * 13 + 200) % 4096; }
__device__ __forceinline__ void atomic_max_pos(float* p, float v) { atomicMax((unsigned*)p, __float_as_uint(v)); }
__global__ void dbg_kv(const float* xs, const float* w_in, float* kv) {
    const int c = blockIdx.x * 256 + threadIdx.x; const int bi = blockIdx.y >> 8; const int t0 = (blockIdx.y & 255) * 16;
    xs += (size_t)(bi ? 5 : 0) * SEQ * D_MODEL; kv += (size_t)bi * SEQ * 2048;
    const int col = c < 1024 ? 512 + c : 2048 + (c - 1024);
    float acc[16];
#pragma unroll
    for (int i = 0; i < 16; ++i) acc[i] = 0.f;
    for (int k = 0; k < D_MODEL; ++k) { const float w = w_in[(size_t)k * PROJ + col];
#pragma unroll
        for (int i = 0; i < 16; ++i) acc[i] += xs[(size_t)(t0 + i) * D_MODEL + k] * w; }
#pragma unroll
    for (int i = 0; i < 16; ++i) kv[(size_t)(t0 + i) * 2048 + c] = acc[i];
}
__device__ __forceinline__ float blk_sum(float v, float* red) { __syncthreads(); red[threadIdx.x] = v; __syncthreads(); for (int s = 128; s > 0; s >>= 1) { if ((int)threadIdx.x < s) red[threadIdx.x] += red[threadIdx.x + s]; __syncthreads(); } const float r = red[0]; __syncthreads(); return r; }
__device__ __forceinline__ float blk_max(float v, float* red) { __syncthreads(); red[threadIdx.x] = v; __syncthreads(); for (int s = 128; s > 0; s >>= 1) { if ((int)threadIdx.x < s) red[threadIdx.x] = fmaxf(red[threadIdx.x], red[threadIdx.x + s]); __syncthreads(); } const float r = red[0]; __syncthreads(); return r; }
__global__ void __launch_bounds__(256) dbg_tok_kernel(Args a, int L, int mode) {
    __shared__ float xs[1024], qa[512], qb[512], gl[2048], ya[512], yb[512], mg[1024], mixed[1024], x1[1024], hbuf[512], sc[4096], red[256], lgs[16];
    const int tid = threadIdx.x; const int t = dbg_tok(blockIdx.x >> 1); const int bi = blockIdx.x & 1, bb = bi ? 5 : 0; const size_t grow = (size_t)bb * SEQ + t;
    unsigned char* ws = a.ws;
    const float* xsnap = a.in[0] + (size_t)bb * SEQ * D_MODEL; const float* kv = (const float*)(ws + WS_DKV) + (size_t)bi * SEQ * 2048; float* st = (float*)(ws + WS_DST);
    const float* w_in = a.in[1] + (size_t)L * D_MODEL * PROJ; const float* relb = a.in[2] + (size_t)L * NH * N_REL;
    const float* w_upa = a.in[3] + (size_t)L * WA * D_MODEL; const float* w_upb = a.in[4] + (size_t)L * WA * D_MODEL; const float* w_out = a.in[5] + (size_t)L * D_MODEL * D_MODEL;
    const float* g1 = a.in[6] + (size_t)L * D_MODEL; const float* b1 = a.in[7] + (size_t)L * D_MODEL; const float* w_router = a.in[8]; const float* b_router = a.in[9];
    const float* w_gate = a.in[10] + (size_t)L * NE * D_MODEL * FE; const float* w_up = a.in[11] + (size_t)L * NE * D_MODEL * FE; const float* w_down = a.in[12] + (size_t)L * NE * FE * D_MODEL;
    for (int i = tid; i < 1024; i += 256) xs[i] = xsnap[(size_t)t * D_MODEL + i];
    __syncthreads();
    for (int j = tid; j < 3072; j += 256) { const int col = j < 512 ? j : (j < 1024 ? 1536 + (j - 512) : 3072 + (j - 1024)); float s = 0.f;
        for (int k = 0; k < 1024; ++k) s += xs[k] * w_in[(size_t)k * PROJ + col];
        if (j < 512) qa[j] = s; else if (j < 1024) qb[j - 512] = s; else gl[j - 1024] = s; }
    __syncthreads();
    for (int h = 0; h < 8; ++h) {
        const int c = t >> 6; const int k0 = (c - 8) > 0 ? (c - 8) * 64 : 0, k1 = c * 64 + 63; const int nk = k1 - k0 + 1;
        float mx = -1e30f;
        for (int i = tid; i < nk; i += 256) { const int key = k0 + i; float s = 0.f; for (int d = 0; d < 64; ++d) s += qa[h * 64 + d] * kv[(size_t)key * 2048 + h * 64 + d];
            int rel = t - key; rel = rel < -128 ? -128 : (rel > 128 ? 128 : rel); s = s * 0.125f + relb[h * N_REL + rel + 128]; sc[i] = s; mx = fmaxf(mx, s); }
        mx = blk_max(mx, red);
        float sm = 0.f; for (int i = tid; i < nk; i += 256) { const float p = expf(sc[i] - mx); sc[i] = p; sm += p; }
        sm = blk_sum(sm, red);
        if (tid < 64) { float o = 0.f; for (int i = 0; i < nk; ++i) o += sc[i] * kv[(size_t)(k0 + i) * 2048 + 512 + h * 64 + tid]; ya[h * 64 + tid] = o / sm; }
        __syncthreads();
        for (int s = tid; s < t; s += 256) { float z = 0.f; for (int d = 0; d < 64; ++d) z += qb[h * 64 + d] * kv[(size_t)s * 2048 + 1024 + h * 64 + d]; sc[s] = z * 0.125f; }
        __syncthreads();
        if (tid < 64) { float y = 0.f; for (int s = 0; s < t; ++s) { const float beta = 1.0f / (1.0f + expf(-sc[s])); y += beta * (kv[(size_t)s * 2048 + 1536 + h * 64 + tid] - y); } yb[h * 64 + tid] = y; }
        __syncthreads();
    }
    if (mode == 0) {
        const bf16_t* OA = (const bf16_t*)(ws + WS_QQ); const bf16_t* OB = (const bf16_t*)(ws + WS_QQ) + WA;
        float na = 0.f, da = 0.f, nb = 0.f, db = 0.f;
        for (int i = tid; i < 512; i += 256) { const float oa = h2f(OA[grow * D_MODEL + i]), ob = h2f(OB[grow * D_MODEL + i]);
            na += (oa - ya[i]) * (oa - ya[i]); da += ya[i] * ya[i]; nb += (ob - yb[i]) * (ob - yb[i]); db += yb[i] * yb[i]; }
        na = blk_sum(na, red); da = blk_sum(da, red); nb = blk_sum(nb, red); db = blk_sum(db, red);
        if (tid == 0) { atomicAdd(st + 4, na); atomicAdd(st + 5, da); atomicAdd(st + 6, nb); atomicAdd(st + 7, db); }
        return; }
    for (int cidx = tid; cidx < 1024; cidx += 256) { float ua = 0.f, ub = 0.f; for (int k = 0; k < 512; ++k) { ua += ya[k] * w_upa[(size_t)k * D_MODEL + cidx]; ub += yb[k] * w_upb[(size_t)k * D_MODEL + cidx]; }
        const float ga = 1.0f / (1.0f + expf(-gl[cidx])), gb = 1.0f / (1.0f + expf(-gl[1024 + cidx])); mg[cidx] = ga * ua + gb * ub; }
    __syncthreads();
    float num = 0.f, den = 0.f;
    for (int cidx = tid; cidx < 1024; cidx += 256) { float s = 0.f; for (int k = 0; k < 1024; ++k) s += mg[k] * w_out[(size_t)k * D_MODEL + cidx]; mixed[cidx] = s;
        const float opt = h2f(((const bf16_t*)(ws + WS_PRE))[grow * D_MODEL + cidx]) - ALPHA * xs[cidx]; num += (opt - s) * (opt - s); den += s * s; }
    num = blk_sum(num, red); den = blk_sum(den, red);
    if (tid == 0) { atomicAdd(st + 0, num); atomicAdd(st + 1, den); atomic_max_pos(st + 8, num / den); }
    float s1 = 0.f; for (int i = tid; i < 1024; i += 256) { x1[i] = ALPHA * xs[i] + mixed[i]; s1 += x1[i]; }
    const float mean = blk_sum(s1, red) / 1024.f; float s2 = 0.f; for (int i = tid; i < 1024; i += 256) { const float d = x1[i] - mean; s2 += d * d; }
    const float rstd = 1.0f / sqrtf(blk_sum(s2, red) / 1024.f + LN_EPS);
    for (int i = tid; i < 1024; i += 256) x1[i] = (x1[i] - mean) * rstd * g1[i] + b1[i];
    __syncthreads();
    if (tid < 16) { float s = 0.f; for (int k = 0; k < 1024; ++k) s += x1[k] * w_router[k * 16 + tid]; lgs[tid] = s + b_router[tid]; }
    __syncthreads();
    int best = 0; for (int e = 1; e < 16; ++e) if (lgs[e] > lgs[best]) best = e;
    const int grp = best >> 2; int e2 = -1; for (int e = grp * 4; e < grp * 4 + 4; ++e) if (e != best && (e2 < 0 || lgs[e] > lgs[e2])) e2 = e;
    const float pw1 = 1.0f / (1.0f + expf(lgs[e2] - lgs[best])), pw2 = 1.0f - pw1;
    const f32x2 wo = ((const f32x2*)(ws + WS_RECW))[grow]; const bf16_t* Y = (const bf16_t*)(ws + WS_Y);
    float fnum = 0.f, fden = 0.f; float ff[4] = {0.f, 0.f, 0.f, 0.f};
    for (int kk = 0; kk < 2; ++kk) { const int e = kk ? e2 : best; const float pw = kk ? pw2 : pw1;
        for (int f = tid; f < 512; f += 256) { float g = 0.f, u = 0.f; for (int k = 0; k < 1024; ++k) { g += x1[k] * w_gate[((size_t)e * D_MODEL + k) * FE + f]; u += x1[k] * w_up[((size_t)e * D_MODEL + k) * FE + f]; }
            hbuf[f] = g / (1.0f + expf(-g)) * u; }
        __syncthreads();
        for (int j = 0; j < 4; ++j) { const int cidx = tid + 256 * j; float s = 0.f; for (int f = 0; f < 512; ++f) s += hbuf[f] * w_down[((size_t)e * FE + f) * D_MODEL + cidx]; ff[j] += pw * s; }
        __syncthreads(); }
    for (int j = 0; j < 4; ++j) { const int cidx = tid + 256 * j; const float opt = wo.x * h2f(Y[(size_t)(2 * grow) * D_MODEL + cidx]) + wo.y * h2f(Y[(size_t)(2 * grow + 1) * D_MODEL + cidx]);
        fnum += (opt - ff[j]) * (opt - ff[j]); fden += ff[j] * ff[j]; }
    fnum = blk_sum(fnum, red); fden = blk_sum(fden, red);
    if (tid == 0) { atomicAdd(st + 2, fnum); atomicAdd(st + 3, fden); atomic_max_pos(st + 9, fnum / fden); }
    const float* g2 = a.in[13] + (size_t)L * D_MODEL; const float* b2 = a.in[14] + (size_t)L * D_MODEL;
    float t1 = 0.f; for (int j = 0; j < 4; ++j) { const int cidx = tid + 256 * j; mixed[cidx] = ALPHA * x1[cidx] + ff[j]; t1 += mixed[cidx]; }
    const float mean2 = blk_sum(t1, red) / 1024.f; float t2 = 0.f; for (int j = 0; j < 4; ++j) { const float d = mixed[tid + 256 * j] - mean2; t2 += d * d; }
    const float rstd2 = 1.0f / sqrtf(blk_sum(t2, red) / 1024.f + LN_EPS);
    float xnum = 0.f, xden = 0.f;
    for (int j = 0; j < 4; ++j) { const int cidx = tid + 256 * j; const float ref = (mixed[cidx] - mean2) * rstd2 * g2[cidx] + b2[cidx];
        const float opt = (L == DEPTH - 1) ? a.out[grow * D_MODEL + cidx] : h2f(((const bf16_t*)(ws + WS_XB))[grow * D_MODEL + cidx]);
        xnum += (opt - ref) * (opt - ref); xden += ref * ref; }
    xnum = blk_sum(xnum, red); xden = blk_sum(xden, red);
    if (tid == 0) { atomicAdd(st + 10, xnum); atomicAdd(st + 11, xden); atomic_max_pos(st + 12, xnum / xden); }
}
__global__ void dbg_inject(float* out, const float* st, int n4) {
    const float delta = sqrtf((DBG_PROBE == 1) ? st[0] / st[1] : (DBG_PROBE == 2) ? st[2] / st[3] : (DBG_PROBE == 3) ? st[4] / st[5] : (DBG_PROBE == 4) ? st[6] / st[7] : (DBG_PROBE == 5) ? st[8] : (DBG_PROBE == 6) ? st[9] : (DBG_PROBE == 7) ? st[10] / st[11] : st[12]); const float f = 1.0f + DBG_GAIN * delta;
    for (int i = blockIdx.x * blockDim.x + threadIdx.x; i < n4; i += gridDim.x * blockDim.x) { f32x4 v = ((f32x4*)out)[i]; v = v * f; ((f32x4*)out)[i] = v; }
}
#endif

extern "C" void kernel_launch(void* const* d_in, const int* in_sizes, int n_in, void* d_out, int out_size, void* d_ws, size_t ws_size, hipStream_t stream) {
    static int grid = 0;
    if (grid == 0) {
        if (n_in != 15 || in_sizes[0] != T * D_MODEL || out_size != T * D_MODEL || ws_size < WS_END) {
            fprintf(stderr, "kernel_launch: unexpected shapes (n_in %d in0 %d out %d ws %zu; need ws >= %zu); nothing launched\n", n_in, n_in > 0 ? in_sizes[0] : -1, out_size, ws_size, (size_t)WS_END); grid = -1; return; }
        int dev = 0, cus = 0, per_cu = 0;
        if (hipGetDevice(&dev) != hipSuccess || hipDeviceGetAttribute(&cus, hipDeviceAttributeMultiprocessorCount, dev) != hipSuccess) { grid = -1; return; }
        if (hipFuncSetAttribute((const void*)fwd, hipFuncAttributeMaxDynamicSharedMemorySize, LDS_BYTES) != hipSuccess) { fprintf(stderr, "kernel_launch: hipFuncSetAttribute failed\n"); grid = -1; return; }
        if (hipOccupancyMaxActiveBlocksPerMultiprocessor(&per_cu, (const void*)fwd, NWAVES * 64, LDS_BYTES) != hipSuccess || per_cu < 1)
            fprintf(stderr, "kernel_launch: note: occupancy query reports %d workgroups per CU\n", per_cu);
        (void)hipGetLastError();
        grid = cus;
        if (grid != 256) fprintf(stderr, "kernel_launch: %d CUs; the attention deal needs 256\n", grid);
    }
    if (grid < 0) return;
    if (hipMemsetAsync((char*)d_ws + WS_CTL, 0, CTL_ZERO_BYTES, stream) != hipSuccess) { fprintf(stderr, "kernel_launch: memset failed\n"); return; }
    Args a{};
    for (int i = 0; i < 15; ++i) a.in[i] = (const float*)d_in[i];
    a.out = (float*)d_out; a.ws = (unsigned char*)d_ws;
#if DBG_PROBE
    {
        const int L = DBG_LAYER, p0 = 1 + 8 * L, p1 = 1 + 8 * (L + 1);
        hipMemsetAsync((char*)d_ws + WS_DST, 0, 64, stream);
        a.li = 0; a.ph_lo = 0; a.ph_hi = p0; hipLaunchKernelGGL(fwd, dim3(grid), dim3(NWAVES * 64), LDS_BYTES, stream, a);
        hipLaunchKernelGGL(dbg_kv, dim3(8, 512), dim3(256), 0, stream, (const float*)d_in[0], (const float*)d_in[1] + (size_t)L * D_MODEL * PROJ, (float*)((char*)d_ws + WS_DKV));
        a.li = 1; a.ph_lo = p0; a.ph_hi = p0 + 2; hipLaunchKernelGGL(fwd, dim3(grid), dim3(NWAVES * 64), LDS_BYTES, stream, a);
        hipLaunchKernelGGL(dbg_tok_kernel, dim3(128), dim3(256), 0, stream, a, L, 0);
        a.li = 3; a.ph_lo = p0 + 2; a.ph_hi = p1; hipLaunchKernelGGL(fwd, dim3(grid), dim3(NWAVES * 64), LDS_BYTES, stream, a);
        hipLaunchKernelGGL(dbg_tok_kernel, dim3(128), dim3(256), 0, stream, a, L, 1);
        if (p1 < N_PHASES) { a.li = 2; a.ph_lo = p1; a.ph_hi = N_PHASES; hipLaunchKernelGGL(fwd, dim3(grid), dim3(NWAVES * 64), LDS_BYTES, stream, a); }
        hipLaunchKernelGGL(dbg_inject, dim3(1024), dim3(256), 0, stream, (float*)d_out, (const float*)((char*)d_ws + WS_DST), T * D_MODEL / 4);
    }
#elif MK_MULTI
    for (int p = 0; p < N_PHASES; ++p) { a.ph_lo = p; a.ph_hi = p + 1; hipLaunchKernelGGL(fwd, dim3(grid), dim3(NWAVES * 64), LDS_BYTES, stream, a); }
#else
    a.ph_lo = 0; a.ph_hi = N_PHASES;
    hipLaunchKernelGGL(fwd, dim3(grid), dim3(NWAVES * 64), LDS_BYTES, stream, a);
#endif
    const hipError_t le = hipPeekAtLastError();
    if (le != hipSuccess) fprintf(stderr, "kernel_launch: launch failed: %s\n", hipGetErrorName(le));
}
```

```cpp
#include <hip/hip_runtime.h>
#include <cstdio>
#include <cstdint>

#ifndef MK_MULTI
#define MK_MULTI 0
#endif

#ifndef PROBE_PH
#define PROBE_PH (-1)
#endif
#ifndef PROBE_MULT
#define PROBE_MULT 1
#endif
#ifndef PHASE_MASK
#define PHASE_MASK 0x1ff
#endif
#define HAS(k) ((PHASE_MASK >> (k)) & 1)
#define LAS __attribute__((address_space(3)))
#define PBS_BEGIN(id, lds) do { if (PROBE_PH == 100 + (id) && threadIdx.x == 0) *(volatile LAS unsigned long long*)((lds) + MISC_OFF + 80) = __builtin_amdgcn_s_memrealtime(); } while (0)
#define PBS_END(id, lds) do { if (PROBE_PH == 100 + (id) && threadIdx.x == 0) { volatile LAS unsigned long long* p_ = (volatile LAS unsigned long long*)((lds) + MISC_OFF + 64); p_[0] = p_[0] + (__builtin_amdgcn_s_memrealtime() - p_[2]); } } while (0)
#define GAS __attribute__((address_space(1)))
typedef unsigned short bf16_t;
typedef short bf16x8 __attribute__((ext_vector_type(8)));
typedef short s16x4 __attribute__((ext_vector_type(4)));
typedef float f32x4 __attribute__((ext_vector_type(4)));
typedef float f32x2 __attribute__((ext_vector_type(2)));
typedef float f32x16 __attribute__((ext_vector_type(16)));
typedef unsigned u32x4 __attribute__((ext_vector_type(4)));
typedef unsigned u32x2 __attribute__((ext_vector_type(2)));

constexpr int D_MODEL = 1024, BATCH = 8, SEQ = 4096, DEPTH = 4, T = BATCH * SEQ;
constexpr int NH = 8, HD = 64, WA = NH * HD;
constexpr int PROJ = 3 * WA + 3 * WA + 2 * D_MODEL;
constexpr int N_REL = 257, NE = 16, FE = 512;
constexpr float ALPHA = 1.681792830507429f;
constexpr float LN_EPS = 1e-5f;
constexpr float LOG2E = 1.4426950408889634f;
constexpr float C2 = 0.125f * LOG2E;

constexpr size_t MiB = 1u << 20;
constexpr size_t WS_CTL = 0, CTL_ZERO_BYTES = 1 * MiB;
constexpr size_t WS_RECW = 2 * MiB;
constexpr size_t WS_LIST = 4 * MiB;
constexpr size_t WS_WIN = 8 * MiB, WS_WUP = 18 * MiB  , WS_WOUT = 20 * MiB, WS_WGU = 22 * MiB, WS_WD = 54 * MiB;
constexpr size_t WS_RTAB = 70 * MiB;
constexpr size_t RTAB_STRIDE = 65536 + 256;
constexpr size_t WS_XB = 72 * MiB;
constexpr size_t WS_QQ = 136 * MiB, WS_KA = 200 * MiB, WS_VA = 232 * MiB, WS_KB = 264 * MiB, WS_VB = 296 * MiB;
constexpr size_t WS_GA = 328 * MiB, WS_GB = 392 * MiB;
constexpr size_t WS_PRE = 328 * MiB;
constexpr size_t WS_MERGED = 456 * MiB;
constexpr size_t WS_Y = 136 * MiB;
constexpr size_t WS_H = 456 * MiB;
constexpr size_t WS_END = 526 * MiB;
constexpr int CW_TMO = 0;
constexpr int CW_BAR = 4096;
constexpr int CW_CNT = 32768;

constexpr int RING_BYTES = 131072;
constexpr int LDSCTL_OFF = RING_BYTES, MISC_OFF = LDSCTL_OFF + 320;
constexpr int UTAB_OFF = LDSCTL_OFF + 1024;
constexpr int LDS_BYTES = 147456;

#ifndef USE_F16
#define USE_F16 1
#endif
typedef _Float16 h16x2 __attribute__((ext_vector_type(2)));
typedef _Float16 h16x8 __attribute__((ext_vector_type(8)));
#if USE_F16
__device__ __forceinline__ unsigned cvt_pk_bf16(float lo, float hi) { const f32x2 v = {lo, hi}; return __builtin_bit_cast(unsigned, __builtin_convertvector(v, h16x2)); }
__device__ __forceinline__ float bf_lo(unsigned w) { return (float)__builtin_bit_cast(h16x2, w)[0]; }
__device__ __forceinline__ float bf_hi(unsigned w) { return (float)__builtin_bit_cast(h16x2, w)[1]; }
#define MFMA16(a, b, c) __builtin_amdgcn_mfma_f32_16x16x32_f16(__builtin_bit_cast(h16x8, a), __builtin_bit_cast(h16x8, b), c, 0, 0, 0)
#define MFMA32(a, b, c) __builtin_amdgcn_mfma_f32_32x32x16_f16(__builtin_bit_cast(h16x8, a), __builtin_bit_cast(h16x8, b), c, 0, 0, 0)
#else
__device__ __forceinline__ unsigned cvt_pk_bf16(float lo, float hi) { unsigned r; asm volatile("v_cvt_pk_bf16_f32 %0, %1, %2" : "=v"(r) : "v"(lo), "v"(hi)); return r; }
__device__ __forceinline__ float bf_lo(unsigned w) { return __uint_as_float(w << 16); }
__device__ __forceinline__ float bf_hi(unsigned w) { return __uint_as_float(w & 0xffff0000u); }
#define MFMA16(a, b, c) __builtin_amdgcn_mfma_f32_16x16x32_bf16(a, b, c, 0, 0, 0)
#define MFMA32(a, b, c) MFMA32(a, b, c)
#endif
__device__ __forceinline__ float h2f(bf16_t h) { return bf_lo((unsigned)h); }
__device__ __forceinline__ float fast_exp2(float x) { return __builtin_amdgcn_exp2f(x); }
__device__ __forceinline__ float fast_rcp(float x) { return __builtin_amdgcn_rcpf(x); }
__device__ __forceinline__ float sigmoidf_(float v) { return fast_rcp(1.0f + fast_exp2(-LOG2E * v)); }
__device__ __forceinline__ float wave_sum(float v) {
#define DPP_ADD(ctrl, rmask) v += __builtin_bit_cast(float, __builtin_amdgcn_update_dpp(0, __builtin_bit_cast(int, v), ctrl, rmask, 0xf, false))
    DPP_ADD(0x111, 0xf); DPP_ADD(0x112, 0xf); DPP_ADD(0x114, 0xf); DPP_ADD(0x118, 0xf);
    DPP_ADD(0x142, 0xa); DPP_ADD(0x143, 0xc);
#undef DPP_ADD
    return __builtin_bit_cast(float, __builtin_amdgcn_readlane(__builtin_bit_cast(int, v), 63));
}
#define LDS_WAIT() asm volatile("s_waitcnt lgkmcnt(0)" ::: "memory")
#define VM_WAIT() asm volatile("s_waitcnt vmcnt(0)" ::: "memory")

namespace pg8 {
constexpr int BM = 256, BK = 64, HALF = 128, HTB = HALF * BK * 2, STAGE_BYTES = 8 * HTB, NXCD = 8, WGM = 8;
__host__ __device__ __forceinline__ int lds_byte(int r, int c) { const int st = (r >> 4) * 2 + (c >> 5), rr = r & 15, cc = c & 31, ob = rr * 64 + cc * 2; return st * 1024 + (ob ^ (((ob >> 9) & 1) << 5)); }
__host__ __device__ __forceinline__ void stage_rc(int b, int& R, int& C) { const int st = b / 1024, sb = b % 1024, swz = sb ^ (((sb >> 9) & 1) << 5); R = (st >> 1) * 16 + swz / 64; C = (st & 1) * 32 + (swz % 64) / 2; }
__host__ __device__ __forceinline__ int perm32(int rho) { const int n = rho >> 4, i = rho & 15; return 8 * (i >> 2) + 4 * n + (i & 3); }

struct Unit { const char* A; const char* B; int pm, pn, x0, x1, x2, x3; };

struct TileOrder {
    int nM, nN, nwg, G, c;
    __device__ __forceinline__ void init(int nM_, int nN_, int G_, int c_) { nM = nM_; nN = nN_; nwg = nM * nN; G = G_; c = c_; }
    __device__ __forceinline__ bool next(int i, int& pm, int& pn) const {
        const long L = (long)i * G + c; if (L >= nwg) return false;
        int wgid = (int)L; { const int q = nwg / NXCD, r = nwg % NXCD, xcd = wgid % NXCD, off = wgid / NXCD; wgid = (xcd < r ? xcd * (q + 1) : r * (q + 1) + (xcd - r) * q) + off; }
        const int nig = WGM * nN, gid = wgid / nig, fm = gid * WGM, gsz = (nM - fm) < WGM ? (nM - fm) : WGM;
        pm = fm + ((wgid % nig) % gsz); pn = (wgid % nig) / gsz; return true;
    }
};

template <class Epi, class Sched, bool GATHER, bool ALIGN_EPI, bool MIDHOOK = false>
__device__ __forceinline__ void gemm_phase(LAS unsigned char* lds, const int K, const Sched& S, const Epi& E, const int LD_ = 0) {
    const int LD = LD_ ? LD_ : K;
    int tid_ = threadIdx.x; asm volatile("" : "+v"(tid_));
    const int tid = tid_, wid = __builtin_amdgcn_readfirstlane(tid >> 6), lane = tid & 63, wr = wid >> 2, wc = wid & 3, fr = lane & 15, fq = lane >> 4;
    const int nt = K / BK;
    unsigned voffB[2]; int RA[2], CA2[2];
#pragma unroll
    for (int i = 0; i < 2; ++i) { int R, C; stage_rc(tid * 16 + i * 8192, R, C); const int Rb = Epi::PERM ? ((R & ~31) + perm32(R & 31)) : R;
        RA[i] = R; CA2[i] = C * 2; voffB[i] = (unsigned)(Rb * LD + C) * 2u; }
    const size_t kstep = (size_t)(BK * 2);
    const size_t hstep = (size_t)HALF * LD * 2;
    const unsigned ldsw = (unsigned)wid * 1024u;
    const int aoff = lds_byte(wr * 64 + fr, fq * 8), boff = lds_byte(wc * 32 + fr, fq * 8);
#define PG8_SA(b, h) (((b) * 2 + (h)) * HTB)
#define PG8_SB(b, h) ((4 + (b) * 2 + (h)) * HTB)
#define PG8_STAGE(bufoff, gbase, voff) do { _Pragma("unroll") for (int _i = 0; _i < 2; ++_i) \
        __builtin_amdgcn_global_load_lds((const unsigned*)((const char*)(gbase) + (voff)[_i]), (LAS unsigned*)(lds + (bufoff) + ldsw + _i * 8192), 16, 0, 0); } while (0)
#define PG8_LDA(dst, b, h) do { _Pragma("unroll") for (int m = 0; m < 4; ++m) _Pragma("unroll") for (int k = 0; k < 2; ++k) dst[m][k] = *(const LAS bf16x8*)(lds + PG8_SA(b, h) + aoff + m * 2048 + k * 1024); } while (0)
#define PG8_LDB(dst, b, h) do { _Pragma("unroll") for (int n = 0; n < 2; ++n) _Pragma("unroll") for (int k = 0; k < 2; ++k) dst[n][k] = *(const LAS bf16x8*)(lds + PG8_SB(b, h) + boff + n * 2048 + k * 1024); } while (0)
#define PG8_MMA(ai, bj, At, Bt) do { __builtin_amdgcn_s_setprio(1); _Pragma("unroll") for (int m = 0; m < 4; ++m) _Pragma("unroll") for (int n = 0; n < 2; ++n) _Pragma("unroll") for (int k = 0; k < 2; ++k) \
        acc[ai][bj][m][n] = MFMA16(Bt[n][k], At[m][k], acc[ai][bj][m][n]); __builtin_amdgcn_s_setprio(0); } while (0)
#define PG8_WAIT_V(n) asm volatile("s_waitcnt vmcnt(" #n ")" ::: "memory")
#define PG8_WAIT_L(n) asm volatile("s_waitcnt lgkmcnt(" #n ")" ::: "memory")
#define PG8_BAR __builtin_amdgcn_s_barrier()
#define PG8_SCHED __builtin_amdgcn_sched_barrier(0)
    Unit cur, nxt; int ui = 0;
    if (!S.next(0, cur)) return;
    unsigned oc0[2], oc1[2], on0[2], on1[2];
    if constexpr (GATHER) { S.offs(cur, RA, CA2, oc0, oc1); }
    else {
#pragma unroll
        for (int i = 0; i < 2; ++i) { oc0[i] = (unsigned)(RA[i] * LD) * 2u + (unsigned)CA2[i]; oc1[i] = oc0[i]; on0[i] = oc0[i]; on1[i] = oc0[i]; } }
    const size_t ah = GATHER ? (size_t)0 : hstep;
    f32x4 acc[2][2][4][2];
#pragma unroll
    for (int a = 0; a < 2; ++a)
#pragma unroll
        for (int b = 0; b < 2; ++b)
#pragma unroll
            for (int m = 0; m < 4; ++m)
#pragma unroll
                for (int n = 0; n < 2; ++n) acc[a][b][m][n] = (f32x4){0.f, 0.f, 0.f, 0.f};
    bf16x8 At[4][2], B0[2][2], B1[2][2];
    const char* cA = cur.A; const char* cB = cur.B;
    PG8_STAGE(PG8_SB(0, 0), cB, voffB); PG8_STAGE(PG8_SB(0, 1), cB + hstep, voffB); PG8_STAGE(PG8_SA(0, 0), cA, oc0); PG8_STAGE(PG8_SA(0, 1), cA + ah, oc1);
    if (wr == 1) PG8_BAR;
    PG8_WAIT_V(2); PG8_BAR;
    PG8_STAGE(PG8_SB(1, 0), cB + kstep, voffB); PG8_STAGE(PG8_SA(1, 0), cA + kstep, oc0); PG8_STAGE(PG8_SB(1, 1), cB + hstep + kstep, voffB);
    PG8_WAIT_V(6); PG8_BAR;
    for (;;) {
        const bool has_next = S.next(ui + 1, nxt);
        const char* nA = has_next ? nxt.A : cA; const char* nB = has_next ? nxt.B : cB;
        if constexpr (GATHER) { if (has_next) S.offs(nxt, RA, CA2, on0, on1); else { on0[0] = oc0[0]; on0[1] = oc0[1]; on1[0] = oc1[0]; on1[1] = oc1[1]; } }
        for (int t = 0; t < nt; t += 2) {
            const bool last = (t == nt - 2);
            const char* a1 = cA + (size_t)(t + 1) * kstep;
            const char* a2 = last ? nA : cA + (size_t)(t + 2) * kstep; const char* b2 = last ? nB : cB + (size_t)(t + 2) * kstep;
            const char* a3 = a2 + kstep; const char* b3 = b2 + kstep;
            unsigned o20[2], o21[2];
            if constexpr (GATHER) { o20[0] = last ? on0[0] : oc0[0]; o20[1] = last ? on0[1] : oc0[1]; o21[0] = last ? on1[0] : oc1[0]; o21[1] = last ? on1[1] : oc1[1]; }
            else { o20[0] = oc0[0]; o20[1] = oc0[1]; o21[0] = oc0[0]; o21[1] = oc0[1]; }
            PG8_LDB(B0, 0, 0); PG8_LDB(B1, 0, 1); PG8_SCHED; PG8_LDA(At, 0, 0); PG8_STAGE(PG8_SA(1, 1), a1 + ah, oc1);
            PG8_WAIT_V(8); PG8_WAIT_L(0); PG8_BAR; PG8_MMA(0, 0, At, B0); PG8_MMA(0, 1, At, B1); PG8_BAR; PG8_SCHED;
            PG8_LDA(At, 0, 1); PG8_STAGE(PG8_SB(0, 0), b2, voffB); PG8_STAGE(PG8_SB(0, 1), b2 + hstep, voffB); PG8_STAGE(PG8_SA(0, 0), a2, o20);
            PG8_WAIT_V(8); PG8_WAIT_L(0); PG8_BAR; PG8_MMA(1, 0, At, B0); PG8_MMA(1, 1, At, B1); PG8_BAR; PG8_SCHED;
            PG8_LDB(B0, 1, 0); PG8_LDB(B1, 1, 1); PG8_SCHED; PG8_LDA(At, 1, 0); PG8_STAGE(PG8_SA(0, 1), a2 + ah, o21);
            PG8_WAIT_V(8); PG8_WAIT_L(0); PG8_BAR; PG8_MMA(0, 0, At, B0); PG8_MMA(0, 1, At, B1); PG8_BAR; PG8_SCHED;
            PG8_LDA(At, 1, 1); PG8_STAGE(PG8_SB(1, 0), b3, voffB); PG8_STAGE(PG8_SB(1, 1), b3 + hstep, voffB); PG8_STAGE(PG8_SA(1, 0), a3, o20);
            PG8_WAIT_V(8); PG8_WAIT_L(0); PG8_BAR; PG8_MMA(1, 0, At, B0); PG8_MMA(1, 1, At, B1); PG8_BAR; PG8_SCHED;
        }
        if constexpr (ALIGN_EPI) { if (wr == 0) PG8_BAR; }
        bool keep = false;
        if constexpr (MIDHOOK) { if (cur.x0 == 0) { E.mid(acc, cur, wr, wc, fr, fq); keep = true; } else E(acc, cur, wr, wc, fr, fq); }
        else E(acc, cur, wr, wc, fr, fq);
        if (!has_next) break;
        if (!keep) {
#pragma unroll
        for (int a = 0; a < 2; ++a)
#pragma unroll
            for (int b = 0; b < 2; ++b)
#pragma unroll
                for (int m = 0; m < 4; ++m)
#pragma unroll
                    for (int n = 0; n < 2; ++n) acc[a][b][m][n] = (f32x4){0.f, 0.f, 0.f, 0.f};
        }
        cur = nxt; cA = nA; cB = nB; ++ui;
        if constexpr (GATHER) { oc0[0] = on0[0]; oc0[1] = on0[1]; oc1[0] = on1[0]; oc1[1] = on1[1]; }
        if constexpr (ALIGN_EPI) { if (wr == 1) PG8_BAR; }
    }
    PG8_WAIT_V(0);
    if constexpr (!ALIGN_EPI) { if (wr == 0) PG8_BAR; }
    PG8_BAR;
#undef PG8_SA
#undef PG8_SB
#undef PG8_STAGE
#undef PG8_LDA
#undef PG8_LDB
#undef PG8_MMA
#undef PG8_WAIT_V
#undef PG8_WAIT_L
#undef PG8_BAR
#undef PG8_SCHED
}

struct SchedPlain {
    TileOrder o; const char* A; const char* B; size_t tstep;
    __device__ __forceinline__ bool next(int i, Unit& u) const { int pm, pn; if (!o.next(i, pm, pn)) return false; u.pm = pm; u.pn = pn; u.x0 = 0; u.x1 = 0; u.x2 = 0; u.x3 = 0; u.A = A + (size_t)pm * tstep; u.B = B + (size_t)pn * tstep; return true; }
};
struct SchedTwo {
    TileOrder o; const char* A; const char* B; size_t tstep;
    __device__ __forceinline__ bool next(int i, Unit& u) const { int pm, pn; if (!o.next(i >> 1, pm, pn)) return false; const int br = i & 1; u.pm = pm; u.pn = pn; u.x0 = br; u.x1 = 0; u.x2 = 0; u.x3 = 0;
        u.A = A + (size_t)pm * tstep + (size_t)br * (WA * 2); u.B = B + (size_t)pn * tstep + (size_t)br * (WA * 2); return true; }
};
struct SchedMoe {
    const LAS int* utab; int nunits;
    const char* Abase; const char* Bbase; size_t a_row_bytes; size_t b_exp_bytes; size_t b_tile_bytes; const int* list; int gather_k2;
    __device__ __forceinline__ bool next(int i, Unit& u) const {
        if (i >= nunits) return false;
        const int e = utab[i * 5 + 0], pn = utab[i * 5 + 1], lo_ = utab[i * 5 + 2], nv = utab[i * 5 + 3], rb = utab[i * 5 + 4];
        u.pm = e; u.pn = pn; u.x0 = lo_; u.x1 = nv; u.x2 = rb; u.x3 = i;
        u.A = Abase + (size_t)rb * a_row_bytes; u.B = Bbase + (size_t)e * b_exp_bytes + (size_t)pn * b_tile_bytes; return true; }
    __device__ __forceinline__ void offs(const Unit& u, const int (&RA)[2], const int (&CA2)[2], unsigned (&o0)[2], unsigned (&o1)[2]) const {
        const int* lp = list + (size_t)u.pm * T + u.x0;
#pragma unroll
        for (int i = 0; i < 2; ++i) {
            int r0 = RA[i], r1 = RA[i] + HALF; r0 = r0 < u.x1 ? r0 : u.x1 - 1; r1 = r1 < u.x1 ? r1 : u.x1 - 1;
            const int t0 = lp[r0] >> 1, t1 = lp[r1] >> 1;
            o0[i] = (unsigned)t0 * (unsigned)gather_k2 + (unsigned)CA2[i]; o1[i] = (unsigned)t1 * (unsigned)gather_k2 + (unsigned)CA2[i]; }
    }
};
}

using pg8::Unit;
struct EpiInProj {
    static constexpr bool PERM = true;
    unsigned char* ws;
    __device__ __forceinline__ void operator()(const f32x4 (&acc)[2][2][4][2], const Unit& u, int wr, int wc, int fr, int fq) const {
        const int pn = u.pn; bf16_t* base; int ldc, colt; float sc = 1.f; const bool gate = pn >= 12;
        if (!gate) { const int piece = pn >> 1; colt = (pn & 1) * 256; ldc = WA;
            if (piece == 0) { base = (bf16_t*)(ws + WS_QQ); ldc = D_MODEL; sc = C2; }
            else if (piece == 3) { base = (bf16_t*)(ws + WS_QQ) + WA; ldc = D_MODEL; sc = C2; }
            else base = (bf16_t*)(ws + (piece == 1 ? WS_KA : piece == 2 ? WS_VA : piece == 4 ? WS_KB : WS_VB)); }
        else { const int g = (pn - 12) >> 2; base = (bf16_t*)(ws + (g ? WS_GB : WS_GA)); ldc = D_MODEL; colt = ((pn - 12) & 3) * 256; }
        const int row0 = u.pm * 256 + wr * 64 + fr, col0 = colt + wc * 32 + 8 * fq;
#pragma unroll
        for (int ai = 0; ai < 2; ++ai)
#pragma unroll
            for (int m = 0; m < 4; ++m) { bf16_t* rowp = base + (size_t)(row0 + ai * 128 + m * 16) * ldc + col0;
#pragma unroll
                for (int bj = 0; bj < 2; ++bj) { f32x4 v0 = acc[ai][bj][m][0], v1 = acc[ai][bj][m][1];
                    if (gate) {
#pragma unroll
                        for (int i = 0; i < 4; ++i) { v0[i] = sigmoidf_(v0[i]); v1[i] = sigmoidf_(v1[i]); } }
                    else { v0 = v0 * sc; v1 = v1 * sc; }
                    u32x4 w; w.x = cvt_pk_bf16(v0[0], v0[1]); w.y = cvt_pk_bf16(v0[2], v0[3]); w.z = cvt_pk_bf16(v1[0], v1[1]); w.w = cvt_pk_bf16(v1[2], v1[3]);
                    *(u32x4*)(rowp + bj * 128) = w; } }
    }
};
struct EpiMerge {
    static constexpr bool PERM = true;
    const bf16_t* ga; const bf16_t* gb; bf16_t* merged;
    __device__ __forceinline__ void mid(f32x4 (&acc)[2][2][4][2], const Unit& u, int wr, int wc, int fr, int fq) const {
        unsigned o0 = ((unsigned)(u.pm * 256 + wr * 64 + fr) * D_MODEL + (unsigned)(u.pn * 256 + wc * 32 + 8 * fq)) * 2u;
        asm volatile("" : "+v"(o0));
#pragma unroll
        for (int ai = 0; ai < 2; ++ai)
#pragma unroll
            for (int m = 0; m < 4; ++m) {
#pragma unroll
                for (int bj = 0; bj < 2; ++bj) { const unsigned ob = o0 + (unsigned)((ai * 128 + m * 16) * D_MODEL + bj * 128) * 2u;
                    const u32x4 aw = *(const u32x4*)((const char*)ga + ob), bw = *(const u32x4*)((const char*)gb + ob);
                    const float a_[8] = {bf_lo(aw.x), bf_hi(aw.x), bf_lo(aw.y), bf_hi(aw.y), bf_lo(aw.z), bf_hi(aw.z), bf_lo(aw.w), bf_hi(aw.w)};
                    const float b_[8] = {bf_lo(bw.x), bf_hi(bw.x), bf_lo(bw.y), bf_hi(bw.y), bf_lo(bw.z), bf_hi(bw.z), bf_lo(bw.w), bf_hi(bw.w)};
#pragma unroll
                    for (int i = 0; i < 4; ++i) { acc[ai][bj][m][0][i] *= a_[i] * fast_rcp(__builtin_fmaxf(b_[i], 6.103515625e-5f)); acc[ai][bj][m][1][i] *= a_[4 + i] * fast_rcp(__builtin_fmaxf(b_[4 + i], 6.103515625e-5f)); } }
                asm volatile("" ::: "memory"); }
    }
    __device__ __forceinline__ void operator()(const f32x4 (&acc)[2][2][4][2], const Unit& u, int wr, int wc, int fr, int fq) const {
        unsigned o0 = ((unsigned)(u.pm * 256 + wr * 64 + fr) * D_MODEL + (unsigned)(u.pn * 256 + wc * 32 + 8 * fq)) * 2u;
        asm volatile("" : "+v"(o0));
#pragma unroll
        for (int ai = 0; ai < 2; ++ai)
#pragma unroll
            for (int m = 0; m < 4; ++m) {
#pragma unroll
                for (int bj = 0; bj < 2; ++bj) { const unsigned ob = o0 + (unsigned)((ai * 128 + m * 16) * D_MODEL + bj * 128) * 2u;
                    const f32x4 a0 = acc[ai][bj][m][0], a1 = acc[ai][bj][m][1];
                    const u32x4 bw = *(const u32x4*)((const char*)gb + ob);
                    const float b_[8] = {bf_lo(bw.x), bf_hi(bw.x), bf_lo(bw.y), bf_hi(bw.y), bf_lo(bw.z), bf_hi(bw.z), bf_lo(bw.w), bf_hi(bw.w)};
                    float v[8];
#pragma unroll
                    for (int i = 0; i < 4; ++i) { v[i] = a0[i] * __builtin_fmaxf(b_[i], 6.103515625e-5f); v[4 + i] = a1[i] * __builtin_fmaxf(b_[4 + i], 6.103515625e-5f); }
                    u32x4 w; w.x = cvt_pk_bf16(v[0], v[1]); w.y = cvt_pk_bf16(v[2], v[3]); w.z = cvt_pk_bf16(v[4], v[5]); w.w = cvt_pk_bf16(v[6], v[7]);
                    *(u32x4*)((char*)merged + ob) = w; }
                asm volatile("" ::: "memory"); }
    }
};
struct EpiOut {
    static constexpr bool PERM = true;
    const float* xin; const bf16_t* xb; bf16_t* pre;
    __device__ __forceinline__ void operator()(const f32x4 (&acc)[2][2][4][2], const Unit& u, int wr, int wc, int fr, int fq) const {
        const int row0 = u.pm * 256 + wr * 64 + fr, col0 = u.pn * 256 + wc * 32 + 8 * fq;
#pragma unroll
        for (int ai = 0; ai < 2; ++ai)
#pragma unroll
            for (int m = 0; m < 4; ++m) { const size_t ro = (size_t)(row0 + ai * 128 + m * 16) * D_MODEL + col0;
#pragma unroll
                for (int bj = 0; bj < 2; ++bj) { f32x4 x0, x1;
                    if (xin) { x0 = *(const f32x4*)(xin + ro + bj * 128); x1 = *(const f32x4*)(xin + ro + bj * 128 + 4); }
                    else { const u32x4 xw = *(const u32x4*)(xb + ro + bj * 128); x0 = (f32x4){bf_lo(xw.x), bf_hi(xw.x), bf_lo(xw.y), bf_hi(xw.y)}; x1 = (f32x4){bf_lo(xw.z), bf_hi(xw.z), bf_lo(xw.w), bf_hi(xw.w)}; }
                    const f32x4 v0 = x0 * ALPHA + acc[ai][bj][m][0], v1 = x1 * ALPHA + acc[ai][bj][m][1];
                    u32x4 w; w.x = cvt_pk_bf16(v0[0], v0[1]); w.y = cvt_pk_bf16(v0[2], v0[3]); w.z = cvt_pk_bf16(v1[0], v1[1]); w.w = cvt_pk_bf16(v1[2], v1[3]);
                    *(u32x4*)(pre + ro + bj * 128) = w; } }
    }
};
struct EpiGU {
    static constexpr bool PERM = true;
    bf16_t* h;
    __device__ __forceinline__ void operator()(const f32x4 (&acc)[2][2][4][2], const Unit& u, int wr, int wc, int fr, int fq) const {
        const int row0 = u.x2 + wr * 64 + fr, col0 = u.pn * 128 + wc * 32 + 8 * fq;
#pragma unroll
        for (int ai = 0; ai < 2; ++ai)
#pragma unroll
            for (int m = 0; m < 4; ++m) { bf16_t* rowp = h + (size_t)(row0 + ai * 128 + m * 16) * FE + col0; float v[8];
#pragma unroll
                for (int n = 0; n < 2; ++n)
#pragma unroll
                    for (int i = 0; i < 4; ++i) { const float g = acc[ai][0][m][n][i], uu = acc[ai][1][m][n][i]; v[n * 4 + i] = g * sigmoidf_(g) * uu; }
                u32x4 w; w.x = cvt_pk_bf16(v[0], v[1]); w.y = cvt_pk_bf16(v[2], v[3]); w.z = cvt_pk_bf16(v[4], v[5]); w.w = cvt_pk_bf16(v[6], v[7]);
                *(u32x4*)rowp = w; }
    }
};
struct EpiDown {
    static constexpr bool PERM = true;
    bf16_t* y; const LAS int* ent;
    __device__ __forceinline__ void operator()(const f32x4 (&acc)[2][2][4][2], const Unit& u, int wr, int wc, int fr, int fq) const {
        const LAS int* lp = ent + u.x3 * 256;
        const int col0 = u.pn * 256 + wc * 32 + 8 * fq;
#pragma unroll
        for (int ai = 0; ai < 2; ++ai)
#pragma unroll
            for (int m = 0; m < 4; ++m) { const int entry = lp[ai * 128 + wr * 64 + m * 16 + fr];
                if (entry >= 0) { bf16_t* rowp = y + (size_t)entry * D_MODEL + col0;
#pragma unroll
                    for (int bj = 0; bj < 2; ++bj) { const f32x4 v0 = acc[ai][bj][m][0], v1 = acc[ai][bj][m][1];
                        u32x4 w; w.x = cvt_pk_bf16(v0[0], v0[1]); w.y = cvt_pk_bf16(v0[2], v0[3]); w.z = cvt_pk_bf16(v1[0], v1[1]); w.w = cvt_pk_bf16(v1[2], v1[3]);
                        *(u32x4*)(rowp + bj * 128) = w; } } }
    }
};

namespace att {
constexpr int DM = WA, DMQ = D_MODEL;
constexpr int SLOTB = 8192, NSLOT = 8, PFD = 3;
constexpr int LDS_K = 0, LDS_V = NSLOT * SLOTB, LDS_WS = LDSCTL_OFF + 4096, LDS_TAB = LDS_WS + 8 * 256, LDS_FLG = LDS_TAB + 1024, LDS_END = LDS_FLG + 64, LDS_OST = 0;
static_assert(2 * NSLOT * SLOTB <= RING_BYTES && LDS_END <= LDS_BYTES, "attention LDS map");
#define SBAR() __builtin_amdgcn_sched_barrier(0)
#define WAIT_BAR0() asm volatile("s_waitcnt vmcnt(0) lgkmcnt(0)\n\ts_barrier" ::: "memory")
#define WAIT_BARN(N) asm volatile("s_waitcnt vmcnt(" #N ") lgkmcnt(0)\n\ts_barrier" ::: "memory")
#define STEP_WAIT(tcur, tlow) do { if ((tcur) - 2 >= (tlow)) { WAIT_BARN(4); } else if ((tcur) - 1 >= (tlow)) { WAIT_BARN(2); } else { WAIT_BAR0(); } } while (0)
__device__ __forceinline__ int crow(int r, int hi) { return (r & 3) + 8 * (r >> 2) + 4 * hi; }
__device__ __forceinline__ void glds16(const void* gsrc, unsigned lds_dst) { unsigned keep;
    asm volatile("s_mov_b32 %0, m0\n\ts_mov_b32 m0, %2\n\ts_nop 0\n\tglobal_load_lds_dwordx4 %1, off\n\ts_mov_b32 m0, %0" : "=&s"(keep) : "v"(gsrc), "s"(lds_dst) : "memory"); }
__device__ __forceinline__ float max3f(float a, float b, float c) { return __builtin_fmaxf(__builtin_fmaxf(a, b), c); }
__device__ __forceinline__ void qkt(f32x16& p0, f32x16& p1, const LAS char* Kslot, const bf16x8* qr, const f32x16& cin, int r32, int hi) {
    const LAS char* kb = Kslot + hi * 1024 + r32 * 16;
#pragma unroll
    for (int d0 = 0; d0 < 4; ++d0) {
        const bf16x8 b0 = *(const LAS bf16x8*)(kb + d0 * 2048);
        const bf16x8 b1 = *(const LAS bf16x8*)(kb + d0 * 2048 + 512);
        if (d0 == 0) { p0 = MFMA32(b0, qr[0], cin); p1 = MFMA32(b1, qr[0], cin); }
        else { p0 = MFMA32(b0, qr[d0], p0); p1 = MFMA32(b1, qr[d0], p1); } }
}
__device__ __forceinline__ float rowmax(const f32x16& p0, const f32x16& p1) {
    float a = max3f(p0[0], p0[1], p1[0]), b = max3f(p0[2], p0[3], p1[1]); a = max3f(a, p1[2], p1[3]);
#pragma unroll
    for (int r = 4; r < 16; r += 4) { a = max3f(a, p0[r], p0[r + 1]); b = max3f(b, p0[r + 2], p0[r + 3]); a = max3f(a, p1[r], p1[r + 1]); b = max3f(b, p1[r + 2], p1[r + 3]); }
    const float m = __builtin_fmaxf(a, b);
    auto rr = __builtin_amdgcn_permlane32_swap(__float_as_uint(m), __float_as_uint(m), false, false);
    return __builtin_fmaxf(__uint_as_float(rr[0]), __uint_as_float(rr[1]));
}
__device__ __forceinline__ void pv(f32x16* o, int vb, bf16x8 pa0, bf16x8 pa1, bf16x8 pa2, bf16x8 pa3) {
#pragma unroll
    for (int d0 = 0; d0 < 2; ++d0) { s16x4 lo[4], hi[4];
#pragma unroll
        for (int ks = 0; ks < 4; ++ks) {
            asm volatile("ds_read_b64_tr_b16 %0,%1 offset:%c2" : "=&v"(lo[ks]) : "v"(vb), "i"(d0 * 4096 + ks * 1024) : "memory");
            asm volatile("ds_read_b64_tr_b16 %0,%1 offset:%c2" : "=&v"(hi[ks]) : "v"(vb), "i"(d0 * 4096 + ks * 1024 + 512) : "memory"); }
        asm volatile("s_waitcnt lgkmcnt(0)" ::: "memory"); SBAR();
#define PK(k) (bf16x8){lo[k][0], lo[k][1], lo[k][2], lo[k][3], hi[k][0], hi[k][1], hi[k][2], hi[k][3]}
        o[d0] = MFMA32(pa0, PK(0), o[d0]);
        o[d0] = MFMA32(pa1, PK(1), o[d0]);
        o[d0] = MFMA32(pa2, PK(2), o[d0]);
        o[d0] = MFMA32(pa3, PK(3), o[d0]);
#undef PK
    }
}
#define PKW(P, B) cvt_pk_bf16(P[B], P[B + 1])
__device__ __forceinline__ void store_o(const f32x16* o, const float* rs, bf16_t* Ow, LAS char* shm, int wid, int lane, int r32, int hi) {
    LAS bf16_t* stg = (LAS bf16_t*)(shm + LDS_OST) + wid * 2048;
#pragma unroll
    for (int r = 0; r < 16; ++r) { const int orow = crow(r, hi);
#pragma unroll
        for (int d0 = 0; d0 < 2; ++d0) stg[orow * 64 + d0 * 32 + r32] = (bf16_t)(cvt_pk_bf16(o[d0][r] * rs[r], 0.f) & 0xffffu); }
    LDS_WAIT();
#pragma unroll
    for (int i = 0; i < 4; ++i) { const int row = i * 8 + (lane >> 3), ch = lane & 7; const u32x4 v = *(const LAS u32x4*)(stg + row * 64 + ch * 8); *(u32x4*)(Ow + (size_t)row * DMQ + ch * 8) = v; }
}

#define DMA_K(t) glds16(ksrc + (long)(t) * 64 * DM, (unsigned)__builtin_amdgcn_readfirstlane(kdst + ((t) & (NSLOT - 1)) * SLOTB))
#define DMA_V(t) glds16(vsrc + (long)(t) * 64 * DM, (unsigned)__builtin_amdgcn_readfirstlane(vdst + ((t) & (NSLOT - 1)) * SLOTB))
__device__ __forceinline__ void attn_a_unit(int b, int h, int u, const bf16_t* Q, const bf16_t* K, const bf16_t* V, bf16_t* O, const float* bias_h, LAS char* shm) {
    int tid_ = threadIdx.x; asm volatile("" : "+v"(tid_)); const int tid = tid_, lane = tid & 63, r32 = lane & 31, hi = lane >> 5; const int wid = __builtin_amdgcn_readfirstlane(tid >> 6);
    const long rowbase = (long)b * SEQ; const int q0 = u * 256;
    const bf16_t* Qw = Q + (rowbase + q0 + wid * 32) * DMQ + h * HD;
    const bf16_t* Kh = K + rowbase * DM + h * HD; const bf16_t* Vh = V + rowbase * DM + h * HD;
    const unsigned lds0 = (unsigned)(size_t)shm;
    LAS float* wsf = (LAS float*)(shm + LDS_WS) + wid * 64;
    LAS float* tab = (LAS float*)(shm + LDS_TAB);
    if (tid < 256) { int rel = tid - 64; rel = rel < -128 ? -128 : (rel > 128 ? 128 : rel); tab[tid] = bias_h[rel + 128] * LOG2E; }
    const float bfar = bias_h[256] * LOG2E;
    const bf16_t* ksrc = Kh + (long)lane * DM + wid * 8;
    const bf16_t* vsrc = Vh + (long)(16 * (wid & 3) + (lane >> 2)) * DM + (wid >> 2) * 32 + (lane & 3) * 8;
    const unsigned kdst = lds0 + LDS_K + wid * 1024, vdst = lds0 + LDS_V + wid * 1024;
    const int vb0 = (int)(lds0 + LDS_V) + ((lane >> 4) & 1) * 32 + (lane & 3) * 8 + (4 * hi + ((lane & 15) >> 2)) * 64;
    const int tb = 4 * u, pr = wid >> 1;
    const int nsteps = (tb + 4) < 9 ? (tb + 4) : 9;
    const int tlow = (tb - 8) > 0 ? (tb - 8) : 0;
    bf16x8 qr[4];
#pragma unroll
    for (int d0 = 0; d0 < 4; ++d0) qr[d0] = *(const bf16x8*)(Qw + (long)r32 * DMQ + d0 * 16 + hi * 8);
#pragma unroll
    for (int i = 3; i >= 1 - PFD; --i) { if (tb + i >= tlow) { DMA_K(tb + i); DMA_V(tb + i); } }
    float mhat = 0.f, l_reg = 0.f; f32x16 o[2]; o[0] = f32x16{}; o[1] = f32x16{};
    for (int s = 0; s < nsteps; ++s) {
        STEP_WAIT(tb - s, tlow);
        { const int tn = tb - s - PFD; if (tn >= tlow) { DMA_K(tn); DMA_V(tn); } }
        const int j = tb + pr - s;
        if (j >= 0) {
            const int sl = (j & (NSLOT - 1)) * SLOTB;
            const bool far = (s >= 3), first = (s == 0);
            f32x16 cin; const float c0 = (far ? bfar : 0.f) - mhat;
#pragma unroll
            for (int r = 0; r < 16; ++r) cin[r] = c0;
            f32x16 p0, p1;
            qkt(p0, p1, shm + LDS_K + sl, qr, cin, r32, hi);
            if (!far) {
                const LAS float* tp = tab + (s * 64 + 32 * (wid & 1) + r32 + 64 - 4 * hi);
#pragma unroll
                for (int r = 0; r < 16; ++r) { const int kv = (r & 3) + 8 * (r >> 2); p0[r] += tp[-kv]; p1[r] += tp[-kv - 32]; }
            }
            const float rm = rowmax(p0, p1);
            bool upd; float dl;
            if (first) { upd = true; dl = rm; } else { upd = __any(rm > 8.f) != 0; dl = __builtin_fmaxf(rm, 0.f); }
            if (upd) {
                mhat += dl;
#pragma unroll
                for (int r = 0; r < 16; ++r) { p0[r] -= dl; p1[r] -= dl; }
                if (!first) { const float f = fast_exp2(-dl); l_reg *= f; if (hi == 0) wsf[r32] = f; LDS_WAIT();
#pragma unroll
                    for (int r = 0; r < 16; ++r) { const float fr_ = wsf[crow(r, hi)]; o[0][r] *= fr_; o[1][r] *= fr_; } }
            }
            float sacc = 0.f;
#pragma unroll
            for (int r = 0; r < 16; ++r) { p0[r] = fast_exp2(p0[r]); p1[r] = fast_exp2(p1[r]); sacc += p0[r] + p1[r]; }
            l_reg += sacc;
            u32x4 pw0 = (u32x4){PKW(p0, 0), PKW(p0, 2), PKW(p0, 4), PKW(p0, 6)}, pw1 = (u32x4){PKW(p0, 8), PKW(p0, 10), PKW(p0, 12), PKW(p0, 14)};
            u32x4 pw2 = (u32x4){PKW(p1, 0), PKW(p1, 2), PKW(p1, 4), PKW(p1, 6)}, pw3 = (u32x4){PKW(p1, 8), PKW(p1, 10), PKW(p1, 12), PKW(p1, 14)};
            pv(o, vb0 + sl, __builtin_bit_cast(bf16x8, pw0), __builtin_bit_cast(bf16x8, pw1), __builtin_bit_cast(bf16x8, pw2), __builtin_bit_cast(bf16x8, pw3));
        }
    }
    { auto rr = __builtin_amdgcn_permlane32_swap(__float_as_uint(l_reg), __float_as_uint(l_reg), false, false); l_reg = __uint_as_float(rr[0]) + __uint_as_float(rr[1]); }
    if (hi == 0) wsf[32 + r32] = l_reg; LDS_WAIT();
    float rli[16];
#pragma unroll
    for (int r = 0; r < 16; ++r) rli[r] = fast_rcp(wsf[32 + crow(r, hi)]);
    asm volatile("s_waitcnt lgkmcnt(0)\n\ts_barrier" ::: "memory");
    store_o(o, rli, O + (rowbase + q0 + wid * 32) * DMQ + h * HD, shm, wid, lane, r32, hi);
    asm volatile("s_waitcnt lgkmcnt(0)\n\ts_barrier" ::: "memory");
}

__device__ __forceinline__ void attn_b_unit(int b, int h, int qb, const bf16_t* Q, const bf16_t* K, const bf16_t* V, bf16_t* O, LAS char* shm) {
    int tid_ = threadIdx.x; asm volatile("" : "+v"(tid_)); const int tid = tid_, lane = tid & 63, r32 = lane & 31, hi = lane >> 5; const int wid = __builtin_amdgcn_readfirstlane(tid >> 6);
    const long rowbase = (long)b * SEQ; const int q0 = qb * 256;
    const bf16_t* Qw = Q + (rowbase + q0 + wid * 32) * DMQ + h * HD;
    const bf16_t* Kh = K + rowbase * DM + h * HD; const bf16_t* Vh = V + rowbase * DM + h * HD;
    const unsigned lds0 = (unsigned)(size_t)shm;
    LAS unsigned* flg = (LAS unsigned*)(shm + LDS_FLG);
    const bf16_t* ksrc = Kh + (long)lane * DM + wid * 8;
    const bf16_t* vsrc = Vh + (long)(16 * (wid & 3) + (lane >> 2)) * DM + (wid >> 2) * 32 + (lane & 3) * 8;
    const unsigned kdst = lds0 + LDS_K + wid * 1024, vdst = lds0 + LDS_V + wid * 1024;
    const int vb0 = (int)(lds0 + LDS_V) + ((lane >> 4) & 1) * 32 + (lane & 3) * 8 + (4 * hi + ((lane & 15) >> 2)) * 64;
    const int tb = 4 * qb, pr = wid >> 1;
    const int tq = 32 * (wid & 1) + r32;
    bf16x8 qr[4];
#pragma unroll
    for (int d0 = 0; d0 < 4; ++d0) qr[d0] = *(const bf16x8*)(Qw + (long)r32 * DMQ + d0 * 16 + hi * 8);
#pragma unroll
    for (int i = 3; i >= 1 - PFD; --i) { if (tb + i >= 0) { DMA_K(tb + i); DMA_V(tb + i); } }
    float R = 1.0f; bool wdone = false; f32x16 o[2]; o[0] = f32x16{}; o[1] = f32x16{};
    for (int s = 0; ; ++s) {
        STEP_WAIT(tb - s, 0);
        if (s > 0) { const LAS unsigned* f = flg + ((s - 1) & 1) * 8; unsigned all = 1u;
#pragma unroll
            for (int w = 0; w < 8; ++w) all &= f[w];
            if (__builtin_amdgcn_readfirstlane(all) != 0u) break; }
        { const int tn = tb - s - PFD; if (tn >= 0) { DMA_K(tn); DMA_V(tn); } }
        const int j = tb + pr - s;
        if (j >= 0 && !wdone) {
            const int sl = (j & (NSLOT - 1)) * SLOTB;
            f32x16 cin = f32x16{}; f32x16 p0, p1;
            qkt(p0, p1, shm + LDS_K + sl, qr, cin, r32, hi);
#pragma unroll
            for (int r = 0; r < 16; ++r) { p0[r] = fast_rcp(1.0f + fast_exp2(p0[r])); p1[r] = fast_rcp(1.0f + fast_exp2(p1[r])); }
            if (s == 0) {
#pragma unroll
                for (int r = 0; r < 16; ++r) { const int kv = crow(r, hi); if (kv >= tq) p0[r] = 1.0f; if (kv + 32 >= tq) p1[r] = 1.0f; } }
            float W[8], part[8];
#pragma unroll
            for (int i = 0; i < 8; ++i) { const float pb = (i < 4) ? (p0[4 * i] * p0[4 * i + 1]) * (p0[4 * i + 2] * p0[4 * i + 3]) : (p1[4 * i - 16] * p1[4 * i - 15]) * (p1[4 * i - 14] * p1[4 * i - 13]);
                auto rr = __builtin_amdgcn_permlane32_swap(__float_as_uint(pb), __float_as_uint(pb), false, false);
                const float vlo = __uint_as_float(rr[0]), vhi = __uint_as_float(rr[1]);
                W[i] = vlo * vhi; part[i] = hi ? 1.0f : vhi; }
            float sw = R;
#pragma unroll
            for (int i = 7; i >= 0; --i) { float c = sw * part[i];
                if (i < 4) {
#pragma unroll
                    for (int rr_ = 3; rr_ >= 0; --rr_) { const float t_ = c * p0[4 * i + rr_]; p0[4 * i + rr_] = c - t_; c = t_; } }
                else {
#pragma unroll
                    for (int rr_ = 3; rr_ >= 0; --rr_) { const float t_ = c * p1[4 * i - 16 + rr_]; p1[4 * i - 16 + rr_] = c - t_; c = t_; } }
                sw *= W[i]; }
            R = sw;
            u32x4 pw0 = (u32x4){PKW(p0, 0), PKW(p0, 2), PKW(p0, 4), PKW(p0, 6)}, pw1 = (u32x4){PKW(p0, 8), PKW(p0, 10), PKW(p0, 12), PKW(p0, 14)};
            u32x4 pw2 = (u32x4){PKW(p1, 0), PKW(p1, 2), PKW(p1, 4), PKW(p1, 6)}, pw3 = (u32x4){PKW(p1, 8), PKW(p1, 10), PKW(p1, 12), PKW(p1, 14)};
            pv(o, vb0 + sl, __builtin_bit_cast(bf16x8, pw0), __builtin_bit_cast(bf16x8, pw1), __builtin_bit_cast(bf16x8, pw2), __builtin_bit_cast(bf16x8, pw3));
            wdone = __all(R == 0.0f) != 0;
        }
        if (j <= 0) wdone = true;
        if (lane == 0) flg[(s & 1) * 8 + wid] = wdone ? 1u : 0u;
    }
    float ones[16];
#pragma unroll
    for (int r = 0; r < 16; ++r) ones[r] = 1.0f;
    asm volatile("s_waitcnt vmcnt(0) lgkmcnt(0)\n\ts_barrier" ::: "memory");
    store_o(o, ones, O + (rowbase + q0 + wid * 32) * DMQ + h * HD, shm, wid, lane, r32, hi);
    asm volatile("s_waitcnt lgkmcnt(0)\n\ts_barrier" ::: "memory");
}
#undef DMA_K
#undef DMA_V
#undef PKW
#undef SBAR
#undef WAIT_BAR0
}

#define XB_TMO      128
#define XB_XCNT(j)  (256  + 64 * (j))
#define XB_XSUB(j)  (1280 + 64 * (j))
#define XB_XGEN(j)  (2304 + 64 * (j))
#define XB_TOP      3328
#define XB_TOPGEN   3392
#define XCD_BAR_WORDS 3456
#define XB_SPIN_CAP (1u << 22)
__device__ __forceinline__ unsigned xb_ld(unsigned* p)              { return __hip_atomic_load(p, __ATOMIC_RELAXED, __HIP_MEMORY_SCOPE_AGENT); }
__device__ __forceinline__ unsigned xb_add(unsigned* p, unsigned v) { return __hip_atomic_fetch_add(p, v, __ATOMIC_RELAXED, __HIP_MEMORY_SCOPE_AGENT); }
__device__ __forceinline__ unsigned xb_xcc_id() { return (unsigned)__builtin_amdgcn_s_getreg((3 << 11) | 20) & 0xFu; }
#define XB_SPIN(cond, bar) do { unsigned _sp = 0; while (cond) { __builtin_amdgcn_s_sleep(1); \
    if ((++_sp & 255u) == 0u) { if (xb_ld(&(bar)[XB_TMO])) break; if (_sp > XB_SPIN_CAP) { atomicAdd(&(bar)[XB_TMO], 1u); break; } } } } while (0)
struct XcdBarrier { unsigned* bar; unsigned x; volatile LAS unsigned* st; };
__device__ __forceinline__ XcdBarrier xcd_barrier_post(unsigned* bar, volatile LAS unsigned* st) {
    XcdBarrier b; b.bar = bar; b.x = xb_xcc_id(); b.st = st;
    if (threadIdx.x == 0) (void)xb_add(&bar[XB_XCNT(b.x)], 1u);
    return b;
}
__device__ __forceinline__ void xcd_barrier_complete(unsigned* bar, unsigned x, unsigned& nloc, unsigned& nx) {
    const unsigned G = gridDim.x * gridDim.y * gridDim.z;
    unsigned sum, cnt, mine, sp = 0u;
    for (;;) {
        sum = 0u; cnt = 0u; mine = 0u;
#pragma unroll
        for (unsigned j = 0; j < 16; ++j) { const unsigned c = xb_ld(&bar[XB_XCNT(j)]); sum += c; cnt += (c > 0u) ? 1u : 0u; mine = (j == x) ? c : mine; }
        if (sum == G) break;
        __builtin_amdgcn_s_sleep(1);
        if ((++sp & 255u) == 0u) { if (xb_ld(&bar[XB_TMO])) break; if (sp > XB_SPIN_CAP) { atomicAdd(&bar[XB_TMO], 1u); break; } }
    }
    nloc = mine > 0u ? mine : 1u; nx = cnt > 0u ? cnt : 1u;
}
__device__ __forceinline__ void xcd_barrier(const XcdBarrier& b) {
    asm volatile("s_waitcnt vmcnt(0)" ::: "memory");
    __syncthreads();
    if (threadIdx.x == 0) {
        unsigned* bar = b.bar;
        __builtin_amdgcn_s_waitcnt(0);
        unsigned nloc = b.st[0], nx = b.st[1];
        if (nloc == 0u) { xcd_barrier_complete(bar, b.x, nloc, nx); b.st[0] = nloc; b.st[1] = nx; }
        const unsigned old = xb_add(&bar[XB_XSUB(b.x)], 1u);
        const unsigned gen = old / nloc;
        if (old + 1u == (gen + 1u) * nloc) {
            __builtin_amdgcn_fence(__ATOMIC_RELEASE, "agent");
            asm volatile("s_waitcnt vmcnt(0)" ::: "memory");
            const unsigned og = xb_add(&bar[XB_TOP], 1u);
            const unsigned tg = og / nx;
            if (og + 1u == (tg + 1u) * nx) xb_add(&bar[XB_TOPGEN], 1u);
            else XB_SPIN(xb_ld(&bar[XB_TOPGEN]) == tg, bar);
            __builtin_amdgcn_fence(__ATOMIC_ACQUIRE, "agent");
            xb_add(&bar[XB_XGEN(b.x)], 1u);
            asm volatile("s_waitcnt vmcnt(0)" ::: "memory");
        } else {
            XB_SPIN(xb_ld(&bar[XB_XGEN(b.x)]) == gen, bar);
            __builtin_amdgcn_fence(__ATOMIC_ACQUIRE, "agent");
            asm volatile("s_waitcnt vmcnt(0)" ::: "memory");
        }
    }
    __syncthreads();
}

__device__ __forceinline__ unsigned f2bf(float f) { unsigned u = __builtin_bit_cast(unsigned, f); return (u + 0x7fffu + ((u >> 16) & 1u)) >> 16; }
__device__ __forceinline__ unsigned pk2(float lo, float hi) { return cvt_pk_bf16(lo, hi); }
__device__ __forceinline__ void transpose_item(const float* W, int K, int N, bf16_t* WT, int row_off, LAS float* scr, int item, int lane, int ldw = 0, int koff = 0) {
    if (ldw == 0) ldw = K;
    const int nblk = N / 32, kb = item / nblk, nb = item % nblk, k0 = 64 * kb, n0 = 32 * nb;
    f32x4 ld[8];
#pragma unroll
    for (int i = 0; i < 8; ++i) ld[i] = *(const f32x4*)(W + (size_t)(k0 + 8 * i + (lane >> 3)) * N + n0 + 4 * (lane & 7));
#pragma unroll
    for (int i = 0; i < 8; ++i) { LAS float* d = scr + (8 * i + (lane >> 3)) * 33 + 4 * (lane & 7); d[0] = ld[i].x; d[1] = ld[i].y; d[2] = ld[i].z; d[3] = ld[i].w; }
    LDS_WAIT(); asm volatile("" ::: "memory");
    const int c = lane & 7;
#pragma unroll
    for (int j = 0; j < 4; ++j) { const int n = (lane >> 3) + 8 * j; const LAS float* s = scr + (8 * c) * 33 + n;
        u32x4 o; o.x = pk2(s[0 * 33], s[1 * 33]); o.y = pk2(s[2 * 33], s[3 * 33]); o.z = pk2(s[4 * 33], s[5 * 33]); o.w = pk2(s[6 * 33], s[7 * 33]);
        *(u32x4*)(WT + (size_t)(row_off + n0 + n) * ldw + koff + k0 + 8 * c) = o; }
    LDS_WAIT(); asm volatile("" ::: "memory");
}

struct Args { const float* in[15]; float* out; unsigned char* ws; int ph_lo, ph_hi, li, pad; };
typedef const __attribute__((address_space(4))) char* kptr_t;
__device__ __forceinline__ kptr_t kbase() { kptr_t kp = (kptr_t)__builtin_amdgcn_kernarg_segment_ptr(); asm volatile("" : "+s"(kp)); return kp; }
__device__ __forceinline__ const float* arg_in(int i) { return *(const float* const __attribute__((address_space(4)))*)(kbase() + 8 * i); }
__device__ __forceinline__ float* arg_out() { return *(float* const __attribute__((address_space(4)))*)(kbase() + 120); }
__device__ __forceinline__ unsigned char* arg_ws() { return *(unsigned char* const __attribute__((address_space(4)))*)(kbase() + 128); }
__device__ __forceinline__ int arg_lo() { return *(const __attribute__((address_space(4))) int*)(kbase() + 136); }
__device__ __forceinline__ int arg_hi() { return *(const __attribute__((address_space(4))) int*)(kbase() + 140); }
__device__ __forceinline__ int arg_li() { return *(const __attribute__((address_space(4))) int*)(kbase() + 144); }
static_assert(sizeof(Args) == 152, "Args layout");

constexpr int NWAVES = 8;
constexpr int PH_PER_LAYER = 8, N_PHASES = 1 + DEPTH * PH_PER_LAYER;
#define PH_COMMON() int tid_ = threadIdx.x; asm volatile("" : "+v"(tid_)); const int tid = tid_, lane = tid & 63, wave = __builtin_amdgcn_readfirstlane(tid >> 6); const int G = gridDim.x, bx = blockIdx.x; \
    const int vcu = (G % 8 == 0) ? (bx % 8) * (G / 8) + bx / 8 : bx; const int gw = vcu * NWAVES + wave, NGW = G * NWAVES; unsigned char* ws = arg_ws(); \
    (void)tid; (void)lane; (void)wave; (void)vcu; (void)gw; (void)NGW; (void)ws

__device__ __forceinline__ void convert_weights(int l, LAS unsigned char* lds) {
    PH_COMMON();
    LAS float* scr = (LAS float*)(lds + wave * 16384);
    const float* w_in = arg_in(1) + (size_t)l * D_MODEL * PROJ;
    const float* w_upa = arg_in(3) + (size_t)l * WA * D_MODEL;
    const float* w_upb = arg_in(4) + (size_t)l * WA * D_MODEL;
    const float* w_out = arg_in(5) + (size_t)l * D_MODEL * D_MODEL;
    const float* w_gate = arg_in(10) + (size_t)l * NE * D_MODEL * FE;
    const float* w_up = arg_in(11) + (size_t)l * NE * D_MODEL * FE;
    const float* w_down = arg_in(12) + (size_t)l * NE * FE * D_MODEL;
    constexpr int I_IN = (D_MODEL / 64) * (PROJ / 32), I_UP = (WA / 64) * (D_MODEL / 32), I_OUT = (D_MODEL / 64) * (D_MODEL / 32);
    constexpr int I_G = (D_MODEL / 64) * (FE / 32), I_D = (FE / 64) * (D_MODEL / 32);
    constexpr int NITEMS = I_IN + 2 * I_UP + I_OUT + NE * (2 * I_G + I_D);
    for (int it = gw; it < NITEMS; it += NGW) {
        int r = it;
        if (r < I_IN) { transpose_item(w_in, D_MODEL, PROJ, (bf16_t*)(ws + WS_WIN), 0, scr, r, lane); continue; } r -= I_IN;
        if (r < I_UP) { transpose_item(w_upa, WA, D_MODEL, (bf16_t*)(ws + WS_WUP), 0, scr, r, lane, D_MODEL, 0); continue; } r -= I_UP;
        if (r < I_UP) { transpose_item(w_upb, WA, D_MODEL, (bf16_t*)(ws + WS_WUP), 0, scr, r, lane, D_MODEL, WA); continue; } r -= I_UP;
        if (r < I_OUT) { transpose_item(w_out, D_MODEL, D_MODEL, (bf16_t*)(ws + WS_WOUT), 0, scr, r, lane); continue; } r -= I_OUT;
        const int e = r / (2 * I_G + I_D); r -= e * (2 * I_G + I_D);
        if (r < 2 * I_G) { const int up = r >= I_G; if (up) r -= I_G;
            const int nb = r % (FE / 32), n0 = nb * 32;
            const int row_off = e * 1024 + (n0 / 128) * 128 + (up ? 128 : 0);
            transpose_item((up ? w_up : w_gate) + (size_t)e * D_MODEL * FE, D_MODEL, FE, (bf16_t*)(ws + WS_WGU), row_off, scr, r, lane); continue; }
        r -= 2 * I_G;
        transpose_item(w_down + (size_t)e * FE * D_MODEL, FE, D_MODEL, (bf16_t*)(ws + WS_WD), e * 1024, scr, r, lane);
    }
}

__device__ __forceinline__ void phase0(LAS unsigned char* lds) {
    convert_weights(0, lds);
    PH_COMMON();
    const float* x_in = arg_in(0); bf16_t* XB = (bf16_t*)(ws + WS_XB);
    {
        const float* w_router = arg_in(8); const float* b_router = arg_in(9);
        for (int p = gw * 64 + lane; p < DEPTH * 2048; p += NGW * 64) { const int ll = p >> 11, q = p & 2047, kt = q >> 6, ln = q & 63, n = ln & 15, c0 = 32 * kt + 8 * (ln >> 4);
            const float* g1 = arg_in(6) + (size_t)ll * D_MODEL; unsigned hw[4], lw[4];
#pragma unroll
            for (int j = 0; j < 4; ++j) { const float w0 = g1[c0 + 2 * j] * w_router[(c0 + 2 * j) * 16 + n], w1 = g1[c0 + 2 * j + 1] * w_router[(c0 + 2 * j + 1) * 16 + n];
                hw[j] = cvt_pk_bf16(w0, w1); lw[j] = cvt_pk_bf16(w0 - bf_lo(hw[j]), w1 - bf_hi(hw[j])); }
            unsigned char* tb = ws + WS_RTAB + (size_t)ll * RTAB_STRIDE;
            *(u32x4*)(tb + q * 16) = (u32x4){hw[0], hw[1], hw[2], hw[3]}; *(u32x4*)(tb + 32768 + q * 16) = (u32x4){lw[0], lw[1], lw[2], lw[3]}; }
        for (int idx = gw; idx < DEPTH * 32; idx += NGW) { const int ll = idx >> 5, wh = (idx >> 4) & 1, e = idx & 15;
            const float* vv = (wh ? arg_in(7) : arg_in(6)) + (size_t)ll * D_MODEL; float s = 0.f;
            for (int c = lane; c < D_MODEL; c += 64) s += vv[c] * w_router[c * 16 + e];
            s = wave_sum(s); if (wh) s += b_router[e];
            if (lane == 0) ((float*)(ws + WS_RTAB + (size_t)ll * RTAB_STRIDE + 65536))[wh * 16 + e] = s; }
    }
    for (int m = gw; m < T; m += NGW) { const f32x4* xr = (const f32x4*)(x_in + (size_t)m * D_MODEL) + lane; u32x2* o8 = (u32x2*)(XB + (size_t)m * D_MODEL) + lane;
#pragma unroll
        for (int j = 0; j < 4; ++j) { const f32x4 v = xr[64 * j]; u32x2 w; w.x = cvt_pk_bf16(v.x, v.y); w.y = cvt_pk_bf16(v.z, v.w); o8[64 * j] = w; } }
}
__device__ __forceinline__ void phase1(LAS unsigned char* lds) {
    PH_COMMON();
    pg8::SchedPlain S; S.o.init(T / 256, PROJ / 256, G, bx); S.A = (const char*)(ws + WS_XB); S.B = (const char*)(ws + WS_WIN); S.tstep = (size_t)256 * D_MODEL * 2;
    EpiInProj E{ws};
    pg8::gemm_phase<EpiInProj, pg8::SchedPlain, false, true>(lds, D_MODEL, S, E);
}
__device__ __forceinline__ void phase2(LAS unsigned char* lds, int l) {
    PH_COMMON();
    const int bh = vcu >> 2, s = vcu & 3; const int b = bh >> 3, h = bh & 7;
    if (G != 256) return;
    const float* bias_h = arg_in(2) + ((size_t)l * NH + h) * N_REL;
    bf16_t* QAp = (bf16_t*)(ws + WS_QQ); bf16_t* KAp = (bf16_t*)(ws + WS_KA); bf16_t* VAp = (bf16_t*)(ws + WS_VA);
    bf16_t* QBp = (bf16_t*)(ws + WS_QQ) + WA; bf16_t* KBp = (bf16_t*)(ws + WS_KB); bf16_t* VBp = (bf16_t*)(ws + WS_VB);
    PBS_BEGIN(6, lds);
    for (int i = 0; i < 4; ++i) { const int u = (i == 0) ? s : (i == 1) ? 7 - s : (i == 2) ? 8 + s : 15 - s; att::attn_a_unit(b, h, u, QAp, KAp, VAp, QAp, bias_h, (LAS char*)lds); }
    PBS_END(6, lds); PBS_BEGIN(7, lds);
    for (int i = 0; i < 4; ++i) { const int u = (i == 0) ? s : (i == 1) ? 7 - s : (i == 2) ? 8 + s : 15 - s; att::attn_b_unit(b, h, u, QBp, KBp, VBp, QBp, (LAS char*)lds); }
    PBS_END(7, lds);
}
__device__ __forceinline__ void phase3(LAS unsigned char* lds) {
    PH_COMMON();
    pg8::SchedTwo S; S.o.init(T / 256, D_MODEL / 256, G, bx); S.A = (const char*)(ws + WS_QQ); S.B = (const char*)(ws + WS_WUP); S.tstep = (size_t)256 * D_MODEL * 2;
    EpiMerge E{(const bf16_t*)(ws + WS_GA), (const bf16_t*)(ws + WS_GB), (bf16_t*)(ws + WS_MERGED)};
    pg8::gemm_phase<EpiMerge, pg8::SchedTwo, false, true, true>(lds, WA, S, E, D_MODEL);
}
__device__ __forceinline__ void phase4(LAS unsigned char* lds, int l) {
    PH_COMMON();
    pg8::SchedPlain S; S.o.init(T / 256, D_MODEL / 256, G, bx); S.A = (const char*)(ws + WS_MERGED); S.B = (const char*)(ws + WS_WOUT); S.tstep = (size_t)256 * D_MODEL * 2;
    EpiOut E{(l == 0) ? arg_in(0) : (const float*)nullptr, (const bf16_t*)(ws + WS_XB), (bf16_t*)(ws + WS_PRE)};
    pg8::gemm_phase<EpiOut, pg8::SchedPlain, false, true>(lds, D_MODEL, S, E);
}
#define dppf(v, ctrl) __builtin_bit_cast(float, __builtin_amdgcn_update_dpp(__builtin_bit_cast(int, (float)(v)), __builtin_bit_cast(int, (float)(v)), ctrl, 0xf, 0xf, false))
#define dppi(v, ctrl) __builtin_amdgcn_update_dpp((int)(v), (int)(v), ctrl, 0xf, 0xf, false)
__device__ __forceinline__ void phase5(LAS unsigned char* lds, int l) {
    static_assert(USE_F16 == 1, "the MFMA router path takes the pre-LN tensor as IEEE half");
    PH_COMMON();
    const float* g1 = arg_in(6) + (size_t)l * D_MODEL; const float* b1 = arg_in(7) + (size_t)l * D_MODEL;
    bf16_t* XB = (bf16_t*)(ws + WS_XB); const bf16_t* PRE = (const bf16_t*)(ws + WS_PRE);
    int* LIST = (int*)(ws + WS_LIST); f32x2* RECW = (f32x2*)(ws + WS_RECW);
    unsigned* gcnt = (unsigned*)(ws + WS_CTL) + CW_CNT + 64 * l;
    PBS_BEGIN(1, lds);
    LAS float* S23 = (LAS float*)(lds + 69632); LAS f32x2* rstat = (LAS f32x2*)(lds + 70656) + wave * 16;
    LAS unsigned* lcnt = (LAS unsigned*)(lds + 81920);
    LAS int* lrec = (LAS int*)(lds + 81920 + 256);
    { const unsigned char* tb = ws + WS_RTAB + (size_t)l * RTAB_STRIDE;
        for (int i = tid; i < 4096; i += NWAVES * 64) ((LAS u32x4*)lds)[i] = ((const u32x4*)tb)[i];
        if (tid < 32) { S23[tid] = ((const float*)(tb + 65536))[tid]; lcnt[tid] = 0u; } }
    __syncthreads();
    PBS_END(1, lds); PBS_BEGIN(2, lds);
    int krow = 0;
    u32x2 nv[4];
    { const u32x2* pr = (const u32x2*)(PRE + (size_t)gw * D_MODEL) + lane;
#pragma unroll
      for (int j = 0; j < 4; ++j) nv[j] = pr[64 * j]; }
    for (int m = gw; m < T; m += NGW, ++krow) {
        f32x4 v[4]; float s = 0.f;
#pragma unroll
        for (int j = 0; j < 4; ++j) { v[j] = (f32x4){bf_lo(nv[j].x), bf_hi(nv[j].x), bf_lo(nv[j].y), bf_hi(nv[j].y)}; s += (v[j].x + v[j].y) + (v[j].z + v[j].w); }
        if (m + NGW < T) { const u32x2* pr = (const u32x2*)(PRE + (size_t)(m + NGW) * D_MODEL) + lane;
#pragma unroll
            for (int j = 0; j < 4; ++j) nv[j] = pr[64 * j]; }
        const float mean = wave_sum(s) * (1.f / D_MODEL); float s2 = 0.f;
#pragma unroll
        for (int j = 0; j < 4; ++j) { v[j] = v[j] - mean; s2 += (v[j].x * v[j].x + v[j].y * v[j].y) + (v[j].z * v[j].z + v[j].w * v[j].w); }
        const float rstd = 1.f / sqrtf(wave_sum(s2) * (1.f / D_MODEL) + LN_EPS);
        if (lane == 0) rstat[krow] = (f32x2){mean, rstd};
#pragma unroll
        for (int j = 0; j < 4; ++j) { const f32x4 gg = *((const f32x4*)g1 + lane + 64 * j), bb = *((const f32x4*)b1 + lane + 64 * j);
            v[j] = v[j] * rstd * gg + bb;
            u32x2 w; w.x = cvt_pk_bf16(v[j].x, v[j].y); w.y = cvt_pk_bf16(v[j].z, v[j].w); *((u32x2*)(XB + (size_t)m * D_MODEL) + lane + 64 * j) = w; }
    }
    {
        const int n = lane & 15, kg = lane >> 4;
        const bf16_t* arow = PRE + (size_t)(gw + n * NGW) * D_MODEL + 8 * kg;
        f32x4 acc = (f32x4){0.f, 0.f, 0.f, 0.f};
#pragma unroll 4
        for (int kt = 0; kt < 32; ++kt) { const bf16x8 a = *(const bf16x8*)(arow + 32 * kt);
            const bf16x8 bh = *(const LAS bf16x8*)(lds + (kt * 64 + lane) * 16), bl = *(const LAS bf16x8*)(lds + 32768 + (kt * 64 + lane) * 16);
            acc = MFMA16(a, bh, acc); acc = MFMA16(a, bl, acc); }
        const float s2n = S23[n], s3n = S23[16 + n];
#pragma unroll
        for (int i = 0; i < 4; ++i) {
            const int kr = 4 * kg + i; const f32x2 st = rstat[kr];
            const float v = st.y * (acc[i] - st.x * s2n) + s3n;
            float mx = v; mx = fmaxf(mx, dppf(mx, 0xB1)); mx = fmaxf(mx, dppf(mx, 0x4E)); mx = fmaxf(mx, dppf(mx, 0x141)); mx = fmaxf(mx, dppf(mx, 0x140));
            int best = (v == mx) ? n : 16; best = min(best, dppi(best, 0xB1)); best = min(best, dppi(best, 0x4E)); best = min(best, dppi(best, 0x141)); best = min(best, dppi(best, 0x140));
            const float u = (n == best) ? -3.0e38f : v;
            float m2 = u; m2 = fmaxf(m2, dppf(m2, 0xB1)); m2 = fmaxf(m2, dppf(m2, 0x4E));
            int e2 = (u == m2) ? n : 16; e2 = min(e2, dppi(e2, 0xB1)); e2 = min(e2, dppi(e2, 0x4E));
            if (n == best) { const int m = gw + kr * NGW;
                const float w1 = fast_rcp(1.0f + fast_exp2((m2 - v) * LOG2E)), w2 = 1.0f - w1;
                RECW[m] = (f32x2){w1, w2};
                const int lp1 = (int)__hip_atomic_fetch_add(lcnt + best, 1u, __ATOMIC_RELAXED, __HIP_MEMORY_SCOPE_WORKGROUP);
                const int lp2 = (int)__hip_atomic_fetch_add(lcnt + e2, 1u, __ATOMIC_RELAXED, __HIP_MEMORY_SCOPE_WORKGROUP);
                LAS int* rp = lrec + (wave * 16 + kr) * 4; rp[0] = best; rp[1] = lp1; rp[2] = e2; rp[3] = lp2; }
        }
    }
    PBS_END(2, lds);
    __syncthreads();
    PBS_BEGIN(3, lds);
    if (tid < 16) { const unsigned n = lcnt[tid]; lcnt[16 + tid] = n ? __hip_atomic_fetch_add(gcnt + tid, n, __ATOMIC_RELAXED, __HIP_MEMORY_SCOPE_AGENT) : 0u; }
    __syncthreads();
    if (lane < 16 && gw + lane * NGW < T) { const int m = gw + lane * NGW; const LAS int* rp = lrec + (wave * 16 + lane) * 4;
        LIST[(size_t)rp[0] * T + lcnt[16 + rp[0]] + rp[1]] = m * 2; LIST[(size_t)rp[2] * T + lcnt[16 + rp[2]] + rp[3]] = m * 2 + 1; }
    __syncthreads();
    PBS_END(3, lds);
}
__device__ __forceinline__ int moe_units(LAS unsigned char* lds, int l) {
    PH_COMMON();
    LAS int* utab = (LAS int*)(lds + UTAB_OFF);
    unsigned* gcnt = (unsigned*)(ws + WS_CTL) + CW_CNT + 64 * l;
    __syncthreads();
    if (tid == 0) {
        LAS int* ts = utab + 128; LAS int* ncnt = utab + 160;
        int acc_t = 0;
        for (int e = 0; e < 16; ++e) { const int n = (int)__hip_atomic_load(gcnt + e, __ATOMIC_RELAXED, __HIP_MEMORY_SCOPE_AGENT); ncnt[e] = n; ts[e] = acc_t; acc_t += (n + 255) / 256; }
        ts[16] = acc_t;
        const int nunits = acc_t * 4; int cnt = 0;
        for (int i = 0; cnt < 6; ++i) { const long L = (long)i * G + bx; if (L >= nunits) break;
            int U = (int)L; { const int q = nunits / 8, r = nunits % 8, xcd = U % 8, off = U / 8; U = (xcd < r ? xcd * (q + 1) : r * (q + 1) + (xcd - r) * q) + off; }
            const int tile = U >> 2, pn = U & 3; int e = 0; while (ts[e + 1] <= tile) ++e;
            const int mt = tile - ts[e]; const int n = ncnt[e]; const int nv = (n - 256 * mt) < 256 ? (n - 256 * mt) : 256;
            utab[cnt * 5 + 0] = e; utab[cnt * 5 + 1] = pn; utab[cnt * 5 + 2] = mt * 256; utab[cnt * 5 + 3] = nv; utab[cnt * 5 + 4] = tile * 256;
            ++cnt; }
        utab[192] = cnt;
    }
    __syncthreads();
    return utab[192];
}
__device__ __forceinline__ void phase6(LAS unsigned char* lds, int l) {
    const int nun = moe_units(lds, l);
    PH_COMMON();
    pg8::SchedMoe S; S.utab = (LAS int*)(lds + UTAB_OFF); S.nunits = nun; S.Abase = (const char*)(ws + WS_XB); S.Bbase = (const char*)(ws + WS_WGU); S.a_row_bytes = 0;
    S.b_exp_bytes = (size_t)1024 * D_MODEL * 2; S.b_tile_bytes = (size_t)256 * D_MODEL * 2; S.list = (const int*)(ws + WS_LIST); S.gather_k2 = D_MODEL * 2;
    EpiGU E{(bf16_t*)(ws + WS_H)};
    pg8::gemm_phase<EpiGU, pg8::SchedMoe, true, true>(lds, D_MODEL, S, E);
}
__device__ __forceinline__ void phase7(LAS unsigned char* lds, int l) {
    const int nun = moe_units(lds, l);
    PH_COMMON();
    pg8::SchedMoe S; S.utab = (LAS int*)(lds + UTAB_OFF); S.nunits = nun; S.Abase = (const char*)(ws + WS_H); S.Bbase = (const char*)(ws + WS_WD); S.a_row_bytes = (size_t)FE * 2;
    S.b_exp_bytes = (size_t)1024 * FE * 2; S.b_tile_bytes = (size_t)256 * FE * 2; S.list = (const int*)(ws + WS_LIST); S.gather_k2 = 0;
    LAS int* ent = (LAS int*)(lds + LDSCTL_OFF + 8192);
    { const LAS int* ut = (const LAS int*)(lds + UTAB_OFF); const int* LISTp = (const int*)(ws + WS_LIST); const int nst = nun < 6 ? nun : 6;
        for (int i = tid; i < nst * 256; i += NWAVES * 64) { const int un = i >> 8, r = i & 255; const int e = ut[un * 5 + 0], lo_ = ut[un * 5 + 2], nv = ut[un * 5 + 3];
            ent[i] = (r < nv) ? LISTp[(size_t)e * T + lo_ + r] : -1; } }
    __syncthreads();
    EpiDown E{(bf16_t*)(ws + WS_Y), ent};
    pg8::gemm_phase<EpiDown, pg8::SchedMoe, false, true>(lds, FE, S, E);
}
__device__ __forceinline__ void phase8(LAS unsigned char* lds, int l) {
    PH_COMMON();
    const float* g2 = arg_in(13) + (size_t)l * D_MODEL; const float* b2 = arg_in(14) + (size_t)l * D_MODEL;
    float* xout = arg_out(); bf16_t* XB = (bf16_t*)(ws + WS_XB); const bf16_t* Y = (const bf16_t*)(ws + WS_Y); const f32x2* RECW = (const f32x2*)(ws + WS_RECW);
    PBS_BEGIN(4, lds);
    u32x2 nx[4], na[4], nc[4]; f32x2 nw;
#define P8_LOAD(mm) do { nw = RECW[mm]; const u32x2* xr = (const u32x2*)(XB + (size_t)(mm) * D_MODEL) + lane; \
        const u32x2* y0 = (const u32x2*)(Y + (size_t)(2 * (mm)) * D_MODEL) + lane; const u32x2* y1 = (const u32x2*)(Y + (size_t)(2 * (mm) + 1) * D_MODEL) + lane; \
        _Pragma("unroll") for (int j = 0; j < 4; ++j) { nx[j] = xr[64 * j]; na[j] = y0[64 * j]; nc[j] = y1[64 * j]; } } while (0)
    P8_LOAD(gw);
    const bool lastl = (l + 1 == DEPTH);
    for (int m = gw; m < T; m += NGW) {
        const f32x2 wv = nw; u32x2 cx[4], ca[4], cc[4];
#pragma unroll
        for (int j = 0; j < 4; ++j) { cx[j] = nx[j]; ca[j] = na[j]; cc[j] = nc[j]; }
        if (m + NGW < T) P8_LOAD(m + NGW);
        f32x4 v[4]; float s = 0.f;
#pragma unroll
        for (int j = 0; j < 4; ++j) { const u32x2 xw = cx[j]; const u32x2 a = ca[j], c = cc[j];
            v[j].x = bf_lo(xw.x) * ALPHA + wv.x * bf_lo(a.x) + wv.y * bf_lo(c.x); v[j].y = bf_hi(xw.x) * ALPHA + wv.x * bf_hi(a.x) + wv.y * bf_hi(c.x);
            v[j].z = bf_lo(xw.y) * ALPHA + wv.x * bf_lo(a.y) + wv.y * bf_lo(c.y); v[j].w = bf_hi(xw.y) * ALPHA + wv.x * bf_hi(a.y) + wv.y * bf_hi(c.y);
            s += (v[j].x + v[j].y) + (v[j].z + v[j].w); }
        const float mean = wave_sum(s) * (1.f / D_MODEL); float s2 = 0.f;
#pragma unroll
        for (int j = 0; j < 4; ++j) { v[j] = v[j] - mean; s2 += (v[j].x * v[j].x + v[j].y * v[j].y) + (v[j].z * v[j].z + v[j].w * v[j].w); }
        const float rstd = 1.f / sqrtf(wave_sum(s2) * (1.f / D_MODEL) + LN_EPS);
#pragma unroll
        for (int j = 0; j < 4; ++j) { const f32x4 gg = *((const f32x4*)g2 + lane + 64 * j), bb = *((const f32x4*)b2 + lane + 64 * j);
            v[j] = v[j] * rstd * gg + bb;
            if (lastl) *((f32x4*)(xout + (size_t)m * D_MODEL) + lane + 64 * j) = v[j];
            else { u32x2 w; w.x = cvt_pk_bf16(v[j].x, v[j].y); w.y = cvt_pk_bf16(v[j].z, v[j].w); *((u32x2*)(XB + (size_t)m * D_MODEL) + lane + 64 * j) = w; } }
    }
#undef P8_LOAD
    PBS_END(4, lds);
    PBS_BEGIN(5, lds);
    if (l + 1 < DEPTH) { __syncthreads(); convert_weights(l + 1, lds); }
    PBS_END(5, lds);
}

__global__ void __launch_bounds__(NWAVES * 64, 2) fwd(Args args) {
    extern __shared__ __attribute__((aligned(16))) unsigned char lds_raw[];
    LAS unsigned char* lds = (LAS unsigned char*)lds_raw;
    volatile LAS unsigned* MISC = (volatile LAS unsigned*)(lds + MISC_OFF);
    for (int u = threadIdx.x; u < (LDS_BYTES - LDSCTL_OFF) / 4; u += NWAVES * 64) ((LAS unsigned*)(lds + LDSCTL_OFF))[u] = 0u;
    __syncthreads();
    XcdBarrier bar; bar.bar = (unsigned*)(arg_ws() + WS_CTL) + CW_BAR + arg_li() * XCD_BAR_WORDS; bar.x = 0; bar.st = nullptr;
    if (!MK_MULTI) bar = xcd_barrier_post((unsigned*)(arg_ws() + WS_CTL) + CW_BAR + arg_li() * XCD_BAR_WORDS, MISC + 8);
    const int lo = arg_lo(), hi = arg_hi();
#define IN(k) (lo <= (k) && (k) < hi)
#define SEAM(k) do { if (!MK_MULTI && IN(k) && IN((k) + 1)) { XcdBarrier b2_ = bar; asm volatile("" : "+s"(b2_.bar)); xcd_barrier(b2_); } } while (0)
    unsigned long long tacc = 0ull, tst = 0ull; (void)tacc; (void)tst;
#define PB_BEGIN(k) do { if (PROBE_PH == (k)) tst = __builtin_amdgcn_s_memrealtime(); } while (0)
#define PB_END(k) do { if (PROBE_PH == (k)) tacc += __builtin_amdgcn_s_memrealtime() - tst; } while (0)
    PB_BEGIN(0);
    if (HAS(0) && IN(0)) phase0(lds);
    SEAM(0);
    PB_END(0);
    for (int l = 0; l < DEPTH; ++l) {
        const int pb = 1 + l * PH_PER_LAYER;
        PB_BEGIN(1);
        if (HAS(1) && IN(pb + 0)) phase1(lds);
        SEAM(pb + 0);
        PB_END(1);
        PB_BEGIN(2);
        if (HAS(2) && IN(pb + 1)) phase2(lds, l);
        SEAM(pb + 1);
        PB_END(2);
        PB_BEGIN(3);
        if (HAS(3) && IN(pb + 2)) phase3(lds);
        SEAM(pb + 2);
        PB_END(3);
        PB_BEGIN(4);
        if (HAS(4) && IN(pb + 3)) phase4(lds, l);
        SEAM(pb + 3);
        PB_END(4);
        PB_BEGIN(5);
        if (HAS(5) && IN(pb + 4)) phase5(lds, l);
        SEAM(pb + 4);
        PB_END(5);
        PB_BEGIN(6);
        if (HAS(6) && IN(pb + 5)) phase6(lds, l);
        SEAM(pb + 5);
        PB_END(6);
        PB_BEGIN(7);
        if (HAS(7) && IN(pb + 6)) phase7(lds, l);
        SEAM(pb + 6);
        PB_END(7);
        PB_BEGIN(8);
        if (HAS(8) && IN(pb + 7)) phase8(lds, l);
        SEAM(pb + 7);
        PB_END(8);
    }
    if (PROBE_PH >= 100) tacc = *(volatile LAS unsigned long long*)(lds + MISC_OFF + 64);
    if (PROBE_PH >= 0 && blockIdx.x == 0) { const unsigned long long t0 = __builtin_amdgcn_s_memrealtime(); while (__builtin_amdgcn_s_memrealtime() - t0 < tacc * PROBE_MULT) __builtin_amdgcn_s_sleep(8); }
#undef IN
#undef SEAM
    (void)args;
}


#ifndef DBG_PROBE
#define DBG_PROBE 0
#endif
#ifndef DBG_LAYER
#define DBG_LAYER 0
#endif
#ifndef DBG_GAIN
#define DBG_GAIN 1.0f
#endif
#if DBG_PROBE
constexpr size_t WS_DXS = 528 * MiB, WS_DKV = 544 * MiB, WS_DST = 610 * MiB;
__device__ __forceinline__ int dbg_tok(int i) { const int sp[8] = {0, 1, 63, 64, 65, 575, 576, 4095}; return i < 8 ? sp[i] : (i * 67 + (i % 5) * 13 + 200) % 4096; }
__device__ __forceinline__ void atomic_max_pos(float* p, float v) { atomicMax((unsigned*)p, __float_as_uint(v)); }
__global__ void dbg_kv(const float* xs, const float* w_in, float* kv) {
    const int c = blockIdx.x * 256 + threadIdx.x; const int bi = blockIdx.y >> 8; const int t0 = (blockIdx.y & 255) * 16;
    xs += (size_t)(bi ? 5 : 0) * SEQ * D_MODEL; kv += (size_t)bi * SEQ * 2048;
    const int col = c < 1024 ? 512 + c : 2048 + (c - 1024);
    float acc[16];
#pragma unroll
    for (int i = 0; i < 16; ++i) acc[i] = 0.f;
    for (int k = 0; k < D_MODEL; ++k) { const float w = w_in[(size_t)k * PROJ + col];
#pragma unroll
        for (int i = 0; i < 16; ++i) acc[i] += xs[(size_t)(t0 + i) * D_MODEL + k] * w; }
#pragma unroll
    for (int i = 0; i < 16; ++i) kv[(size_t)(t0 + i) * 2048 + c] = acc[i];
}
__device__ __forceinline__ float blk_sum(float v, float* red) { __syncthreads(); red[threadIdx.x] = v; __syncthreads(); for (int s = 128; s > 0; s >>= 1) { if ((int)threadIdx.x < s) red[threadIdx.x] += red[threadIdx.x + s]; __syncthreads(); } const float r = red[0]; __syncthreads(); return r; }
__device__ __forceinline__ float blk_max(float v, float* red) { __syncthreads(); red[threadIdx.x] = v; __syncthreads(); for (int s = 128; s > 0; s >>= 1) { if ((int)threadIdx.x < s) red[threadIdx.x] = fmaxf(red[threadIdx.x], red[threadIdx.x + s]); __syncthreads(); } const float r = red[0]; __syncthreads(); return r; }
__global__ void __launch_bounds__(256) dbg_tok_kernel(Args a, int L, int mode) {
    __shared__ float xs[1024], qa[512], qb[512], gl[2048], ya[512], yb[512], mg[1024], mixed[1024], x1[1024], hbuf[512], sc[4096], red[256], lgs[16];
    const int tid = threadIdx.x; const int t = dbg_tok(blockIdx.x >> 1); const int bi = blockIdx.x & 1, bb = bi ? 5 : 0; const size_t grow = (size_t)bb * SEQ + t;
    unsigned char* ws = a.ws;
    const float* xsnap = a.in[0] + (size_t)bb * SEQ * D_MODEL; const float* kv = (const float*)(ws + WS_DKV) + (size_t)bi * SEQ * 2048; float* st = (float*)(ws + WS_DST);
    const float* w_in = a.in[1] + (size_t)L * D_MODEL * PROJ; const float* relb = a.in[2] + (size_t)L * NH * N_REL;
    const float* w_upa = a.in[3] + (size_t)L * WA * D_MODEL; const float* w_upb = a.in[4] + (size_t)L * WA * D_MODEL; const float* w_out = a.in[5] + (size_t)L * D_MODEL * D_MODEL;
    const float* g1 = a.in[6] + (size_t)L * D_MODEL; const float* b1 = a.in[7] + (size_t)L * D_MODEL; const float* w_router = a.in[8]; const float* b_router = a.in[9];
    const float* w_gate = a.in[10] + (size_t)L * NE * D_MODEL * FE; const float* w_up = a.in[11] + (size_t)L * NE * D_MODEL * FE; const float* w_down = a.in[12] + (size_t)L * NE * FE * D_MODEL;
    for (int i = tid; i < 1024; i += 256) xs[i] = xsnap[(size_t)t * D_MODEL + i];
    __syncthreads();
    for (int j = tid; j < 3072; j += 256) { const int col = j < 512 ? j : (j < 1024 ? 1536 + (j - 512) : 3072 + (j - 1024)); float s = 0.f;
        for (int k = 0; k < 1024; ++k) s += xs[k] * w_in[(size_t)k * PROJ + col];
        if (j < 512) qa[j] = s; else if (j < 1024) qb[j - 512] = s; else gl[j - 1024] = s; }
    __syncthreads();
    for (int h = 0; h < 8; ++h) {
        const int c = t >> 6; const int k0 = (c - 8) > 0 ? (c - 8) * 64 : 0, k1 = c * 64 + 63; const int nk = k1 - k0 + 1;
        float mx = -1e30f;
        for (int i = tid; i < nk; i += 256) { const int key = k0 + i; float s = 0.f; for (int d = 0; d < 64; ++d) s += qa[h * 64 + d] * kv[(size_t)key * 2048 + h * 64 + d];
            int rel = t - key; rel = rel < -128 ? -128 : (rel > 128 ? 128 : rel); s = s * 0.125f + relb[h * N_REL + rel + 128]; sc[i] = s; mx = fmaxf(mx, s); }
        mx = blk_max(mx, red);
        float sm = 0.f; for (int i = tid; i < nk; i += 256) { const float p = expf(sc[i] - mx); sc[i] = p; sm += p; }
        sm = blk_sum(sm, red);
        if (tid < 64) { float o = 0.f; for (int i = 0; i < nk; ++i) o += sc[i] * kv[(size_t)(k0 + i) * 2048 + 512 + h * 64 + tid]; ya[h * 64 + tid] = o / sm; }
        __syncthreads();
        for (int s = tid; s < t; s += 256) { float z = 0.f; for (int d = 0; d < 64; ++d) z += qb[h * 64 + d] * kv[(size_t)s * 2048 + 1024 + h * 64 + d]; sc[s] = z * 0.125f; }
        __syncthreads();
        if (tid < 64) { float y = 0.f; for (int s = 0; s < t; ++s) { const float beta = 1.0f / (1.0f + expf(-sc[s])); y += beta * (kv[(size_t)s * 2048 + 1536 + h * 64 + tid] - y); } yb[h * 64 + tid] = y; }
        __syncthreads();
    }
    if (mode == 0) {
        const bf16_t* OA = (const bf16_t*)(ws + WS_QQ); const bf16_t* OB = (const bf16_t*)(ws + WS_QQ) + WA;
        float na = 0.f, da = 0.f, nb = 0.f, db = 0.f;
        for (int i = tid; i < 512; i += 256) { const float oa = h2f(OA[grow * D_MODEL + i]), ob = h2f(OB[grow * D_MODEL + i]);
            na += (oa - ya[i]) * (oa - ya[i]); da += ya[i] * ya[i]; nb += (ob - yb[i]) * (ob - yb[i]); db += yb[i] * yb[i]; }
        na = blk_sum(na, red); da = blk_sum(da, red); nb = blk_sum(nb, red); db = blk_sum(db, red);
        if (tid == 0) { atomicAdd(st + 4, na); atomicAdd(st + 5, da); atomicAdd(st + 6, nb); atomicAdd(st + 7, db); }
        return; }
    for (int cidx = tid; cidx < 1024; cidx += 256) { float ua = 0.f, ub = 0.f; for (int k = 0; k < 512; ++k) { ua += ya[k] * w_upa[(size_t)k * D_MODEL + cidx]; ub += yb[k] * w_upb[(size_t)k * D_MODEL + cidx]; }
        const float ga = 1.0f / (1.0f + expf(-gl[cidx])), gb = 1.0f / (1.0f + expf(-gl[1024 + cidx])); mg[cidx] = ga * ua + gb * ub; }
    __syncthreads();
    float num = 0.f, den = 0.f;
    for (int cidx = tid; cidx < 1024; cidx += 256) { float s = 0.f; for (int k = 0; k < 1024; ++k) s += mg[k] * w_out[(size_t)k * D_MODEL + cidx]; mixed[cidx] = s;
        const float opt = h2f(((const bf16_t*)(ws + WS_PRE))[grow * D_MODEL + cidx]) - ALPHA * xs[cidx]; num += (opt - s) * (opt - s); den += s * s; }
    num = blk_sum(num, red); den = blk_sum(den, red);
    if (tid == 0) { atomicAdd(st + 0, num); atomicAdd(st + 1, den); atomic_max_pos(st + 8, num / den); }
    float s1 = 0.f; for (int i = tid; i < 1024; i += 256) { x1[i] = ALPHA * xs[i] + mixed[i]; s1 += x1[i]; }
    const float mean = blk_sum(s1, red) / 1024.f; float s2 = 0.f; for (int i = tid; i < 1024; i += 256) { const float d = x1[i] - mean; s2 += d * d; }
    const float rstd = 1.0f / sqrtf(blk_sum(s2, red) / 1024.f + LN_EPS);
    for (int i = tid; i < 1024; i += 256) x1[i] = (x1[i] - mean) * rstd * g1[i] + b1[i];
    __syncthreads();
    if (tid < 16) { float s = 0.f; for (int k = 0; k < 1024; ++k) s += x1[k] * w_router[k * 16 + tid]; lgs[tid] = s + b_router[tid]; }
    __syncthreads();
    int best = 0; for (int e = 1; e < 16; ++e) if (lgs[e] > lgs[best]) best = e;
    const int grp = best >> 2; int e2 = -1; for (int e = grp * 4; e < grp * 4 + 4; ++e) if (e != best && (e2 < 0 || lgs[e] > lgs[e2])) e2 = e;
    const float pw1 = 1.0f / (1.0f + expf(lgs[e2] - lgs[best])), pw2 = 1.0f - pw1;
    const f32x2 wo = ((const f32x2*)(ws + WS_RECW))[grow]; const bf16_t* Y = (const bf16_t*)(ws + WS_Y);
    float fnum = 0.f, fden = 0.f; float ff[4] = {0.f, 0.f, 0.f, 0.f};
    for (int kk = 0; kk < 2; ++kk) { const int e = kk ? e2 : best; const float pw = kk ? pw2 : pw1;
        for (int f = tid; f < 512; f += 256) { float g = 0.f, u = 0.f; for (int k = 0; k < 1024; ++k) { g += x1[k] * w_gate[((size_t)e * D_MODEL + k) * FE + f]; u += x1[k] * w_up[((size_t)e * D_MODEL + k) * FE + f]; }
            hbuf[f] = g / (1.0f + expf(-g)) * u; }
        __syncthreads();
        for (int j = 0; j < 4; ++j) { const int cidx = tid + 256 * j; float s = 0.f; for (int f = 0; f < 512; ++f) s += hbuf[f] * w_down[((size_t)e * FE + f) * D_MODEL + cidx]; ff[j] += pw * s; }
        __syncthreads(); }
    for (int j = 0; j < 4; ++j) { const int cidx = tid + 256 * j; const float opt = wo.x * h2f(Y[(size_t)(2 * grow) * D_MODEL + cidx]) + wo.y * h2f(Y[(size_t)(2 * grow + 1) * D_MODEL + cidx]);
        fnum += (opt - ff[j]) * (opt - ff[j]); fden += ff[j] * ff[j]; }
    fnum = blk_sum(fnum, red); fden = blk_sum(fden, red);
    if (tid == 0) { atomicAdd(st + 2, fnum); atomicAdd(st + 3, fden); atomic_max_pos(st + 9, fnum / fden); }
    const float* g2 = a.in[13] + (size_t)L * D_MODEL; const float* b2 = a.in[14] + (size_t)L * D_MODEL;
    float t1 = 0.f; for (int j = 0; j < 4; ++j) { const int cidx = tid + 256 * j; mixed[cidx] = ALPHA * x1[cidx] + ff[j]; t1 += mixed[cidx]; }
    const float mean2 = blk_sum(t1, red) / 1024.f; float t2 = 0.f; for (int j = 0; j < 4; ++j) { const float d = mixed[tid + 256 * j] - mean2; t2 += d * d; }
    const float rstd2 = 1.0f / sqrtf(blk_sum(t2, red) / 1024.f + LN_EPS);
    float xnum = 0.f, xden = 0.f;
    for (int j = 0; j < 4; ++j) { const int cidx = tid + 256 * j; const float ref = (mixed[cidx] - mean2) * rstd2 * g2[cidx] + b2[cidx];
        const float opt = (L == DEPTH - 1) ? a.out[grow * D_MODEL + cidx] : h2f(((const bf16_t*)(ws + WS_XB))[grow * D_MODEL + cidx]);
        xnum += (opt - ref) * (opt - ref); xden += ref * ref; }
    xnum = blk_sum(xnum, red); xden = blk_sum(xden, red);
    if (tid == 0) { atomicAdd(st + 10, xnum); atomicAdd(st + 11, xden); atomic_max_pos(st + 12, xnum / xden); }
}
__global__ void dbg_inject(float* out, const float* st, int n4) {
    const float delta = sqrtf((DBG_PROBE == 1) ? st[0] / st[1] : (DBG_PROBE == 2) ? st[2] / st[3] : (DBG_PROBE == 3) ? st[4] / st[5] : (DBG_PROBE == 4) ? st[6] / st[7] : (DBG_PROBE == 5) ? st[8] : (DBG_PROBE == 6) ? st[9] : (DBG_PROBE == 7) ? st[10] / st[11] : st[12]); const float f = 1.0f + DBG_GAIN * delta;
    for (int i = blockIdx.x * blockDim.x + threadIdx.x; i < n4; i += gridDim.x * blockDim.x) { f32x4 v = ((f32x4*)out)[i]; v = v * f; ((f32x4*)out)[i] = v; }
}
#endif

extern "C" void kernel_launch(void* const* d_in, const int* in_sizes, int n_in, void* d_out, int out_size, void* d_ws, size_t ws_size, hipStream_t stream) {
    static int grid = 0;
    if (grid == 0) {
        if (n_in != 15 || in_sizes[0] != T * D_MODEL || out_size != T * D_MODEL || ws_size < WS_END) {
            fprintf(stderr, "kernel_launch: unexpected shapes (n_in %d in0 %d out %d ws %zu; need ws >= %zu); nothing launched\n", n_in, n_in > 0 ? in_sizes[0] : -1, out_size, ws_size, (size_t)WS_END); grid = -1; return; }
        int dev = 0, cus = 0, per_cu = 0;
        if (hipGetDevice(&dev) != hipSuccess || hipDeviceGetAttribute(&cus, hipDeviceAttributeMultiprocessorCount, dev) != hipSuccess) { grid = -1; return; }
        if (hipFuncSetAttribute((const void*)fwd, hipFuncAttributeMaxDynamicSharedMemorySize, LDS_BYTES) != hipSuccess) { fprintf(stderr, "kernel_launch: hipFuncSetAttribute failed\n"); grid = -1; return; }
        if (hipOccupancyMaxActiveBlocksPerMultiprocessor(&per_cu, (const void*)fwd, NWAVES * 64, LDS_BYTES) != hipSuccess || per_cu < 1)
            fprintf(stderr, "kernel_launch: note: occupancy query reports %d workgroups per CU\n", per_cu);
        (void)hipGetLastError();
        grid = cus;
        if (grid != 256) fprintf(stderr, "kernel_launch: %d CUs; the attention deal needs 256\n", grid);
    }
    if (grid < 0) return;
    if (hipMemsetAsync((char*)d_ws + WS_CTL, 0, CTL_ZERO_BYTES, stream) != hipSuccess) { fprintf(stderr, "kernel_launch: memset failed\n"); return; }
    Args a{};
    for (int i = 0; i < 15; ++i) a.in[i] = (const float*)d_in[i];
    a.out = (float*)d_out; a.ws = (unsigned char*)d_ws;
#if DBG_PROBE
    {
        const int L = DBG_LAYER, p0 = 1 + 8 * L, p1 = 1 + 8 * (L + 1);
        hipMemsetAsync((char*)d_ws + WS_DST, 0, 64, stream);
        a.li = 0; a.ph_lo = 0; a.ph_hi = p0; hipLaunchKernelGGL(fwd, dim3(grid), dim3(NWAVES * 64), LDS_BYTES, stream, a);
        hipLaunchKernelGGL(dbg_kv, dim3(8, 512), dim3(256), 0, stream, (const float*)d_in[0], (const float*)d_in[1] + (size_t)L * D_MODEL * PROJ, (float*)((char*)d_ws + WS_DKV));
        a.li = 1; a.ph_lo = p0; a.ph_hi = p0 + 2; hipLaunchKernelGGL(fwd, dim3(grid), dim3(NWAVES * 64), LDS_BYTES, stream, a);
        hipLaunchKernelGGL(dbg_tok_kernel, dim3(128), dim3(256), 0, stream, a, L, 0);
        a.li = 3; a.ph_lo = p0 + 2; a.ph_hi = p1; hipLaunchKernelGGL(fwd, dim3(grid), dim3(NWAVES * 64), LDS_BYTES, stream, a);
        hipLaunchKernelGGL(dbg_tok_kernel, dim3(128), dim3(256), 0, stream, a, L, 1);
        if (p1 < N_PHASES) { a.li = 2; a.ph_lo = p1; a.ph_hi = N_PHASES; hipLaunchKernelGGL(fwd, dim3(grid), dim3(NWAVES * 64), LDS_BYTES, stream, a); }
        hipLaunchKernelGGL(dbg_inject, dim3(1024), dim3(256), 0, stream, (float*)d_out, (const float*)((char*)d_ws + WS_DST), T * D_MODEL / 4);
    }
#elif MK_MULTI
    for (int p = 0; p < N_PHASES; ++p) { a.ph_lo = p; a.ph_hi = p + 1; hipLaunchKernelGGL(fwd, dim3(grid), dim3(NWAVES * 64), LDS_BYTES, stream, a); }
#else
    a.ph_lo = 0; a.ph_hi = N_PHASES;
    hipLaunchKernelGGL(fwd, dim3(grid), dim3(NWAVES * 64), LDS_BYTES, stream, a);
#endif
    const hipError_t le = hipPeekAtLastError();
    if (le != hipSuccess) fprintf(stderr, "kernel_launch: launch failed: %s\n", hipGetErrorName(le));
}
```

```cpp
#include <hip/hip_runtime.h>
#include <cstdio>
#include <cstdint>

#ifndef MK_MULTI
#define MK_MULTI 0
#endif

#ifndef PROBE_PH
#define PROBE_PH (-1)
#endif
#ifndef PROBE_MULT
#define PROBE_MULT 1
#endif
#ifndef PHASE_MASK
#define PHASE_MASK 0x1ff
#endif
#define HAS(k) ((PHASE_MASK >> (k)) & 1)
#define LAS __attribute__((address_space(3)))
#define PBS_BEGIN(id, lds) do { if (PROBE_PH == 100 + (id) && threadIdx.x == 0) *(volatile LAS unsigned long long*)((lds) + MISC_OFF + 80) = __builtin_amdgcn_s_memrealtime(); } while (0)
#define PBS_END(id, lds) do { if (PROBE_PH == 100 + (id) && threadIdx.x == 0) { volatile LAS unsigned long long* p_ = (volatile LAS unsigned long long*)((lds) + MISC_OFF + 64); p_[0] = p_[0] + (__builtin_amdgcn_s_memrealtime() - p_[2]); } } while (0)
#define GAS __attribute__((address_space(1)))
typedef unsigned short bf16_t;
typedef short bf16x8 __attribute__((ext_vector_type(8)));
typedef short s16x4 __attribute__((ext_vector_type(4)));
typedef float f32x4 __attribute__((ext_vector_type(4)));
typedef float f32x2 __attribute__((ext_vector_type(2)));
typedef float f32x16 __attribute__((ext_vector_type(16)));
typedef unsigned u32x4 __attribute__((ext_vector_type(4)));
typedef unsigned u32x2 __attribute__((ext_vector_type(2)));

constexpr int D_MODEL = 1024, BATCH = 8, SEQ = 4096, DEPTH = 4, T = BATCH * SEQ;
constexpr int NH = 8, HD = 64, WA = NH * HD;
constexpr int PROJ = 3 * WA + 3 * WA + 2 * D_MODEL;
constexpr int N_REL = 257, NE = 16, FE = 512;
constexpr float ALPHA = 1.681792830507429f;
constexpr float LN_EPS = 1e-5f;
constexpr float LOG2E = 1.4426950408889634f;
constexpr float C2 = 0.125f * LOG2E;

constexpr size_t MiB = 1u << 20;
constexpr size_t WS_CTL = 0, CTL_ZERO_BYTES = 1 * MiB;
constexpr size_t WS_RECW = 2 * MiB;
constexpr size_t WS_LIST = 4 * MiB;
constexpr size_t WS_WIN = 8 * MiB, WS_WUP = 18 * MiB  , WS_WOUT = 20 * MiB, WS_WGU = 22 * MiB, WS_WD = 54 * MiB;
constexpr size_t WS_RTAB = 70 * MiB;
constexpr size_t RTAB_STRIDE = 65536 + 256;
constexpr size_t WS_XB = 72 * MiB;
constexpr size_t WS_QQ = 136 * MiB, WS_KA = 200 * MiB, WS_VA = 232 * MiB, WS_KB = 264 * MiB, WS_VB = 296 * MiB;
constexpr size_t WS_GA = 328 * MiB, WS_GB = 392 * MiB;
constexpr size_t WS_PRE = 328 * MiB;
constexpr size_t WS_MERGED = 456 * MiB;
constexpr size_t WS_Y = 136 * MiB;
constexpr size_t WS_H = 456 * MiB;
constexpr size_t WS_END = 526 * MiB;
constexpr int CW_TMO = 0;
constexpr int CW_BAR = 4096;
constexpr int CW_CNT = 32768;

constexpr int RING_BYTES = 131072;
constexpr int LDSCTL_OFF = RING_BYTES, MISC_OFF = LDSCTL_OFF + 320;
constexpr int UTAB_OFF = LDSCTL_OFF + 1024;
constexpr int LDS_BYTES = 147456;

#ifndef USE_F16
#define USE_F16 1
#endif
typedef _Float16 h16x2 __attribute__((ext_vector_type(2)));
typedef _Float16 h16x8 __attribute__((ext_vector_type(8)));
#if USE_F16
__device__ __forceinline__ unsigned cvt_pk_bf16(float lo, float hi) { const f32x2 v = {lo, hi}; return __builtin_bit_cast(unsigned, __builtin_convertvector(v, h16x2)); }
__device__ __forceinline__ float bf_lo(unsigned w) { return (float)__builtin_bit_cast(h16x2, w)[0]; }
__device__ __forceinline__ float bf_hi(unsigned w) { return (float)__builtin_bit_cast(h16x2, w)[1]; }
#define MFMA16(a, b, c) __builtin_amdgcn_mfma_f32_16x16x32_f16(__builtin_bit_cast(h16x8, a), __builtin_bit_cast(h16x8, b), c, 0, 0, 0)
#define MFMA32(a, b, c) __builtin_amdgcn_mfma_f32_32x32x16_f16(__builtin_bit_cast(h16x8, a), __builtin_bit_cast(h16x8, b), c, 0, 0, 0)
#else
__device__ __forceinline__ unsigned cvt_pk_bf16(float lo, float hi) { unsigned r; asm volatile("v_cvt_pk_bf16_f32 %0, %1, %2" : "=v"(r) : "v"(lo), "v"(hi)); return r; }
__device__ __forceinline__ float bf_lo(unsigned w) { return __uint_as_float(w << 16); }
__device__ __forceinline__ float bf_hi(unsigned w) { return __uint_as_float(w & 0xffff0000u); }
#define MFMA16(a, b, c) __builtin_amdgcn_mfma_f32_16x16x32_bf16(a, b, c, 0, 0, 0)
#define MFMA32(a, b, c) MFMA32(a, b, c)
#endif
__device__ __forceinline__ float h2f(bf16_t h) { return bf_lo((unsigned)h); }
__device__ __forceinline__ float fast_exp2(float x) { return __builtin_amdgcn_exp2f(x); }
__device__ __forceinline__ float fast_rcp(float x) { return __builtin_amdgcn_rcpf(x); }
__device__ __forceinline__ float sigmoidf_(float v) { return fast_rcp(1.0f + fast_exp2(-LOG2E * v)); }
__device__ __forceinline__ float wave_sum(float v) {
#define DPP_ADD(ctrl, rmask) v += __builtin_bit_cast(float, __builtin_amdgcn_update_dpp(0, __builtin_bit_cast(int, v), ctrl, rmask, 0xf, false))
    DPP_ADD(0x111, 0xf); DPP_ADD(0x112, 0xf); DPP_ADD(0x114, 0xf); DPP_ADD(0x118, 0xf);
    DPP_ADD(0x142, 0xa); DPP_ADD(0x143, 0xc);
#undef DPP_ADD
    return __builtin_bit_cast(float, __builtin_amdgcn_readlane(__builtin_bit_cast(int, v), 63));
}
#define LDS_WAIT() asm volatile("s_waitcnt lgkmcnt(0)" ::: "memory")
#define VM_WAIT() asm volatile("s_waitcnt vmcnt(0)" ::: "memory")

namespace pg8 {
constexpr int BM = 256, BK = 64, HALF = 128, HTB = HALF * BK * 2, STAGE_BYTES = 8 * HTB, NXCD = 8, WGM = 8;
__host__ __device__ __forceinline__ int lds_byte(int r, int c) { const int st = (r >> 4) * 2 + (c >> 5), rr = r & 15, cc = c & 31, ob = rr * 64 + cc * 2; return st * 1024 + (ob ^ (((ob >> 9) & 1) << 5)); }
__host__ __device__ __forceinline__ void stage_rc(int b, int& R, int& C) { const int st = b / 1024, sb = b % 1024, swz = sb ^ (((sb >> 9) & 1) << 5); R = (st >> 1) * 16 + swz / 64; C = (st & 1) * 32 + (swz % 64) / 2; }
__host__ __device__ __forceinline__ int perm32(int rho) { const int n = rho >> 4, i = rho & 15; return 8 * (i >> 2) + 4 * n + (i & 3); }

struct Unit { const char* A; const char* B; int pm, pn, x0, x1, x2, x3; };

struct TileOrder {
    int nM, nN, nwg, G, c;
    __device__ __forceinline__ void init(int nM_, int nN_, int G_, int c_) { nM = nM_; nN = nN_; nwg = nM * nN; G = G_; c = c_; }
    __device__ __forceinline__ bool next(int i, int& pm, int& pn) const {
        const long L = (long)i * G + c; if (L >= nwg) return false;
        int wgid = (int)L; { const int q = nwg / NXCD, r = nwg % NXCD, xcd = wgid % NXCD, off = wgid / NXCD; wgid = (xcd < r ? xcd * (q + 1) : r * (q + 1) + (xcd - r) * q) + off; }
        const int nig = WGM * nN, gid = wgid / nig, fm = gid * WGM, gsz = (nM - fm) < WGM ? (nM - fm) : WGM;
        pm = fm + ((wgid % nig) % gsz); pn = (wgid % nig) / gsz; return true;
    }
};

template <class Epi, class Sched, bool GATHER, bool ALIGN_EPI, bool MIDHOOK = false>
__device__ __forceinline__ void gemm_phase(LAS unsigned char* lds, const int K, const Sched& S, const Epi& E, const int LD_ = 0) {
    const int LD = LD_ ? LD_ : K;
    int tid_ = threadIdx.x; asm volatile("" : "+v"(tid_));
    const int tid = tid_, wid = __builtin_amdgcn_readfirstlane(tid >> 6), lane = tid & 63, wr = wid >> 2, wc = wid & 3, fr = lane & 15, fq = lane >> 4;
    const int nt = K / BK;
    unsigned voffB[2]; int RA[2], CA2[2];
#pragma unroll
    for (int i = 0; i < 2; ++i) { int R, C; stage_rc(tid * 16 + i * 8192, R, C); const int Rb = Epi::PERM ? ((R & ~31) + perm32(R & 31)) : R;
        RA[i] = R; CA2[i] = C * 2; voffB[i] = (unsigned)(Rb * LD + C) * 2u; }
    const size_t kstep = (size_t)(BK * 2);
    const size_t hstep = (size_t)HALF * LD * 2;
    const unsigned ldsw = (unsigned)wid * 1024u;
    const int aoff = lds_byte(wr * 64 + fr, fq * 8), boff = lds_byte(wc * 32 + fr, fq * 8);
#define PG8_SA(b, h) (((b) * 2 + (h)) * HTB)
#define PG8_SB(b, h) ((4 + (b) * 2 + (h)) * HTB)
#define PG8_STAGE(bufoff, gbase, voff) do { _Pragma("unroll") for (int _i = 0; _i < 2; ++_i) \
        __builtin_amdgcn_global_load_lds((const unsigned*)((const char*)(gbase) + (voff)[_i]), (LAS unsigned*)(lds + (bufoff) + ldsw + _i * 8192), 16, 0, 0); } while (0)
#define PG8_LDA(dst, b, h) do { _Pragma("unroll") for (int m = 0; m < 4; ++m) _Pragma("unroll") for (int k = 0; k < 2; ++k) dst[m][k] = *(const LAS bf16x8*)(lds + PG8_SA(b, h) + aoff + m * 2048 + k * 1024); } while (0)
#define PG8_LDB(dst, b, h) do { _Pragma("unroll") for (int n = 0; n < 2; ++n) _Pragma("unroll") for (int k = 0; k < 2; ++k) dst[n][k] = *(const LAS bf16x8*)(lds + PG8_SB(b, h) + boff + n * 2048 + k * 1024); } while (0)
#define PG8_MMA(ai, bj, At, Bt) do { __builtin_amdgcn_s_setprio(1); _Pragma("unroll") for (int m = 0; m < 4; ++m) _Pragma("unroll") for (int n = 0; n < 2; ++n) _Pragma("unroll") for (int k = 0; k < 2; ++k) \
        acc[ai][bj][m][n] = MFMA16(Bt[n][k], At[m][k], acc[ai][bj][m][n]); __builtin_amdgcn_s_setprio(0); } while (0)
#define PG8_WAIT_V(n) asm volatile("s_waitcnt vmcnt(" #n ")" ::: "memory")
#define PG8_WAIT_L(n) asm volatile("s_waitcnt lgkmcnt(" #n ")" ::: "memory")
#define PG8_BAR __builtin_amdgcn_s_barrier()
#define PG8_SCHED __builtin_amdgcn_sched_barrier(0)
    Unit cur, nxt; int ui = 0;
    if (!S.next(0, cur)) return;
    unsigned oc0[2], oc1[2], on0[2], on1[2];
    if constexpr (GATHER) { S.offs(cur, RA, CA2, oc0, oc1); }
    else {
#pragma unroll
        for (int i = 0; i < 2; ++i) { oc0[i] = (unsigned)(RA[i] * LD) * 2u + (unsigned)CA2[i]; oc1[i] = oc0[i]; on0[i] = oc0[i]; on1[i] = oc0[i]; } }
    const size_t ah = GATHER ? (size_t)0 : hstep;
    f32x4 acc[2][2][4][2];
#pragma unroll
    for (int a = 0; a < 2; ++a)
#pragma unroll
        for (int b = 0; b < 2; ++b)
#pragma unroll
            for (int m = 0; m < 4; ++m)
#pragma unroll
                for (int n = 0; n < 2; ++n) acc[a][b][m][n] = (f32x4){0.f, 0.f, 0.f, 0.f};
    bf16x8 At[4][2], B0[2][2], B1[2][2];
    const char* cA = cur.A; const char* cB = cur.B;
    PG8_STAGE(PG8_SB(0, 0), cB, voffB); PG8_STAGE(PG8_SB(0, 1), cB + hstep, voffB); PG8_STAGE(PG8_SA(0, 0), cA, oc0); PG8_STAGE(PG8_SA(0, 1), cA + ah, oc1);
    if (wr == 1) PG8_BAR;
    PG8_WAIT_V(2); PG8_BAR;
    PG8_STAGE(PG8_SB(1, 0), cB + kstep, voffB); PG8_STAGE(PG8_SA(1, 0), cA + kstep, oc0); PG8_STAGE(PG8_SB(1, 1), cB + hstep + kstep, voffB);
    PG8_WAIT_V(6); PG8_BAR;
    for (;;) {
        const bool has_next = S.next(ui + 1, nxt);
        const char* nA = has_next ? nxt.A : cA; const char* nB = has_next ? nxt.B : cB;
        if constexpr (GATHER) { if (has_next) S.offs(nxt, RA, CA2, on0, on1); else { on0[0] = oc0[0]; on0[1] = oc0[1]; on1[0] = oc1[0]; on1[1] = oc1[1]; } }
        for (int t = 0; t < nt; t += 2) {
            const bool last = (t == nt - 2);
            const char* a1 = cA + (size_t)(t + 1) * kstep;
            const char* a2 = last ? nA : cA + (size_t)(t + 2) * kstep; const char* b2 = last ? nB : cB + (size_t)(t + 2) * kstep;
            const char* a3 = a2 + kstep; const char* b3 = b2 + kstep;
            unsigned o20[2], o21[2];
            if constexpr (GATHER) { o20[0] = last ? on0[0] : oc0[0]; o20[1] = last ? on0[1] : oc0[1]; o21[0] = last ? on1[0] : oc1[0]; o21[1] = last ? on1[1] : oc1[1]; }
            else { o20[0] = oc0[0]; o20[1] = oc0[1]; o21[0] = oc0[0]; o21[1] = oc0[1]; }
            PG8_LDB(B0, 0, 0); PG8_LDB(B1, 0, 1); PG8_SCHED; PG8_LDA(At, 0, 0); PG8_STAGE(PG8_SA(1, 1), a1 + ah, oc1);
            PG8_WAIT_V(8); PG8_WAIT_L(0); PG8_BAR; PG8_MMA(0, 0, At, B0); PG8_MMA(0, 1, At, B1); PG8_BAR; PG8_SCHED;
            PG8_LDA(At, 0, 1); PG8_STAGE(PG8_SB(0, 0), b2, voffB); PG8_STAGE(PG8_SB(0, 1), b2 + hstep, voffB); PG8_STAGE(PG8_SA(0, 0), a2, o20);
            PG8_WAIT_V(8); PG8_WAIT_L(0); PG8_BAR; PG8_MMA(1, 0, At, B0); PG8_MMA(1, 1, At, B1); PG8_BAR; PG8_SCHED;
            PG8_LDB(B0, 1, 0); PG8_LDB(B1, 1, 1); PG8_SCHED; PG8_LDA(At, 1, 0); PG8_STAGE(PG8_SA(0, 1), a2 + ah, o21);
            PG8_WAIT_V(8); PG8_WAIT_L(0); PG8_BAR; PG8_MMA(0, 0, At, B0); PG8_MMA(0, 1, At, B1); PG8_BAR; PG8_SCHED;
            PG8_LDA(At, 1, 1); PG8_STAGE(PG8_SB(1, 0), b3, voffB); PG8_STAGE(PG8_SB(1, 1), b3 + hstep, voffB); PG8_STAGE(PG8_SA(1, 0), a3, o20);
            PG8_WAIT_V(8); PG8_WAIT_L(0); PG8_BAR; PG8_MMA(1, 0, At, B0); PG8_MMA(1, 1, At, B1); PG8_BAR; PG8_SCHED;
        }
        if constexpr (ALIGN_EPI) { if (wr == 0) PG8_BAR; }
        bool keep = false;
        if constexpr (MIDHOOK) { if (cur.x0 == 0) { E.mid(acc, cur, wr, wc, fr, fq); keep = true; } else E(acc, cur, wr, wc, fr, fq); }
        else E(acc, cur, wr, wc, fr, fq);
        if (!has_next) break;
        if (!keep) {
#pragma unroll
        for (int a = 0; a < 2; ++a)
#pragma unroll
            for (int b = 0; b < 2; ++b)
#pragma unroll
                for (int m = 0; m < 4; ++m)
#pragma unroll
                    for (int n = 0; n < 2; ++n) acc[a][b][m][n] = (f32x4){0.f, 0.f, 0.f, 0.f};
        }
        cur = nxt; cA = nA; cB = nB; ++ui;
        if constexpr (GATHER) { oc0[0] = on0[0]; oc0[1] = on0[1]; oc1[0] = on1[0]; oc1[1] = on1[1]; }
        if constexpr (ALIGN_EPI) { if (wr == 1) PG8_BAR; }
    }
    PG8_WAIT_V(0);
    if constexpr (!ALIGN_EPI) { if (wr == 0) PG8_BAR; }
    PG8_BAR;
#undef PG8_SA
#undef PG8_SB
#undef PG8_STAGE
#undef PG8_LDA
#undef PG8_LDB
#undef PG8_MMA
#undef PG8_WAIT_V
#undef PG8_WAIT_L
#undef PG8_BAR
#undef PG8_SCHED
}

struct SchedPlain {
    TileOrder o; const char* A; const char* B; size_t tstep;
    __device__ __forceinline__ bool next(int i, Unit& u) const { int pm, pn; if (!o.next(i, pm, pn)) return false; u.pm = pm; u.pn = pn; u.x0 = 0; u.x1 = 0; u.x2 = 0; u.x3 = 0; u.A = A + (size_t)pm * tstep; u.B = B + (size_t)pn * tstep; return true; }
};
struct SchedTwo {
    TileOrder o; const char* A; const char* B; size_t tstep;
    __device__ __forceinline__ bool next(int i, Unit& u) const { int pm, pn; if (!o.next(i >> 1, pm, pn)) return false; const int br = i & 1; u.pm = pm; u.pn = pn; u.x0 = br; u.x1 = 0; u.x2 = 0; u.x3 = 0;
        u.A = A + (size_t)pm * tstep + (size_t)br * (WA * 2); u.B = B + (size_t)pn * tstep + (size_t)br * (WA * 2); return true; }
};
struct SchedMoe {
    const LAS int* utab; int nunits;
    const char* Abase; const char* Bbase; size_t a_row_bytes; size_t b_exp_bytes; size_t b_tile_bytes; const int* list; int gather_k2;
    __device__ __forceinline__ bool next(int i, Unit& u) const {
        if (i >= nunits) return false;
        const int e = utab[i * 5 + 0], pn = utab[i * 5 + 1], lo_ = utab[i * 5 + 2], nv = utab[i * 5 + 3], rb = utab[i * 5 + 4];
        u.pm = e; u.pn = pn; u.x0 = lo_; u.x1 = nv; u.x2 = rb; u.x3 = i;
        u.A = Abase + (size_t)rb * a_row_bytes; u.B = Bbase + (size_t)e * b_exp_bytes + (size_t)pn * b_tile_bytes; return true; }
    __device__ __forceinline__ void offs(const Unit& u, const int (&RA)[2], const int (&CA2)[2], unsigned (&o0)[2], unsigned (&o1)[2]) const {
        const int* lp = list + (size_t)u.pm * T + u.x0;
#pragma unroll
        for (int i = 0; i < 2; ++i) {
            int r0 = RA[i], r1 = RA[i] + HALF; r0 = r0 < u.x1 ? r0 : u.x1 - 1; r1 = r1 < u.x1 ? r1 : u.x1 - 1;
            const int t0 = lp[r0] >> 1, t1 = lp[r1] >> 1;
            o0[i] = (unsigned)t0 * (unsigned)gather_k2 + (unsigned)CA2[i]; o1[i] = (unsigned)t1 * (unsigned)gather_k2 + (unsigned)CA2[i]; }
    }
};
}

using pg8::Unit;
struct EpiInProj {
    static constexpr bool PERM = true;
    unsigned char* ws;
    __device__ __forceinline__ void operator()(const f32x4 (&acc)[2][2][4][2], const Unit& u, int wr, int wc, int fr, int fq) const {
        const int pn = u.pn; bf16_t* base; int ldc, colt; float sc = 1.f; const bool gate = pn >= 12;
        if (!gate) { const int piece = pn >> 1; colt = (pn & 1) * 256; ldc = WA;
            if (piece == 0) { base = (bf16_t*)(ws + WS_QQ); ldc = D_MODEL; sc = C2; }
            else if (piece == 3) { base = (bf16_t*)(ws + WS_QQ) + WA; ldc = D_MODEL; sc = C2; }
            else base = (bf16_t*)(ws + (piece == 1 ? WS_KA : piece == 2 ? WS_VA : piece == 4 ? WS_KB : WS_VB)); }
        else { const int g = (pn - 12) >> 2; base = (bf16_t*)(ws + (g ? WS_GB : WS_GA)); ldc = D_MODEL; colt = ((pn - 12) & 3) * 256; }
        const int row0 = u.pm * 256 + wr * 64 + fr, col0 = colt + wc * 32 + 8 * fq;
#pragma unroll
        for (int ai = 0; ai < 2; ++ai)
#pragma unroll
            for (int m = 0; m < 4; ++m) { bf16_t* rowp = base + (size_t)(row0 + ai * 128 + m * 16) * ldc + col0;
#pragma unroll
                for (int bj = 0; bj < 2; ++bj) { f32x4 v0 = acc[ai][bj][m][0], v1 = acc[ai][bj][m][1];
                    if (gate) {
#pragma unroll
                        for (int i = 0; i < 4; ++i) { v0[i] = sigmoidf_(v0[i]); v1[i] = sigmoidf_(v1[i]); } }
                    else { v0 = v0 * sc; v1 = v1 * sc; }
                    u32x4 w; w.x = cvt_pk_bf16(v0[0], v0[1]); w.y = cvt_pk_bf16(v0[2], v0[3]); w.z = cvt_pk_bf16(v1[0], v1[1]); w.w = cvt_pk_bf16(v1[2], v1[3]);
                    *(u32x4*)(rowp + bj * 128) = w; } }
    }
};
struct EpiMerge {
    static constexpr bool PERM = true;
    const bf16_t* ga; const bf16_t* gb; bf16_t* merged;
    __device__ __forceinline__ void mid(f32x4 (&acc)[2][2][4][2], const Unit& u, int wr, int wc, int fr, int fq) const {
        unsigned o0 = ((unsigned)(u.pm * 256 + wr * 64 + fr) * D_MODEL + (unsigned)(u.pn * 256 + wc * 32 + 8 * fq)) * 2u;
        asm volatile("" : "+v"(o0));
#pragma unroll
        for (int ai = 0; ai < 2; ++ai)
#pragma unroll
            for (int m = 0; m < 4; ++m) {
#pragma unroll
                for (int bj = 0; bj < 2; ++bj) { const unsigned ob = o0 + (unsigned)((ai * 128 + m * 16) * D_MODEL + bj * 128) * 2u;
                    const u32x4 aw = *(const u32x4*)((const char*)ga + ob), bw = *(const u32x4*)((const char*)gb + ob);
                    const float a_[8] = {bf_lo(aw.x), bf_hi(aw.x), bf_lo(aw.y), bf_hi(aw.y), bf_lo(aw.z), bf_hi(aw.z), bf_lo(aw.w), bf_hi(aw.w)};
                    const float b_[8] = {bf_lo(bw.x), bf_hi(bw.x), bf_lo(bw.y), bf_hi(bw.y), bf_lo(bw.z), bf_hi(bw.z), bf_lo(bw.w), bf_hi(bw.w)};
#pragma unroll
                    for (int i = 0; i < 4; ++i) { acc[ai][bj][m][0][i] *= a_[i] * fast_rcp(__builtin_fmaxf(b_[i], 6.103515625e-5f)); acc[ai][bj][m][1][i] *= a_[4 + i] * fast_rcp(__builtin_fmaxf(b_[4 + i], 6.103515625e-5f)); } }
                asm volatile("" ::: "memory"); }
    }
    __device__ __forceinline__ void operator()(const f32x4 (&acc)[2][2][4][2], const Unit& u, int wr, int wc, int fr, int fq) const {
        unsigned o0 = ((unsigned)(u.pm * 256 + wr * 64 + fr) * D_MODEL + (unsigned)(u.pn * 256 + wc * 32 + 8 * fq)) * 2u;
        asm volatile("" : "+v"(o0));
#pragma unroll
        for (int ai = 0; ai < 2; ++ai)
#pragma unroll
            for (int m = 0; m < 4; ++m) {
#pragma unroll
                for (int bj = 0; bj < 2; ++bj) { const unsigned ob = o0 + (unsigned)((ai * 128 + m * 16) * D_MODEL + bj * 128) * 2u;
                    const f32x4 a0 = acc[ai][bj][m][0], a1 = acc[ai][bj][m][1];
                    const u32x4 bw = *(const u32x4*)((const char*)gb + ob);
                    const float b_[8] = {bf_lo(bw.x), bf_hi(bw.x), bf_lo(bw.y), bf_hi(bw.y), bf_lo(bw.z), bf_hi(bw.z), bf_lo(bw.w), bf_hi(bw.w)};
                    float v[8];
#pragma unroll
                    for (int i = 0; i < 4; ++i) { v[i] = a0[i] * __builtin_fmaxf(b_[i], 6.103515625e-5f); v[4 + i] = a1[i] * __builtin_fmaxf(b_[4 + i], 6.103515625e-5f); }
                    u32x4 w; w.x = cvt_pk_bf16(v[0], v[1]); w.y = cvt_pk_bf16(v[2], v[3]); w.z = cvt_pk_bf16(v[4], v[5]); w.w = cvt_pk_bf16(v[6], v[7]);
                    *(u32x4*)((char*)merged + ob) = w; }
                asm volatile("" ::: "memory"); }
    }
};
struct EpiOut {
    static constexpr bool PERM = true;
    const float* xin; const bf16_t* xb; bf16_t* pre;
    __device__ __forceinline__ void operator()(const f32x4 (&acc)[2][2][4][2], const Unit& u, int wr, int wc, int fr, int fq) const {
        const int row0 = u.pm * 256 + wr * 64 + fr, col0 = u.pn * 256 + wc * 32 + 8 * fq;
#pragma unroll
        for (int ai = 0; ai < 2; ++ai)
#pragma unroll
            for (int m = 0; m < 4; ++m) { const size_t ro = (size_t)(row0 + ai * 128 + m * 16) * D_MODEL + col0;
#pragma unroll
                for (int bj = 0; bj < 2; ++bj) { f32x4 x0, x1;
                    if (xin) { x0 = *(const f32x4*)(xin + ro + bj * 128); x1 = *(const f32x4*)(xin + ro + bj * 128 + 4); }
                    else { const u32x4 xw = *(const u32x4*)(xb + ro + bj * 128); x0 = (f32x4){bf_lo(xw.x), bf_hi(xw.x), bf_lo(xw.y), bf_hi(xw.y)}; x1 = (f32x4){bf_lo(xw.z), bf_hi(xw.z), bf_lo(xw.w), bf_hi(xw.w)}; }
                    const f32x4 v0 = x0 * ALPHA + acc[ai][bj][m][0], v1 = x1 * ALPHA + acc[ai][bj][m][1];
                    u32x4 w; w.x = cvt_pk_bf16(v0[0], v0[1]); w.y = cvt_pk_bf16(v0[2], v0[3]); w.z = cvt_pk_bf16(v1[0], v1[1]); w.w = cvt_pk_bf16(v1[2], v1[3]);
                    *(u32x4*)(pre + ro + bj * 128) = w; } }
    }
};
struct EpiGU {
    static constexpr bool PERM = true;
    bf16_t* h;
    __device__ __forceinline__ void operator()(const f32x4 (&acc)[2][2][4][2], const Unit& u, int wr, int wc, int fr, int fq) const {
        const int row0 = u.x2 + wr * 64 + fr, col0 = u.pn * 128 + wc * 32 + 8 * fq;
#pragma unroll
        for (int ai = 0; ai < 2; ++ai)
#pragma unroll
            for (int m = 0; m < 4; ++m) { bf16_t* rowp = h + (size_t)(row0 + ai * 128 + m * 16) * FE + col0; float v[8];
#pragma unroll
                for (int n = 0; n < 2; ++n)
#pragma unroll
                    for (int i = 0; i < 4; ++i) { const float g = acc[ai][0][m][n][i], uu = acc[ai][1][m][n][i]; v[n * 4 + i] = g * sigmoidf_(g) * uu; }
                u32x4 w; w.x = cvt_pk_bf16(v[0], v[1]); w.y = cvt_pk_bf16(v[2], v[3]); w.z = cvt_pk_bf16(v[4], v[5]); w.w = cvt_pk_bf16(v[6], v[7]);
                *(u32x4*)rowp = w; }
    }
};
struct EpiDown {
    static constexpr bool PERM = true;
    bf16_t* y; const LAS int* ent;
    __device__ __forceinline__ void operator()(const f32x4 (&acc)[2][2][4][2], const Unit& u, int wr, int wc, int fr, int fq) const {
        const LAS int* lp = ent + u.x3 * 256;
        const int col0 = u.pn * 256 + wc * 32 + 8 * fq;
#pragma unroll
        for (int ai = 0; ai < 2; ++ai)
#pragma unroll
            for (int m = 0; m < 4; ++m) { const int entry = lp[ai * 128 + wr * 64 + m * 16 + fr];
                if (entry >= 0) { bf16_t* rowp = y + (size_t)entry * D_MODEL + col0;
#pragma unroll
                    for (int bj = 0; bj < 2; ++bj) { const f32x4 v0 = acc[ai][bj][m][0], v1 = acc[ai][bj][m][1];
                        u32x4 w; w.x = cvt_pk_bf16(v0[0], v0[1]); w.y = cvt_pk_bf16(v0[2], v0[3]); w.z = cvt_pk_bf16(v1[0], v1[1]); w.w = cvt_pk_bf16(v1[2], v1[3]);
                        *(u32x4*)(rowp + bj * 128) = w; } } }
    }
};

namespace att {
constexpr int DM = WA, DMQ = D_MODEL;
constexpr int SLOTB = 8192, NSLOT = 8, PFD = 3;
constexpr int LDS_K = 0, LDS_V = NSLOT * SLOTB, LDS_WS = LDSCTL_OFF + 4096, LDS_TAB = LDS_WS + 8 * 256, LDS_FLG = LDS_TAB + 1024, LDS_END = LDS_FLG + 64, LDS_OST = 0;
static_assert(2 * NSLOT * SLOTB <= RING_BYTES && LDS_END <= LDS_BYTES, "attention LDS map");
#define SBAR() __builtin_amdgcn_sched_barrier(0)
#define WAIT_BAR0() asm volatile("s_waitcnt vmcnt(0) lgkmcnt(0)\n\ts_barrier" ::: "memory")
#define WAIT_BARN(N) asm volatile("s_waitcnt vmcnt(" #N ") lgkmcnt(0)\n\ts_barrier" ::: "memory")
#define STEP_WAIT(tcur, tlow) do { if ((tcur) - 2 >= (tlow)) { WAIT_BARN(4); } else if ((tcur) - 1 >= (tlow)) { WAIT_BARN(2); } else { WAIT_BAR0(); } } while (0)
__device__ __forceinline__ int crow(int r, int hi) { return (r & 3) + 8 * (r >> 2) + 4 * hi; }
__device__ __forceinline__ void glds16(const void* gsrc, unsigned lds_dst) { unsigned keep;
    asm volatile("s_mov_b32 %0, m0\n\ts_mov_b32 m0, %2\n\ts_nop 0\n\tglobal_load_lds_dwordx4 %1, off\n\ts_mov_b32 m0, %0" : "=&s"(keep) : "v"(gsrc), "s"(lds_dst) : "memory"); }
__device__ __forceinline__ float max3f(float a, float b, float c) { return __builtin_fmaxf(__builtin_fmaxf(a, b), c); }
__device__ __forceinline__ void qkt(f32x16& p0, f32x16& p1, const LAS char* Kslot, const bf16x8* qr, const f32x16& cin, int r32, int hi) {
    const LAS char* kb = Kslot + hi * 1024 + r32 * 16;
#pragma unroll
    for (int d0 = 0; d0 < 4; ++d0) {
        const bf16x8 b0 = *(const LAS bf16x8*)(kb + d0 * 2048);
        const bf16x8 b1 = *(const LAS bf16x8*)(kb + d0 * 2048 + 512);
        if (d0 == 0) { p0 = MFMA32(b0, qr[0], cin); p1 = MFMA32(b1, qr[0], cin); }
        else { p0 = MFMA32(b0, qr[d0], p0); p1 = MFMA32(b1, qr[d0], p1); } }
}
__device__ __forceinline__ float rowmax(const f32x16& p0, const f32x16& p1) {
    float a = max3f(p0[0], p0[1], p1[0]), b = max3f(p0[2], p0[3], p1[1]); a = max3f(a, p1[2], p1[3]);
#pragma unroll
    for (int r = 4; r < 16; r += 4) { a = max3f(a, p0[r], p0[r + 1]); b = max3f(b, p0[r + 2], p0[r + 3]); a = max3f(a, p1[r], p1[r + 1]); b = max3f(b, p1[r + 2], p1[r + 3]); }
    const float m = __builtin_fmaxf(a, b);
    auto rr = __builtin_amdgcn_permlane32_swap(__float_as_uint(m), __float_as_uint(m), false, false);
    return __builtin_fmaxf(__uint_as_float(rr[0]), __uint_as_float(rr[1]));
}
__device__ __forceinline__ void pv(f32x16* o, int vb, bf16x8 pa0, bf16x8 pa1, bf16x8 pa2, bf16x8 pa3) {
#pragma unroll
    for (int d0 = 0; d0 < 2; ++d0) { s16x4 lo[4], hi[4];
#pragma unroll
        for (int ks = 0; ks < 4; ++ks) {
            asm volatile("ds_read_b64_tr_b16 %0,%1 offset:%c2" : "=&v"(lo[ks]) : "v"(vb), "i"(d0 * 4096 + ks * 1024) : "memory");
            asm volatile("ds_read_b64_tr_b16 %0,%1 offset:%c2" : "=&v"(hi[ks]) : "v"(vb), "i"(d0 * 4096 + ks * 1024 + 512) : "memory"); }
        asm volatile("s_waitcnt lgkmcnt(0)" ::: "memory"); SBAR();
#define PK(k) (bf16x8){lo[k][0], lo[k][1], lo[k][2], lo[k][3], hi[k][0], hi[k][1], hi[k][2], hi[k][3]}
        o[d0] = MFMA32(pa0, PK(0), o[d0]);
        o[d0] = MFMA32(pa1, PK(1), o[d0]);
        o[d0] = MFMA32(pa2, PK(2), o[d0]);
        o[d0] = MFMA32(pa3, PK(3), o[d0]);
#undef PK
    }
}
#define PKW(P, B) cvt_pk_bf16(P[B], P[B + 1])
__device__ __forceinline__ void store_o(const f32x16* o, const float* rs, bf16_t* Ow, LAS char* shm, int wid, int lane, int r32, int hi) {
    LAS bf16_t* stg = (LAS bf16_t*)(shm + LDS_OST) + wid * 2048;
#pragma unroll
    for (int r = 0; r < 16; ++r) { const int orow = crow(r, hi);
#pragma unroll
        for (int d0 = 0; d0 < 2; ++d0) stg[orow * 64 + d0 * 32 + r32] = (bf16_t)(cvt_pk_bf16(o[d0][r] * rs[r], 0.f) & 0xffffu); }
    LDS_WAIT();
#pragma unroll
    for (int i = 0; i < 4; ++i) { const int row = i * 8 + (lane >> 3), ch = lane & 7; const u32x4 v = *(const LAS u32x4*)(stg + row * 64 + ch * 8); *(u32x4*)(Ow + (size_t)row * DMQ + ch * 8) = v; }
}

#define DMA_K(t) glds16(ksrc + (long)(t) * 64 * DM, (unsigned)__builtin_amdgcn_readfirstlane(kdst + ((t) & (NSLOT - 1)) * SLOTB))
#define DMA_V(t) glds16(vsrc + (long)(t) * 64 * DM, (unsigned)__builtin_amdgcn_readfirstlane(vdst + ((t) & (NSLOT - 1)) * SLOTB))
__device__ __forceinline__ void attn_a_unit(int b, int h, int u, const bf16_t* Q, const bf16_t* K, const bf16_t* V, bf16_t* O, const float* bias_h, LAS char* shm) {
    int tid_ = threadIdx.x; asm volatile("" : "+v"(tid_)); const int tid = tid_, lane = tid & 63, r32 = lane & 31, hi = lane >> 5; const int wid = __builtin_amdgcn_readfirstlane(tid >> 6);
    const long rowbase = (long)b * SEQ; const int q0 = u * 256;
    const bf16_t* Qw = Q + (rowbase + q0 + wid * 32) * DMQ + h * HD;
    const bf16_t* Kh = K + rowbase * DM + h * HD; const bf16_t* Vh = V + rowbase * DM + h * HD;
    const unsigned lds0 = (unsigned)(size_t)shm;
    LAS float* wsf = (LAS float*)(shm + LDS_WS) + wid * 64;
    LAS float* tab = (LAS float*)(shm + LDS_TAB);
    if (tid < 256) { int rel = tid - 64; rel = rel < -128 ? -128 : (rel > 128 ? 128 : rel); tab[tid] = bias_h[rel + 128] * LOG2E; }
    const float bfar = bias_h[256] * LOG2E;
    const bf16_t* ksrc = Kh + (long)lane * DM + wid * 8;
    const bf16_t* vsrc = Vh + (long)(16 * (wid & 3) + (lane >> 2)) * DM + (wid >> 2) * 32 + (lane & 3) * 8;
    const unsigned kdst = lds0 + LDS_K + wid * 1024, vdst = lds0 + LDS_V + wid * 1024;
    const int vb0 = (int)(lds0 + LDS_V) + ((lane >> 4) & 1) * 32 + (lane & 3) * 8 + (4 * hi + ((lane & 15) >> 2)) * 64;
    const int tb = 4 * u, pr = wid >> 1;
    const int nsteps = (tb + 4) < 9 ? (tb + 4) : 9;
    const int tlow = (tb - 8) > 0 ? (tb - 8) : 0;
    bf16x8 qr[4];
#pragma unroll
    for (int d0 = 0; d0 < 4; ++d0) qr[d0] = *(const bf16x8*)(Qw + (long)r32 * DMQ + d0 * 16 + hi * 8);
#pragma unroll
    for (int i = 3; i >= 1 - PFD; --i) { if (tb + i >= tlow) { DMA_K(tb + i); DMA_V(tb + i); } }
    float mhat = 0.f, l_reg = 0.f; f32x16 o[2]; o[0] = f32x16{}; o[1] = f32x16{};
    for (int s = 0; s < nsteps; ++s) {
        STEP_WAIT(tb - s, tlow);
        { const int tn = tb - s - PFD; if (tn >= tlow) { DMA_K(tn); DMA_V(tn); } }
        const int j = tb + pr - s;
        if (j >= 0) {
            const int sl = (j & (NSLOT - 1)) * SLOTB;
            const bool far = (s >= 3), first = (s == 0);
            f32x16 cin; const float c0 = (far ? bfar : 0.f) - mhat;
#pragma unroll
            for (int r = 0; r < 16; ++r) cin[r] = c0;
            f32x16 p0, p1;
            qkt(p0, p1, shm + LDS_K + sl, qr, cin, r32, hi);
            if (!far) {
                const LAS float* tp = tab + (s * 64 + 32 * (wid & 1) + r32 + 64 - 4 * hi);
#pragma unroll
                for (int r = 0; r < 16; ++r) { const int kv = (r & 3) + 8 * (r >> 2); p0[r] += tp[-kv]; p1[r] += tp[-kv - 32]; }
            }
            const float rm = rowmax(p0, p1);
            bool upd; float dl;
            if (first) { upd = true; dl = rm; } else { upd = __any(rm > 8.f) != 0; dl = __builtin_fmaxf(rm, 0.f); }
            if (upd) {
                mhat += dl;
#pragma unroll
                for (int r = 0; r < 16; ++r) { p0[r] -= dl; p1[r] -= dl; }
                if (!first) { const float f = fast_exp2(-dl); l_reg *= f; if (hi == 0) wsf[r32] = f; LDS_WAIT();
#pragma unroll
                    for (int r = 0; r < 16; ++r) { const float fr_ = wsf[crow(r, hi)]; o[0][r] *= fr_; o[1][r] *= fr_; } }
            }
            float sacc = 0.f;
#pragma unroll
            for (int r = 0; r < 16; ++r) { p0[r] = fast_exp2(p0[r]); p1[r] = fast_exp2(p1[r]); sacc += p0[r] + p1[r]; }
            l_reg += sacc;
            u32x4 pw0 = (u32x4){PKW(p0, 0), PKW(p0, 2), PKW(p0, 4), PKW(p0, 6)}, pw1 = (u32x4){PKW(p0, 8), PKW(p0, 10), PKW(p0, 12), PKW(p0, 14)};
            u32x4 pw2 = (u32x4){PKW(p1, 0), PKW(p1, 2), PKW(p1, 4), PKW(p1, 6)}, pw3 = (u32x4){PKW(p1, 8), PKW(p1, 10), PKW(p1, 12), PKW(p1, 14)};
            pv(o, vb0 + sl, __builtin_bit_cast(bf16x8, pw0), __builtin_bit_cast(bf16x8, pw1), __builtin_bit_cast(bf16x8, pw2), __builtin_bit_cast(bf16x8, pw3));
        }
    }
    { auto rr = __builtin_amdgcn_permlane32_swap(__float_as_uint(l_reg), __float_as_uint(l_reg), false, false); l_reg = __uint_as_float(rr[0]) + __uint_as_float(rr[1]); }
    if (hi == 0) wsf[32 + r32] = l_reg; LDS_WAIT();
    float rli[16];
#pragma unroll
    for (int r = 0; r < 16; ++r) rli[r] = fast_rcp(wsf[32 + crow(r, hi)]);
    asm volatile("s_waitcnt lgkmcnt(0)\n\ts_barrier" ::: "memory");
    store_o(o, rli, O + (rowbase + q0 + wid * 32) * DMQ + h * HD, shm, wid, lane, r32, hi);
    asm volatile("s_waitcnt lgkmcnt(0)\n\ts_barrier" ::: "memory");
}

typedef LAS const char* lds_cptr;
typedef short v4i16_t __attribute__((ext_vector_type(4)));
__device__ __forceinline__ s16x4 vtr(lds_cptr p) { return __builtin_bit_cast(s16x4, __builtin_amdgcn_ds_read_tr16_b64_v4i16((LAS v4i16_t*)p)); }
__device__ __forceinline__ void kload8(bf16x8* kf, lds_cptr kp) {
    kf[0] = *(const LAS bf16x8*)(kp);        kf[1] = *(const LAS bf16x8*)(kp + 512);
    kf[2] = *(const LAS bf16x8*)(kp + 2048); kf[3] = *(const LAS bf16x8*)(kp + 2560);
    kf[4] = *(const LAS bf16x8*)(kp + 4096); kf[5] = *(const LAS bf16x8*)(kp + 4608);
    kf[6] = *(const LAS bf16x8*)(kp + 6144); kf[7] = *(const LAS bf16x8*)(kp + 6656);
}
__device__ __forceinline__ void kload2(bf16x8* kf, lds_cptr kp, int j) { kf[2 * j] = *(const LAS bf16x8*)(kp + j * 2048); kf[2 * j + 1] = *(const LAS bf16x8*)(kp + j * 2048 + 512); }
#define WAIT_BARC(N) asm volatile("s_waitcnt vmcnt(" #N ") lgkmcnt(0)\n\ts_barrier" ::: "memory")
__device__ __forceinline__ void attn_a_unit_fast(int b, int h, int u, const bf16_t* Q, const bf16_t* K, const bf16_t* V, bf16_t* O, const float* bias_h, LAS char* shm) {
    int tid_ = threadIdx.x; asm volatile("" : "+v"(tid_)); const int tid = tid_, lane = tid & 63, r32 = lane & 31, hi = lane >> 5; const int wid = __builtin_amdgcn_readfirstlane(tid >> 6);
    const long rowbase = (long)b * SEQ; const int q0 = u * 256;
    const bf16_t* Qw = Q + (rowbase + q0 + wid * 32) * DMQ + h * HD;
    const bf16_t* Kh = K + rowbase * DM + h * HD; const bf16_t* Vh = V + rowbase * DM + h * HD;
    const unsigned lds0 = (unsigned)(size_t)shm;
    LAS float* wsf = (LAS float*)(shm + LDS_WS) + wid * 64;
    LAS float* tab = (LAS float*)(shm + LDS_TAB);
    if (tid < 256) { int rel = tid - 64; rel = rel < -128 ? -128 : (rel > 128 ? 128 : rel); tab[tid] = bias_h[rel + 128] * LOG2E; }
    const float bfar = bias_h[256] * LOG2E;
    const bf16_t* ksrc = Kh + (long)lane * DM + wid * 8;
    const bf16_t* vsrc = Vh + (long)(16 * (wid & 3) + (lane >> 2)) * DM + (wid >> 2) * 32 + (lane & 3) * 8;
    const unsigned kdst = lds0 + LDS_K + wid * 1024, vdst = lds0 + LDS_V + wid * 1024;
    const int vb0 = (int)(lds0 + LDS_V) + ((lane >> 4) & 1) * 32 + (lane & 3) * 8 + (4 * hi + ((lane & 15) >> 2)) * 64;
    const lds_cptr kp0 = (lds_cptr)shm + LDS_K + hi * 1024 + r32 * 16;
    const lds_cptr vp0 = (lds_cptr)shm + LDS_V + ((lane >> 4) & 1) * 32 + (lane & 3) * 8 + (4 * hi + ((lane & 15) >> 2)) * 64;
    const int tb = 4 * u, pr = wid >> 1;
#define SLOTOF(t) (((t) & (NSLOT - 1)) * SLOTB)
    bf16x8 qr[4];
#pragma unroll
    for (int d0 = 0; d0 < 4; ++d0) qr[d0] = *(const bf16x8*)(Qw + (long)r32 * DMQ + d0 * 16 + hi * 8);
    DMA_K(tb + 3); DMA_K(tb + 2); DMA_K(tb + 1); DMA_K(tb); DMA_K(tb - 1); DMA_V(tb + 3); DMA_V(tb + 2); DMA_V(tb + 1);
    DMA_K(tb - 2); DMA_V(tb); DMA_K(tb - 3); DMA_V(tb - 1); DMA_K(tb - 4); DMA_V(tb - 2);
    float mhat = 0.f, l_reg = 0.f; f32x16 o[2]; o[0] = f32x16{}; o[1] = f32x16{}; f32x16 negm = f32x16{}; asm volatile("" : "+v"(negm));
    bf16x8 kf[8]; f32x16 pA0, pA1, pB0, pB1; bool resc = false;
    s16x4 vlo[8], vhi[8]; u32x4 pw0, pw1, pw2, pw3;
    const int ib = 32 * (wid & 1) + r32 + 64 - 4 * hi;
#define PAF(k) __builtin_bit_cast(bf16x8, pw##k)
#define VFR(i) (bf16x8){vlo[i][0], vlo[i][1], vlo[i][2], vlo[i][3], vhi[i][0], vhi[i][1], vhi[i][2], vhi[i][3]}
#define PIN(x) asm volatile("" : "+v"(x))
#define MX3(a, b, c) __builtin_fmaxf(__builtin_fmaxf((a), (b)), (c))
#define GAPA(MF, A0, A1, A2, A3, W0, W1, PW) do { MF; sacc += A0; sacc += A1; sacc += A2; sacc += A3; PIN(sacc); W0; W1; PIN(PW); SBAR(); } while (0)
#define EX(v) __builtin_amdgcn_exp2f(v)
#define GAPB(MF, X, B) do { MF; X[B] = EX(X[B]); X[B + 1] = EX(X[B + 1]); X[B + 2] = EX(X[B + 2]); X[B + 3] = EX(X[B + 3]); PIN(X); SBAR(); } while (0)
#define VRD(i) do { vlo[i] = vtr(vp_ + (((i) >> 2) * 4096 + ((i) & 3) * 1024)); vhi[i] = vtr(vp_ + (((i) >> 2) * 4096 + ((i) & 3) * 1024 + 512)); } while (0)
#define KRD(G, j) do { if (G) { kload2(kf, kp_, j); SBAR(); } } while (0)
#define CINIT(C0, C1, S) do { const LAS float* tp_ = tab + ((S) * 64 + ib); _Pragma("unroll") for (int r = 0; r < 16; ++r) { const int kv = (r & 3) + 8 * (r >> 2); C0[r] = tp_[-kv] - mhat; C1[r] = tp_[-kv - 32] - mhat; } } while (0)
#define ASTEP(C0, C1, P0, P1, S, NWAIT) do { SBAR(); \
    const int js_ = tb + pr - (S); const lds_cptr vp_ = vp0 + SLOTOF(js_ + 1); const lds_cptr kp_ = kp0 + SLOTOF(js_ - 1); \
    if ((S) <= 2) { CINIT(C0, C1, S); SBAR(); } \
    VRD(0); SBAR(); float sacc = (P0[0] + P0[1]); \
    GAPA(C0 = MFMA32(kf[0], qr[0], ((S) <= 2 ? C0 : negm)), P0[2], P0[3], P0[4], P0[5],     pw0[0] = PKW(P0, 0), pw0[1] = PKW(P0, 2), pw0); \
    VRD(4); SBAR(); GAPA(C1 = MFMA32(kf[1], qr[0], ((S) <= 2 ? C1 : negm)), P0[6], P0[7], P0[8], P0[9],     pw0[2] = PKW(P0, 4), pw0[3] = PKW(P0, 6), pw0); \
    VRD(1); SBAR(); GAPA(C0 = MFMA32(kf[2], qr[1], C0),   P0[10], P0[11], P0[12], P0[13], pw1[0] = PKW(P0, 8), pw1[1] = PKW(P0, 10), pw1); \
    VRD(5); SBAR(); GAPA(C1 = MFMA32(kf[3], qr[1], C1),   P0[14], P0[15], P1[0], P1[1],   pw1[2] = PKW(P0, 12), pw1[3] = PKW(P0, 14), pw1); \
    VRD(2); SBAR(); GAPA(C0 = MFMA32(kf[4], qr[2], C0),   P1[2], P1[3], P1[4], P1[5],     pw2[0] = PKW(P1, 0), pw2[1] = PKW(P1, 2), pw2); \
    VRD(6); SBAR(); GAPA(C1 = MFMA32(kf[5], qr[2], C1),   P1[6], P1[7], P1[8], P1[9],     pw2[2] = PKW(P1, 4), pw2[3] = PKW(P1, 6), pw2); \
    VRD(3); SBAR(); GAPA(C0 = MFMA32(kf[6], qr[3], C0),   P1[10], P1[11], P1[12], P1[13], pw3[0] = PKW(P1, 8), pw3[1] = PKW(P1, 10), pw3); \
    VRD(7); SBAR(); GAPA(C1 = MFMA32(kf[7], qr[3], C1),   P1[14], P1[15], 0.f, 0.f,       pw3[2] = PKW(P1, 12), pw3[3] = PKW(P1, 14), pw3); \
    l_reg += sacc; \
    if ((S) <= 3) { DMA_K(tb - (S) - 5); } if ((S) <= 5) { DMA_V(tb - (S) - 3); } \
    { float a = MX3(C0[0], C0[1], C1[0]), b_ = MX3(C0[2], C0[3], C1[1]); a = MX3(a, C1[2], C1[3]); \
      _Pragma("unroll") for (int r = 4; r < 16; r += 4) { a = MX3(a, C0[r], C0[r + 1]); b_ = MX3(b_, C0[r + 2], C0[r + 3]); a = MX3(a, C1[r], C1[r + 1]); b_ = MX3(b_, C1[r + 2], C1[r + 3]); } \
      float rm = __builtin_fmaxf(a, b_); { auto rr = __builtin_amdgcn_permlane32_swap(__float_as_uint(rm), __float_as_uint(rm), false, false); rm = __builtin_fmaxf(__uint_as_float(rr[0]), __uint_as_float(rr[1])); } \
      resc = false; \
      if (__builtin_expect(__any(rm > 8.f), 0)) { const float dl = __builtin_fmaxf(rm, 0.f); mhat += dl; \
        _Pragma("unroll") for (int r = 0; r < 16; ++r) { C0[r] -= dl; C1[r] -= dl; } \
        const float f = __builtin_amdgcn_exp2f(-dl); l_reg *= f; if (hi == 0) wsf[r32] = f; resc = true; } \
      _Pragma("unroll") for (int r = 0; r < 16; ++r) negm[r] = bfar - mhat; asm volatile("" : "+v"(negm)); } \
    SBAR(); \
    GAPB(o[0] = MFMA32(PAF(0), VFR(0), o[0]), C0, 0); \
    GAPB(o[1] = MFMA32(PAF(0), VFR(4), o[1]), C0, 4); \
    KRD((S) < 8, 0); GAPB(o[0] = MFMA32(PAF(1), VFR(1), o[0]), C0, 8); \
    KRD((S) < 8, 1); GAPB(o[1] = MFMA32(PAF(1), VFR(5), o[1]), C0, 12); \
    KRD((S) < 8, 2); GAPB(o[0] = MFMA32(PAF(2), VFR(2), o[0]), C1, 0); \
    KRD((S) < 8, 3); GAPB(o[1] = MFMA32(PAF(2), VFR(6), o[1]), C1, 4); \
    GAPB(o[0] = MFMA32(PAF(3), VFR(3), o[0]), C1, 8); \
    GAPB(o[1] = MFMA32(PAF(3), VFR(7), o[1]), C1, 12); \
    WAIT_BARC(NWAIT); \
    if (resc) { LDS_WAIT(); _Pragma("unroll") for (int d_ = 0; d_ < 2; ++d_) _Pragma("unroll") for (int r = 0; r < 16; ++r) o[d_][r] *= wsf[crow(r, hi)]; } \
  } while (0)
    WAIT_BARC(9);
    { const int j0 = tb + pr; f32x16 c0v, c1v; { const LAS float* tp_ = tab + ib;
#pragma unroll
        for (int r = 0; r < 16; ++r) { const int kv = (r & 3) + 8 * (r >> 2); c0v[r] = tp_[-kv]; c1v[r] = tp_[-kv - 32]; } }
      const LAS char* kb = shm + LDS_K + SLOTOF(j0) + hi * 1024 + r32 * 16;
#pragma unroll
      for (int d0 = 0; d0 < 4; ++d0) { const bf16x8 b0 = *(const LAS bf16x8*)(kb + d0 * 2048); const bf16x8 b1 = *(const LAS bf16x8*)(kb + d0 * 2048 + 512);
          if (d0 == 0) { pA0 = MFMA32(b0, qr[0], c0v); pA1 = MFMA32(b1, qr[0], c1v); } else { pA0 = MFMA32(b0, qr[d0], pA0); pA1 = MFMA32(b1, qr[d0], pA1); } }
      kload8(kf, kp0 + SLOTOF(j0 - 1));
      const float rm = rowmax(pA0, pA1); mhat = rm;
#pragma unroll
      for (int r = 0; r < 16; ++r) { pA0[r] = EX(pA0[r] - rm); pA1[r] = EX(pA1[r] - rm); negm[r] = bfar - mhat; }
      asm volatile("" : "+v"(negm)); }
    WAIT_BARC(4);
    DMA_K(tb - 5); DMA_V(tb - 3);
    ASTEP(pB0, pB1, pA0, pA1, 1, 6);
    ASTEP(pA0, pA1, pB0, pB1, 2, 6);
    ASTEP(pB0, pB1, pA0, pA1, 3, 6);
    ASTEP(pA0, pA1, pB0, pB1, 4, 5);
    ASTEP(pB0, pB1, pA0, pA1, 5, 4);
    ASTEP(pA0, pA1, pB0, pB1, 6, 2);
    ASTEP(pB0, pB1, pA0, pA1, 7, 1);
    ASTEP(pA0, pA1, pB0, pB1, 8, 0);
    { float sacc = 0.f;
#pragma unroll
      for (int r = 0; r < 16; ++r) sacc += pA0[r] + pA1[r];
      l_reg += sacc;
      pw0 = (u32x4){PKW(pA0, 0), PKW(pA0, 2), PKW(pA0, 4), PKW(pA0, 6)}; pw1 = (u32x4){PKW(pA0, 8), PKW(pA0, 10), PKW(pA0, 12), PKW(pA0, 14)};
      pw2 = (u32x4){PKW(pA1, 0), PKW(pA1, 2), PKW(pA1, 4), PKW(pA1, 6)}; pw3 = (u32x4){PKW(pA1, 8), PKW(pA1, 10), PKW(pA1, 12), PKW(pA1, 14)};
      SBAR(); pv(o, vb0 + SLOTOF(tb + pr - 8), PAF(0), PAF(1), PAF(2), PAF(3)); }
    { auto rr = __builtin_amdgcn_permlane32_swap(__float_as_uint(l_reg), __float_as_uint(l_reg), false, false); l_reg = __uint_as_float(rr[0]) + __uint_as_float(rr[1]); }
    if (hi == 0) wsf[32 + r32] = l_reg; LDS_WAIT();
    float rli[16];
#pragma unroll
    for (int r = 0; r < 16; ++r) rli[r] = fast_rcp(wsf[32 + crow(r, hi)]);
    asm volatile("s_waitcnt lgkmcnt(0)\n\ts_barrier" ::: "memory");
    store_o(o, rli, O + (rowbase + q0 + wid * 32) * DMQ + h * HD, shm, wid, lane, r32, hi);
    asm volatile("s_waitcnt lgkmcnt(0)\n\ts_barrier" ::: "memory");
#undef SLOTOF
#undef PAF
#undef VFR
#undef PIN
#undef MX3
#undef GAPA
#undef EX
#undef GAPB
#undef VRD
#undef KRD
#undef CINIT
#undef ASTEP
}

__device__ __forceinline__ void attn_b_unit(int b, int h, int qb, const bf16_t* Q, const bf16_t* K, const bf16_t* V, bf16_t* O, LAS char* shm) {
    int tid_ = threadIdx.x; asm volatile("" : "+v"(tid_)); const int tid = tid_, lane = tid & 63, r32 = lane & 31, hi = lane >> 5; const int wid = __builtin_amdgcn_readfirstlane(tid >> 6);
    const long rowbase = (long)b * SEQ; const int q0 = qb * 256;
    const bf16_t* Qw = Q + (rowbase + q0 + wid * 32) * DMQ + h * HD;
    const bf16_t* Kh = K + rowbase * DM + h * HD; const bf16_t* Vh = V + rowbase * DM + h * HD;
    const unsigned lds0 = (unsigned)(size_t)shm;
    LAS unsigned* flg = (LAS unsigned*)(shm + LDS_FLG);
    const bf16_t* ksrc = Kh + (long)lane * DM + wid * 8;
    const bf16_t* vsrc = Vh + (long)(16 * (wid & 3) + (lane >> 2)) * DM + (wid >> 2) * 32 + (lane & 3) * 8;
    const unsigned kdst = lds0 + LDS_K + wid * 1024, vdst = lds0 + LDS_V + wid * 1024;
    const int vb0 = (int)(lds0 + LDS_V) + ((lane >> 4) & 1) * 32 + (lane & 3) * 8 + (4 * hi + ((lane & 15) >> 2)) * 64;
    const int tb = 4 * qb, pr = wid >> 1;
    const int tq = 32 * (wid & 1) + r32;
    bf16x8 qr[4];
#pragma unroll
    for (int d0 = 0; d0 < 4; ++d0) qr[d0] = *(const bf16x8*)(Qw + (long)r32 * DMQ + d0 * 16 + hi * 8);
#pragma unroll
    for (int i = 3; i >= 1 - PFD; --i) { if (tb + i >= 0) { DMA_K(tb + i); DMA_V(tb + i); } }
    float R = 1.0f; bool wdone = false; f32x16 o[2]; o[0] = f32x16{}; o[1] = f32x16{};
    for (int s = 0; ; ++s) {
        STEP_WAIT(tb - s, 0);
        if (s > 0) { const LAS unsigned* f = flg + ((s - 1) & 1) * 8; unsigned all = 1u;
#pragma unroll
            for (int w = 0; w < 8; ++w) all &= f[w];
            if (__builtin_amdgcn_readfirstlane(all) != 0u) break; }
        { const int tn = tb - s - PFD; if (tn >= 0) { DMA_K(tn); DMA_V(tn); } }
        const int j = tb + pr - s;
        if (j >= 0 && !wdone) {
            const int sl = (j & (NSLOT - 1)) * SLOTB;
            f32x16 cin = f32x16{}; f32x16 p0, p1;
            qkt(p0, p1, shm + LDS_K + sl, qr, cin, r32, hi);
#pragma unroll
            for (int r = 0; r < 16; ++r) { p0[r] = fast_rcp(1.0f + fast_exp2(p0[r])); p1[r] = fast_rcp(1.0f + fast_exp2(p1[r])); }
            if (s == 0) {
#pragma unroll
                for (int r = 0; r < 16; ++r) { const int kv = crow(r, hi); if (kv >= tq) p0[r] = 1.0f; if (kv + 32 >= tq) p1[r] = 1.0f; } }
            float W[8], part[8];
#pragma unroll
            for (int i = 0; i < 8; ++i) { const float pb = (i < 4) ? (p0[4 * i] * p0[4 * i + 1]) * (p0[4 * i + 2] * p0[4 * i + 3]) : (p1[4 * i - 16] * p1[4 * i - 15]) * (p1[4 * i - 14] * p1[4 * i - 13]);
                auto rr = __builtin_amdgcn_permlane32_swap(__float_as_uint(pb), __float_as_uint(pb), false, false);
                const float vlo = __uint_as_float(rr[0]), vhi = __uint_as_float(rr[1]);
                W[i] = vlo * vhi; part[i] = hi ? 1.0f : vhi; }
            float sw = R;
#pragma unroll
            for (int i = 7; i >= 0; --i) { float c = sw * part[i];
                if (i < 4) {
#pragma unroll
                    for (int rr_ = 3; rr_ >= 0; --rr_) { const float t_ = c * p0[4 * i + rr_]; p0[4 * i + rr_] = c - t_; c = t_; } }
                else {
#pragma unroll
                    for (int rr_ = 3; rr_ >= 0; --rr_) { const float t_ = c * p1[4 * i - 16 + rr_]; p1[4 * i - 16 + rr_] = c - t_; c = t_; } }
                sw *= W[i]; }
            R = sw;
            u32x4 pw0 = (u32x4){PKW(p0, 0), PKW(p0, 2), PKW(p0, 4), PKW(p0, 6)}, pw1 = (u32x4){PKW(p0, 8), PKW(p0, 10), PKW(p0, 12), PKW(p0, 14)};
            u32x4 pw2 = (u32x4){PKW(p1, 0), PKW(p1, 2), PKW(p1, 4), PKW(p1, 6)}, pw3 = (u32x4){PKW(p1, 8), PKW(p1, 10), PKW(p1, 12), PKW(p1, 14)};
            pv(o, vb0 + sl, __builtin_bit_cast(bf16x8, pw0), __builtin_bit_cast(bf16x8, pw1), __builtin_bit_cast(bf16x8, pw2), __builtin_bit_cast(bf16x8, pw3));
            wdone = __all(R == 0.0f) != 0;
        }
        if (j <= 0) wdone = true;
        if (lane == 0) flg[(s & 1) * 8 + wid] = wdone ? 1u : 0u;
    }
    float ones[16];
#pragma unroll
    for (int r = 0; r < 16; ++r) ones[r] = 1.0f;
    asm volatile("s_waitcnt vmcnt(0) lgkmcnt(0)\n\ts_barrier" ::: "memory");
    store_o(o, ones, O + (rowbase + q0 + wid * 32) * DMQ + h * HD, shm, wid, lane, r32, hi);
    asm volatile("s_waitcnt lgkmcnt(0)\n\ts_barrier" ::: "memory");
}
#undef DMA_K
#undef DMA_V
#undef PKW
#undef SBAR
#undef WAIT_BAR0
}

#define XB_TMO      128
#define XB_XCNT(j)  (256  + 64 * (j))
#define XB_XSUB(j)  (1280 + 64 * (j))
#define XB_XGEN(j)  (2304 + 64 * (j))
#define XB_TOP      3328
#define XB_TOPGEN   3392
#define XCD_BAR_WORDS 3456
#define XB_SPIN_CAP (1u << 22)
__device__ __forceinline__ unsigned xb_ld(unsigned* p)              { return __hip_atomic_load(p, __ATOMIC_RELAXED, __HIP_MEMORY_SCOPE_AGENT); }
__device__ __forceinline__ unsigned xb_add(unsigned* p, unsigned v) { return __hip_atomic_fetch_add(p, v, __ATOMIC_RELAXED, __HIP_MEMORY_SCOPE_AGENT); }
__device__ __forceinline__ unsigned xb_xcc_id() { return (unsigned)__builtin_amdgcn_s_getreg((3 << 11) | 20) & 0xFu; }
#define XB_SPIN(cond, bar) do { unsigned _sp = 0; while (cond) { __builtin_amdgcn_s_sleep(1); \
    if ((++_sp & 255u) == 0u) { if (xb_ld(&(bar)[XB_TMO])) break; if (_sp > XB_SPIN_CAP) { atomicAdd(&(bar)[XB_TMO], 1u); break; } } } } while (0)
struct XcdBarrier { unsigned* bar; unsigned x; volatile LAS unsigned* st; };
__device__ __forceinline__ XcdBarrier xcd_barrier_post(unsigned* bar, volatile LAS unsigned* st) {
    XcdBarrier b; b.bar = bar; b.x = xb_xcc_id(); b.st = st;
    if (threadIdx.x == 0) (void)xb_add(&bar[XB_XCNT(b.x)], 1u);
    return b;
}
__device__ __forceinline__ void xcd_barrier_complete(unsigned* bar, unsigned x, unsigned& nloc, unsigned& nx) {
    const unsigned G = gridDim.x * gridDim.y * gridDim.z;
    unsigned sum, cnt, mine, sp = 0u;
    for (;;) {
        sum = 0u; cnt = 0u; mine = 0u;
#pragma unroll
        for (unsigned j = 0; j < 16; ++j) { const unsigned c = xb_ld(&bar[XB_XCNT(j)]); sum += c; cnt += (c > 0u) ? 1u : 0u; mine = (j == x) ? c : mine; }
        if (sum == G) break;
        __builtin_amdgcn_s_sleep(1);
        if ((++sp & 255u) == 0u) { if (xb_ld(&bar[XB_TMO])) break; if (sp > XB_SPIN_CAP) { atomicAdd(&bar[XB_TMO], 1u); break; } }
    }
    nloc = mine > 0u ? mine : 1u; nx = cnt > 0u ? cnt : 1u;
}
__device__ __forceinline__ void xcd_barrier(const XcdBarrier& b) {
    asm volatile("s_waitcnt vmcnt(0)" ::: "memory");
    __syncthreads();
    if (threadIdx.x == 0) {
        unsigned* bar = b.bar;
        __builtin_amdgcn_s_waitcnt(0);
        unsigned nloc = b.st[0], nx = b.st[1];
        if (nloc == 0u) { xcd_barrier_complete(bar, b.x, nloc, nx); b.st[0] = nloc; b.st[1] = nx; }
        const unsigned old = xb_add(&bar[XB_XSUB(b.x)], 1u);
        const unsigned gen = old / nloc;
        if (old + 1u == (gen + 1u) * nloc) {
            __builtin_amdgcn_fence(__ATOMIC_RELEASE, "agent");
            asm volatile("s_waitcnt vmcnt(0)" ::: "memory");
            const unsigned og = xb_add(&bar[XB_TOP], 1u);
            const unsigned tg = og / nx;
            if (og + 1u == (tg + 1u) * nx) xb_add(&bar[XB_TOPGEN], 1u);
            else XB_SPIN(xb_ld(&bar[XB_TOPGEN]) == tg, bar);
            __builtin_amdgcn_fence(__ATOMIC_ACQUIRE, "agent");
            xb_add(&bar[XB_XGEN(b.x)], 1u);
            asm volatile("s_waitcnt vmcnt(0)" ::: "memory");
        } else {
            XB_SPIN(xb_ld(&bar[XB_XGEN(b.x)]) == gen, bar);
            __builtin_amdgcn_fence(__ATOMIC_ACQUIRE, "agent");
            asm volatile("s_waitcnt vmcnt(0)" ::: "memory");
        }
    }
    __syncthreads();
}

__device__ __forceinline__ unsigned f2bf(float f) { unsigned u = __builtin_bit_cast(unsigned, f); return (u + 0x7fffu + ((u >> 16) & 1u)) >> 16; }
__device__ __forceinline__ unsigned pk2(float lo, float hi) { return cvt_pk_bf16(lo, hi); }
__device__ __forceinline__ void transpose_item(const float* W, int K, int N, bf16_t* WT, int row_off, LAS float* scr, int item, int lane, int ldw = 0, int koff = 0) {
    if (ldw == 0) ldw = K;
    const int nblk = N / 32, kb = item / nblk, nb = item % nblk, k0 = 64 * kb, n0 = 32 * nb;
    f32x4 ld[8];
#pragma unroll
    for (int i = 0; i < 8; ++i) ld[i] = *(const f32x4*)(W + (size_t)(k0 + 8 * i + (lane >> 3)) * N + n0 + 4 * (lane & 7));
#pragma unroll
    for (int i = 0; i < 8; ++i) { LAS float* d = scr + (8 * i + (lane >> 3)) * 33 + 4 * (lane & 7); d[0] = ld[i].x; d[1] = ld[i].y; d[2] = ld[i].z; d[3] = ld[i].w; }
    LDS_WAIT(); asm volatile("" ::: "memory");
    const int c = lane & 7;
#pragma unroll
    for (int j = 0; j < 4; ++j) { const int n = (lane >> 3) + 8 * j; const LAS float* s = scr + (8 * c) * 33 + n;
        u32x4 o; o.x = pk2(s[0 * 33], s[1 * 33]); o.y = pk2(s[2 * 33], s[3 * 33]); o.z = pk2(s[4 * 33], s[5 * 33]); o.w = pk2(s[6 * 33], s[7 * 33]);
        *(u32x4*)(WT + (size_t)(row_off + n0 + n) * ldw + koff + k0 + 8 * c) = o; }
    LDS_WAIT(); asm volatile("" ::: "memory");
}

struct Args { const float* in[15]; float* out; unsigned char* ws; int ph_lo, ph_hi, li, pad; };
typedef const __attribute__((address_space(4))) char* kptr_t;
__device__ __forceinline__ kptr_t kbase() { kptr_t kp = (kptr_t)__builtin_amdgcn_kernarg_segment_ptr(); asm volatile("" : "+s"(kp)); return kp; }
__device__ __forceinline__ const float* arg_in(int i) { return *(const float* const __attribute__((address_space(4)))*)(kbase() + 8 * i); }
__device__ __forceinline__ float* arg_out() { return *(float* const __attribute__((address_space(4)))*)(kbase() + 120); }
__device__ __forceinline__ unsigned char* arg_ws() { return *(unsigned char* const __attribute__((address_space(4)))*)(kbase() + 128); }
__device__ __forceinline__ int arg_lo() { return *(const __attribute__((address_space(4))) int*)(kbase() + 136); }
__device__ __forceinline__ int arg_hi() { return *(const __attribute__((address_space(4))) int*)(kbase() + 140); }
__device__ __forceinline__ int arg_li() { return *(const __attribute__((address_space(4))) int*)(kbase() + 144); }
static_assert(sizeof(Args) == 152, "Args layout");

constexpr int NWAVES = 8;
constexpr int PH_PER_LAYER = 8, N_PHASES = 1 + DEPTH * PH_PER_LAYER;
#define PH_COMMON() int tid_ = threadIdx.x; asm volatile("" : "+v"(tid_)); const int tid = tid_, lane = tid & 63, wave = __builtin_amdgcn_readfirstlane(tid >> 6); const int G = gridDim.x, bx = blockIdx.x; \
    const int vcu = (G % 8 == 0) ? (bx % 8) * (G / 8) + bx / 8 : bx; const int gw = vcu * NWAVES + wave, NGW = G * NWAVES; unsigned char* ws = arg_ws(); \
    (void)tid; (void)lane; (void)wave; (void)vcu; (void)gw; (void)NGW; (void)ws

__device__ __forceinline__ void convert_weights(int l, LAS unsigned char* lds) {
    PH_COMMON();
    LAS float* scr = (LAS float*)(lds + wave * 16384);
    const float* w_in = arg_in(1) + (size_t)l * D_MODEL * PROJ;
    const float* w_upa = arg_in(3) + (size_t)l * WA * D_MODEL;
    const float* w_upb = arg_in(4) + (size_t)l * WA * D_MODEL;
    const float* w_out = arg_in(5) + (size_t)l * D_MODEL * D_MODEL;
    const float* w_gate = arg_in(10) + (size_t)l * NE * D_MODEL * FE;
    const float* w_up = arg_in(11) + (size_t)l * NE * D_MODEL * FE;
    const float* w_down = arg_in(12) + (size_t)l * NE * FE * D_MODEL;
    constexpr int I_IN = (D_MODEL / 64) * (PROJ / 32), I_UP = (WA / 64) * (D_MODEL / 32), I_OUT = (D_MODEL / 64) * (D_MODEL / 32);
    constexpr int I_G = (D_MODEL / 64) * (FE / 32), I_D = (FE / 64) * (D_MODEL / 32);
    constexpr int NITEMS = I_IN + 2 * I_UP + I_OUT + NE * (2 * I_G + I_D);
    for (int it = gw; it < NITEMS; it += NGW) {
        int r = it;
        if (r < I_IN) { transpose_item(w_in, D_MODEL, PROJ, (bf16_t*)(ws + WS_WIN), 0, scr, r, lane); continue; } r -= I_IN;
        if (r < I_UP) { transpose_item(w_upa, WA, D_MODEL, (bf16_t*)(ws + WS_WUP), 0, scr, r, lane, D_MODEL, 0); continue; } r -= I_UP;
        if (r < I_UP) { transpose_item(w_upb, WA, D_MODEL, (bf16_t*)(ws + WS_WUP), 0, scr, r, lane, D_MODEL, WA); continue; } r -= I_UP;
        if (r < I_OUT) { transpose_item(w_out, D_MODEL, D_MODEL, (bf16_t*)(ws + WS_WOUT), 0, scr, r, lane); continue; } r -= I_OUT;
        const int e = r / (2 * I_G + I_D); r -= e * (2 * I_G + I_D);
        if (r < 2 * I_G) { const int up = r >= I_G; if (up) r -= I_G;
            const int nb = r % (FE / 32), n0 = nb * 32;
            const int row_off = e * 1024 + (n0 / 128) * 128 + (up ? 128 : 0);
            transpose_item((up ? w_up : w_gate) + (size_t)e * D_MODEL * FE, D_MODEL, FE, (bf16_t*)(ws + WS_WGU), row_off, scr, r, lane); continue; }
        r -= 2 * I_G;
        transpose_item(w_down + (size_t)e * FE * D_MODEL, FE, D_MODEL, (bf16_t*)(ws + WS_WD), e * 1024, scr, r, lane);
    }
}

__device__ __forceinline__ void phase0(LAS unsigned char* lds) {
    convert_weights(0, lds);
    PH_COMMON();
    const float* x_in = arg_in(0); bf16_t* XB = (bf16_t*)(ws + WS_XB);
    {
        const float* w_router = arg_in(8); const float* b_router = arg_in(9);
        for (int p = gw * 64 + lane; p < DEPTH * 2048; p += NGW * 64) { const int ll = p >> 11, q = p & 2047, kt = q >> 6, ln = q & 63, n = ln & 15, c0 = 32 * kt + 8 * (ln >> 4);
            const float* g1 = arg_in(6) + (size_t)ll * D_MODEL; unsigned hw[4], lw[4];
#pragma unroll
            for (int j = 0; j < 4; ++j) { const float w0 = g1[c0 + 2 * j] * w_router[(c0 + 2 * j) * 16 + n], w1 = g1[c0 + 2 * j + 1] * w_router[(c0 + 2 * j + 1) * 16 + n];
                hw[j] = cvt_pk_bf16(w0, w1); lw[j] = cvt_pk_bf16(w0 - bf_lo(hw[j]), w1 - bf_hi(hw[j])); }
            unsigned char* tb = ws + WS_RTAB + (size_t)ll * RTAB_STRIDE;
            *(u32x4*)(tb + q * 16) = (u32x4){hw[0], hw[1], hw[2], hw[3]}; *(u32x4*)(tb + 32768 + q * 16) = (u32x4){lw[0], lw[1], lw[2], lw[3]}; }
        for (int idx = gw; idx < DEPTH * 32; idx += NGW) { const int ll = idx >> 5, wh = (idx >> 4) & 1, e = idx & 15;
            const float* vv = (wh ? arg_in(7) : arg_in(6)) + (size_t)ll * D_MODEL; float s = 0.f;
            for (int c = lane; c < D_MODEL; c += 64) s += vv[c] * w_router[c * 16 + e];
            s = wave_sum(s); if (wh) s += b_router[e];
            if (lane == 0) ((float*)(ws + WS_RTAB + (size_t)ll * RTAB_STRIDE + 65536))[wh * 16 + e] = s; }
    }
    for (int m = gw; m < T; m += NGW) { const f32x4* xr = (const f32x4*)(x_in + (size_t)m * D_MODEL) + lane; u32x2* o8 = (u32x2*)(XB + (size_t)m * D_MODEL) + lane;
#pragma unroll
        for (int j = 0; j < 4; ++j) { const f32x4 v = xr[64 * j]; u32x2 w; w.x = cvt_pk_bf16(v.x, v.y); w.y = cvt_pk_bf16(v.z, v.w); o8[64 * j] = w; } }
}
__device__ __forceinline__ void phase1(LAS unsigned char* lds) {
    PH_COMMON();
    pg8::SchedPlain S; S.o.init(T / 256, PROJ / 256, G, bx); S.A = (const char*)(ws + WS_XB); S.B = (const char*)(ws + WS_WIN); S.tstep = (size_t)256 * D_MODEL * 2;
    EpiInProj E{ws};
    pg8::gemm_phase<EpiInProj, pg8::SchedPlain, false, true>(lds, D_MODEL, S, E);
}
__device__ __forceinline__ void phase2(LAS unsigned char* lds, int l) {
    PH_COMMON();
    const int bh = vcu >> 2, s = vcu & 3; const int b = bh >> 3, h = bh & 7;
    if (G != 256) return;
    const float* bias_h = arg_in(2) + ((size_t)l * NH + h) * N_REL;
    bf16_t* QAp = (bf16_t*)(ws + WS_QQ); bf16_t* KAp = (bf16_t*)(ws + WS_KA); bf16_t* VAp = (bf16_t*)(ws + WS_VA);
    bf16_t* QBp = (bf16_t*)(ws + WS_QQ) + WA; bf16_t* KBp = (bf16_t*)(ws + WS_KB); bf16_t* VBp = (bf16_t*)(ws + WS_VB);
    PBS_BEGIN(6, lds);
    for (int i = 0; i < 4; ++i) { const int u = (i == 0) ? s : (i == 1) ? 7 - s : (i == 2) ? 8 + s : 15 - s; if (u >= 2) att::attn_a_unit_fast(b, h, u, QAp, KAp, VAp, QAp, bias_h, (LAS char*)lds); else att::attn_a_unit(b, h, u, QAp, KAp, VAp, QAp, bias_h, (LAS char*)lds); }
    PBS_END(6, lds); PBS_BEGIN(7, lds);
    for (int i = 0; i < 4; ++i) { const int u = (i == 0) ? s : (i == 1) ? 7 - s : (i == 2) ? 8 + s : 15 - s; att::attn_b_unit(b, h, u, QBp, KBp, VBp, QBp, (LAS char*)lds); }
    PBS_END(7, lds);
}
__device__ __forceinline__ void phase3(LAS unsigned char* lds) {
    PH_COMMON();
    pg8::SchedTwo S; S.o.init(T / 256, D_MODEL / 256, G, bx); S.A = (const char*)(ws + WS_QQ); S.B = (const char*)(ws + WS_WUP); S.tstep = (size_t)256 * D_MODEL * 2;
    EpiMerge E{(const bf16_t*)(ws + WS_GA), (const bf16_t*)(ws + WS_GB), (bf16_t*)(ws + WS_MERGED)};
    pg8::gemm_phase<EpiMerge, pg8::SchedTwo, false, true, true>(lds, WA, S, E, D_MODEL);
}
__device__ __forceinline__ void phase4(LAS unsigned char* lds, int l) {
    PH_COMMON();
    pg8::SchedPlain S; S.o.init(T / 256, D_MODEL / 256, G, bx); S.A = (const char*)(ws + WS_MERGED); S.B = (const char*)(ws + WS_WOUT); S.tstep = (size_t)256 * D_MODEL * 2;
    EpiOut E{(l == 0) ? arg_in(0) : (const float*)nullptr, (const bf16_t*)(ws + WS_XB), (bf16_t*)(ws + WS_PRE)};
    pg8::gemm_phase<EpiOut, pg8::SchedPlain, false, true>(lds, D_MODEL, S, E);
}
#define dppf(v, ctrl) __builtin_bit_cast(float, __builtin_amdgcn_update_dpp(__builtin_bit_cast(int, (float)(v)), __builtin_bit_cast(int, (float)(v)), ctrl, 0xf, 0xf, false))
#define dppi(v, ctrl) __builtin_amdgcn_update_dpp((int)(v), (int)(v), ctrl, 0xf, 0xf, false)
__device__ __forceinline__ void phase5(LAS unsigned char* lds, int l) {
    static_assert(USE_F16 == 1, "the MFMA router path takes the pre-LN tensor as IEEE half");
    PH_COMMON();
    const float* g1 = arg_in(6) + (size_t)l * D_MODEL; const float* b1 = arg_in(7) + (size_t)l * D_MODEL;
    bf16_t* XB = (bf16_t*)(ws + WS_XB); const bf16_t* PRE = (const bf16_t*)(ws + WS_PRE);
    int* LIST = (int*)(ws + WS_LIST); f32x2* RECW = (f32x2*)(ws + WS_RECW);
    unsigned* gcnt = (unsigned*)(ws + WS_CTL) + CW_CNT + 64 * l;
    PBS_BEGIN(1, lds);
    LAS float* S23 = (LAS float*)(lds + 69632); LAS f32x2* rstat = (LAS f32x2*)(lds + 70656) + wave * 16;
    LAS unsigned* lcnt = (LAS unsigned*)(lds + 81920);
    LAS int* lrec = (LAS int*)(lds + 81920 + 256);
    { const unsigned char* tb = ws + WS_RTAB + (size_t)l * RTAB_STRIDE;
        for (int i = tid; i < 4096; i += NWAVES * 64) ((LAS u32x4*)lds)[i] = ((const u32x4*)tb)[i];
        if (tid < 32) { S23[tid] = ((const float*)(tb + 65536))[tid]; lcnt[tid] = 0u; } }
    __syncthreads();
    PBS_END(1, lds); PBS_BEGIN(2, lds);
    int krow = 0;
    u32x2 nv[4];
    { const u32x2* pr = (const u32x2*)(PRE + (size_t)gw * D_MODEL) + lane;
#pragma unroll
      for (int j = 0; j < 4; ++j) nv[j] = pr[64 * j]; }
    for (int m = gw; m < T; m += NGW, ++krow) {
        f32x4 v[4]; float s = 0.f;
#pragma unroll
        for (int j = 0; j < 4; ++j) { v[j] = (f32x4){bf_lo(nv[j].x), bf_hi(nv[j].x), bf_lo(nv[j].y), bf_hi(nv[j].y)}; s += (v[j].x + v[j].y) + (v[j].z + v[j].w); }
        if (m + NGW < T) { const u32x2* pr = (const u32x2*)(PRE + (size_t)(m + NGW) * D_MODEL) + lane;
#pragma unroll
            for (int j = 0; j < 4; ++j) nv[j] = pr[64 * j]; }
        const float mean = wave_sum(s) * (1.f / D_MODEL); float s2 = 0.f;
#pragma unroll
        for (int j = 0; j < 4; ++j) { v[j] = v[j] - mean; s2 += (v[j].x * v[j].x + v[j].y * v[j].y) + (v[j].z * v[j].z + v[j].w * v[j].w); }
        const float rstd = 1.f / sqrtf(wave_sum(s2) * (1.f / D_MODEL) + LN_EPS);
        if (lane == 0) rstat[krow] = (f32x2){mean, rstd};
#pragma unroll
        for (int j = 0; j < 4; ++j) { const f32x4 gg = *((const f32x4*)g1 + lane + 64 * j), bb = *((const f32x4*)b1 + lane + 64 * j);
            v[j] = v[j] * rstd * gg + bb;
            u32x2 w; w.x = cvt_pk_bf16(v[j].x, v[j].y); w.y = cvt_pk_bf16(v[j].z, v[j].w); *((u32x2*)(XB + (size_t)m * D_MODEL) + lane + 64 * j) = w; }
    }
    {
        const int n = lane & 15, kg = lane >> 4;
        const bf16_t* arow = PRE + (size_t)(gw + n * NGW) * D_MODEL + 8 * kg;
        f32x4 acc = (f32x4){0.f, 0.f, 0.f, 0.f};
#pragma unroll 4
        for (int kt = 0; kt < 32; ++kt) { const bf16x8 a = *(const bf16x8*)(arow + 32 * kt);
            const bf16x8 bh = *(const LAS bf16x8*)(lds + (kt * 64 + lane) * 16), bl = *(const LAS bf16x8*)(lds + 32768 + (kt * 64 + lane) * 16);
            acc = MFMA16(a, bh, acc); acc = MFMA16(a, bl, acc); }
        const float s2n = S23[n], s3n = S23[16 + n];
#pragma unroll
        for (int i = 0; i < 4; ++i) {
            const int kr = 4 * kg + i; const f32x2 st = rstat[kr];
            const float v = st.y * (acc[i] - st.x * s2n) + s3n;
            float mx = v; mx = fmaxf(mx, dppf(mx, 0xB1)); mx = fmaxf(mx, dppf(mx, 0x4E)); mx = fmaxf(mx, dppf(mx, 0x141)); mx = fmaxf(mx, dppf(mx, 0x140));
            int best = (v == mx) ? n : 16; best = min(best, dppi(best, 0xB1)); best = min(best, dppi(best, 0x4E)); best = min(best, dppi(best, 0x141)); best = min(best, dppi(best, 0x140));
            const float u = (n == best) ? -3.0e38f : v;
            float m2 = u; m2 = fmaxf(m2, dppf(m2, 0xB1)); m2 = fmaxf(m2, dppf(m2, 0x4E));
            int e2 = (u == m2) ? n : 16; e2 = min(e2, dppi(e2, 0xB1)); e2 = min(e2, dppi(e2, 0x4E));
            if (n == best) { const int m = gw + kr * NGW;
                const float w1 = fast_rcp(1.0f + fast_exp2((m2 - v) * LOG2E)), w2 = 1.0f - w1;
                RECW[m] = (f32x2){w1, w2};
                const int lp1 = (int)__hip_atomic_fetch_add(lcnt + best, 1u, __ATOMIC_RELAXED, __HIP_MEMORY_SCOPE_WORKGROUP);
                const int lp2 = (int)__hip_atomic_fetch_add(lcnt + e2, 1u, __ATOMIC_RELAXED, __HIP_MEMORY_SCOPE_WORKGROUP);
                LAS int* rp = lrec + (wave * 16 + kr) * 4; rp[0] = best; rp[1] = lp1; rp[2] = e2; rp[3] = lp2; }
        }
    }
    PBS_END(2, lds);
    __syncthreads();
    PBS_BEGIN(3, lds);
    if (tid < 16) { const unsigned n = lcnt[tid]; lcnt[16 + tid] = n ? __hip_atomic_fetch_add(gcnt + tid, n, __ATOMIC_RELAXED, __HIP_MEMORY_SCOPE_AGENT) : 0u; }
    __syncthreads();
    if (lane < 16 && gw + lane * NGW < T) { const int m = gw + lane * NGW; const LAS int* rp = lrec + (wave * 16 + lane) * 4;
        LIST[(size_t)rp[0] * T + lcnt[16 + rp[0]] + rp[1]] = m * 2; LIST[(size_t)rp[2] * T + lcnt[16 + rp[2]] + rp[3]] = m * 2 + 1; }
    __syncthreads();
    PBS_END(3, lds);
}
__device__ __forceinline__ int moe_units(LAS unsigned char* lds, int l) {
    PH_COMMON();
    LAS int* utab = (LAS int*)(lds + UTAB_OFF);
    unsigned* gcnt = (unsigned*)(ws + WS_CTL) + CW_CNT + 64 * l;
    __syncthreads();
    if (tid == 0) {
        LAS int* ts = utab + 128; LAS int* ncnt = utab + 160;
        int acc_t = 0;
        for (int e = 0; e < 16; ++e) { const int n = (int)__hip_atomic_load(gcnt + e, __ATOMIC_RELAXED, __HIP_MEMORY_SCOPE_AGENT); ncnt[e] = n; ts[e] = acc_t; acc_t += (n + 255) / 256; }
        ts[16] = acc_t;
        const int nunits = acc_t * 4; int cnt = 0;
        for (int i = 0; cnt < 6; ++i) { const long L = (long)i * G + bx; if (L >= nunits) break;
            int U = (int)L; { const int q = nunits / 8, r = nunits % 8, xcd = U % 8, off = U / 8; U = (xcd < r ? xcd * (q + 1) : r * (q + 1) + (xcd - r) * q) + off; }
            const int tile = U >> 2, pn = U & 3; int e = 0; while (ts[e + 1] <= tile) ++e;
            const int mt = tile - ts[e]; const int n = ncnt[e]; const int nv = (n - 256 * mt) < 256 ? (n - 256 * mt) : 256;
            utab[cnt * 5 + 0] = e; utab[cnt * 5 + 1] = pn; utab[cnt * 5 + 2] = mt * 256; utab[cnt * 5 + 3] = nv; utab[cnt * 5 + 4] = tile * 256;
            ++cnt; }
        utab[192] = cnt;
    }
    __syncthreads();
    return utab[192];
}
__device__ __forceinline__ void phase6(LAS unsigned char* lds, int l) {
    const int nun = moe_units(lds, l);
    PH_COMMON();
    pg8::SchedMoe S; S.utab = (LAS int*)(lds + UTAB_OFF); S.nunits = nun; S.Abase = (const char*)(ws + WS_XB); S.Bbase = (const char*)(ws + WS_WGU); S.a_row_bytes = 0;
    S.b_exp_bytes = (size_t)1024 * D_MODEL * 2; S.b_tile_bytes = (size_t)256 * D_MODEL * 2; S.list = (const int*)(ws + WS_LIST); S.gather_k2 = D_MODEL * 2;
    EpiGU E{(bf16_t*)(ws + WS_H)};
    pg8::gemm_phase<EpiGU, pg8::SchedMoe, true, true>(lds, D_MODEL, S, E);
}
__device__ __forceinline__ void phase7(LAS unsigned char* lds, int l) {
    const int nun = moe_units(lds, l);
    PH_COMMON();
    pg8::SchedMoe S; S.utab = (LAS int*)(lds + UTAB_OFF); S.nunits = nun; S.Abase = (const char*)(ws + WS_H); S.Bbase = (const char*)(ws + WS_WD); S.a_row_bytes = (size_t)FE * 2;
    S.b_exp_bytes = (size_t)1024 * FE * 2; S.b_tile_bytes = (size_t)256 * FE * 2; S.list = (const int*)(ws + WS_LIST); S.gather_k2 = 0;
    LAS int* ent = (LAS int*)(lds + LDSCTL_OFF + 8192);
    { const LAS int* ut = (const LAS int*)(lds + UTAB_OFF); const int* LISTp = (const int*)(ws + WS_LIST); const int nst = nun < 6 ? nun : 6;
        for (int i = tid; i < nst * 256; i += NWAVES * 64) { const int un = i >> 8, r = i & 255; const int e = ut[un * 5 + 0], lo_ = ut[un * 5 + 2], nv = ut[un * 5 + 3];
            ent[i] = (r < nv) ? LISTp[(size_t)e * T + lo_ + r] : -1; } }
    __syncthreads();
    EpiDown E{(bf16_t*)(ws + WS_Y), ent};
    pg8::gemm_phase<EpiDown, pg8::SchedMoe, false, true>(lds, FE, S, E);
}
__device__ __forceinline__ void phase8(LAS unsigned char* lds, int l) {
    PH_COMMON();
    const float* g2 = arg_in(13) + (size_t)l * D_MODEL; const float* b2 = arg_in(14) + (size_t)l * D_MODEL;
    float* xout = arg_out(); bf16_t* XB = (bf16_t*)(ws + WS_XB); const bf16_t* Y = (const bf16_t*)(ws + WS_Y); const f32x2* RECW = (const f32x2*)(ws + WS_RECW);
    PBS_BEGIN(4, lds);
    u32x2 nx[4], na[4], nc[4]; f32x2 nw;
#define P8_LOAD(mm) do { nw = RECW[mm]; const u32x2* xr = (const u32x2*)(XB + (size_t)(mm) * D_MODEL) + lane; \
        const u32x2* y0 = (const u32x2*)(Y + (size_t)(2 * (mm)) * D_MODEL) + lane; const u32x2* y1 = (const u32x2*)(Y + (size_t)(2 * (mm) + 1) * D_MODEL) + lane; \
        _Pragma("unroll") for (int j = 0; j < 4; ++j) { nx[j] = xr[64 * j]; na[j] = y0[64 * j]; nc[j] = y1[64 * j]; } } while (0)
    P8_LOAD(gw);
    const bool lastl = (l + 1 == DEPTH);
    for (int m = gw; m < T; m += NGW) {
        const f32x2 wv = nw; u32x2 cx[4], ca[4], cc[4];
#pragma unroll
        for (int j = 0; j < 4; ++j) { cx[j] = nx[j]; ca[j] = na[j]; cc[j] = nc[j]; }
        if (m + NGW < T) P8_LOAD(m + NGW);
        f32x4 v[4]; float s = 0.f;
#pragma unroll
        for (int j = 0; j < 4; ++j) { const u32x2 xw = cx[j]; const u32x2 a = ca[j], c = cc[j];
            v[j].x = bf_lo(xw.x) * ALPHA + wv.x * bf_lo(a.x) + wv.y * bf_lo(c.x); v[j].y = bf_hi(xw.x) * ALPHA + wv.x * bf_hi(a.x) + wv.y * bf_hi(c.x);
            v[j].z = bf_lo(xw.y) * ALPHA + wv.x * bf_lo(a.y) + wv.y * bf_lo(c.y); v[j].w = bf_hi(xw.y) * ALPHA + wv.x * bf_hi(a.y) + wv.y * bf_hi(c.y);
            s += (v[j].x + v[j].y) + (v[j].z + v[j].w); }
        const float mean = wave_sum(s) * (1.f / D_MODEL); float s2 = 0.f;
#pragma unroll
        for (int j = 0; j < 4; ++j) { v[j] = v[j] - mean; s2 += (v[j].x * v[j].x + v[j].y * v[j].y) + (v[j].z * v[j].z + v[j].w * v[j].w); }
        const float rstd = 1.f / sqrtf(wave_sum(s2) * (1.f / D_MODEL) + LN_EPS);
#pragma unroll
        for (int j = 0; j < 4; ++j) { const f32x4 gg = *((const f32x4*)g2 + lane + 64 * j), bb = *((const f32x4*)b2 + lane + 64 * j);
            v[j] = v[j] * rstd * gg + bb;
            if (lastl) *((f32x4*)(xout + (size_t)m * D_MODEL) + lane + 64 * j) = v[j];
            else { u32x2 w; w.x = cvt_pk_bf16(v[j].x, v[j].y); w.y = cvt_pk_bf16(v[j].z, v[j].w); *((u32x2*)(XB + (size_t)m * D_MODEL) + lane + 64 * j) = w; } }
    }
#undef P8_LOAD
    PBS_END(4, lds);
    PBS_BEGIN(5, lds);
    if (l + 1 < DEPTH) { __syncthreads(); convert_weights(l + 1, lds); }
    PBS_END(5, lds);
}

__global__ void __launch_bounds__(NWAVES * 64, 2) fwd(Args args) {
    extern __shared__ __attribute__((aligned(16))) unsigned char lds_raw[];
    LAS unsigned char* lds = (LAS unsigned char*)lds_raw;
    volatile LAS unsigned* MISC = (volatile LAS unsigned*)(lds + MISC_OFF);
    for (int u = threadIdx.x; u < (LDS_BYTES - LDSCTL_OFF) / 4; u += NWAVES * 64) ((LAS unsigned*)(lds + LDSCTL_OFF))[u] = 0u;
    __syncthreads();
    XcdBarrier bar; bar.bar = (unsigned*)(arg_ws() + WS_CTL) + CW_BAR + arg_li() * XCD_BAR_WORDS; bar.x = 0; bar.st = nullptr;
    if (!MK_MULTI) bar = xcd_barrier_post((unsigned*)(arg_ws() + WS_CTL) + CW_BAR + arg_li() * XCD_BAR_WORDS, MISC + 8);
    const int lo = arg_lo(), hi = arg_hi();
#define IN(k) (lo <= (k) && (k) < hi)
#define SEAM(k) do { if (!MK_MULTI && IN(k) && IN((k) + 1)) { XcdBarrier b2_ = bar; asm volatile("" : "+s"(b2_.bar)); xcd_barrier(b2_); } } while (0)
    unsigned long long tacc = 0ull, tst = 0ull; (void)tacc; (void)tst;
#define PB_BEGIN(k) do { if (PROBE_PH == (k)) tst = __builtin_amdgcn_s_memrealtime(); } while (0)
#define PB_END(k) do { if (PROBE_PH == (k)) tacc += __builtin_amdgcn_s_memrealtime() - tst; } while (0)
    PB_BEGIN(0);
    if (HAS(0) && IN(0)) phase0(lds);
    SEAM(0);
    PB_END(0);
    for (int l = 0; l < DEPTH; ++l) {
        const int pb = 1 + l * PH_PER_LAYER;
        PB_BEGIN(1);
        if (HAS(1) && IN(pb + 0)) phase1(lds);
        SEAM(pb + 0);
        PB_END(1);
        PB_BEGIN(2);
        if (HAS(2) && IN(pb + 1)) phase2(lds, l);
        SEAM(pb + 1);
        PB_END(2);
        PB_BEGIN(3);
        if (HAS(3) && IN(pb + 2)) phase3(lds);
        SEAM(pb + 2);
        PB_END(3);
        PB_BEGIN(4);
        if (HAS(4) && IN(pb + 3)) phase4(lds, l);
        SEAM(pb + 3);
        PB_END(4);
        PB_BEGIN(5);
        if (HAS(5) && IN(pb + 4)) phase5(lds, l);
        SEAM(pb + 4);
        PB_END(5);
        PB_BEGIN(6);
        if (HAS(6) && IN(pb + 5)) phase6(lds, l);
        SEAM(pb + 5);
        PB_END(6);
        PB_BEGIN(7);
        if (HAS(7) && IN(pb + 6)) phase7(lds, l);
        SEAM(pb + 6);
        PB_END(7);
        PB_BEGIN(8);
        if (HAS(8) && IN(pb + 7)) phase8(lds, l);
        SEAM(pb + 7);
        PB_END(8);
    }
    if (PROBE_PH >= 100) tacc = *(volatile LAS unsigned long long*)(lds + MISC_OFF + 64);
    if (PROBE_PH >= 0 && blockIdx.x == 0) { const unsigned long long t0 = __builtin_amdgcn_s_memrealtime(); while (__builtin_amdgcn_s_memrealtime() - t0 < tacc * PROBE_MULT) __builtin_amdgcn_s_sleep(8); }
#undef IN
#undef SEAM
    (void)args;
}


#ifndef DBG_PROBE
#define DBG_PROBE 0
#endif
#ifndef DBG_LAYER
#define DBG_LAYER 0
#endif
#ifndef DBG_GAIN
#define DBG_GAIN 1.0f
#endif
#if DBG_PROBE
constexpr size_t WS_DXS = 528 * MiB, WS_DKV = 544 * MiB, WS_DST = 610 * MiB;
__device__ __forceinline__ int dbg_tok(int i) { const int sp[8] = {0, 1, 63, 64, 65, 575, 576, 4095}; return i < 8 ? sp[i] : (i * 67 + (i % 5) * 13 + 200) % 4096; }
__device__ __forceinline__ void atomic_max_pos(float* p, float v) { atomicMax((unsigned*)p, __float_as_uint(v)); }
__global__ void dbg_kv(const float* xs, const float* w_in, float* kv) {
    const int c = blockIdx.x * 256 + threadIdx.x; const int bi = blockIdx.y >> 8; const int t0 = (blockIdx.y & 255) * 16;
    xs += (size_t)(bi ? 5 : 0) * SEQ * D_MODEL; kv += (size_t)bi * SEQ * 2048;
    const int col = c < 1024 ? 512 + c : 2048 + (c - 1024);
    float acc[16];
#pragma unroll
    for (int i = 0; i < 16; ++i) acc[i] = 0.f;
    for (int k = 0; k < D_MODEL; ++k) { const float w = w_in[(size_t)k * PROJ + col];
#pragma unroll
        for (int i = 0; i < 16; ++i) acc[i] += xs[(size_t)(t0 + i) * D_MODEL + k] * w; }
#pragma unroll
    for (int i = 0; i < 16; ++i) kv[(size_t)(t0 + i) * 2048 + c] = acc[i];
}
__device__ __forceinline__ float blk_sum(float v, float* red) { __syncthreads(); red[threadIdx.x] = v; __syncthreads(); for (int s = 128; s > 0; s >>= 1) { if ((int)threadIdx.x < s) red[threadIdx.x] += red[threadIdx.x + s]; __syncthreads(); } const float r = red[0]; __syncthreads(); return r; }
__device__ __forceinline__ float blk_max(float v, float* red) { __syncthreads(); red[threadIdx.x] = v; __syncthreads(); for (int s = 128; s > 0; s >>= 1) { if ((int)threadIdx.x < s) red[threadIdx.x] = fmaxf(red[threadIdx.x], red[threadIdx.x + s]); __syncthreads(); } const float r = red[0]; __syncthreads(); return r; }
__global__ void __launch_bounds__(256) dbg_tok_kernel(Args a, int L, int mode) {
    __shared__ float xs[1024], qa[512], qb[512], gl[2048], ya[512], yb[512], mg[1024], mixed[1024], x1[1024], hbuf[512], sc[4096], red[256], lgs[16];
    const int tid = threadIdx.x; const int t = dbg_tok(blockIdx.x >> 1); const int bi = blockIdx.x & 1, bb = bi ? 5 : 0; const size_t grow = (size_t)bb * SEQ + t;
    unsigned char* ws = a.ws;
    const float* xsnap = a.in[0] + (size_t)bb * SEQ * D_MODEL; const float* kv = (const float*)(ws + WS_DKV) + (size_t)bi * SEQ * 2048; float* st = (float*)(ws + WS_DST);
    const float* w_in = a.in[1] + (size_t)L * D_MODEL * PROJ; const float* relb = a.in[2] + (size_t)L * NH * N_REL;
    const float* w_upa = a.in[3] + (size_t)L * WA * D_MODEL; const float* w_upb = a.in[4] + (size_t)L * WA * D_MODEL; const float* w_out = a.in[5] + (size_t)L * D_MODEL * D_MODEL;
    const float* g1 = a.in[6] + (size_t)L * D_MODEL; const float* b1 = a.in[7] + (size_t)L * D_MODEL; const float* w_router = a.in[8]; const float* b_router = a.in[9];
    const float* w_gate = a.in[10] + (size_t)L * NE * D_MODEL * FE; const float* w_up = a.in[11] + (size_t)L * NE * D_MODEL * FE; const float* w_down = a.in[12] + (size_t)L * NE * FE * D_MODEL;
    for (int i = tid; i < 1024; i += 256) xs[i] = xsnap[(size_t)t * D_MODEL + i];
    __syncthreads();
    for (int j = tid; j < 3072; j += 256) { const int col = j < 512 ? j : (j < 1024 ? 1536 + (j - 512) : 3072 + (j - 1024)); float s = 0.f;
        for (int k = 0; k < 1024; ++k) s += xs[k] * w_in[(size_t)k * PROJ + col];
        if (j < 512) qa[j] = s; else if (j < 1024) qb[j - 512] = s; else gl[j - 1024] = s; }
    __syncthreads();
    for (int h = 0; h < 8; ++h) {
        const int c = t >> 6; const int k0 = (c - 8) > 0 ? (c - 8) * 64 : 0, k1 = c * 64 + 63; const int nk = k1 - k0 + 1;
        float mx = -1e30f;
        for (int i = tid; i < nk; i += 256) { const int key = k0 + i; float s = 0.f; for (int d = 0; d < 64; ++d) s += qa[h * 64 + d] * kv[(size_t)key * 2048 + h * 64 + d];
            int rel = t - key; rel = rel < -128 ? -128 : (rel > 128 ? 128 : rel); s = s * 0.125f + relb[h * N_REL + rel + 128]; sc[i] = s; mx = fmaxf(mx, s); }
        mx = blk_max(mx, red);
        float sm = 0.f; for (int i = tid; i < nk; i += 256) { const float p = expf(sc[i] - mx); sc[i] = p; sm += p; }
        sm = blk_sum(sm, red);
        if (tid < 64) { float o = 0.f; for (int i = 0; i < nk; ++i) o += sc[i] * kv[(size_t)(k0 + i) * 2048 + 512 + h * 64 + tid]; ya[h * 64 + tid] = o / sm; }
        __syncthreads();
        for (int s = tid; s < t; s += 256) { float z = 0.f; for (int d = 0; d < 64; ++d) z += qb[h * 64 + d] * kv[(size_t)s * 2048 + 1024 + h * 64 + d]; sc[s] = z * 0.125f; }
        __syncthreads();
        if (tid < 64) { float y = 0.f; for (int s = 0; s < t; ++s) { const float beta = 1.0f / (1.0f + expf(-sc[s])); y += beta * (kv[(size_t)s * 2048 + 1536 + h * 64 + tid] - y); } yb[h * 64 + tid] = y; }
        __syncthreads();
    }
    if (mode == 0) {
        const bf16_t* OA = (const bf16_t*)(ws + WS_QQ); const bf16_t* OB = (const bf16_t*)(ws + WS_QQ) + WA;
        float na = 0.f, da = 0.f, nb = 0.f, db = 0.f;
        for (int i = tid; i < 512; i += 256) { const float oa = h2f(OA[grow * D_MODEL + i]), ob = h2f(OB[grow * D_MODEL + i]);
            na += (oa - ya[i]) * (oa - ya[i]); da += ya[i] * ya[i]; nb += (ob - yb[i]) * (ob - yb[i]); db += yb[i] * yb[i]; }
        na = blk_sum(na, red); da = blk_sum(da, red); nb = blk_sum(nb, red); db = blk_sum(db, red);
        if (tid == 0) { atomicAdd(st + 4, na); atomicAdd(st + 5, da); atomicAdd(st + 6, nb); atomicAdd(st + 7, db); }
        return; }
    for (int cidx = tid; cidx < 1024; cidx += 256) { float ua = 0.f, ub = 0.f; for (int k = 0; k < 512; ++k) { ua += ya[k] * w_upa[(size_t)k * D_MODEL + cidx]; ub += yb[k] * w_upb[(size_t)k * D_MODEL + cidx]; }
        const float ga = 1.0f / (1.0f + expf(-gl[cidx])), gb = 1.0f / (1.0f + expf(-gl[1024 + cidx])); mg[cidx] = ga * ua + gb * ub; }
    __syncthreads();
    float num = 0.f, den = 0.f;
    for (int cidx = tid; cidx < 1024; cidx += 256) { float s = 0.f; for (int k = 0; k < 1024; ++k) s += mg[k] * w_out[(size_t)k * D_MODEL + cidx]; mixed[cidx] = s;
        const float opt = h2f(((const bf16_t*)(ws + WS_PRE))[grow * D_MODEL + cidx]) - ALPHA * xs[cidx]; num += (opt - s) * (opt - s); den += s * s; }
    num = blk_sum(num, red); den = blk_sum(den, red);
    if (tid == 0) { atomicAdd(st + 0, num); atomicAdd(st + 1, den); atomic_max_pos(st + 8, num / den); }
    float s1 = 0.f; for (int i = tid; i < 1024; i += 256) { x1[i] = ALPHA * xs[i] + mixed[i]; s1 += x1[i]; }
    const float mean = blk_sum(s1, red) / 1024.f; float s2 = 0.f; for (int i = tid; i < 1024; i += 256) { const float d = x1[i] - mean; s2 += d * d; }
    const float rstd = 1.0f / sqrtf(blk_sum(s2, red) / 1024.f + LN_EPS);
    for (int i = tid; i < 1024; i += 256) x1[i] = (x1[i] - mean) * rstd * g1[i] + b1[i];
    __syncthreads();
    if (tid < 16) { float s = 0.f; for (int k = 0; k < 1024; ++k) s += x1[k] * w_router[k * 16 + tid]; lgs[tid] = s + b_router[tid]; }
    __syncthreads();
    int best = 0; for (int e = 1; e < 16; ++e) if (lgs[e] > lgs[best]) best = e;
    const int grp = best >> 2; int e2 = -1; for (int e = grp * 4; e < grp * 4 + 4; ++e) if (e != best && (e2 < 0 || lgs[e] > lgs[e2])) e2 = e;
    const float pw1 = 1.0f / (1.0f + expf(lgs[e2] - lgs[best])), pw2 = 1.0f - pw1;
    const f32x2 wo = ((const f32x2*)(ws + WS_RECW))[grow]; const bf16_t* Y = (const bf16_t*)(ws + WS_Y);
    float fnum = 0.f, fden = 0.f; float ff[4] = {0.f, 0.f, 0.f, 0.f};
    for (int kk = 0; kk < 2; ++kk) { const int e = kk ? e2 : best; const float pw = kk ? pw2 : pw1;
        for (int f = tid; f < 512; f += 256) { float g = 0.f, u = 0.f; for (int k = 0; k < 1024; ++k) { g += x1[k] * w_gate[((size_t)e * D_MODEL + k) * FE + f]; u += x1[k] * w_up[((size_t)e * D_MODEL + k) * FE + f]; }
            hbuf[f] = g / (1.0f + expf(-g)) * u; }
        __syncthreads();
        for (int j = 0; j < 4; ++j) { const int cidx = tid + 256 * j; float s = 0.f; for (int f = 0; f < 512; ++f) s += hbuf[f] * w_down[((size_t)e * FE + f) * D_MODEL + cidx]; ff[j] += pw * s; }
        __syncthreads(); }
    for (int j = 0; j < 4; ++j) { const int cidx = tid + 256 * j; const float opt = wo.x * h2f(Y[(size_t)(2 * grow) * D_MODEL + cidx]) + wo.y * h2f(Y[(size_t)(2 * grow + 1) * D_MODEL + cidx]);
        fnum += (opt - ff[j]) * (opt - ff[j]); fden += ff[j] * ff[j]; }
    fnum = blk_sum(fnum, red); fden = blk_sum(fden, red);
    if (tid == 0) { atomicAdd(st + 2, fnum); atomicAdd(st + 3, fden); atomic_max_pos(st + 9, fnum / fden); }
    const float* g2 = a.in[13] + (size_t)L * D_MODEL; const float* b2 = a.in[14] + (size_t)L * D_MODEL;
    float t1 = 0.f; for (int j = 0; j < 4; ++j) { const int cidx = tid + 256 * j; mixed[cidx] = ALPHA * x1[cidx] + ff[j]; t1 += mixed[cidx]; }
    const float mean2 = blk_sum(t1, red) / 1024.f; float t2 = 0.f; for (int j = 0; j < 4; ++j) { const float d = mixed[tid + 256 * j] - mean2; t2 += d * d; }
    const float rstd2 = 1.0f / sqrtf(blk_sum(t2, red) / 1024.f + LN_EPS);
    float xnum = 0.f, xden = 0.f;
    for (int j = 0; j < 4; ++j) { const int cidx = tid + 256 * j; const float ref = (mixed[cidx] - mean2) * rstd2 * g2[cidx] + b2[cidx];
        const float opt = (L == DEPTH - 1) ? a.out[grow * D_MODEL + cidx] : h2f(((const bf16_t*)(ws + WS_XB))[grow * D_MODEL + cidx]);
        xnum += (opt - ref) * (opt - ref); xden += ref * ref; }
    xnum = blk_sum(xnum, red); xden = blk_sum(xden, red);
    if (tid == 0) { atomicAdd(st + 10, xnum); atomicAdd(st + 11, xden); atomic_max_pos(st + 12, xnum / xden); }
}
__global__ void dbg_inject(float* out, const float* st, int n4) {
    const float delta = sqrtf((DBG_PROBE == 1) ? st[0] / st[1] : (DBG_PROBE == 2) ? st[2] / st[3] : (DBG_PROBE == 3) ? st[4] / st[5] : (DBG_PROBE == 4) ? st[6] / st[7] : (DBG_PROBE == 5) ? st[8] : (DBG_PROBE == 6) ? st[9] : (DBG_PROBE == 7) ? st[10] / st[11] : st[12]); const float f = 1.0f + DBG_GAIN * delta;
    for (int i = blockIdx.x * blockDim.x + threadIdx.x; i < n4; i += gridDim.x * blockDim.x) { f32x4 v = ((f32x4*)out)[i]; v = v * f; ((f32x4*)out)[i] = v; }
}
#endif

extern "C" void kernel_launch(void* const* d_in, const int* in_sizes, int n_in, void* d_out, int out_size, void* d_ws, size_t ws_size, hipStream_t stream) {
    static int grid = 0;
    if (grid == 0) {
        if (n_in != 15 || in_sizes[0] != T * D_MODEL || out_size != T * D_MODEL || ws_size < WS_END) {
            fprintf(stderr, "kernel_launch: unexpected shapes (n_in %d in0 %d out %d ws %zu; need ws >= %zu); nothing launched\n", n_in, n_in > 0 ? in_sizes[0] : -1, out_size, ws_size, (size_t)WS_END); grid = -1; return; }
        int dev = 0, cus = 0, per_cu = 0;
        if (hipGetDevice(&dev) != hipSuccess || hipDeviceGetAttribute(&cus, hipDeviceAttributeMultiprocessorCount, dev) != hipSuccess) { grid = -1; return; }
        if (hipFuncSetAttribute((const void*)fwd, hipFuncAttributeMaxDynamicSharedMemorySize, LDS_BYTES) != hipSuccess) { fprintf(stderr, "kernel_launch: hipFuncSetAttribute failed\n"); grid = -1; return; }
        if (hipOccupancyMaxActiveBlocksPerMultiprocessor(&per_cu, (const void*)fwd, NWAVES * 64, LDS_BYTES) != hipSuccess || per_cu < 1)
            fprintf(stderr, "kernel_launch: note: occupancy query reports %d workgroups per CU\n", per_cu);
        (void)hipGetLastError();
        grid = cus;
        if (grid != 256) fprintf(stderr, "kernel_launch: %d CUs; the attention deal needs 256\n", grid);
    }
    if (grid < 0) return;
    if (hipMemsetAsync((char*)d_ws + WS_CTL, 0, CTL_ZERO_BYTES, stream) != hipSuccess) { fprintf(stderr, "kernel_launch: memset failed\n"); return; }
    Args a{};
    for (int i = 0; i < 15; ++i) a.in[i] = (const float*)d_in[i];
    a.out = (float*)d_out; a.ws = (unsigned char*)d_ws;
#if DBG_PROBE
    {
        const int L = DBG_LAYER, p0 = 1 + 8 * L, p1 = 1 + 8 * (L + 1);
        hipMemsetAsync((char*)d_ws + WS_DST, 0, 64, stream);
        a.li = 0; a.ph_lo = 0; a.ph_hi = p0; hipLaunchKernelGGL(fwd, dim3(grid), dim3(NWAVES * 64), LDS_BYTES, stream, a);
        hipLaunchKernelGGL(dbg_kv, dim3(8, 512), dim3(256), 0, stream, (const float*)d_in[0], (const float*)d_in[1] + (size_t)L * D_MODEL * PROJ, (float*)((char*)d_ws + WS_DKV));
        a.li = 1; a.ph_lo = p0; a.ph_hi = p0 + 2; hipLaunchKernelGGL(fwd, dim3(grid), dim3(NWAVES * 64), LDS_BYTES, stream, a);
        hipLaunchKernelGGL(dbg_tok_kernel, dim3(128), dim3(256), 0, stream, a, L, 0);
        a.li = 3; a.ph_lo = p0 + 2; a.ph_hi = p1; hipLaunchKernelGGL(fwd, dim3(grid), dim3(NWAVES * 64), LDS_BYTES, stream, a);
        hipLaunchKernelGGL(dbg_tok_kernel, dim3(128), dim3(256), 0, stream, a, L, 1);
        if (p1 < N_PHASES) { a.li = 2; a.ph_lo = p1; a.ph_hi = N_PHASES; hipLaunchKernelGGL(fwd, dim3(grid), dim3(NWAVES * 64), LDS_BYTES, stream, a); }
        hipLaunchKernelGGL(dbg_inject, dim3(1024), dim3(256), 0, stream, (float*)d_out, (const float*)((char*)d_ws + WS_DST), T * D_MODEL / 4);
    }
#elif MK_MULTI
    for (int p = 0; p < N_PHASES; ++p) { a.ph_lo = p; a.ph_hi = p + 1; hipLaunchKernelGGL(fwd, dim3(grid), dim3(NWAVES * 64), LDS_BYTES, stream, a); }
#else
    a.ph_lo = 0; a.ph_hi = N_PHASES;
    hipLaunchKernelGGL(fwd, dim3(grid), dim3(NWAVES * 64), LDS_BYTES, stream, a);
#endif
    const hipError_t le = hipPeekAtLastError();
    if (le != hipSuccess) fprintf(stderr, "kernel_launch: launch failed: %s\n", hipGetErrorName(le));
}
```

```cpp
#include <hip/hip_runtime.h>
#include <cstdio>
#include <cstdint>

#ifndef MK_MULTI
#define MK_MULTI 0
#endif

#ifndef PROBE_PH
#define PROBE_PH (-1)
#endif
#ifndef PROBE_MULT
#define PROBE_MULT 1
#endif
#ifndef IN_FP8
#define IN_FP8 1
#endif
#ifndef MIX_FP8
#define MIX_FP8 1
#endif
#ifndef Y_FP8
#define Y_FP8 1
#endif
#ifndef GATE_FP8
#define GATE_FP8 1
#endif
#ifndef Q_FP8
#define Q_FP8 1
#endif
#ifndef WIDE_EPI
#define WIDE_EPI 1
#endif
#ifndef EPI_DRAIN
#define EPI_DRAIN 1
#endif
#ifndef GB_INV
#define GB_INV 1
#endif
#ifndef MOE_FP8
#define MOE_FP8 1
#endif
#ifndef PHASE_MASK
#define PHASE_MASK 0x1ff
#endif
#define HAS(k) ((PHASE_MASK >> (k)) & 1)
#define LAS __attribute__((address_space(3)))
#define PBS_BEGIN(id, lds) do { if (PROBE_PH == 100 + (id) && threadIdx.x == 0) *(volatile LAS unsigned long long*)((lds) + MISC_OFF + 80) = __builtin_amdgcn_s_memrealtime(); } while (0)
#define PBS_END(id, lds) do { if (PROBE_PH == 100 + (id) && threadIdx.x == 0) { volatile LAS unsigned long long* p_ = (volatile LAS unsigned long long*)((lds) + MISC_OFF + 64); p_[0] = p_[0] + (__builtin_amdgcn_s_memrealtime() - p_[2]); } } while (0)
#define GAS __attribute__((address_space(1)))
typedef unsigned short bf16_t;
typedef short bf16x8 __attribute__((ext_vector_type(8)));
typedef short bf16x16_t __attribute__((ext_vector_type(16)));
typedef int v8i32_t __attribute__((ext_vector_type(8)));
typedef short s16x4 __attribute__((ext_vector_type(4)));
typedef float f32x4 __attribute__((ext_vector_type(4)));
typedef float f32x2 __attribute__((ext_vector_type(2)));
typedef float f32x16 __attribute__((ext_vector_type(16)));
typedef unsigned u32x4 __attribute__((ext_vector_type(4)));
typedef unsigned u32x2 __attribute__((ext_vector_type(2)));

constexpr int D_MODEL = 1024, BATCH = 8, SEQ = 4096, DEPTH = 4, T = BATCH * SEQ;
constexpr int NH = 8, HD = 64, WA = NH * HD;
constexpr int PROJ = 3 * WA + 3 * WA + 2 * D_MODEL;
constexpr int N_REL = 257, NE = 16, FE = 512;
constexpr float ALPHA = 1.681792830507429f;
constexpr float LN_EPS = 1e-5f;
constexpr float LOG2E = 1.4426950408889634f;
constexpr float C2 = 0.125f * LOG2E;

constexpr size_t MiB = 1u << 20;
constexpr size_t WS_CTL = 0, CTL_ZERO_BYTES = 160 * 1024;
constexpr size_t WS_RECW = 2 * MiB;
constexpr size_t WS_LIST = 4 * MiB;
constexpr size_t WS_WIN = 8 * MiB, WS_WUP = 18 * MiB  , WS_WOUT = 20 * MiB, WS_WGU = 22 * MiB, WS_WD = 54 * MiB;
constexpr size_t WS_RTAB = 70 * MiB;
constexpr size_t RTAB_STRIDE = 65536 + 256;
constexpr size_t WS_XB = 72 * MiB;
constexpr size_t WS_QQ = 136 * MiB, WS_KA = 200 * MiB, WS_VA = 232 * MiB, WS_KB = 264 * MiB, WS_VB = 296 * MiB;
constexpr size_t WS_GA = 328 * MiB, WS_GB = 392 * MiB;
constexpr size_t WS_PRE = 328 * MiB;
constexpr size_t WS_MERGED = 456 * MiB;
constexpr size_t WS_Y = 136 * MiB;
constexpr size_t WS_H = 456 * MiB;
constexpr size_t WS_XB8 = 526 * MiB;
constexpr size_t WS_STAT = 3 * MiB;
constexpr size_t WS_O8 = 488 * MiB;
constexpr size_t WS_XA8 = 558 * MiB;
constexpr size_t WS_END = (IN_FP8 ? 590 : MOE_FP8 ? 558 : 526) * MiB;
constexpr int CW_TMO = 0;
constexpr int CW_BAR = 4096;
constexpr int CW_CNT = 32768;
static_assert((CW_CNT + 64 * 4) * 4 <= (int)CTL_ZERO_BYTES && (CW_BAR + 4 * 3456) * 4 <= CW_CNT * 4, "control words inside the zeroed region");

constexpr int RING_BYTES = 131072;
constexpr int LDSCTL_OFF = RING_BYTES, MISC_OFF = LDSCTL_OFF + 320;
constexpr int UTAB_OFF = LDSCTL_OFF + 1024;
constexpr int LDS_BYTES = 163840;

#ifndef USE_F16
#define USE_F16 1
#endif
typedef _Float16 h16x2 __attribute__((ext_vector_type(2)));
typedef _Float16 h16x8 __attribute__((ext_vector_type(8)));
#if USE_F16
__device__ __forceinline__ unsigned cvt_pk_bf16(float lo, float hi) { const f32x2 v = {lo, hi}; return __builtin_bit_cast(unsigned, __builtin_convertvector(v, h16x2)); }
__device__ __forceinline__ float bf_lo(unsigned w) { return (float)__builtin_bit_cast(h16x2, w)[0]; }
__device__ __forceinline__ float bf_hi(unsigned w) { return (float)__builtin_bit_cast(h16x2, w)[1]; }
#define MFMA16(a, b, c) __builtin_amdgcn_mfma_f32_16x16x32_f16(__builtin_bit_cast(h16x8, a), __builtin_bit_cast(h16x8, b), c, 0, 0, 0)
#define MFMA32(a, b, c) __builtin_amdgcn_mfma_f32_32x32x16_f16(__builtin_bit_cast(h16x8, a), __builtin_bit_cast(h16x8, b), c, 0, 0, 0)
#else
__device__ __forceinline__ unsigned cvt_pk_bf16(float lo, float hi) { unsigned r; asm volatile("v_cvt_pk_bf16_f32 %0, %1, %2" : "=v"(r) : "v"(lo), "v"(hi)); return r; }
__device__ __forceinline__ float bf_lo(unsigned w) { return __uint_as_float(w << 16); }
__device__ __forceinline__ float bf_hi(unsigned w) { return __uint_as_float(w & 0xffff0000u); }
#define MFMA16(a, b, c) __builtin_amdgcn_mfma_f32_16x16x32_bf16(a, b, c, 0, 0, 0)
#define MFMA32(a, b, c) MFMA32(a, b, c)
#endif
__device__ __forceinline__ float h2f(bf16_t h) { return bf_lo((unsigned)h); }
__device__ __forceinline__ float fast_exp2(float x) { return __builtin_amdgcn_exp2f(x); }
__device__ __forceinline__ float fast_rcp(float x) { return __builtin_amdgcn_rcpf(x); }
__device__ __forceinline__ float sigmoidf_(float v) { return fast_rcp(1.0f + fast_exp2(-LOG2E * v)); }
__device__ __forceinline__ float wave_sum(float v) {
#define DPP_ADD(ctrl, rmask) v += __builtin_bit_cast(float, __builtin_amdgcn_update_dpp(0, __builtin_bit_cast(int, v), ctrl, rmask, 0xf, false))
    DPP_ADD(0x111, 0xf); DPP_ADD(0x112, 0xf); DPP_ADD(0x114, 0xf); DPP_ADD(0x118, 0xf);
    DPP_ADD(0x142, 0xa); DPP_ADD(0x143, 0xc);
#undef DPP_ADD
    return __builtin_bit_cast(float, __builtin_amdgcn_readlane(__builtin_bit_cast(int, v), 63));
}
constexpr int F8S_G = 8;
constexpr int F8S_Q = 5;
constexpr int F8S_Y = 7;
constexpr int F8S_O = 6, F8S_M = 7;
constexpr int F8S_X = 3, F8S_W = 5, F8S_H = 4;
__device__ __forceinline__ float sat8(float v) { return __builtin_amdgcn_fmed3f(v, -448.f, 448.f); }
__device__ __forceinline__ void dec8(u32x2 w, f32x4& lo, f32x4& hi) { const auto a = __builtin_amdgcn_cvt_pk_f32_fp8(w.x, false), b = __builtin_amdgcn_cvt_pk_f32_fp8(w.x, true), c = __builtin_amdgcn_cvt_pk_f32_fp8(w.y, false), d = __builtin_amdgcn_cvt_pk_f32_fp8(w.y, true);
    lo = (f32x4){a[0], a[1], b[0], b[1]}; hi = (f32x4){c[0], c[1], d[0], d[1]}; }
__device__ __forceinline__ unsigned pk4_fp8(float a, float b, float c, float d) { unsigned w = 0; a = sat8(a); b = sat8(b); c = sat8(c); d = sat8(d); w = __builtin_amdgcn_cvt_pk_fp8_f32(a, b, w, false); w = __builtin_amdgcn_cvt_pk_fp8_f32(c, d, w, true); return w; }
__device__ __forceinline__ unsigned pk4_fp8_ns(float a, float b, float c, float d) { unsigned w = 0; w = __builtin_amdgcn_cvt_pk_fp8_f32(a, b, w, false); w = __builtin_amdgcn_cvt_pk_fp8_f32(c, d, w, true); return w; }
#define LDS_WAIT() asm volatile("s_waitcnt lgkmcnt(0)" ::: "memory")
#define VM_WAIT() asm volatile("s_waitcnt vmcnt(0)" ::: "memory")

namespace pg8 {
constexpr int BM = 256, BK = 64, HALF = 128, HTB = HALF * BK * 2, STAGE_BYTES = 8 * HTB, NXCD = 8, WGM = 8;
__host__ __device__ __forceinline__ int lds_byte(int r, int c) { const int st = (r >> 4) * 2 + (c >> 5), rr = r & 15, cc = c & 31, ob = rr * 64 + cc * 2; return st * 1024 + (ob ^ (((ob >> 9) & 1) << 5)); }
__host__ __device__ __forceinline__ void stage_rc(int b, int& R, int& C) { const int st = b / 1024, sb = b % 1024, swz = sb ^ (((sb >> 9) & 1) << 5); R = (st >> 1) * 16 + swz / 64; C = (st & 1) * 32 + (swz % 64) / 2; }
__host__ __device__ __forceinline__ int perm32(int rho) { const int n = rho >> 4, i = rho & 15; return 8 * (i >> 2) + 4 * n + (i & 3); }
__host__ __device__ __forceinline__ int perm64(int rho) { const int n = rho >> 4, i = rho & 15; return 16 * (i >> 2) + 4 * n + (i & 3); }

struct Unit { const char* A; const char* B; int pm, pn, x0, x1, x2, x3; };

struct TileOrder {
    int nM, nN, nwg, G, c;
    __device__ __forceinline__ void init(int nM_, int nN_, int G_, int c_) { nM = nM_; nN = nN_; nwg = nM * nN; G = G_; c = c_; }
    __device__ __forceinline__ bool next(int i, int& pm, int& pn) const {
        const long L = (long)i * G + c; if (L >= nwg) return false;
        int wgid = (int)L; { const int q = nwg / NXCD, r = nwg % NXCD, xcd = wgid % NXCD, off = wgid / NXCD; wgid = (xcd < r ? xcd * (q + 1) : r * (q + 1) + (xcd - r) * q) + off; }
        const int nig = WGM * nN, gid = wgid / nig, fm = gid * WGM, gsz = (nM - fm) < WGM ? (nM - fm) : WGM;
        pm = fm + ((wgid % nig) % gsz); pn = (wgid % nig) / gsz; return true;
    }
};

template <class Epi, class Sched, bool GATHER, bool ALIGN_EPI, bool MIDHOOK = false, bool FP8 = false>
__device__ __forceinline__ void gemm_phase(LAS unsigned char* lds, const int K, const Sched& S, const Epi& E, const int LD_ = 0, const int scale_w = 127, const int scale_x = 127) {
    const int LD = LD_ ? LD_ : K;
    int tid_ = threadIdx.x; asm volatile("" : "+v"(tid_));
    const int tid = tid_, wid = __builtin_amdgcn_readfirstlane(tid >> 6), lane = tid & 63, wr = wid >> 2, wc = wid & 3, fr = lane & 15, fq = lane >> 4;
    int nt_ = K / BK; if constexpr (FP8) asm volatile("" : "+s"(nt_));
    const int nt = nt_;
    unsigned voffB[2]; int RA[2], CA2[2];
#pragma unroll
    for (int i = 0; i < 2; ++i) { int R, C; stage_rc(tid * 16 + i * 8192, R, C); const int Rb = Epi::WIDE ? (64 * (R >> 5) + perm64(R & 31)) : Epi::PERM ? ((R & ~31) + perm32(R & 31)) : R;
        RA[i] = R; CA2[i] = C * 2; voffB[i] = (unsigned)(Rb * LD + C) * 2u; }
    const size_t kstep = (size_t)(BK * 2);
    const size_t hstep = (size_t)HALF * LD * 2;
    const size_t hstepB = Epi::WIDE ? (size_t)8 * LD * 2 : hstep;
    const unsigned ldsw = (unsigned)wid * 1024u;
    const int aoff = lds_byte(wr * 64 + fr, fq * 8), boff = lds_byte(wc * 32 + fr, fq * 8);
    const int aoff8a = lds_byte(wr * 64 + fr, (fq & 1) * 16) + (fq >> 1) * 1024, boff8a = lds_byte(wc * 32 + fr, (fq & 1) * 16) + (fq >> 1) * 1024;
    (void)aoff8a; (void)boff8a; (void)scale_w; (void)scale_x;
#define PG8_SA(b, h) (((b) * 2 + (h)) * HTB)
#define PG8_SB(b, h) ((4 + (b) * 2 + (h)) * HTB)
#define PG8_STAGE(bufoff, gbase, voff) do { _Pragma("unroll") for (int _i = 0; _i < 2; ++_i) \
        __builtin_amdgcn_global_load_lds((const unsigned*)((const char*)(gbase) + (voff)[_i]), (LAS unsigned*)(lds + (bufoff) + ldsw + _i * 8192), 16, 0, 0); } while (0)
#define PG8_LDA(dst, b, h) do { if constexpr (false) { _Pragma("unroll") for (int m = 0; m < 4; ++m) { dst[m][0] = *(const LAS bf16x8*)(lds + PG8_SA(b, h) + aoff8a + m * 2048); dst[m][1] = *(const LAS bf16x8*)(lds + PG8_SA(b, h) + aoff8a + m * 2048 + 16); } } \
    else { _Pragma("unroll") for (int m = 0; m < 4; ++m) _Pragma("unroll") for (int k = 0; k < 2; ++k) dst[m][k] = *(const LAS bf16x8*)(lds + PG8_SA(b, h) + aoff + m * 2048 + k * 1024); } } while (0)
#define PG8_LDB(dst, b, h) do { if constexpr (false) { _Pragma("unroll") for (int n = 0; n < 2; ++n) { dst[n][0] = *(const LAS bf16x8*)(lds + PG8_SB(b, h) + boff8a + n * 2048); dst[n][1] = *(const LAS bf16x8*)(lds + PG8_SB(b, h) + boff8a + n * 2048 + 16); } } \
    else { _Pragma("unroll") for (int n = 0; n < 2; ++n) _Pragma("unroll") for (int k = 0; k < 2; ++k) dst[n][k] = *(const LAS bf16x8*)(lds + PG8_SB(b, h) + boff + n * 2048 + k * 1024); } } while (0)
#define PG8_F8(x) __builtin_bit_cast(v8i32_t, x)
#define PG8_MMA(ai, bj, At, Bt) do { __builtin_amdgcn_s_setprio(1); \
    if constexpr (FP8) { _Pragma("unroll") for (int m = 0; m < 4; ++m) _Pragma("unroll") for (int n = 0; n < 2; ++n) { \
        const bf16x16_t b16_ = __builtin_shufflevector(Bt[n][0], Bt[n][1], 0, 1, 2, 3, 4, 5, 6, 7, 8, 9, 10, 11, 12, 13, 14, 15), a16_ = __builtin_shufflevector(At[m][0], At[m][1], 0, 1, 2, 3, 4, 5, 6, 7, 8, 9, 10, 11, 12, 13, 14, 15); \
        const v8i32_t b8_ = PG8_F8(b16_), a8_ = PG8_F8(a16_); asm volatile("v_mfma_f32_16x16x128_f8f6f4 %0, %1, %2, %0" : "+v"(acc[ai][bj][m][n]) : "v"(b8_), "v"(a8_)); } } \
    else { _Pragma("unroll") for (int m = 0; m < 4; ++m) _Pragma("unroll") for (int n = 0; n < 2; ++n) _Pragma("unroll") for (int k = 0; k < 2; ++k) \
        acc[ai][bj][m][n] = MFMA16(Bt[n][k], At[m][k], acc[ai][bj][m][n]); } __builtin_amdgcn_s_setprio(0); } while (0)
#define PG8_WAIT_V(n) asm volatile("s_waitcnt vmcnt(" #n ")" ::: "memory")
#define PG8_WAIT_L(n) asm volatile("s_waitcnt lgkmcnt(" #n ")" ::: "memory")
#define PG8_BAR __builtin_amdgcn_s_barrier()
#define PG8_SCHED __builtin_amdgcn_sched_barrier(0)
    Unit cur, nxt; int ui = 0;
    if (!S.next(0, cur)) return;
    unsigned oc0[2], oc1[2], on0[2], on1[2];
    if constexpr (GATHER) { S.offs(cur, RA, CA2, oc0, oc1); }
    else {
#pragma unroll
        for (int i = 0; i < 2; ++i) { oc0[i] = (unsigned)(RA[i] * LD) * 2u + (unsigned)CA2[i]; oc1[i] = oc0[i]; on0[i] = oc0[i]; on1[i] = oc0[i]; } }
    const size_t ah = GATHER ? (size_t)0 : hstep;
    f32x4 acc[2][2][4][2];
#pragma unroll
    for (int a = 0; a < 2; ++a)
#pragma unroll
        for (int b = 0; b < 2; ++b)
#pragma unroll
            for (int m = 0; m < 4; ++m)
#pragma unroll
                for (int n = 0; n < 2; ++n) acc[a][b][m][n] = (f32x4){0.f, 0.f, 0.f, 0.f};
    bf16x8 At[4][2], B0[2][2], B1[2][2];
    const char* cA = cur.A; const char* cB = cur.B;
    PG8_STAGE(PG8_SB(0, 0), cB, voffB); PG8_STAGE(PG8_SB(0, 1), cB + hstepB, voffB); PG8_STAGE(PG8_SA(0, 0), cA, oc0); PG8_STAGE(PG8_SA(0, 1), cA + ah, oc1);
    if (wr == 1) PG8_BAR;
    PG8_WAIT_V(2); PG8_BAR;
    PG8_STAGE(PG8_SB(1, 0), cB + kstep, voffB); PG8_STAGE(PG8_SA(1, 0), cA + kstep, oc0); PG8_STAGE(PG8_SB(1, 1), cB + hstepB + kstep, voffB);
    PG8_WAIT_V(6); PG8_BAR;
    for (;;) {
        const bool has_next = S.next(ui + 1, nxt);
        const char* nA = has_next ? nxt.A : cA; const char* nB = has_next ? nxt.B : cB;
        int rw0[2] = {0, 0}, rw1[2] = {0, 0};
        if constexpr (GATHER) { if (has_next) S.offs_raw(nxt, RA, rw0, rw1); }
        for (int t = 0; t < nt; t += 2) {
            const bool last = (t == nt - 2);
            const bool fst = EPI_DRAIN && !GATHER && (t == 0) && (ui > 0);
            const char* a1 = cA + (size_t)(t + 1) * kstep;
            const char* a2 = last ? nA : cA + (size_t)(t + 2) * kstep; const char* b2 = last ? nB : cB + (size_t)(t + 2) * kstep;
            const char* a3 = a2 + kstep; const char* b3 = b2 + kstep;
            unsigned o20[2], o21[2];
            if constexpr (GATHER) { o20[0] = oc0[0]; o20[1] = oc0[1]; o21[0] = oc1[0]; o21[1] = oc1[1];
                if (last) { asm volatile("" : "+v"(rw0[0]), "+v"(rw0[1]), "+v"(rw1[0]), "+v"(rw1[1]));
                    if (has_next) S.offs_fin(rw0, rw1, CA2, on0, on1); else { on0[0] = oc0[0]; on0[1] = oc0[1]; on1[0] = oc1[0]; on1[1] = oc1[1]; }
                    o20[0] = on0[0]; o20[1] = on0[1]; o21[0] = on1[0]; o21[1] = on1[1]; } }
            else { o20[0] = oc0[0]; o20[1] = oc0[1]; o21[0] = oc0[0]; o21[1] = oc0[1]; }
            PG8_LDB(B0, 0, 0); PG8_LDB(B1, 0, 1); PG8_SCHED; PG8_LDA(At, 0, 0); PG8_STAGE(PG8_SA(1, 1), a1 + ah, oc1);
            if (!fst) PG8_WAIT_V(8); PG8_WAIT_L(0); PG8_BAR; PG8_MMA(0, 0, At, B0); PG8_MMA(0, 1, At, B1); PG8_BAR; PG8_SCHED;
            PG8_LDA(At, 0, 1); PG8_STAGE(PG8_SB(0, 0), b2, voffB); PG8_STAGE(PG8_SB(0, 1), b2 + hstepB, voffB); PG8_STAGE(PG8_SA(0, 0), a2, o20);
            if (!fst) PG8_WAIT_V(8); PG8_WAIT_L(0); PG8_BAR; PG8_MMA(1, 0, At, B0); PG8_MMA(1, 1, At, B1); PG8_BAR; PG8_SCHED;
            PG8_LDB(B0, 1, 0); PG8_LDB(B1, 1, 1); PG8_SCHED; PG8_LDA(At, 1, 0); PG8_STAGE(PG8_SA(0, 1), a2 + ah, o21);
            PG8_WAIT_V(8); PG8_WAIT_L(0); PG8_BAR; PG8_MMA(0, 0, At, B0); PG8_MMA(0, 1, At, B1); PG8_BAR; PG8_SCHED;
            PG8_LDA(At, 1, 1); PG8_STAGE(PG8_SB(1, 0), b3, voffB); PG8_STAGE(PG8_SB(1, 1), b3 + hstepB, voffB); PG8_STAGE(PG8_SA(1, 0), a3, o20);
            PG8_WAIT_V(8); PG8_WAIT_L(0); PG8_BAR; PG8_MMA(1, 0, At, B0); PG8_MMA(1, 1, At, B1); PG8_BAR; PG8_SCHED;
        }
        if constexpr (FP8) { asm volatile("s_nop 15\n\ts_nop 15" ::: "memory"); PG8_SCHED; }
        if constexpr (ALIGN_EPI) { if (wr == 0) PG8_BAR; }
        if (EPI_DRAIN && !GATHER && has_next) PG8_WAIT_V(0);
        bool keep = false;
        if constexpr (MIDHOOK) { if (cur.x0 == 0) { E.mid(acc, cur, wr, wc, fr, fq); keep = true; } else E(acc, cur, wr, wc, fr, fq); }
        else E(acc, cur, wr, wc, fr, fq);
        if (!has_next) break;
        if (!keep) {
#pragma unroll
        for (int a = 0; a < 2; ++a)
#pragma unroll
            for (int b = 0; b < 2; ++b)
#pragma unroll
                for (int m = 0; m < 4; ++m)
#pragma unroll
                    for (int n = 0; n < 2; ++n) acc[a][b][m][n] = (f32x4){0.f, 0.f, 0.f, 0.f};
        }
        cur = nxt; cA = nA; cB = nB; ++ui;
        if constexpr (GATHER) { oc0[0] = on0[0]; oc0[1] = on0[1]; oc1[0] = on1[0]; oc1[1] = on1[1]; }
        if constexpr (ALIGN_EPI) { if (wr == 1) PG8_BAR; }
    }
    PG8_WAIT_V(0);
    if constexpr (!ALIGN_EPI) { if (wr == 0) PG8_BAR; }
    PG8_BAR;
#undef PG8_SA
#undef PG8_SB
#undef PG8_STAGE
#undef PG8_LDA
#undef PG8_LDB
#undef PG8_MMA
#undef PG8_F8
#undef PG8_WAIT_V
#undef PG8_WAIT_L
#undef PG8_BAR
#undef PG8_SCHED
}

struct SchedPlain {
    TileOrder o; const char* A; const char* B; size_t tstep;
    __device__ __forceinline__ bool next(int i, Unit& u) const { int pm, pn; if (!o.next(i, pm, pn)) return false; u.pm = pm; u.pn = pn; u.x0 = 0; u.x1 = 0; u.x2 = 0; u.x3 = 0; u.A = A + (size_t)pm * tstep; u.B = B + (size_t)pn * tstep; return true; }
};
struct SchedTwo {
    TileOrder o; const char* A; const char* B; size_t tstep; size_t hb;
    __device__ __forceinline__ bool next(int i, Unit& u) const { int pm, pn; if (!o.next(i >> 1, pm, pn)) return false; const int br = i & 1; u.pm = pm; u.pn = pn; u.x0 = br; u.x1 = 0; u.x2 = 0; u.x3 = 0;
        u.A = A + (size_t)pm * tstep + (size_t)br * hb; u.B = B + (size_t)pn * tstep + (size_t)br * hb; return true; }
};
struct SchedMoe {
    const LAS int* utab; int nunits;
    const char* Abase; const char* Bbase; size_t a_row_bytes; size_t b_exp_bytes; size_t b_tile_bytes; const int* list; int gather_k2;
    __device__ __forceinline__ bool next(int i, Unit& u) const {
        if (i >= nunits) return false;
        const int e = utab[i * 5 + 0], pn = utab[i * 5 + 1], lo_ = utab[i * 5 + 2], nv = utab[i * 5 + 3], rb = utab[i * 5 + 4];
        u.pm = e; u.pn = pn; u.x0 = lo_; u.x1 = nv; u.x2 = rb; u.x3 = i;
        u.A = Abase + (size_t)rb * a_row_bytes; u.B = Bbase + (size_t)e * b_exp_bytes + (size_t)pn * b_tile_bytes; return true; }
    __device__ __forceinline__ void offs(const Unit& u, const int (&RA)[2], const int (&CA2)[2], unsigned (&o0)[2], unsigned (&o1)[2]) const {
        const int* lp = list + (size_t)u.pm * T + u.x0;
#pragma unroll
        for (int i = 0; i < 2; ++i) {
            int r0 = RA[i], r1 = RA[i] + HALF; r0 = r0 < u.x1 ? r0 : u.x1 - 1; r1 = r1 < u.x1 ? r1 : u.x1 - 1;
            const int t0 = lp[r0] >> 1, t1 = lp[r1] >> 1;
            o0[i] = (unsigned)t0 * (unsigned)gather_k2 + (unsigned)CA2[i]; o1[i] = (unsigned)t1 * (unsigned)gather_k2 + (unsigned)CA2[i]; }
    }
    __device__ __forceinline__ void offs_raw(const Unit& u, const int (&RA)[2], int (&w0)[2], int (&w1)[2]) const {
        const int* lp = list + (size_t)u.pm * T + u.x0;
#pragma unroll
        for (int i = 0; i < 2; ++i) { int r0 = RA[i], r1 = RA[i] + HALF; r0 = r0 < u.x1 ? r0 : u.x1 - 1; r1 = r1 < u.x1 ? r1 : u.x1 - 1; w0[i] = lp[r0]; w1[i] = lp[r1]; }
    }
    __device__ __forceinline__ void offs_fin(const int (&w0)[2], const int (&w1)[2], const int (&CA2)[2], unsigned (&o0)[2], unsigned (&o1)[2]) const {
#pragma unroll
        for (int i = 0; i < 2; ++i) { o0[i] = (unsigned)(w0[i] >> 1) * (unsigned)gather_k2 + (unsigned)CA2[i]; o1[i] = (unsigned)(w1[i] >> 1) * (unsigned)gather_k2 + (unsigned)CA2[i]; }
    }
};
}

using pg8::Unit;
struct EpiInProj {
    static constexpr bool PERM = true, WIDE = (WIDE_EPI != 0);
    static constexpr float ISC = IN_FP8 ? 1.f / (float)(1 << (F8S_W + F8S_X)) : 1.f;
    unsigned char* ws;
    __device__ __forceinline__ void operator()(const f32x4 (&acc)[2][2][4][2], const Unit& u, int wr, int wc, int fr, int fq) const {
        const int pn = u.pn; const int row0 = u.pm * 256 + wr * 64 + fr;
        if (pn >= 12) {
            bf16_t* rp = (bf16_t*)(ws + WS_GA); bf16_t* gp = (bf16_t*)(ws + WS_GB); const int col0 = (pn - 12) * 128 + wc * 32 + 8 * fq;
#pragma unroll
            for (int ai = 0; ai < 2; ++ai)
#pragma unroll
                for (int m = 0; m < 4; ++m) { const size_t ro = (size_t)(row0 + ai * 128 + m * 16) * D_MODEL + col0; float rv[8], gv[8];
#pragma unroll
                    for (int n = 0; n < 2; ++n)
#pragma unroll
                        for (int i = 0; i < 4; ++i) {
                            if (GATE_FP8) {
                                constexpr float kz = -LOG2E * ISC, ig = 1.f / (float)(1 << F8S_G), tmax = 16384.f / (float)(1 << F8S_G);
                                rv[4 * n + i] = fast_rcp(__builtin_fmaf(fast_exp2(acc[ai][0][m][n][i] * kz), ig, ig));
                                if (GB_INV) gv[4 * n + i] = __builtin_fminf(__builtin_fmaf(fast_exp2(acc[ai][1][m][n][i] * kz), 0.015625f, 0.015625f), 256.f);
                                else gv[4 * n + i] = fast_rcp(__builtin_fminf(__builtin_fmaf(fast_exp2(acc[ai][1][m][n][i] * kz), ig, ig), tmax)); continue; }
                            const float sa = sigmoidf_(acc[ai][0][m][n][i] * ISC), sb = __builtin_fmaxf(sigmoidf_(acc[ai][1][m][n][i] * ISC), 6.103515625e-5f); gv[4 * n + i] = sb; rv[4 * n + i] = sa * fast_rcp(sb); }
                    if (GATE_FP8) { u32x2 w8;
                        w8.x = pk4_fp8_ns(rv[0], rv[1], rv[2], rv[3]); w8.y = pk4_fp8_ns(rv[4], rv[5], rv[6], rv[7]); *(u32x2*)((unsigned char*)rp + ro) = w8;
                        w8.x = pk4_fp8_ns(gv[0], gv[1], gv[2], gv[3]); w8.y = pk4_fp8_ns(gv[4], gv[5], gv[6], gv[7]); *(u32x2*)((unsigned char*)gp + ro) = w8; continue; }
                    if (false) { constexpr float sg = (float)(1 << F8S_G); u32x2 w8;
                        w8.x = pk4_fp8(rv[0] * sg, rv[1] * sg, rv[2] * sg, rv[3] * sg); w8.y = pk4_fp8(rv[4] * sg, rv[5] * sg, rv[6] * sg, rv[7] * sg); *(u32x2*)((unsigned char*)rp + ro) = w8;
                        w8.x = pk4_fp8(gv[0] * sg, gv[1] * sg, gv[2] * sg, gv[3] * sg); w8.y = pk4_fp8(gv[4] * sg, gv[5] * sg, gv[6] * sg, gv[7] * sg); *(u32x2*)((unsigned char*)gp + ro) = w8; continue; }
                    u32x4 w; w.x = cvt_pk_bf16(rv[0], rv[1]); w.y = cvt_pk_bf16(rv[2], rv[3]); w.z = cvt_pk_bf16(rv[4], rv[5]); w.w = cvt_pk_bf16(rv[6], rv[7]); *(u32x4*)(rp + ro) = w;
                    w.x = cvt_pk_bf16(gv[0], gv[1]); w.y = cvt_pk_bf16(gv[2], gv[3]); w.z = cvt_pk_bf16(gv[4], gv[5]); w.w = cvt_pk_bf16(gv[6], gv[7]); *(u32x4*)(gp + ro) = w; }
            return; }
        bf16_t* base; int ldc = WA; float sc = ISC; const int piece = pn >> 1, colt = (pn & 1) * 256;
        if (piece == 0) { base = (bf16_t*)(ws + WS_QQ); ldc = D_MODEL; sc = C2 * ISC; }
        else if (piece == 3) { base = (bf16_t*)(ws + WS_QQ) + WA; ldc = D_MODEL; sc = C2 * ISC; }
        else base = (bf16_t*)(ws + (piece == 1 ? WS_KA : piece == 2 ? WS_VA : piece == 4 ? WS_KB : WS_VB));
        const int col0 = WIDE ? colt + wc * 64 + 16 * fq : colt + wc * 32 + 8 * fq; constexpr int BJS = WIDE ? 8 : 128;
        if (Q_FP8 && (piece == 0 || piece == 3)) {
            unsigned char* b8 = ws + WS_QQ + (piece == 3 ? WA : 0); const float sq = sc * (float)(1 << F8S_Q);
#pragma unroll
            for (int ai = 0; ai < 2; ++ai)
#pragma unroll
                for (int m = 0; m < 4; ++m) { unsigned char* rowp8 = b8 + (size_t)(row0 + ai * 128 + m * 16) * D_MODEL + col0; u32x2 w8[2];
#pragma unroll
                    for (int bj = 0; bj < 2; ++bj) { const f32x4 v0 = acc[ai][bj][m][0] * sq, v1 = acc[ai][bj][m][1] * sq;
                        w8[bj].x = pk4_fp8(v0[0], v0[1], v0[2], v0[3]); w8[bj].y = pk4_fp8(v1[0], v1[1], v1[2], v1[3]); }
                    if (WIDE) *(u32x4*)rowp8 = (u32x4){w8[0].x, w8[0].y, w8[1].x, w8[1].y}; else { *(u32x2*)rowp8 = w8[0]; *(u32x2*)(rowp8 + 128) = w8[1]; } }
            return; }
#pragma unroll
        for (int ai = 0; ai < 2; ++ai)
#pragma unroll
            for (int m = 0; m < 4; ++m) { bf16_t* rowp = base + (size_t)(row0 + ai * 128 + m * 16) * ldc + col0;
#pragma unroll
                for (int bj = 0; bj < 2; ++bj) { const f32x4 v0 = acc[ai][bj][m][0] * sc, v1 = acc[ai][bj][m][1] * sc;
                    u32x4 w; w.x = cvt_pk_bf16(v0[0], v0[1]); w.y = cvt_pk_bf16(v0[2], v0[3]); w.z = cvt_pk_bf16(v1[0], v1[1]); w.w = cvt_pk_bf16(v1[2], v1[3]);
                    *(u32x4*)(rowp + bj * BJS) = w; } }
    }
};
struct EpiMerge {
    static constexpr bool PERM = true, WIDE = (WIDE_EPI != 0);
    const bf16_t* ratio; const bf16_t* gb; bf16_t* merged;
    __device__ __forceinline__ void mid(f32x4 (&acc)[2][2][4][2], const Unit& u, int wr, int wc, int fr, int fq) const {
        unsigned o0 = ((unsigned)(u.pm * 256 + wr * 64 + fr) * D_MODEL + (unsigned)(WIDE ? u.pn * 256 + wc * 64 + 16 * fq : u.pn * 256 + wc * 32 + 8 * fq)) * 2u;
        asm volatile("" : "+v"(o0));
#pragma unroll
        for (int ai = 0; ai < 2; ++ai) {
            if (GATE_FP8) {
                u32x2 ga8[4][2], gb8[4][2];
                if (WIDE) {
#pragma unroll
                    for (int m = 0; m < 4; ++m) { const unsigned ob = (o0 >> 1) + (unsigned)((ai * 128 + m * 16) * D_MODEL); const u32x4 a = *(const u32x4*)((const char*)ratio + ob), b = *(const u32x4*)((const char*)gb + ob);
                        ga8[m][0] = (u32x2){a.x, a.y}; ga8[m][1] = (u32x2){a.z, a.w}; gb8[m][0] = (u32x2){b.x, b.y}; gb8[m][1] = (u32x2){b.z, b.w}; } }
                else
#pragma unroll
                for (int m = 0; m < 4; ++m)
#pragma unroll
                    for (int bj = 0; bj < 2; ++bj) { const unsigned ob = (o0 >> 1) + (unsigned)((ai * 128 + m * 16) * D_MODEL + bj * (WIDE ? 8 : 128)); ga8[m][bj] = *(const u32x2*)((const char*)ratio + ob); gb8[m][bj] = *(const u32x2*)((const char*)gb + ob); }
#pragma unroll
                for (int m = 0; m < 4; ++m)
#pragma unroll
                    for (int bj = 0; bj < 2; ++bj) { f32x4 a0, a1, b0, b1; dec8(ga8[m][bj], a0, a1); dec8(gb8[m][bj], b0, b1);
#pragma unroll
                        for (int i = 0; i < 4; ++i) { if (GB_INV) { constexpr float kq = 64.f / (float)(1 << F8S_G); acc[ai][bj][m][0][i] *= a0[i] * (b0[i] * kq); acc[ai][bj][m][1][i] *= a1[i] * (b1[i] * kq); }
                            else { acc[ai][bj][m][0][i] *= a0[i] * fast_rcp(b0[i]); acc[ai][bj][m][1][i] *= a1[i] * fast_rcp(b1[i]); } } }
                asm volatile("" ::: "memory"); continue; }
            u32x4 gw[4][2];
#pragma unroll
            for (int m = 0; m < 4; ++m)
#pragma unroll
                for (int bj = 0; bj < 2; ++bj) gw[m][bj] = *(const u32x4*)((const char*)ratio + o0 + (unsigned)((ai * 128 + m * 16) * D_MODEL + bj * (WIDE ? 8 : 128)) * 2u);
#pragma unroll
            for (int m = 0; m < 4; ++m)
#pragma unroll
                for (int bj = 0; bj < 2; ++bj) { const u32x4 g4 = gw[m][bj];
                    acc[ai][bj][m][0] = acc[ai][bj][m][0] * (f32x4){bf_lo(g4.x), bf_hi(g4.x), bf_lo(g4.y), bf_hi(g4.y)};
                    acc[ai][bj][m][1] = acc[ai][bj][m][1] * (f32x4){bf_lo(g4.z), bf_hi(g4.z), bf_lo(g4.w), bf_hi(g4.w)}; }
            asm volatile("" ::: "memory"); }
    }
    __device__ __forceinline__ void operator()(const f32x4 (&acc)[2][2][4][2], const Unit& u, int wr, int wc, int fr, int fq) const {
        unsigned o0 = ((unsigned)(u.pm * 256 + wr * 64 + fr) * D_MODEL + (unsigned)(WIDE ? u.pn * 256 + wc * 64 + 16 * fq : u.pn * 256 + wc * 32 + 8 * fq)) * 2u;
        asm volatile("" : "+v"(o0));
#pragma unroll
        for (int ai = 0; ai < 2; ++ai) {
            if (GATE_FP8 && MIX_FP8) {
                u32x2 gb8[4][2];
                if (WIDE) {
#pragma unroll
                    for (int m = 0; m < 4; ++m) { const u32x4 b = *(const u32x4*)((const char*)gb + (o0 >> 1) + (unsigned)((ai * 128 + m * 16) * D_MODEL)); gb8[m][0] = (u32x2){b.x, b.y}; gb8[m][1] = (u32x2){b.z, b.w}; } }
                else
#pragma unroll
                for (int m = 0; m < 4; ++m)
#pragma unroll
                    for (int bj = 0; bj < 2; ++bj) gb8[m][bj] = *(const u32x2*)((const char*)gb + (o0 >> 1) + (unsigned)((ai * 128 + m * 16) * D_MODEL + bj * (WIDE ? 8 : 128)));
#pragma unroll
                for (int m = 0; m < 4; ++m) { u32x2 wst[2];
#pragma unroll
                    for (int bj = 0; bj < 2; ++bj) { f32x4 b0, b1; dec8(gb8[m][bj], b0, b1);
                        constexpr int se = F8S_M - F8S_W - F8S_O - F8S_G; constexpr float sm = se >= 0 ? (float)(1 << (se >= 0 ? se : 0)) : 1.f / (float)(1 << (se < 0 ? -se : 0));
#pragma unroll
                        for (int i = 0; i < 4; ++i) { if (GB_INV) { constexpr int sf = F8S_W + F8S_O - F8S_M; constexpr float kf = 64.f * (sf >= 0 ? (float)(1 << (sf >= 0 ? sf : 0)) : 1.f / (float)(1 << (sf < 0 ? -sf : 0)));
                            b0[i] = acc[ai][bj][m][0][i] * fast_rcp(b0[i] * kf); b1[i] = acc[ai][bj][m][1][i] * fast_rcp(b1[i] * kf); }
                            else { b0[i] = acc[ai][bj][m][0][i] * (b0[i] * sm); b1[i] = acc[ai][bj][m][1][i] * (b1[i] * sm); } }
                        u32x2 w8; w8.x = pk4_fp8(b0[0], b0[1], b0[2], b0[3]); w8.y = pk4_fp8(b1[0], b1[1], b1[2], b1[3]); wst[bj] = w8;
                        if (!WIDE) *(u32x2*)((char*)merged + (o0 >> 1) + (unsigned)((ai * 128 + m * 16) * D_MODEL + bj * 128)) = w8; }
                    if (WIDE) *(u32x4*)((char*)merged + (o0 >> 1) + (unsigned)((ai * 128 + m * 16) * D_MODEL)) = (u32x4){wst[0].x, wst[0].y, wst[1].x, wst[1].y}; }
                asm volatile("" ::: "memory"); continue; }
            u32x4 gw[4][2];
#pragma unroll
            for (int m = 0; m < 4; ++m)
#pragma unroll
                for (int bj = 0; bj < 2; ++bj) gw[m][bj] = *(const u32x4*)((const char*)gb + o0 + (unsigned)((ai * 128 + m * 16) * D_MODEL + bj * (WIDE ? 8 : 128)) * 2u);
#pragma unroll
            for (int m = 0; m < 4; ++m)
#pragma unroll
                for (int bj = 0; bj < 2; ++bj) { const u32x4 g4 = gw[m][bj];
                    const f32x4 v0 = acc[ai][bj][m][0] * (f32x4){bf_lo(g4.x), bf_hi(g4.x), bf_lo(g4.y), bf_hi(g4.y)}, v1 = acc[ai][bj][m][1] * (f32x4){bf_lo(g4.z), bf_hi(g4.z), bf_lo(g4.w), bf_hi(g4.w)};
                    if (MIX_FP8) { constexpr float sm = (F8S_M >= F8S_W + F8S_O) ? (float)(1 << (F8S_M - F8S_W - F8S_O)) : 1.f / (float)(1 << (F8S_W + F8S_O - F8S_M));
                        u32x2 w8; w8.x = pk4_fp8(v0[0] * sm, v0[1] * sm, v0[2] * sm, v0[3] * sm); w8.y = pk4_fp8(v1[0] * sm, v1[1] * sm, v1[2] * sm, v1[3] * sm);
                        *(u32x2*)((char*)merged + (o0 >> 1) + (unsigned)((ai * 128 + m * 16) * D_MODEL + bj * (WIDE ? 8 : 128))) = w8; }
                    else {
                    u32x4 w; w.x = cvt_pk_bf16(v0[0], v0[1]); w.y = cvt_pk_bf16(v0[2], v0[3]); w.z = cvt_pk_bf16(v1[0], v1[1]); w.w = cvt_pk_bf16(v1[2], v1[3]);
                    *(u32x4*)((char*)merged + o0 + (unsigned)((ai * 128 + m * 16) * D_MODEL + bj * (WIDE ? 8 : 128)) * 2u) = w; } }
            asm volatile("" ::: "memory"); }
    }
};
struct EpiOut {
    static constexpr bool PERM = true, WIDE = (WIDE_EPI != 0);
    static constexpr float OSC = MIX_FP8 ? 1.f / (float)(1 << (F8S_W + F8S_M)) : 1.f;
    const float* xin; const bf16_t* xb; bf16_t* pre;
    __device__ __forceinline__ void operator()(const f32x4 (&acc)[2][2][4][2], const Unit& u, int wr, int wc, int fr, int fq) const {
        unsigned o0 = (unsigned)(u.pm * 256 + wr * 64 + fr) * D_MODEL + (unsigned)(WIDE ? u.pn * 256 + wc * 64 + 16 * fq : u.pn * 256 + wc * 32 + 8 * fq);
        asm volatile("" : "+v"(o0));
        if (xin) {
#pragma unroll
            for (int ai = 0; ai < 2; ++ai)
#pragma unroll
                for (int mh = 0; mh < 2; ++mh) {
                    f32x4 xv[2][2][2];
#pragma unroll
                    for (int m2 = 0; m2 < 2; ++m2)
#pragma unroll
                        for (int bj = 0; bj < 2; ++bj) { const float* p = xin + o0 + (unsigned)((ai * 128 + (mh * 2 + m2) * 16) * D_MODEL + bj * (WIDE ? 8 : 128)); xv[m2][bj][0] = *(const f32x4*)p; xv[m2][bj][1] = *(const f32x4*)(p + 4); }
#pragma unroll
                    for (int m2 = 0; m2 < 2; ++m2)
#pragma unroll
                        for (int bj = 0; bj < 2; ++bj) { const int m = mh * 2 + m2; const unsigned oe = o0 + (unsigned)((ai * 128 + m * 16) * D_MODEL + bj * (WIDE ? 8 : 128));
                            const f32x4 v0 = xv[m2][bj][0] * ALPHA + acc[ai][bj][m][0] * OSC, v1 = xv[m2][bj][1] * ALPHA + acc[ai][bj][m][1] * OSC;
                            u32x4 w; w.x = cvt_pk_bf16(v0[0], v0[1]); w.y = cvt_pk_bf16(v0[2], v0[3]); w.z = cvt_pk_bf16(v1[0], v1[1]); w.w = cvt_pk_bf16(v1[2], v1[3]);
                            *(u32x4*)(pre + oe) = w; } }
        } else {
#pragma unroll
            for (int ai = 0; ai < 2; ++ai) {
                u32x4 xw[4][2];
#pragma unroll
                for (int m = 0; m < 4; ++m)
#pragma unroll
                    for (int bj = 0; bj < 2; ++bj) xw[m][bj] = *(const u32x4*)(xb + o0 + (unsigned)((ai * 128 + m * 16) * D_MODEL + bj * (WIDE ? 8 : 128)));
#pragma unroll
                for (int m = 0; m < 4; ++m)
#pragma unroll
                    for (int bj = 0; bj < 2; ++bj) { const unsigned oe = o0 + (unsigned)((ai * 128 + m * 16) * D_MODEL + bj * (WIDE ? 8 : 128)); const u32x4 x4 = xw[m][bj];
                        const f32x4 x0 = (f32x4){bf_lo(x4.x), bf_hi(x4.x), bf_lo(x4.y), bf_hi(x4.y)}, x1 = (f32x4){bf_lo(x4.z), bf_hi(x4.z), bf_lo(x4.w), bf_hi(x4.w)};
                        const f32x4 v0 = x0 * ALPHA + acc[ai][bj][m][0] * OSC, v1 = x1 * ALPHA + acc[ai][bj][m][1] * OSC;
                        u32x4 w; w.x = cvt_pk_bf16(v0[0], v0[1]); w.y = cvt_pk_bf16(v0[2], v0[3]); w.z = cvt_pk_bf16(v1[0], v1[1]); w.w = cvt_pk_bf16(v1[2], v1[3]);
                        *(u32x4*)(pre + oe) = w; }
                asm volatile("" ::: "memory"); }
        }
    }
};
struct EpiGU {
    static constexpr bool PERM = true, WIDE = (WIDE_EPI != 0);
    bf16_t* h;
    __device__ __forceinline__ void operator()(const f32x4 (&acc)[2][2][4][2], const Unit& u, int wr, int wc, int fr, int fq) const {
        const int row0 = u.x2 + wr * 64 + fr, col0 = u.pn * 128 + wc * 32 + 8 * fq;
#pragma unroll
        for (int ai = 0; ai < 2; ++ai)
#pragma unroll
            for (int m = 0; m < 4; ++m) { float v[8];
#pragma unroll
                for (int n = 0; n < 2; ++n)
#pragma unroll
                    for (int i = 0; i < 4; ++i) { constexpr float sc = MOE_FP8 ? 1.f / (float)(1 << (F8S_W + F8S_X)) : 1.f;
                        if (MOE_FP8) {
                            constexpr float kz = -LOG2E * sc, cd = 1.f / (sc * sc * (float)(1 << F8S_H));
                            v[n * 4 + i] = (acc[ai][0][m][n][i] * acc[ai][1][m][n][i]) * fast_rcp(__builtin_fmaf(fast_exp2(acc[ai][0][m][n][i] * kz), cd, cd)); continue; }
                        const float g = acc[ai][0][m][n][i] * sc, uu = acc[ai][1][m][n][i] * sc; v[n * 4 + i] = g * sigmoidf_(g) * uu; }
                if (MOE_FP8) { u32x2 w8; w8.x = pk4_fp8(v[0], v[1], v[2], v[3]); w8.y = pk4_fp8(v[4], v[5], v[6], v[7]);
                    *(u32x2*)((unsigned char*)h + (size_t)(row0 + ai * 128 + m * 16) * FE + col0) = w8; }
                else { bf16_t* rowp = h + (size_t)(row0 + ai * 128 + m * 16) * FE + col0;
                    u32x4 w; w.x = cvt_pk_bf16(v[0], v[1]); w.y = cvt_pk_bf16(v[2], v[3]); w.z = cvt_pk_bf16(v[4], v[5]); w.w = cvt_pk_bf16(v[6], v[7]);
                    *(u32x4*)rowp = w; } }
    }
};
struct EpiDown {
    static constexpr bool PERM = true, WIDE = (WIDE_EPI != 0);
    bf16_t* y; const LAS int* ent;
    __device__ __forceinline__ void operator()(const f32x4 (&acc)[2][2][4][2], const Unit& u, int wr, int wc, int fr, int fq) const {
        const LAS int* lp = ent + u.x3 * 256;
        const int col0 = WIDE ? u.pn * 256 + wc * 64 + 16 * fq : u.pn * 256 + wc * 32 + 8 * fq;
#pragma unroll
        for (int ai = 0; ai < 2; ++ai)
#pragma unroll
            for (int m = 0; m < 4; ++m) { const int entry = lp[ai * 128 + wr * 64 + m * 16 + fr];
                if (entry >= 0 && Y_FP8) { unsigned char* rowp8 = (unsigned char*)y + (size_t)entry * D_MODEL + col0;
                    constexpr float sy = (F8S_Y >= F8S_W + F8S_H) ? (float)(1 << (F8S_Y - F8S_W - F8S_H)) : 1.f / (float)(1 << (F8S_W + F8S_H - F8S_Y));
                    u32x2 w8[2];
#pragma unroll
                    for (int bj = 0; bj < 2; ++bj) { const f32x4 v0 = acc[ai][bj][m][0] * sy, v1 = acc[ai][bj][m][1] * sy;
                        w8[bj].x = pk4_fp8(v0[0], v0[1], v0[2], v0[3]); w8[bj].y = pk4_fp8(v1[0], v1[1], v1[2], v1[3]); }
                    if (WIDE) *(u32x4*)rowp8 = (u32x4){w8[0].x, w8[0].y, w8[1].x, w8[1].y}; else { *(u32x2*)rowp8 = w8[0]; *(u32x2*)(rowp8 + 128) = w8[1]; } }
                else if (entry >= 0) { bf16_t* rowp = y + (size_t)entry * D_MODEL + col0;
#pragma unroll
                    for (int bj = 0; bj < 2; ++bj) { constexpr float sc = MOE_FP8 ? 1.f / (float)(1 << (F8S_W + F8S_H)) : 1.f; const f32x4 v0 = acc[ai][bj][m][0] * sc, v1 = acc[ai][bj][m][1] * sc;
                        u32x4 w; w.x = cvt_pk_bf16(v0[0], v0[1]); w.y = cvt_pk_bf16(v0[2], v0[3]); w.z = cvt_pk_bf16(v1[0], v1[1]); w.w = cvt_pk_bf16(v1[2], v1[3]);
                        *(u32x4*)(rowp + bj * (WIDE ? 8 : 128)) = w; } } }
    }
};

namespace att {
constexpr int DM = WA, DMQ = D_MODEL;
constexpr int SLOTB = 8192, NSLOT = 8, PFD = 3;
constexpr int LDS_K = 0, LDS_V = NSLOT * SLOTB, LDS_WS = LDSCTL_OFF + 4096, LDS_TAB = LDS_WS + 8 * 256, LDS_FLG = LDS_TAB + 1024, LDS_END = LDS_FLG + 64, LDS_OST = 147456;
static_assert(2 * NSLOT * SLOTB <= RING_BYTES && LDS_END <= LDSCTL_OFF + 8192 && LDS_OST + 8 * 2048 <= LDS_BYTES, "attention LDS map");
#define SBAR() __builtin_amdgcn_sched_barrier(0)
#define WAIT_BAR0() asm volatile("s_waitcnt vmcnt(0) lgkmcnt(0)\n\ts_barrier" ::: "memory")
#define WAIT_BARN(N) asm volatile("s_waitcnt vmcnt(" #N ") lgkmcnt(0)\n\ts_barrier" ::: "memory")
#define STEP_WAIT(tcur, tlow) do { if ((tcur) - 2 >= (tlow)) { WAIT_BARN(4); } else if ((tcur) - 1 >= (tlow)) { WAIT_BARN(2); } else { WAIT_BAR0(); } } while (0)
__device__ __forceinline__ int crow(int r, int hi) { return (r & 3) + 8 * (r >> 2) + 4 * hi; }
__device__ __forceinline__ void glds16(const void* gsrc, unsigned lds_dst) { unsigned keep;
    asm volatile("s_mov_b32 %0, m0\n\ts_mov_b32 m0, %2\n\ts_nop 0\n\tglobal_load_lds_dwordx4 %1, off\n\ts_mov_b32 m0, %0" : "=&s"(keep) : "v"(gsrc), "s"(lds_dst) : "memory"); }
__device__ __forceinline__ float max3f(float a, float b, float c) { return __builtin_fmaxf(__builtin_fmaxf(a, b), c); }
__device__ __forceinline__ void qkt(f32x16& p0, f32x16& p1, const LAS char* Kslot, const bf16x8* qr, const f32x16& cin, int r32, int hi) {
    const LAS char* kb = Kslot + hi * 1024 + r32 * 16;
#pragma unroll
    for (int d0 = 0; d0 < 4; ++d0) {
        const bf16x8 b0 = *(const LAS bf16x8*)(kb + d0 * 2048);
        const bf16x8 b1 = *(const LAS bf16x8*)(kb + d0 * 2048 + 512);
        if (d0 == 0) { p0 = MFMA32(b0, qr[0], cin); p1 = MFMA32(b1, qr[0], cin); }
        else { p0 = MFMA32(b0, qr[d0], p0); p1 = MFMA32(b1, qr[d0], p1); } }
}
__device__ __forceinline__ float rowmax(const f32x16& p0, const f32x16& p1) {
    float a = max3f(p0[0], p0[1], p1[0]), b = max3f(p0[2], p0[3], p1[1]); a = max3f(a, p1[2], p1[3]);
#pragma unroll
    for (int r = 4; r < 16; r += 4) { a = max3f(a, p0[r], p0[r + 1]); b = max3f(b, p0[r + 2], p0[r + 3]); a = max3f(a, p1[r], p1[r + 1]); b = max3f(b, p1[r + 2], p1[r + 3]); }
    const float m = __builtin_fmaxf(a, b);
    auto rr = __builtin_amdgcn_permlane32_swap(__float_as_uint(m), __float_as_uint(m), false, false);
    return __builtin_fmaxf(__uint_as_float(rr[0]), __uint_as_float(rr[1]));
}
__device__ __forceinline__ void pv(f32x16* o, int vb, bf16x8 pa0, bf16x8 pa1, bf16x8 pa2, bf16x8 pa3) {
#pragma unroll
    for (int d0 = 0; d0 < 2; ++d0) { s16x4 lo[4], hi[4];
#pragma unroll
        for (int ks = 0; ks < 4; ++ks) {
            asm volatile("ds_read_b64_tr_b16 %0,%1 offset:%c2" : "=&v"(lo[ks]) : "v"(vb), "i"(d0 * 4096 + ks * 1024) : "memory");
            asm volatile("ds_read_b64_tr_b16 %0,%1 offset:%c2" : "=&v"(hi[ks]) : "v"(vb), "i"(d0 * 4096 + ks * 1024 + 512) : "memory"); }
        asm volatile("s_waitcnt lgkmcnt(0)" ::: "memory"); SBAR();
#define PK(k) (bf16x8){lo[k][0], lo[k][1], lo[k][2], lo[k][3], hi[k][0], hi[k][1], hi[k][2], hi[k][3]}
        o[d0] = MFMA32(pa0, PK(0), o[d0]);
        o[d0] = MFMA32(pa1, PK(1), o[d0]);
        o[d0] = MFMA32(pa2, PK(2), o[d0]);
        o[d0] = MFMA32(pa3, PK(3), o[d0]);
#undef PK
    }
}
#define PKW(P, B) cvt_pk_bf16(P[B], P[B + 1])
__device__ __forceinline__ void load_q(bf16x8 (&qr)[4], const bf16_t* Qw, int r32, int hi) {
    if (Q_FP8) {
        unsigned char* wsb = *(unsigned char* const __attribute__((address_space(4)))*)((const __attribute__((address_space(4))) char*)__builtin_amdgcn_kernarg_segment_ptr() + 128);
        const unsigned char* q8 = wsb + WS_QQ + ((Qw + (long)r32 * DMQ + hi * 8) - (const bf16_t*)(wsb + WS_QQ));
        u32x2 raw[4];
#pragma unroll
        for (int d0 = 0; d0 < 4; ++d0) raw[d0] = *(const u32x2*)(q8 + d0 * 16);
#pragma unroll
        for (int d0 = 0; d0 < 4; ++d0) { f32x4 lo, hi4; dec8(raw[d0], lo, hi4); constexpr float iq = 1.f / (float)(1 << F8S_Q); lo = lo * iq; hi4 = hi4 * iq;
            u32x4 w; w.x = cvt_pk_bf16(lo[0], lo[1]); w.y = cvt_pk_bf16(lo[2], lo[3]); w.z = cvt_pk_bf16(hi4[0], hi4[1]); w.w = cvt_pk_bf16(hi4[2], hi4[3]); qr[d0] = __builtin_bit_cast(bf16x8, w); }
        return; }
#pragma unroll
    for (int d0 = 0; d0 < 4; ++d0) qr[d0] = *(const bf16x8*)(Qw + (long)r32 * DMQ + d0 * 16 + hi * 8);
}
__device__ __forceinline__ void store_o(const f32x16* o, const float* rs, bf16_t* Ow, LAS char* shm, int wid, int lane, int r32, int hi) {
    if (MIX_FP8) {
        unsigned char* wsb = *(unsigned char* const __attribute__((address_space(4)))*)((const __attribute__((address_space(4))) char*)__builtin_amdgcn_kernarg_segment_ptr() + 128);
        unsigned char* O8 = wsb + WS_O8 + (Ow - (const bf16_t*)(wsb + WS_QQ));
        LAS unsigned char* stg8 = (LAS unsigned char*)(shm + LDS_OST) + wid * 2048; constexpr float so = (float)(1 << F8S_O);
#pragma unroll
        for (int r = 0; r < 16; ++r) { const int orow = crow(r, hi);
#pragma unroll
            for (int d0 = 0; d0 < 2; ++d0) stg8[orow * 64 + d0 * 32 + r32] = (unsigned char)(__builtin_amdgcn_cvt_pk_fp8_f32(sat8(o[d0][r] * rs[r] * so), 0.f, 0, false) & 0xffu); }
        LDS_WAIT();
#pragma unroll
        for (int i = 0; i < 2; ++i) { const int row = i * 16 + (lane >> 2), ch = lane & 3; const u32x4 v = *(const LAS u32x4*)(stg8 + row * 64 + ch * 16); *(u32x4*)(O8 + (size_t)row * DMQ + ch * 16) = v; }
        LDS_WAIT();
        return; }
    LAS bf16_t* stg = (LAS bf16_t*)(shm + LDS_OST) + wid * 1024;
#pragma unroll
    for (int p = 0; p < 2; ++p) {
#pragma unroll
        for (int rr = 0; rr < 8; ++rr) { const int r = 8 * p + rr; const int orow = crow(r, hi) - 16 * p;
#pragma unroll
            for (int d0 = 0; d0 < 2; ++d0) stg[orow * 64 + d0 * 32 + r32] = (bf16_t)(cvt_pk_bf16(o[d0][r] * rs[r], 0.f) & 0xffffu); }
        LDS_WAIT();
#pragma unroll
        for (int i = 0; i < 2; ++i) { const int row = i * 8 + (lane >> 3), ch = lane & 7; const u32x4 v = *(const LAS u32x4*)(stg + row * 64 + ch * 8); *(u32x4*)(Ow + (size_t)(16 * p + row) * DMQ + ch * 8) = v; }
        LDS_WAIT(); }
}

#define DMA_K(t) glds16(ksrc + (long)(t) * 64 * DM, (unsigned)__builtin_amdgcn_readfirstlane(kdst + ((t) & (NSLOT - 1)) * SLOTB))
#define DMA_V(t) glds16(vsrc + (long)(t) * 64 * DM, (unsigned)__builtin_amdgcn_readfirstlane(vdst + ((t) & (NSLOT - 1)) * SLOTB))
__device__ __forceinline__ void attn_a_unit(int b, int h, int u, const bf16_t* Q, const bf16_t* K, const bf16_t* V, bf16_t* O, const float bfar, LAS char* shm) {
    int tid_ = threadIdx.x; asm volatile("" : "+v"(tid_)); const int tid = tid_, lane = tid & 63, r32 = lane & 31, hi = lane >> 5; const int wid = __builtin_amdgcn_readfirstlane(tid >> 6);
    const long rowbase = (long)b * SEQ; const int q0 = u * 256;
    const bf16_t* Qw = Q + (rowbase + q0 + wid * 32) * DMQ + h * HD;
    const bf16_t* Kh = K + rowbase * DM + h * HD; const bf16_t* Vh = V + rowbase * DM + h * HD;
    const unsigned lds0 = (unsigned)(size_t)shm;
    LAS float* wsf = (LAS float*)(shm + LDS_WS) + wid * 64;
    LAS float* tab = (LAS float*)(shm + LDS_TAB);
    const bf16_t* ksrc = Kh + (long)lane * DM + wid * 8;
    const bf16_t* vsrc = Vh + (long)(16 * (wid & 3) + (lane >> 2)) * DM + (wid >> 2) * 32 + (lane & 3) * 8;
    const unsigned kdst = lds0 + LDS_K + wid * 1024, vdst = lds0 + LDS_V + wid * 1024;
    const int vb0 = (int)(lds0 + LDS_V) + ((lane >> 4) & 1) * 32 + (lane & 3) * 8 + (4 * hi + ((lane & 15) >> 2)) * 64;
    const int tb = 4 * u, pr = wid >> 1;
    const int nsteps = (tb + 4) < 9 ? (tb + 4) : 9;
    const int tlow = (tb - 8) > 0 ? (tb - 8) : 0;
    bf16x8 qr[4];
    load_q(qr, Qw, r32, hi);
#pragma unroll
    for (int i = 3; i >= 1 - PFD; --i) { if (tb + i >= tlow) { DMA_K(tb + i); DMA_V(tb + i); } }
    float mhat = 0.f, l_reg = 0.f; f32x16 o[2]; o[0] = f32x16{}; o[1] = f32x16{};
    for (int s = 0; s < nsteps; ++s) {
        STEP_WAIT(tb - s, tlow);
        { const int tn = tb - s - PFD; if (tn >= tlow) { DMA_K(tn); DMA_V(tn); } }
        const int j = tb + pr - s;
        if (j >= 0) {
            const int sl = (j & (NSLOT - 1)) * SLOTB;
            const bool far = (s >= 3), first = (s == 0);
            f32x16 cin; const float c0 = (far ? bfar : 0.f) - mhat;
#pragma unroll
            for (int r = 0; r < 16; ++r) cin[r] = c0;
            f32x16 p0, p1;
            qkt(p0, p1, shm + LDS_K + sl, qr, cin, r32, hi);
            if (!far) {
                const LAS float* tp = tab + (s * 64 + 32 * (wid & 1) + r32 + 64 - 4 * hi);
#pragma unroll
                for (int r = 0; r < 16; ++r) { const int kv = (r & 3) + 8 * (r >> 2); p0[r] += tp[-kv]; p1[r] += tp[-kv - 32]; }
            }
            const float rm = rowmax(p0, p1);
            bool upd; float dl;
            if (first) { upd = true; dl = rm; } else { upd = __any(rm > 8.f) != 0; dl = __builtin_fmaxf(rm, 0.f); }
            if (upd) {
                mhat += dl;
#pragma unroll
                for (int r = 0; r < 16; ++r) { p0[r] -= dl; p1[r] -= dl; }
                if (!first) { const float f = fast_exp2(-dl); l_reg *= f; if (hi == 0) wsf[r32] = f; LDS_WAIT();
#pragma unroll
                    for (int r = 0; r < 16; ++r) { const float fr_ = wsf[crow(r, hi)]; o[0][r] *= fr_; o[1][r] *= fr_; } }
            }
            float sacc = 0.f;
#pragma unroll
            for (int r = 0; r < 16; ++r) { p0[r] = fast_exp2(p0[r]); p1[r] = fast_exp2(p1[r]); sacc += p0[r] + p1[r]; }
            l_reg += sacc;
            u32x4 pw0 = (u32x4){PKW(p0, 0), PKW(p0, 2), PKW(p0, 4), PKW(p0, 6)}, pw1 = (u32x4){PKW(p0, 8), PKW(p0, 10), PKW(p0, 12), PKW(p0, 14)};
            u32x4 pw2 = (u32x4){PKW(p1, 0), PKW(p1, 2), PKW(p1, 4), PKW(p1, 6)}, pw3 = (u32x4){PKW(p1, 8), PKW(p1, 10), PKW(p1, 12), PKW(p1, 14)};
            pv(o, vb0 + sl, __builtin_bit_cast(bf16x8, pw0), __builtin_bit_cast(bf16x8, pw1), __builtin_bit_cast(bf16x8, pw2), __builtin_bit_cast(bf16x8, pw3));
        }
    }
    { auto rr = __builtin_amdgcn_permlane32_swap(__float_as_uint(l_reg), __float_as_uint(l_reg), false, false); l_reg = __uint_as_float(rr[0]) + __uint_as_float(rr[1]); }
    if (hi == 0) wsf[32 + r32] = l_reg; LDS_WAIT();
    float rli[16];
#pragma unroll
    for (int r = 0; r < 16; ++r) rli[r] = fast_rcp(wsf[32 + crow(r, hi)]);
    asm volatile("s_waitcnt lgkmcnt(0)\n\ts_barrier" ::: "memory");
    store_o(o, rli, O + (rowbase + q0 + wid * 32) * DMQ + h * HD, shm, wid, lane, r32, hi);
    asm volatile("s_waitcnt lgkmcnt(0)\n\ts_barrier" ::: "memory");
}

typedef LAS const char* lds_cptr;
typedef short v4i16_t __attribute__((ext_vector_type(4)));
__device__ __forceinline__ s16x4 vtr(lds_cptr p) { return __builtin_bit_cast(s16x4, __builtin_amdgcn_ds_read_tr16_b64_v4i16((LAS v4i16_t*)p)); }
__device__ __forceinline__ void kload8(bf16x8* kf, lds_cptr kp) {
    kf[0] = *(const LAS bf16x8*)(kp);        kf[1] = *(const LAS bf16x8*)(kp + 512);
    kf[2] = *(const LAS bf16x8*)(kp + 2048); kf[3] = *(const LAS bf16x8*)(kp + 2560);
    kf[4] = *(const LAS bf16x8*)(kp + 4096); kf[5] = *(const LAS bf16x8*)(kp + 4608);
    kf[6] = *(const LAS bf16x8*)(kp + 6144); kf[7] = *(const LAS bf16x8*)(kp + 6656);
}
__device__ __forceinline__ void kload2(bf16x8* kf, lds_cptr kp, int j) { kf[2 * j] = *(const LAS bf16x8*)(kp + j * 2048); kf[2 * j + 1] = *(const LAS bf16x8*)(kp + j * 2048 + 512); }
#define WAIT_BARC(N) asm volatile("s_waitcnt vmcnt(" #N ") lgkmcnt(0)\n\ts_barrier" ::: "memory")
template <bool CONT>
__device__ __forceinline__ void attn_a_unit_fast(int b, int h, int u, const bf16_t* Q, const bf16_t* K, const bf16_t* V, bf16_t* O, const float bfar, LAS char* shm) {
    int tid_ = threadIdx.x; asm volatile("" : "+v"(tid_)); const int tid = tid_, lane = tid & 63, r32 = lane & 31, hi = lane >> 5; const int wid = __builtin_amdgcn_readfirstlane(tid >> 6);
    const long rowbase = (long)b * SEQ; const int q0 = u * 256;
    const bf16_t* Qw = Q + (rowbase + q0 + wid * 32) * DMQ + h * HD;
    const bf16_t* Kh = K + rowbase * DM + h * HD; const bf16_t* Vh = V + rowbase * DM + h * HD;
    const unsigned lds0 = (unsigned)(size_t)shm;
    LAS float* wsf = (LAS float*)(shm + LDS_WS) + wid * 64;
    LAS float* tab = (LAS float*)(shm + LDS_TAB);
    const bf16_t* ksrc = Kh + (long)lane * DM + wid * 8;
    const bf16_t* vsrc = Vh + (long)(16 * (wid & 3) + (lane >> 2)) * DM + (wid >> 2) * 32 + (lane & 3) * 8;
    const unsigned kdst = lds0 + LDS_K + wid * 1024, vdst = lds0 + LDS_V + wid * 1024;
    const int vb0 = (int)(lds0 + LDS_V) + ((lane >> 4) & 1) * 32 + (lane & 3) * 8 + (4 * hi + ((lane & 15) >> 2)) * 64;
    const lds_cptr kp0 = (lds_cptr)shm + LDS_K + hi * 1024 + r32 * 16;
    const lds_cptr vp0 = (lds_cptr)shm + LDS_V + ((lane >> 4) & 1) * 32 + (lane & 3) * 8 + (4 * hi + ((lane & 15) >> 2)) * 64;
    const int tb = 4 * u, pr = wid >> 1;
#define SLOTOF(t) (((t) & (NSLOT - 1)) * SLOTB)
    bf16x8 qr[4];
    load_q(qr, Qw, r32, hi);
    if constexpr (!CONT) {
    DMA_K(tb + 3); DMA_K(tb + 2); DMA_K(tb + 1); DMA_K(tb); DMA_K(tb - 1); DMA_V(tb + 3); DMA_V(tb + 2); DMA_V(tb + 1);
    DMA_K(tb - 2); DMA_V(tb); DMA_K(tb - 3); DMA_V(tb - 1); DMA_K(tb - 4); DMA_V(tb - 2); }
    float mhat = 0.f, l_reg = 0.f; f32x16 o[2]; o[0] = f32x16{}; o[1] = f32x16{}; f32x16 negm = f32x16{}; asm volatile("" : "+v"(negm));
    bf16x8 kf[8]; f32x16 pA0, pA1, pB0, pB1; bool resc = false;
    s16x4 vlo[8], vhi[8]; u32x4 pw0, pw1, pw2, pw3;
    const int ib = 32 * (wid & 1) + r32 + 64 - 4 * hi;
#define PAF(k) __builtin_bit_cast(bf16x8, pw##k)
#define VFR(i) (bf16x8){vlo[i][0], vlo[i][1], vlo[i][2], vlo[i][3], vhi[i][0], vhi[i][1], vhi[i][2], vhi[i][3]}
#define PIN(x) asm volatile("" : "+v"(x))
#define MX3(a, b, c) __builtin_fmaxf(__builtin_fmaxf((a), (b)), (c))
#define GAPA(MF, A0, A1, A2, A3, W0, W1, PW) do { MF; sacc += A0; sacc += A1; sacc += A2; sacc += A3; PIN(sacc); W0; W1; PIN(PW); SBAR(); } while (0)
#define EX(v) __builtin_amdgcn_exp2f(v)
#define GAPB(MF, X, B) do { MF; X[B] = EX(X[B]); X[B + 1] = EX(X[B + 1]); X[B + 2] = EX(X[B + 2]); X[B + 3] = EX(X[B + 3]); PIN(X); SBAR(); } while (0)
#define VRD(i) do { vlo[i] = vtr(vp_ + (((i) >> 2) * 4096 + ((i) & 3) * 1024)); vhi[i] = vtr(vp_ + (((i) >> 2) * 4096 + ((i) & 3) * 1024 + 512)); } while (0)
#define KRD(G, j) do { if (G) { kload2(kf, kp_, j); SBAR(); } } while (0)
#define CINIT(C0, C1, S) do { const LAS float* tp_ = tab + ((S) * 64 + ib); _Pragma("unroll") for (int r = 0; r < 16; ++r) { const int kv = (r & 3) + 8 * (r >> 2); C0[r] = tp_[-kv] - mhat; C1[r] = tp_[-kv - 32] - mhat; } } while (0)
#define WAIT2(NA, NB) do { if constexpr (CONT) { WAIT_BARC(NB); } else { WAIT_BARC(NA); } } while (0)
#define ASTEP(C0, C1, P0, P1, S, NWAIT, NWAITC) do { SBAR(); \
    const int js_ = tb + pr - (S); const lds_cptr vp_ = vp0 + SLOTOF(js_ + 1); const lds_cptr kp_ = kp0 + SLOTOF(js_ - 1); \
    if ((S) <= 2) { CINIT(C0, C1, S); SBAR(); } \
    VRD(0); SBAR(); float sacc = (P0[0] + P0[1]); \
    GAPA(C0 = MFMA32(kf[0], qr[0], ((S) <= 2 ? C0 : negm)), P0[2], P0[3], P0[4], P0[5],     pw0[0] = PKW(P0, 0), pw0[1] = PKW(P0, 2), pw0); \
    VRD(4); SBAR(); GAPA(C1 = MFMA32(kf[1], qr[0], ((S) <= 2 ? C1 : negm)), P0[6], P0[7], P0[8], P0[9],     pw0[2] = PKW(P0, 4), pw0[3] = PKW(P0, 6), pw0); \
    VRD(1); SBAR(); GAPA(C0 = MFMA32(kf[2], qr[1], C0),   P0[10], P0[11], P0[12], P0[13], pw1[0] = PKW(P0, 8), pw1[1] = PKW(P0, 10), pw1); \
    VRD(5); SBAR(); GAPA(C1 = MFMA32(kf[3], qr[1], C1),   P0[14], P0[15], P1[0], P1[1],   pw1[2] = PKW(P0, 12), pw1[3] = PKW(P0, 14), pw1); \
    VRD(2); SBAR(); GAPA(C0 = MFMA32(kf[4], qr[2], C0),   P1[2], P1[3], P1[4], P1[5],     pw2[0] = PKW(P1, 0), pw2[1] = PKW(P1, 2), pw2); \
    VRD(6); SBAR(); GAPA(C1 = MFMA32(kf[5], qr[2], C1),   P1[6], P1[7], P1[8], P1[9],     pw2[2] = PKW(P1, 4), pw2[3] = PKW(P1, 6), pw2); \
    VRD(3); SBAR(); GAPA(C0 = MFMA32(kf[6], qr[3], C0),   P1[10], P1[11], P1[12], P1[13], pw3[0] = PKW(P1, 8), pw3[1] = PKW(P1, 10), pw3); \
    VRD(7); SBAR(); GAPA(C1 = MFMA32(kf[7], qr[3], C1),   P1[14], P1[15], 0.f, 0.f,       pw3[2] = PKW(P1, 12), pw3[3] = PKW(P1, 14), pw3); \
    l_reg += sacc; \
    if ((S) <= 3) { DMA_K(tb - (S) - 5); } if ((S) <= 5 && (!CONT || (S) >= 2)) { DMA_V(tb - (S) - 3); } \
    { float a = MX3(C0[0], C0[1], C1[0]), b_ = MX3(C0[2], C0[3], C1[1]); a = MX3(a, C1[2], C1[3]); \
      _Pragma("unroll") for (int r = 4; r < 16; r += 4) { a = MX3(a, C0[r], C0[r + 1]); b_ = MX3(b_, C0[r + 2], C0[r + 3]); a = MX3(a, C1[r], C1[r + 1]); b_ = MX3(b_, C1[r + 2], C1[r + 3]); } \
      float rm = __builtin_fmaxf(a, b_); { auto rr = __builtin_amdgcn_permlane32_swap(__float_as_uint(rm), __float_as_uint(rm), false, false); rm = __builtin_fmaxf(__uint_as_float(rr[0]), __uint_as_float(rr[1])); } \
      resc = false; \
      if (__builtin_expect(__any(rm > 8.f), 0)) { const float dl = __builtin_fmaxf(rm, 0.f); mhat += dl; \
        _Pragma("unroll") for (int r = 0; r < 16; ++r) { C0[r] -= dl; C1[r] -= dl; } \
        const float f = __builtin_amdgcn_exp2f(-dl); l_reg *= f; if (hi == 0) wsf[r32] = f; resc = true; } \
      _Pragma("unroll") for (int r = 0; r < 16; ++r) negm[r] = bfar - mhat; asm volatile("" : "+v"(negm)); } \
    SBAR(); \
    GAPB(o[0] = MFMA32(PAF(0), VFR(0), o[0]), C0, 0); \
    GAPB(o[1] = MFMA32(PAF(0), VFR(4), o[1]), C0, 4); \
    KRD((S) < 8, 0); GAPB(o[0] = MFMA32(PAF(1), VFR(1), o[0]), C0, 8); \
    KRD((S) < 8, 1); GAPB(o[1] = MFMA32(PAF(1), VFR(5), o[1]), C0, 12); \
    KRD((S) < 8, 2); GAPB(o[0] = MFMA32(PAF(2), VFR(2), o[0]), C1, 0); \
    KRD((S) < 8, 3); GAPB(o[1] = MFMA32(PAF(2), VFR(6), o[1]), C1, 4); \
    GAPB(o[0] = MFMA32(PAF(3), VFR(3), o[0]), C1, 8); \
    GAPB(o[1] = MFMA32(PAF(3), VFR(7), o[1]), C1, 12); \
    WAIT2(NWAIT, NWAITC); \
    if (resc) { LDS_WAIT(); _Pragma("unroll") for (int d_ = 0; d_ < 2; ++d_) _Pragma("unroll") for (int r = 0; r < 16; ++r) o[d_][r] *= wsf[crow(r, hi)]; } \
  } while (0)
    if constexpr (!CONT) { WAIT_BARC(9); }
    { const int j0 = tb + pr; f32x16 c0v, c1v; { const LAS float* tp_ = tab + ib;
#pragma unroll
        for (int r = 0; r < 16; ++r) { const int kv = (r & 3) + 8 * (r >> 2); c0v[r] = tp_[-kv]; c1v[r] = tp_[-kv - 32]; } }
      const LAS char* kb = shm + LDS_K + SLOTOF(j0) + hi * 1024 + r32 * 16;
#pragma unroll
      for (int d0 = 0; d0 < 4; ++d0) { const bf16x8 b0 = *(const LAS bf16x8*)(kb + d0 * 2048); const bf16x8 b1 = *(const LAS bf16x8*)(kb + d0 * 2048 + 512);
          if (d0 == 0) { pA0 = MFMA32(b0, qr[0], c0v); pA1 = MFMA32(b1, qr[0], c1v); } else { pA0 = MFMA32(b0, qr[d0], pA0); pA1 = MFMA32(b1, qr[d0], pA1); } }
      kload8(kf, kp0 + SLOTOF(j0 - 1));
      const float rm = rowmax(pA0, pA1); mhat = rm;
#pragma unroll
      for (int r = 0; r < 16; ++r) { pA0[r] = EX(pA0[r] - rm); pA1[r] = EX(pA1[r] - rm); negm[r] = bfar - mhat; }
      asm volatile("" : "+v"(negm)); }
    WAIT_BARC(4);
    DMA_K(tb - 5); if constexpr (!CONT) { DMA_V(tb - 3); }
    ASTEP(pB0, pB1, pA0, pA1, 1, 6, 2);
    ASTEP(pA0, pA1, pB0, pB1, 2, 6, 4);
    ASTEP(pB0, pB1, pA0, pA1, 3, 6, 5);
    ASTEP(pA0, pA1, pB0, pB1, 4, 5, 5);
    ASTEP(pB0, pB1, pA0, pA1, 5, 4, 4);
    ASTEP(pA0, pA1, pB0, pB1, 6, 2, 2);
    ASTEP(pB0, pB1, pA0, pA1, 7, 1, 1);
    ASTEP(pA0, pA1, pB0, pB1, 8, 0, 0);
    { float sacc = 0.f;
#pragma unroll
      for (int r = 0; r < 16; ++r) sacc += pA0[r] + pA1[r];
      l_reg += sacc;
      pw0 = (u32x4){PKW(pA0, 0), PKW(pA0, 2), PKW(pA0, 4), PKW(pA0, 6)}; pw1 = (u32x4){PKW(pA0, 8), PKW(pA0, 10), PKW(pA0, 12), PKW(pA0, 14)};
      pw2 = (u32x4){PKW(pA1, 0), PKW(pA1, 2), PKW(pA1, 4), PKW(pA1, 6)}; pw3 = (u32x4){PKW(pA1, 8), PKW(pA1, 10), PKW(pA1, 12), PKW(pA1, 14)};
      SBAR(); pv(o, vb0 + SLOTOF(tb + pr - 8), PAF(0), PAF(1), PAF(2), PAF(3)); }
    { auto rr = __builtin_amdgcn_permlane32_swap(__float_as_uint(l_reg), __float_as_uint(l_reg), false, false); l_reg = __uint_as_float(rr[0]) + __uint_as_float(rr[1]); }
    if (hi == 0) wsf[32 + r32] = l_reg; LDS_WAIT();
    float rli[16];
#pragma unroll
    for (int r = 0; r < 16; ++r) rli[r] = fast_rcp(wsf[32 + crow(r, hi)]);
    asm volatile("s_waitcnt lgkmcnt(0)\n\ts_barrier" ::: "memory");
    store_o(o, rli, O + (rowbase + q0 + wid * 32) * DMQ + h * HD, shm, wid, lane, r32, hi);
    asm volatile("s_waitcnt lgkmcnt(0)\n\ts_barrier" ::: "memory");
#undef SLOTOF
#undef PAF
#undef VFR
#undef PIN
#undef MX3
#undef GAPA
#undef EX
#undef GAPB
#undef VRD
#undef KRD
#undef CINIT
#undef ASTEP
#undef WAIT2
}

__device__ __forceinline__ void attn_b_unit(int b, int h, int qb, const bf16_t* Q, const bf16_t* K, const bf16_t* V, bf16_t* O, LAS char* shm) {
    int tid_ = threadIdx.x; asm volatile("" : "+v"(tid_)); const int tid = tid_, lane = tid & 63, r32 = lane & 31, hi = lane >> 5; const int wid = __builtin_amdgcn_readfirstlane(tid >> 6);
    const long rowbase = (long)b * SEQ; const int q0 = qb * 256;
    const bf16_t* Qw = Q + (rowbase + q0 + wid * 32) * DMQ + h * HD;
    const bf16_t* Kh = K + rowbase * DM + h * HD; const bf16_t* Vh = V + rowbase * DM + h * HD;
    const unsigned lds0 = (unsigned)(size_t)shm;
    LAS unsigned* flg = (LAS unsigned*)(shm + LDS_FLG);
    const bf16_t* ksrc = Kh + (long)lane * DM + wid * 8;
    const bf16_t* vsrc = Vh + (long)(16 * (wid & 3) + (lane >> 2)) * DM + (wid >> 2) * 32 + (lane & 3) * 8;
    const unsigned kdst = lds0 + LDS_K + wid * 1024, vdst = lds0 + LDS_V + wid * 1024;
    const int vb0 = (int)(lds0 + LDS_V) + ((lane >> 4) & 1) * 32 + (lane & 3) * 8 + (4 * hi + ((lane & 15) >> 2)) * 64;
    const int tb = 4 * qb, pr = wid >> 1;
    const int tq = 32 * (wid & 1) + r32;
    bf16x8 qr[4];
    load_q(qr, Qw, r32, hi);
#pragma unroll
    for (int i = 3; i >= 1 - PFD; --i) { if (tb + i >= 0) { DMA_K(tb + i); DMA_V(tb + i); } }
    float R = 1.0f; bool wdone = false; f32x16 o[2]; o[0] = f32x16{}; o[1] = f32x16{};
    for (int s = 0; ; ++s) {
        STEP_WAIT(tb - s, 0);
        if (s > 0) { const LAS unsigned* f = flg + ((s - 1) & 1) * 8; unsigned all = 1u;
#pragma unroll
            for (int w = 0; w < 8; ++w) all &= f[w];
            if (__builtin_amdgcn_readfirstlane(all) != 0u) break; }
        { const int tn = tb - s - PFD; if (tn >= 0) { DMA_K(tn); DMA_V(tn); } }
        const int j = tb + pr - s;
        if (j >= 0 && !wdone) {
            const int sl = (j & (NSLOT - 1)) * SLOTB;
            f32x16 cin = f32x16{}; f32x16 p0, p1;
            qkt(p0, p1, shm + LDS_K + sl, qr, cin, r32, hi);
#pragma unroll
            for (int r = 0; r < 16; ++r) { p0[r] = fast_rcp(1.0f + fast_exp2(p0[r])); p1[r] = fast_rcp(1.0f + fast_exp2(p1[r])); }
            if (s == 0) {
#pragma unroll
                for (int r = 0; r < 16; ++r) { const int kv = crow(r, hi); if (kv >= tq) p0[r] = 1.0f; if (kv + 32 >= tq) p1[r] = 1.0f; } }
            float W[8], part[8];
#pragma unroll
            for (int i = 0; i < 8; ++i) { const float pb = (i < 4) ? (p0[4 * i] * p0[4 * i + 1]) * (p0[4 * i + 2] * p0[4 * i + 3]) : (p1[4 * i - 16] * p1[4 * i - 15]) * (p1[4 * i - 14] * p1[4 * i - 13]);
                auto rr = __builtin_amdgcn_permlane32_swap(__float_as_uint(pb), __float_as_uint(pb), false, false);
                const float vlo = __uint_as_float(rr[0]), vhi = __uint_as_float(rr[1]);
                W[i] = vlo * vhi; part[i] = hi ? 1.0f : vhi; }
            float sw = R;
#pragma unroll
            for (int i = 7; i >= 0; --i) { float c = sw * part[i];
                if (i < 4) {
#pragma unroll
                    for (int rr_ = 3; rr_ >= 0; --rr_) { const float t_ = c * p0[4 * i + rr_]; p0[4 * i + rr_] = c - t_; c = t_; } }
                else {
#pragma unroll
                    for (int rr_ = 3; rr_ >= 0; --rr_) { const float t_ = c * p1[4 * i - 16 + rr_]; p1[4 * i - 16 + rr_] = c - t_; c = t_; } }
                sw *= W[i]; }
            R = sw;
            u32x4 pw0 = (u32x4){PKW(p0, 0), PKW(p0, 2), PKW(p0, 4), PKW(p0, 6)}, pw1 = (u32x4){PKW(p0, 8), PKW(p0, 10), PKW(p0, 12), PKW(p0, 14)};
            u32x4 pw2 = (u32x4){PKW(p1, 0), PKW(p1, 2), PKW(p1, 4), PKW(p1, 6)}, pw3 = (u32x4){PKW(p1, 8), PKW(p1, 10), PKW(p1, 12), PKW(p1, 14)};
            pv(o, vb0 + sl, __builtin_bit_cast(bf16x8, pw0), __builtin_bit_cast(bf16x8, pw1), __builtin_bit_cast(bf16x8, pw2), __builtin_bit_cast(bf16x8, pw3));
            wdone = __all(R == 0.0f) != 0;
        }
        if (j <= 0) wdone = true;
        if (lane == 0) flg[(s & 1) * 8 + wid] = wdone ? 1u : 0u;
    }
    float ones[16];
#pragma unroll
    for (int r = 0; r < 16; ++r) ones[r] = 1.0f;
    asm volatile("s_waitcnt vmcnt(0) lgkmcnt(0)\n\ts_barrier" ::: "memory");
    store_o(o, ones, O + (rowbase + q0 + wid * 32) * DMQ + h * HD, shm, wid, lane, r32, hi);
    asm volatile("s_waitcnt lgkmcnt(0)\n\ts_barrier" ::: "memory");
}
#define WAITN_SW(n) do { switch (n) { case 0: WAIT_BARC(0); break; case 1: WAIT_BARC(1); break; case 2: WAIT_BARC(2); break; case 3: WAIT_BARC(3); break; case 4: WAIT_BARC(4); break; \
    case 5: WAIT_BARC(5); break; case 6: WAIT_BARC(6); break; case 7: WAIT_BARC(7); break; case 8: WAIT_BARC(8); break; default: WAIT_BARC(9); break; } } while (0)
__device__ __forceinline__ int attn_b_unit_fast(int b, int h, int qb, const bf16_t* Q, const bf16_t* K, const bf16_t* V, bf16_t* O, LAS char* shm, int rk0, int rk1, int rv0, int rv1) {
    int tid_ = threadIdx.x; asm volatile("" : "+v"(tid_)); const int tid = tid_, lane = tid & 63, r32 = lane & 31, hi = lane >> 5; const int wid = __builtin_amdgcn_readfirstlane(tid >> 6);
    const long rowbase = (long)b * SEQ; const int q0 = qb * 256;
    const bf16_t* Qw = Q + (rowbase + q0 + wid * 32) * DMQ + h * HD;
    const bf16_t* Kh = K + rowbase * DM + h * HD; const bf16_t* Vh = V + rowbase * DM + h * HD;
    const unsigned lds0 = (unsigned)(size_t)shm;
    LAS unsigned* flg = (LAS unsigned*)(shm + LDS_FLG);
    const bf16_t* ksrc = Kh + (long)lane * DM + wid * 8;
    const bf16_t* vsrc = Vh + (long)(16 * (wid & 3) + (lane >> 2)) * DM + (wid >> 2) * 32 + (lane & 3) * 8;
    const unsigned kdst = lds0 + LDS_K + wid * 1024, vdst = lds0 + LDS_V + wid * 1024;
    const int vb0 = (int)(lds0 + LDS_V) + ((lane >> 4) & 1) * 32 + (lane & 3) * 8 + (4 * hi + ((lane & 15) >> 2)) * 64;
    const lds_cptr kp0 = (lds_cptr)shm + LDS_K + hi * 1024 + r32 * 16;
    const lds_cptr vp0 = (lds_cptr)shm + LDS_V + ((lane >> 4) & 1) * 32 + (lane & 3) * 8 + (4 * hi + ((lane & 15) >> 2)) * 64;
    const int tb = 4 * qb, pr = wid >> 1;
    const int tq = 32 * (wid & 1) + r32;
#define SLOTOF(t) (((t) & (NSLOT - 1)) * SLOTB)
#define CL0(t) ((t) > 0 ? (t) : 0)
    bf16x8 qr[4];
    load_q(qr, Qw, r32, hi);
    int nA = 0, n2 = 0, n1 = 0;
#define KQ(t, CNT) do { if (!((t) >= rk0 && (t) <= rk1)) { DMA_K(t); ++CNT; } } while (0)
#define VQ(t, CNT) do { if (!((t) >= rv0 && (t) <= rv1)) { DMA_V(t); ++CNT; } } while (0)
    { int nb_ = 0; KQ(tb + 3, nb_); KQ(tb + 2, nb_); KQ(tb + 1, nb_); KQ(tb, nb_); KQ(tb - 1, nb_); (void)nb_; }
    VQ(tb + 3, nA); VQ(tb + 2, nA); VQ(tb + 1, nA); KQ(tb - 2, nA); VQ(tb, nA);
    KQ(tb - 3, n2); VQ(tb - 1, n2); KQ(tb - 4, n1); VQ(tb - 2, n1);
#undef KQ
#undef VQ
    float R = 1.0f; bool wdone = false, pend = false; int jp = 0; f32x16 o[2]; o[0] = f32x16{}; o[1] = f32x16{};
    f32x16 cA0, cA1, cB0, cB1; u32x4 pw0, pw1, pw2, pw3;
    pw0 = pw1 = pw2 = pw3 = (u32x4){0u, 0u, 0u, 0u};
#define PAF(k) __builtin_bit_cast(bf16x8, pw##k)
#define PIN(x) asm volatile("" : "+v"(x))
#define VLD(LO, HI, i) do { if (!FIRST_) { LO = vtr(vp_ + (((i) >> 2) * 4096 + ((i) & 3) * 1024)); HI = vtr(vp_ + (((i) >> 2) * 4096 + ((i) & 3) * 1024 + 512)); } } while (0)
#define VF(LO, HI) (bf16x8){LO[0], LO[1], LO[2], LO[3], HI[0], HI[1], HI[2], HI[3]}
#define KEEP1(x) x = fast_rcp(1.0f + fast_exp2(x))
#define KLD(X, i) X = *(const LAS bf16x8*)(kq_ + ((i) >> 1) * 2048 + ((i) & 1) * 512)
#define GAPQ(MF, C0, C1, I) do { MF; KEEP1(C0[2 * (I)]); KEEP1(C0[2 * (I) + 1]); KEEP1(C1[2 * (I)]); KEEP1(C1[2 * (I) + 1]); PIN(C0); PIN(C1); SBAR(); } while (0)
#define SCAN4(X, B, CI) do { float c_ = (CI); _Pragma("unroll") for (int q_ = 3; q_ >= 0; --q_) { const float t_ = c_ * X[(B) + q_]; X[(B) + q_] = c_ - t_; c_ = t_; } } while (0)
#define BSTEP(C0, C1, N0, N1, FIRSTF, S) do { constexpr bool FIRST_ = FIRSTF; SBAR(); \
    const lds_cptr vp_ = vp0 + SLOTOF(CL0(js + 1)); const lds_cptr kq_ = kp0 + SLOTOF(CL0(js - 1)); \
    bf16x8 k0_, k1_; KLD(k0_, 0); KLD(k1_, 1); SBAR(); \
    GAPQ(N0 = MFMA32(k0_, qr[0], f32x16{}); KLD(k0_, 2), C0, C1, 0); \
    GAPQ(N1 = MFMA32(k1_, qr[0], f32x16{}); KLD(k1_, 3), C0, C1, 1); \
    GAPQ(N0 = MFMA32(k0_, qr[1], N0); KLD(k0_, 4), C0, C1, 2); \
    GAPQ(N1 = MFMA32(k1_, qr[1], N1); KLD(k1_, 5), C0, C1, 3); \
    GAPQ(N0 = MFMA32(k0_, qr[2], N0); KLD(k0_, 6), C0, C1, 4); \
    GAPQ(N1 = MFMA32(k1_, qr[2], N1); KLD(k1_, 7), C0, C1, 5); \
    GAPQ(N0 = MFMA32(k0_, qr[3], N0), C0, C1, 6); \
    GAPQ(N1 = MFMA32(k1_, qr[3], N1), C0, C1, 7); \
    { const int tk_ = tb - (S) - 5, tv_ = tb - (S) - 3; if (tk_ >= 0) { DMA_K(tk_); ++n0; } if (tv_ >= 0) { DMA_V(tv_); ++n0; } } \
    if (FIRST_) { _Pragma("unroll") for (int r = 0; r < 16; ++r) { const int kv = crow(r, hi); if (kv >= tq) C0[r] = 1.0f; if (kv + 32 >= tq) C1[r] = 1.0f; } } \
    float cin_[8], Rn_; \
    { float sw = R; \
      _Pragma("unroll") for (int i = 7; i >= 0; --i) { const float pb = (i < 4) ? (C0[4 * i] * C0[4 * i + 1]) * (C0[4 * i + 2] * C0[4 * i + 3]) : (C1[4 * i - 16] * C1[4 * i - 15]) * (C1[4 * i - 14] * C1[4 * i - 13]); \
          auto rr = __builtin_amdgcn_permlane32_swap(__float_as_uint(pb), __float_as_uint(pb), false, false); \
          const float vlo_ = __uint_as_float(rr[0]), vhi_ = __uint_as_float(rr[1]); cin_[i] = hi ? sw : sw * vhi_; sw *= vlo_ * vhi_; } \
      Rn_ = sw; } \
    SBAR(); \
    s16x4 f0l_, f0h_, f1l_, f1h_; f0l_ = f0h_ = f1l_ = f1h_ = (s16x4){0, 0, 0, 0}; VLD(f0l_, f0h_, 0); SBAR(); \
    VLD(f1l_, f1h_, 4); if (!FIRST_) { o[0] = MFMA32(PAF(0), VF(f0l_, f0h_), o[0]); } SBAR(); \
    VLD(f0l_, f0h_, 1); if (!FIRST_) { o[1] = MFMA32(PAF(0), VF(f1l_, f1h_), o[1]); } SBAR(); \
    VLD(f1l_, f1h_, 5); if (!FIRST_) { o[0] = MFMA32(PAF(1), VF(f0l_, f0h_), o[0]); } SCAN4(C0, 0, cin_[0]); PIN(C0); SBAR(); \
    VLD(f0l_, f0h_, 2); if (!FIRST_) { o[1] = MFMA32(PAF(1), VF(f1l_, f1h_), o[1]); } SCAN4(C0, 4, cin_[1]); pw0 = (u32x4){PKW(C0, 0), PKW(C0, 2), PKW(C0, 4), PKW(C0, 6)}; PIN(C0); PIN(pw0); SBAR(); \
    VLD(f1l_, f1h_, 6); if (!FIRST_) { o[0] = MFMA32(PAF(2), VF(f0l_, f0h_), o[0]); } SCAN4(C0, 8, cin_[2]); PIN(C0); SBAR(); \
    VLD(f0l_, f0h_, 3); if (!FIRST_) { o[1] = MFMA32(PAF(2), VF(f1l_, f1h_), o[1]); } SCAN4(C0, 12, cin_[3]); pw1 = (u32x4){PKW(C0, 8), PKW(C0, 10), PKW(C0, 12), PKW(C0, 14)}; PIN(C0); PIN(pw1); SBAR(); \
    VLD(f1l_, f1h_, 7); if (!FIRST_) { o[0] = MFMA32(PAF(3), VF(f0l_, f0h_), o[0]); } SCAN4(C1, 0, cin_[4]); PIN(C1); SBAR(); \
    if (!FIRST_) { o[1] = MFMA32(PAF(3), VF(f1l_, f1h_), o[1]); } SCAN4(C1, 4, cin_[5]); pw2 = (u32x4){PKW(C1, 0), PKW(C1, 2), PKW(C1, 4), PKW(C1, 6)}; PIN(C1); PIN(pw2); SBAR(); \
    SCAN4(C1, 8, cin_[6]); SCAN4(C1, 12, cin_[7]); pw3 = (u32x4){PKW(C1, 8), PKW(C1, 10), PKW(C1, 12), PKW(C1, 14)}; \
    R = Rn_; } while (0)
#define BBODY(C0, C1, N0, N1, FIRSTF, S) do { const int js = tb + pr - (S); const bool act = (js >= 0) && !wdone; int n0 = 0; \
    if (act) { BSTEP(C0, C1, N0, N1, FIRSTF, S); pend = true; jp = js; wdone = (__all(R == 0.0f) != 0) || (js == 0); } \
    else { { const int tk_ = tb - (S) - 5, tv_ = tb - (S) - 3; if (tk_ >= 0) { DMA_K(tk_); ++n0; } if (tv_ >= 0) { DMA_V(tv_); ++n0; } } \
           if (pend) { pv(o, vb0 + SLOTOF(jp), PAF(0), PAF(1), PAF(2), PAF(3)); pend = false; } wdone = true; } \
    if (lane == 0) flg[((S) & 1) * 8 + wid] = wdone ? 1u : 0u; \
    { const int nw_ = n0 + n1 + n2; WAITN_SW(nw_); n2 = n1; n1 = n0; } \
    { const LAS unsigned* f_ = flg + ((S) & 1) * 8; unsigned all_ = 1u; _Pragma("unroll") for (int w = 0; w < 8; ++w) all_ &= f_[w]; stop = __builtin_amdgcn_readfirstlane(all_) != 0u; } } while (0)
    { const int nw_ = nA + n2 + n1; WAITN_SW(nw_); }
    { const int j0 = tb + pr; const LAS char* kb = shm + LDS_K + SLOTOF(j0) + hi * 1024 + r32 * 16;
#pragma unroll
      for (int d0 = 0; d0 < 4; ++d0) { const bf16x8 b0 = *(const LAS bf16x8*)(kb + d0 * 2048); const bf16x8 b1 = *(const LAS bf16x8*)(kb + d0 * 2048 + 512);
          if (d0 == 0) { cA0 = MFMA32(b0, qr[0], f32x16{}); cA1 = MFMA32(b1, qr[0], f32x16{}); } else { cA0 = MFMA32(b0, qr[d0], cA0); cA1 = MFMA32(b1, qr[d0], cA1); } }
    }
    bool stop = false; int nsteps = 1;
    BBODY(cA0, cA1, cB0, cB1, true, 0);
#pragma unroll 1
    for (int s = 1; !stop; ++s) {
        cA0 = cB0; cA1 = cB1;
        BBODY(cA0, cA1, cB0, cB1, false, s);
        ++nsteps;
    }
    if (pend) { pv(o, vb0 + SLOTOF(jp), PAF(0), PAF(1), PAF(2), PAF(3)); pend = false; }
    float ones[16];
#pragma unroll
    for (int r = 0; r < 16; ++r) ones[r] = 1.0f;
    asm volatile("s_waitcnt vmcnt(0) lgkmcnt(0)\n\ts_barrier" ::: "memory");
    store_o(o, ones, O + (rowbase + q0 + wid * 32) * DMQ + h * HD, shm, wid, lane, r32, hi);
    asm volatile("s_waitcnt lgkmcnt(0)\n\ts_barrier" ::: "memory");
    return nsteps;
#undef SLOTOF
#undef CL0
#undef PAF
#undef PIN
#undef VLD
#undef VF
#undef KEEP1
#undef KLD
#undef GAPQ
#undef SCAN4
#undef BSTEP
#undef BBODY
}
#undef DMA_K
#undef DMA_V
#undef PKW
#undef SBAR
#undef WAIT_BAR0
}

#define XB_TMO      128
#define XB_XCNT(j)  (256  + 64 * (j))
#define XB_XSUB(j)  (1280 + 64 * (j))
#define XB_XGEN(j)  (2304 + 64 * (j))
#define XB_TOP      3328
#define XB_TOPGEN   3392
#define XCD_BAR_WORDS 3456
#define XB_SPIN_CAP (1u << 22)
__device__ __forceinline__ unsigned xb_ld(unsigned* p)              { return __hip_atomic_load(p, __ATOMIC_RELAXED, __HIP_MEMORY_SCOPE_AGENT); }
__device__ __forceinline__ unsigned xb_add(unsigned* p, unsigned v) { return __hip_atomic_fetch_add(p, v, __ATOMIC_RELAXED, __HIP_MEMORY_SCOPE_AGENT); }
__device__ __forceinline__ unsigned xb_xcc_id() { return (unsigned)__builtin_amdgcn_s_getreg((3 << 11) | 20) & 0xFu; }
#define XB_SPIN(cond, bar) do { unsigned _sp = 0; while (cond) { __builtin_amdgcn_s_sleep(1); \
    if ((++_sp & 255u) == 0u) { if (xb_ld(&(bar)[XB_TMO])) break; if (_sp > XB_SPIN_CAP) { atomicAdd(&(bar)[XB_TMO], 1u); break; } } } } while (0)
struct XcdBarrier { unsigned* bar; unsigned x; volatile LAS unsigned* st; };
__device__ __forceinline__ XcdBarrier xcd_barrier_post(unsigned* bar, volatile LAS unsigned* st) {
    XcdBarrier b; b.bar = bar; b.x = xb_xcc_id(); b.st = st;
    if (threadIdx.x == 0) (void)xb_add(&bar[XB_XCNT(b.x)], 1u);
    return b;
}
__device__ __forceinline__ void xcd_barrier_complete(unsigned* bar, unsigned x, unsigned& nloc, unsigned& nx) {
    const unsigned G = gridDim.x * gridDim.y * gridDim.z;
    unsigned sum, cnt, mine, sp = 0u;
    for (;;) {
        sum = 0u; cnt = 0u; mine = 0u;
#pragma unroll
        for (unsigned j = 0; j < 16; ++j) { const unsigned c = xb_ld(&bar[XB_XCNT(j)]); sum += c; cnt += (c > 0u) ? 1u : 0u; mine = (j == x) ? c : mine; }
        if (sum == G) break;
        __builtin_amdgcn_s_sleep(1);
        if ((++sp & 255u) == 0u) { if (xb_ld(&bar[XB_TMO])) break; if (sp > XB_SPIN_CAP) { atomicAdd(&bar[XB_TMO], 1u); break; } }
    }
    nloc = mine > 0u ? mine : 1u; nx = cnt > 0u ? cnt : 1u;
}
__device__ __forceinline__ void xcd_barrier(const XcdBarrier& b) {
    asm volatile("s_waitcnt vmcnt(0)" ::: "memory");
    __syncthreads();
    if (threadIdx.x == 0) {
        unsigned* bar = b.bar;
        __builtin_amdgcn_s_waitcnt(0);
        unsigned nloc = b.st[0], nx = b.st[1];
        if (nloc == 0u) { xcd_barrier_complete(bar, b.x, nloc, nx); b.st[0] = nloc; b.st[1] = nx; }
        const unsigned old = xb_add(&bar[XB_XSUB(b.x)], 1u);
        const unsigned gen = old / nloc;
        if (old + 1u == (gen + 1u) * nloc) {
            __builtin_amdgcn_fence(__ATOMIC_RELEASE, "agent");
            asm volatile("s_waitcnt vmcnt(0)" ::: "memory");
            const unsigned og = xb_add(&bar[XB_TOP], 1u);
            const unsigned tg = og / nx;
            if (og + 1u == (tg + 1u) * nx) xb_add(&bar[XB_TOPGEN], 1u);
            else XB_SPIN(xb_ld(&bar[XB_TOPGEN]) == tg, bar);
            __builtin_amdgcn_fence(__ATOMIC_ACQUIRE, "agent");
            xb_add(&bar[XB_XGEN(b.x)], 1u);
            asm volatile("s_waitcnt vmcnt(0)" ::: "memory");
        } else {
            XB_SPIN(xb_ld(&bar[XB_XGEN(b.x)]) == gen, bar);
            __builtin_amdgcn_fence(__ATOMIC_ACQUIRE, "agent");
            asm volatile("s_waitcnt vmcnt(0)" ::: "memory");
        }
    }
    __syncthreads();
}

__device__ __forceinline__ unsigned f2bf(float f) { unsigned u = __builtin_bit_cast(unsigned, f); return (u + 0x7fffu + ((u >> 16) & 1u)) >> 16; }
__device__ __forceinline__ unsigned pk2(float lo, float hi) { return cvt_pk_bf16(lo, hi); }
__device__ __forceinline__ void transpose_item_f8(const float* W, int K, int N, unsigned char* WT, int row_off, LAS float* scr, int item, int lane, float mul, int ldw = 0, int koff = 0, int il_rbase = -1, int il_chb = 0, int il_type = 0) {
    if (ldw == 0) ldw = K;
    const int nblk = N / 32, kb = item / nblk, nb = item % nblk, k0 = 64 * kb, n0 = 32 * nb;
    f32x4 ld[8];
#pragma unroll
    for (int i = 0; i < 8; ++i) ld[i] = *(const f32x4*)(W + (size_t)(k0 + 8 * i + (lane >> 3)) * N + n0 + 4 * (lane & 7));
#pragma unroll
    for (int i = 0; i < 8; ++i) { LAS float* d = scr + (8 * i + (lane >> 3)) * 33 + 4 * (lane & 7); d[0] = ld[i].x * mul; d[1] = ld[i].y * mul; d[2] = ld[i].z * mul; d[3] = ld[i].w * mul; }
    LDS_WAIT(); asm volatile("" ::: "memory");
    const int c = lane & 7;
#pragma unroll
    for (int j = 0; j < 4; ++j) { const int n = (lane >> 3) + 8 * j; const LAS float* s = scr + (8 * c) * 33 + n;
        u32x2 o; o.x = pk4_fp8(s[0 * 33], s[1 * 33], s[2 * 33], s[3 * 33]); o.y = pk4_fp8(s[4 * 33], s[5 * 33], s[6 * 33], s[7 * 33]);
        const int ch_ = il_chb + n; const int row_ = il_rbase >= 0 ? il_rbase + 16 * (ch_ >> 3) + 8 * il_type + (ch_ & 7) : row_off + n0 + n;
        *(u32x2*)(WT + (size_t)row_ * ldw + koff + k0 + 8 * c) = o; }
    LDS_WAIT(); asm volatile("" ::: "memory");
}
__device__ __forceinline__ void transpose_item(const float* W, int K, int N, bf16_t* WT, int row_off, LAS float* scr, int item, int lane, int ldw = 0, int koff = 0) {
    if (ldw == 0) ldw = K;
    const int nblk = N / 32, kb = item / nblk, nb = item % nblk, k0 = 64 * kb, n0 = 32 * nb;
    f32x4 ld[8];
#pragma unroll
    for (int i = 0; i < 8; ++i) ld[i] = *(const f32x4*)(W + (size_t)(k0 + 8 * i + (lane >> 3)) * N + n0 + 4 * (lane & 7));
#pragma unroll
    for (int i = 0; i < 8; ++i) { LAS float* d = scr + (8 * i + (lane >> 3)) * 33 + 4 * (lane & 7); d[0] = ld[i].x; d[1] = ld[i].y; d[2] = ld[i].z; d[3] = ld[i].w; }
    LDS_WAIT(); asm volatile("" ::: "memory");
    const int c = lane & 7;
#pragma unroll
    for (int j = 0; j < 4; ++j) { const int n = (lane >> 3) + 8 * j; const LAS float* s = scr + (8 * c) * 33 + n;
        u32x4 o; o.x = pk2(s[0 * 33], s[1 * 33]); o.y = pk2(s[2 * 33], s[3 * 33]); o.z = pk2(s[4 * 33], s[5 * 33]); o.w = pk2(s[6 * 33], s[7 * 33]);
        *(u32x4*)(WT + (size_t)(row_off + n0 + n) * ldw + koff + k0 + 8 * c) = o; }
    LDS_WAIT(); asm volatile("" ::: "memory");
}

struct Args { const float* in[15]; float* out; unsigned char* ws; int ph_lo, ph_hi, li, pad; };
typedef const __attribute__((address_space(4))) char* kptr_t;
__device__ __forceinline__ kptr_t kbase() { kptr_t kp = (kptr_t)__builtin_amdgcn_kernarg_segment_ptr(); asm volatile("" : "+s"(kp)); return kp; }
__device__ __forceinline__ const float* arg_in(int i) { return *(const float* const __attribute__((address_space(4)))*)(kbase() + 8 * i); }
__device__ __forceinline__ float* arg_out() { return *(float* const __attribute__((address_space(4)))*)(kbase() + 120); }
__device__ __forceinline__ unsigned char* arg_ws() { return *(unsigned char* const __attribute__((address_space(4)))*)(kbase() + 128); }
__device__ __forceinline__ int arg_lo() { return *(const __attribute__((address_space(4))) int*)(kbase() + 136); }
__device__ __forceinline__ int arg_hi() { return *(const __attribute__((address_space(4))) int*)(kbase() + 140); }
__device__ __forceinline__ int arg_li() { return *(const __attribute__((address_space(4))) int*)(kbase() + 144); }
static_assert(sizeof(Args) == 152, "Args layout");

constexpr int NWAVES = 8;
constexpr int PH_PER_LAYER = 8, N_PHASES = 1 + DEPTH * PH_PER_LAYER;
#define PH_COMMON() int tid_ = threadIdx.x; asm volatile("" : "+v"(tid_)); const int tid = tid_, lane = tid & 63, wave = __builtin_amdgcn_readfirstlane(tid >> 6); int bx_ = blockIdx.x; asm volatile("" : "+s"(bx_)); const int G = gridDim.x, bx = bx_; \
    const int vcu = (G % 8 == 0) ? (bx % 8) * (G / 8) + bx / 8 : bx; const int gw = vcu * NWAVES + wave, NGW = G * NWAVES; unsigned char* ws = arg_ws(); \
    (void)tid; (void)lane; (void)wave; (void)vcu; (void)gw; (void)NGW; (void)ws

__device__ __forceinline__ void convert_weights(int l, LAS unsigned char* lds) {
    PH_COMMON();
    LAS float* scr = (LAS float*)(lds + wave * 16384);
    const float* w_in = arg_in(1) + (size_t)l * D_MODEL * PROJ;
    const float* w_upa = arg_in(3) + (size_t)l * WA * D_MODEL;
    const float* w_upb = arg_in(4) + (size_t)l * WA * D_MODEL;
    const float* w_out = arg_in(5) + (size_t)l * D_MODEL * D_MODEL;
    const float* w_gate = arg_in(10) + (size_t)l * NE * D_MODEL * FE;
    const float* w_up = arg_in(11) + (size_t)l * NE * D_MODEL * FE;
    const float* w_down = arg_in(12) + (size_t)l * NE * FE * D_MODEL;
    constexpr int I_IN = (D_MODEL / 64) * (PROJ / 32), I_UP = (WA / 64) * (D_MODEL / 32), I_OUT = (D_MODEL / 64) * (D_MODEL / 32);
    constexpr int I_G = (D_MODEL / 64) * (FE / 32), I_D = (FE / 64) * (D_MODEL / 32);
    constexpr int NITEMS = I_IN + 2 * I_UP + I_OUT + NE * (2 * I_G + I_D);
    for (int it = gw; it < NITEMS; it += NGW) {
        int r = it;
        if (r < I_IN) { const int n0 = 32 * (r % (PROJ / 32)); int row_off = 0;
            if (n0 >= 4096) { const int c0 = n0 - 4096; row_off = 3072 + (c0 / 128) * 256 + 128 + (c0 % 128) - n0; }
            else if (n0 >= 3072) { const int c0 = n0 - 3072; row_off = 3072 + (c0 / 128) * 256 + (c0 % 128) - n0; }
            if (IN_FP8 && WIDE_EPI && n0 >= 3072) { const int ty = n0 >= 4096, c0 = n0 - (ty ? 4096 : 3072);
                transpose_item_f8(w_in, D_MODEL, PROJ, ws + WS_WIN, 0, scr, r, lane, (float)(1 << F8S_W), 0, 0, 3072 + (c0 / 128) * 256, c0 % 128, ty); }
            else if (IN_FP8) transpose_item_f8(w_in, D_MODEL, PROJ, ws + WS_WIN, row_off, scr, r, lane, (float)(1 << F8S_W));
            else transpose_item(w_in, D_MODEL, PROJ, (bf16_t*)(ws + WS_WIN), row_off, scr, r, lane);
            continue; } r -= I_IN;
        if (r < I_UP) { if (MIX_FP8) transpose_item_f8(w_upa, WA, D_MODEL, ws + WS_WUP, 0, scr, r, lane, (float)(1 << F8S_W), D_MODEL, 0); else transpose_item(w_upa, WA, D_MODEL, (bf16_t*)(ws + WS_WUP), 0, scr, r, lane, D_MODEL, 0); continue; } r -= I_UP;
        if (r < I_UP) { if (MIX_FP8) transpose_item_f8(w_upb, WA, D_MODEL, ws + WS_WUP, 0, scr, r, lane, (float)(1 << F8S_W), D_MODEL, WA); else transpose_item(w_upb, WA, D_MODEL, (bf16_t*)(ws + WS_WUP), 0, scr, r, lane, D_MODEL, WA); continue; } r -= I_UP;
        if (r < I_OUT) { if (MIX_FP8) transpose_item_f8(w_out, D_MODEL, D_MODEL, ws + WS_WOUT, 0, scr, r, lane, (float)(1 << F8S_W)); else transpose_item(w_out, D_MODEL, D_MODEL, (bf16_t*)(ws + WS_WOUT), 0, scr, r, lane); continue; } r -= I_OUT;
        const int e = r / (2 * I_G + I_D); r -= e * (2 * I_G + I_D);
        if (r < 2 * I_G) { const int up = r >= I_G; if (up) r -= I_G;
            const int nb = r % (FE / 32), n0 = nb * 32;
            const int row_off = e * 1024 + (n0 / 128) * 128 + (up ? 128 : 0);
            if (MOE_FP8 && WIDE_EPI) transpose_item_f8((up ? w_up : w_gate) + (size_t)e * D_MODEL * FE, D_MODEL, FE, ws + WS_WGU, 0, scr, r, lane, (float)(1 << F8S_W), 0, 0, e * 1024 + (n0 / 128) * 256, n0 % 128, up);
            else if (MOE_FP8) transpose_item_f8((up ? w_up : w_gate) + (size_t)e * D_MODEL * FE, D_MODEL, FE, ws + WS_WGU, row_off, scr, r, lane, (float)(1 << F8S_W));
            else transpose_item((up ? w_up : w_gate) + (size_t)e * D_MODEL * FE, D_MODEL, FE, (bf16_t*)(ws + WS_WGU), row_off, scr, r, lane);
            continue; }
        r -= 2 * I_G;
        if (MOE_FP8) transpose_item_f8(w_down + (size_t)e * FE * D_MODEL, FE, D_MODEL, ws + WS_WD, e * 1024, scr, r, lane, (float)(1 << F8S_W));
        else transpose_item(w_down + (size_t)e * FE * D_MODEL, FE, D_MODEL, (bf16_t*)(ws + WS_WD), e * 1024, scr, r, lane);
    }
}

__device__ __forceinline__ void phase0(LAS unsigned char* lds) {
    convert_weights(0, lds);
    PH_COMMON();
    const float* x_in = arg_in(0); bf16_t* XB = (bf16_t*)(ws + WS_XB);
    {
        const float* w_router = arg_in(8); const float* b_router = arg_in(9);
        for (int p = gw * 64 + lane; p < DEPTH * 2048; p += NGW * 64) { const int ll = p >> 11, q = p & 2047, kt = q >> 6, ln = q & 63, n = ln & 15, c0 = 32 * kt + 8 * (ln >> 4);
            const float* g1 = arg_in(6) + (size_t)ll * D_MODEL; unsigned hw[4], lw[4];
#pragma unroll
            for (int j = 0; j < 4; ++j) { const float w0 = g1[c0 + 2 * j] * w_router[(c0 + 2 * j) * 16 + n], w1 = g1[c0 + 2 * j + 1] * w_router[(c0 + 2 * j + 1) * 16 + n];
                hw[j] = cvt_pk_bf16(w0, w1); lw[j] = cvt_pk_bf16(w0 - bf_lo(hw[j]), w1 - bf_hi(hw[j])); }
            unsigned char* tb = ws + WS_RTAB + (size_t)ll * RTAB_STRIDE;
            *(u32x4*)(tb + q * 16) = (u32x4){hw[0], hw[1], hw[2], hw[3]}; *(u32x4*)(tb + 32768 + q * 16) = (u32x4){lw[0], lw[1], lw[2], lw[3]}; }
        for (int idx = gw; idx < DEPTH * 32; idx += NGW) { const int ll = idx >> 5, wh = (idx >> 4) & 1, e = idx & 15;
            const float* vv = (wh ? arg_in(7) : arg_in(6)) + (size_t)ll * D_MODEL; float s = 0.f;
            for (int c = lane; c < D_MODEL; c += 64) s += vv[c] * w_router[c * 16 + e];
            s = wave_sum(s); if (wh) s += b_router[e];
            if (lane == 0) ((float*)(ws + WS_RTAB + (size_t)ll * RTAB_STRIDE + 65536))[wh * 16 + e] = s; }
    }
    for (int mb = gw; mb < T; mb += 4 * NGW) {
        f32x4 xv[4][4];
#pragma unroll
        for (int r = 0; r < 4; ++r) { const int m = mb + r * NGW; if (m < T) { const f32x4* xr = (const f32x4*)(x_in + (size_t)m * D_MODEL) + lane;
#pragma unroll
            for (int j = 0; j < 4; ++j) xv[r][j] = xr[64 * j]; } }
#pragma unroll
        for (int r = 0; r < 4; ++r) { const int m = mb + r * NGW; if (m < T) { u32x2* o8 = (u32x2*)(XB + (size_t)m * D_MODEL) + lane;
#pragma unroll
            for (int j = 0; j < 4; ++j) { const f32x4 v = xv[r][j]; if (!IN_FP8) { u32x2 w; w.x = cvt_pk_bf16(v.x, v.y); w.y = cvt_pk_bf16(v.z, v.w); o8[64 * j] = w; }
                if (IN_FP8) { constexpr float sx = (float)(1 << F8S_X); *((unsigned*)(ws + WS_XA8 + (size_t)m * D_MODEL) + lane + 64 * j) = pk4_fp8(v.x * sx, v.y * sx, v.z * sx, v.w * sx); } } } }
    }
}
__device__ __forceinline__ void phase1(LAS unsigned char* lds) {
    PH_COMMON();
    pg8::SchedPlain S; S.o.init(T / 256, PROJ / 256, G, bx); S.A = (const char*)(ws + (IN_FP8 ? WS_XA8 : WS_XB)); S.B = (const char*)(ws + WS_WIN); S.tstep = (size_t)256 * D_MODEL * (IN_FP8 ? 1 : 2);
    EpiInProj E{ws};
    if (IN_FP8) pg8::gemm_phase<EpiInProj, pg8::SchedPlain, false, false, false, true>(lds, D_MODEL / 2, S, E);
    else pg8::gemm_phase<EpiInProj, pg8::SchedPlain, false, true>(lds, D_MODEL, S, E);
}
__device__ __forceinline__ void phase2(LAS unsigned char* lds, int l) {
    PH_COMMON();
    const int bh = vcu >> 2, s = vcu & 3; const int b = bh >> 3, h = bh & 7;
    if (G != 256) return;
    const float* bias_h = arg_in(2) + ((size_t)l * NH + h) * N_REL;
    bf16_t* QAp = (bf16_t*)(ws + WS_QQ); bf16_t* KAp = (bf16_t*)(ws + WS_KA); bf16_t* VAp = (bf16_t*)(ws + WS_VA);
    bf16_t* QBp = (bf16_t*)(ws + WS_QQ) + WA; bf16_t* KBp = (bf16_t*)(ws + WS_KB); bf16_t* VBp = (bf16_t*)(ws + WS_VB);
    { LAS float* tab = (LAS float*)(lds + att::LDS_TAB); if (tid < 256) { int rel = tid - 64; rel = rel < -128 ? -128 : (rel > 128 ? 128 : rel); tab[tid] = bias_h[rel + 128] * LOG2E; } }
    const float bfar = bias_h[256] * LOG2E;
    __syncthreads();
    PBS_BEGIN(6, lds);
    for (int i = 0; i < 4; ++i) { const int u = 4 * s + 3 - i;
        if (u >= 2) { if (i > 0) att::attn_a_unit_fast<true>(b, h, u, QAp, KAp, VAp, QAp, bfar, (LAS char*)lds); else att::attn_a_unit_fast<false>(b, h, u, QAp, KAp, VAp, QAp, bfar, (LAS char*)lds); }
        else att::attn_a_unit(b, h, u, QAp, KAp, VAp, QAp, bfar, (LAS char*)lds); }
    PBS_END(6, lds); PBS_BEGIN(7, lds);
    { int rk0 = 1, rk1 = 0, rv0 = 1, rv1 = 0;
      for (int i = 0; i < 4; ++i) { const int u = 4 * s + 3 - i;
        if (u >= 2) { const int S = att::attn_b_unit_fast(b, h, u, QBp, KBp, VBp, QBp, (LAS char*)lds, rk0, rk1, rv0, rv1); const int tbp = 4 * u;
            rk0 = tbp - S - 4 > 0 ? tbp - S - 4 : 0; rk1 = rk0 + 7; rv0 = tbp - S - 2 > 0 ? tbp - S - 2 : 0; rv1 = (rv0 + 7 < tbp + 3) ? rv0 + 7 : tbp + 3; }
        else att::attn_b_unit(b, h, u, QBp, KBp, VBp, QBp, (LAS char*)lds); } }
    PBS_END(7, lds);
}
__device__ __forceinline__ void phase3(LAS unsigned char* lds) {
    PH_COMMON();
    pg8::SchedTwo S; S.o.init(T / 256, D_MODEL / 256, G, bx); S.A = (const char*)(ws + (MIX_FP8 ? WS_O8 : WS_QQ)); S.B = (const char*)(ws + WS_WUP); S.tstep = (size_t)256 * D_MODEL * (MIX_FP8 ? 1 : 2); S.hb = (size_t)WA * (MIX_FP8 ? 1 : 2);
    EpiMerge E{(const bf16_t*)(ws + WS_GA), (const bf16_t*)(ws + WS_GB), (bf16_t*)(ws + WS_MERGED)};
    if (MIX_FP8) pg8::gemm_phase<EpiMerge, pg8::SchedTwo, false, true, true, true>(lds, WA / 2, S, E, D_MODEL / 2);
    else pg8::gemm_phase<EpiMerge, pg8::SchedTwo, false, true, true>(lds, WA, S, E, D_MODEL);
}
__device__ __forceinline__ void phase4(LAS unsigned char* lds, int l) {
    PH_COMMON();
    pg8::SchedPlain S; S.o.init(T / 256, D_MODEL / 256, G, bx); S.A = (const char*)(ws + WS_MERGED); S.B = (const char*)(ws + WS_WOUT); S.tstep = (size_t)256 * D_MODEL * (MIX_FP8 ? 1 : 2);
    EpiOut E{(l == 0) ? arg_in(0) : (const float*)nullptr, (const bf16_t*)(ws + WS_XB), (bf16_t*)(ws + WS_PRE)};
    if (MIX_FP8) pg8::gemm_phase<EpiOut, pg8::SchedPlain, false, true, false, true>(lds, D_MODEL / 2, S, E);
    else pg8::gemm_phase<EpiOut, pg8::SchedPlain, false, true>(lds, D_MODEL, S, E);
}
#define dppf(v, ctrl) __builtin_bit_cast(float, __builtin_amdgcn_update_dpp(__builtin_bit_cast(int, (float)(v)), __builtin_bit_cast(int, (float)(v)), ctrl, 0xf, 0xf, false))
#define dppi(v, ctrl) __builtin_amdgcn_update_dpp((int)(v), (int)(v), ctrl, 0xf, 0xf, false)
__device__ __forceinline__ void phase5(LAS unsigned char* lds, int l) {
    static_assert(USE_F16 == 1, "the MFMA router path takes the pre-LN tensor as IEEE half");
    PH_COMMON();
    const float* g1 = arg_in(6) + (size_t)l * D_MODEL; const float* b1 = arg_in(7) + (size_t)l * D_MODEL;
    bf16_t* XB = (bf16_t*)(ws + WS_XB); const bf16_t* PRE = (const bf16_t*)(ws + WS_PRE);
    int* LIST = (int*)(ws + WS_LIST); f32x2* RECW = (f32x2*)(ws + WS_RECW);
    unsigned* gcnt = (unsigned*)(ws + WS_CTL) + CW_CNT + 64 * l;
    PBS_BEGIN(1, lds);
    LAS float* S23 = (LAS float*)(lds + 69632); LAS f32x2* rstat = (LAS f32x2*)(lds + 70656) + wave * 16;
    LAS unsigned* lcnt = (LAS unsigned*)(lds + 81920);
    LAS int* lrec = (LAS int*)(lds + 81920 + 256);
    { const unsigned char* tb = ws + WS_RTAB + (size_t)l * RTAB_STRIDE;
#pragma unroll
        for (int i = 0; i < 8; ++i) __builtin_amdgcn_global_load_lds((const unsigned*)(tb + ((size_t)((i * NWAVES + wave) * 64 + lane)) * 16), (LAS unsigned*)(lds + (i * NWAVES + wave) * 1024), 16, 0, 0);
        if (tid < 32) { S23[tid] = ((const float*)(tb + 65536))[tid]; lcnt[tid] = 0u; } }
    PBS_END(1, lds); PBS_BEGIN(2, lds);
    f32x4 gg[4], bb[4];
#pragma unroll
    for (int j = 0; j < 4; ++j) { gg[j] = *((const f32x4*)g1 + lane + 64 * j); bb[j] = *((const f32x4*)b1 + lane + 64 * j); }
    int krow = 0;
    u32x2 nv[4];
    { const u32x2* pr = (const u32x2*)(PRE + (size_t)gw * D_MODEL) + lane;
#pragma unroll
      for (int j = 0; j < 4; ++j) nv[j] = pr[64 * j]; }
    for (int m = gw; m < T; m += NGW, ++krow) {
        f32x4 v[4]; float s = 0.f;
#pragma unroll
        for (int j = 0; j < 4; ++j) { v[j] = (f32x4){bf_lo(nv[j].x), bf_hi(nv[j].x), bf_lo(nv[j].y), bf_hi(nv[j].y)}; s += (v[j].x + v[j].y) + (v[j].z + v[j].w); }
        if (m + NGW < T) { const u32x2* pr = (const u32x2*)(PRE + (size_t)(m + NGW) * D_MODEL) + lane;
#pragma unroll
            for (int j = 0; j < 4; ++j) nv[j] = pr[64 * j]; }
        const float mean = wave_sum(s) * (1.f / D_MODEL); float s2 = 0.f;
#pragma unroll
        for (int j = 0; j < 4; ++j) { v[j] = v[j] - mean; s2 += (v[j].x * v[j].x + v[j].y * v[j].y) + (v[j].z * v[j].z + v[j].w * v[j].w); }
        const float rstd = 1.f / sqrtf(wave_sum(s2) * (1.f / D_MODEL) + LN_EPS);
        if (lane == 0) { rstat[krow] = (f32x2){mean, rstd}; ((f32x2*)(ws + WS_STAT))[m] = (f32x2){mean, rstd}; }
#pragma unroll
        for (int j = 0; j < 4; ++j) { v[j] = v[j] * rstd * gg[j] + bb[j];
            if (!MOE_FP8) { u32x2 w; w.x = cvt_pk_bf16(v[j].x, v[j].y); w.y = cvt_pk_bf16(v[j].z, v[j].w); *((u32x2*)(XB + (size_t)m * D_MODEL) + lane + 64 * j) = w; }
            if (MOE_FP8) { constexpr float sx = (float)(1 << F8S_X); *((unsigned*)(ws + WS_XB8 + (size_t)m * D_MODEL) + lane + 64 * j) = pk4_fp8(v[j].x * sx, v[j].y * sx, v[j].z * sx, v[j].w * sx); } }
    }
    asm volatile("s_waitcnt vmcnt(0)" ::: "memory"); __syncthreads();
    {
        const int n = lane & 15, kg = lane >> 4;
        const bf16_t* arow = PRE + (size_t)(gw + n * NGW) * D_MODEL + 8 * kg;
        f32x4 acc = (f32x4){0.f, 0.f, 0.f, 0.f};
#pragma unroll 4
        for (int kt = 0; kt < 32; ++kt) { const bf16x8 a = *(const bf16x8*)(arow + 32 * kt);
            const bf16x8 bh = *(const LAS bf16x8*)(lds + (kt * 64 + lane) * 16), bl = *(const LAS bf16x8*)(lds + 32768 + (kt * 64 + lane) * 16);
            acc = MFMA16(a, bh, acc); acc = MFMA16(a, bl, acc); }
        const float s2n = S23[n], s3n = S23[16 + n];
#pragma unroll
        for (int i = 0; i < 4; ++i) {
            const int kr = 4 * kg + i; const f32x2 st = rstat[kr];
            const float v = st.y * (acc[i] - st.x * s2n) + s3n;
            float mx = v; mx = fmaxf(mx, dppf(mx, 0xB1)); mx = fmaxf(mx, dppf(mx, 0x4E)); mx = fmaxf(mx, dppf(mx, 0x141)); mx = fmaxf(mx, dppf(mx, 0x140));
            int best = (v == mx) ? n : 16; best = min(best, dppi(best, 0xB1)); best = min(best, dppi(best, 0x4E)); best = min(best, dppi(best, 0x141)); best = min(best, dppi(best, 0x140));
            const float u = (n == best) ? -3.0e38f : v;
            float m2 = u; m2 = fmaxf(m2, dppf(m2, 0xB1)); m2 = fmaxf(m2, dppf(m2, 0x4E));
            int e2 = (u == m2) ? n : 16; e2 = min(e2, dppi(e2, 0xB1)); e2 = min(e2, dppi(e2, 0x4E));
            if (n == best) { const int m = gw + kr * NGW;
                const float w1 = fast_rcp(1.0f + fast_exp2((m2 - v) * LOG2E)), w2 = 1.0f - w1;
                RECW[m] = (f32x2){w1, w2};
                const int lp1 = (int)__hip_atomic_fetch_add(lcnt + best, 1u, __ATOMIC_RELAXED, __HIP_MEMORY_SCOPE_WORKGROUP);
                const int lp2 = (int)__hip_atomic_fetch_add(lcnt + e2, 1u, __ATOMIC_RELAXED, __HIP_MEMORY_SCOPE_WORKGROUP);
                LAS int* rp = lrec + (wave * 16 + kr) * 4; rp[0] = best; rp[1] = lp1; rp[2] = e2; rp[3] = lp2; }
        }
    }
    PBS_END(2, lds);
    __syncthreads();
    PBS_BEGIN(3, lds);
    if (tid < 16) { const unsigned n = lcnt[tid]; lcnt[16 + tid] = n ? __hip_atomic_fetch_add(gcnt + tid, n, __ATOMIC_RELAXED, __HIP_MEMORY_SCOPE_AGENT) : 0u; }
    __syncthreads();
    if (lane < 16 && gw + lane * NGW < T) { const int m = gw + lane * NGW; const LAS int* rp = lrec + (wave * 16 + lane) * 4;
        LIST[(size_t)rp[0] * T + lcnt[16 + rp[0]] + rp[1]] = m * 2; LIST[(size_t)rp[2] * T + lcnt[16 + rp[2]] + rp[3]] = m * 2 + 1; }
    __syncthreads();
    PBS_END(3, lds);
}
__device__ __forceinline__ int moe_units(LAS unsigned char* lds, int l) {
    PH_COMMON();
    LAS int* utab = (LAS int*)(lds + UTAB_OFF);
    unsigned* gcnt = (unsigned*)(ws + WS_CTL) + CW_CNT + 64 * l;
    LAS int* ts = utab + 128; LAS int* ncnt = utab + 160;
    __syncthreads();
    if (tid < 16) ncnt[tid] = (int)__hip_atomic_load(gcnt + tid, __ATOMIC_RELAXED, __HIP_MEMORY_SCOPE_AGENT);
    __syncthreads();
    if (tid == 0) { int acc_t = 0;
        for (int e = 0; e < 16; ++e) { ts[e] = acc_t; acc_t += (ncnt[e] + 255) / 256; }
        ts[16] = acc_t;
        const int nunits = acc_t * 4; utab[192] = nunits > bx ? ((nunits - bx + G - 1) / G < 6 ? (nunits - bx + G - 1) / G : 6) : 0; }
    __syncthreads();
    if (tid < 6) { const int nunits = ts[16] * 4; const long L = (long)tid * G + bx;
        if (L < nunits) {
            int U = (int)L; { const int q = nunits / 8, r = nunits % 8, xcd = U % 8, off = U / 8; U = (xcd < r ? xcd * (q + 1) : r * (q + 1) + (xcd - r) * q) + off; }
            const int tile = U >> 2, pn = U & 3; int e = 0; while (ts[e + 1] <= tile) ++e;
            const int mt = tile - ts[e]; const int n = ncnt[e]; const int nv = (n - 256 * mt) < 256 ? (n - 256 * mt) : 256;
            utab[tid * 5 + 0] = e; utab[tid * 5 + 1] = pn; utab[tid * 5 + 2] = mt * 256; utab[tid * 5 + 3] = nv; utab[tid * 5 + 4] = tile * 256; } }
    __syncthreads();
    return utab[192];
}
__device__ __forceinline__ void phase6(LAS unsigned char* lds, int l) {
    const int nun = moe_units(lds, l);
    PH_COMMON();
    constexpr int EB = MOE_FP8 ? 1 : 2;
    pg8::SchedMoe S; S.utab = (LAS int*)(lds + UTAB_OFF); S.nunits = nun; S.Abase = (const char*)(ws + (MOE_FP8 ? WS_XB8 : WS_XB)); S.Bbase = (const char*)(ws + WS_WGU); S.a_row_bytes = 0;
    S.b_exp_bytes = (size_t)1024 * D_MODEL * EB; S.b_tile_bytes = (size_t)256 * D_MODEL * EB; S.list = (const int*)(ws + WS_LIST); S.gather_k2 = D_MODEL * EB;
    EpiGU E{(bf16_t*)(ws + WS_H)};
    if (MOE_FP8) pg8::gemm_phase<EpiGU, pg8::SchedMoe, true, true, false, true>(lds, D_MODEL / 2, S, E, 0, 127 - F8S_W, 127 - F8S_X);
    else pg8::gemm_phase<EpiGU, pg8::SchedMoe, true, true>(lds, D_MODEL, S, E);
}
__device__ __forceinline__ void phase7(LAS unsigned char* lds, int l) {
    const int nun = moe_units(lds, l);
    PH_COMMON();
    constexpr int EB = MOE_FP8 ? 1 : 2;
    pg8::SchedMoe S; S.utab = (LAS int*)(lds + UTAB_OFF); S.nunits = nun; S.Abase = (const char*)(ws + WS_H); S.Bbase = (const char*)(ws + WS_WD); S.a_row_bytes = (size_t)FE * EB;
    S.b_exp_bytes = (size_t)1024 * FE * EB; S.b_tile_bytes = (size_t)256 * FE * EB; S.list = (const int*)(ws + WS_LIST); S.gather_k2 = 0;
    LAS int* ent = (LAS int*)(lds + LDSCTL_OFF + 8192);
    { const LAS int* ut = (const LAS int*)(lds + UTAB_OFF); const int* LISTp = (const int*)(ws + WS_LIST); const int nst = nun < 6 ? nun : 6;
        for (int i = tid; i < nst * 256; i += NWAVES * 64) { const int un = i >> 8, r = i & 255; const int e = ut[un * 5 + 0], lo_ = ut[un * 5 + 2], nv = ut[un * 5 + 3];
            ent[i] = (r < nv) ? LISTp[(size_t)e * T + lo_ + r] : -1; } }
    __syncthreads();
    EpiDown E{(bf16_t*)(ws + WS_Y), ent};
    if (MOE_FP8) pg8::gemm_phase<EpiDown, pg8::SchedMoe, false, true, false, true>(lds, FE / 2, S, E, 0, 127 - F8S_W, 127 - F8S_H);
    else pg8::gemm_phase<EpiDown, pg8::SchedMoe, false, true>(lds, FE, S, E);
}
__device__ __forceinline__ void phase8(LAS unsigned char* lds, int l) {
    PH_COMMON();
    const float* g2 = arg_in(13) + (size_t)l * D_MODEL; const float* b2 = arg_in(14) + (size_t)l * D_MODEL;
    float* xout = arg_out(); bf16_t* XB = (bf16_t*)(ws + WS_XB); const bf16_t* Y = (const bf16_t*)(ws + WS_Y); const f32x2* RECW = (const f32x2*)(ws + WS_RECW);
    PBS_BEGIN(4, lds);
    u32x2 nx[4], na[4], nc[4]; f32x2 nw, nst;
    static_assert(Y_FP8 == 1 && MOE_FP8 == 1, "the combine phase reads the pre-LN tensor + row statistics (e4m3 expert outputs only)");
    const bf16_t* PRE = (const bf16_t*)(ws + WS_PRE); const f32x2* STAT = (const f32x2*)(ws + WS_STAT);
    const float* g1 = arg_in(6) + (size_t)l * D_MODEL; const float* b1 = arg_in(7) + (size_t)l * D_MODEL;
    f32x4 g1v[4], b1v[4];
#pragma unroll
    for (int j = 0; j < 4; ++j) { g1v[j] = *((const f32x4*)g1 + lane + 64 * j); b1v[j] = *((const f32x4*)b1 + lane + 64 * j); }
#define P8_LOAD(mm) do { nw = RECW[mm]; nst = STAT[mm]; const u32x2* xr = (const u32x2*)(PRE + (size_t)(mm) * D_MODEL) + lane; \
        const u32x2* y0 = (const u32x2*)(Y + (size_t)(2 * (mm)) * D_MODEL) + lane; const u32x2* y1 = (const u32x2*)(Y + (size_t)(2 * (mm) + 1) * D_MODEL) + lane; \
        const unsigned* z0 = (const unsigned*)((const unsigned char*)Y + (size_t)(2 * (mm)) * D_MODEL) + lane; const unsigned* z1 = (const unsigned*)((const unsigned char*)Y + (size_t)(2 * (mm) + 1) * D_MODEL) + lane; \
        _Pragma("unroll") for (int j = 0; j < 4; ++j) { nx[j] = xr[64 * j]; if (Y_FP8) { na[j].x = z0[64 * j]; nc[j].x = z1[64 * j]; na[j].y = 0u; nc[j].y = 0u; } else { na[j] = y0[64 * j]; nc[j] = y1[64 * j]; } } } while (0)
    P8_LOAD(gw);
    const bool lastl = (l + 1 == DEPTH);
    f32x4 gg[4], bb[4];
#pragma unroll
    for (int j = 0; j < 4; ++j) { gg[j] = *((const f32x4*)g2 + lane + 64 * j); bb[j] = *((const f32x4*)b2 + lane + 64 * j); }
    for (int m = gw; m < T; m += NGW) {
        const f32x2 wv = nw, st = nst; u32x2 cx[4], ca[4], cc[4];
#pragma unroll
        for (int j = 0; j < 4; ++j) { cx[j] = nx[j]; ca[j] = na[j]; cc[j] = nc[j]; }
        if (m + NGW < T) P8_LOAD(m + NGW);
        f32x4 v[4]; float s = 0.f;
#pragma unroll
        for (int j = 0; j < 4; ++j) { const u32x2 xw = cx[j]; const u32x2 a = ca[j], c = cc[j];
            if (Y_FP8) { constexpr float iy = 1.f / (float)(1 << F8S_Y); const float w0 = wv.x * iy, w1 = wv.y * iy;
                const auto a01 = __builtin_amdgcn_cvt_pk_f32_fp8(a.x, false), a23 = __builtin_amdgcn_cvt_pk_f32_fp8(a.x, true), c01 = __builtin_amdgcn_cvt_pk_f32_fp8(c.x, false), c23 = __builtin_amdgcn_cvt_pk_f32_fp8(c.x, true);
                const f32x4 x1 = ((f32x4){bf_lo(xw.x), bf_hi(xw.x), bf_lo(xw.y), bf_hi(xw.y)} - st.x) * st.y * g1v[j] + b1v[j];
                v[j].x = x1.x * ALPHA + w0 * a01[0] + w1 * c01[0]; v[j].y = x1.y * ALPHA + w0 * a01[1] + w1 * c01[1];
                v[j].z = x1.z * ALPHA + w0 * a23[0] + w1 * c23[0]; v[j].w = x1.w * ALPHA + w0 * a23[1] + w1 * c23[1];
                s += (v[j].x + v[j].y) + (v[j].z + v[j].w); continue; }
            v[j].x = bf_lo(xw.x) * ALPHA + wv.x * bf_lo(a.x) + wv.y * bf_lo(c.x); v[j].y = bf_hi(xw.x) * ALPHA + wv.x * bf_hi(a.x) + wv.y * bf_hi(c.x);
            v[j].z = bf_lo(xw.y) * ALPHA + wv.x * bf_lo(a.y) + wv.y * bf_lo(c.y); v[j].w = bf_hi(xw.y) * ALPHA + wv.x * bf_hi(a.y) + wv.y * bf_hi(c.y);
            s += (v[j].x + v[j].y) + (v[j].z + v[j].w); }
        const float mean = wave_sum(s) * (1.f / D_MODEL); float s2 = 0.f;
#pragma unroll
        for (int j = 0; j < 4; ++j) { v[j] = v[j] - mean; s2 += (v[j].x * v[j].x + v[j].y * v[j].y) + (v[j].z * v[j].z + v[j].w * v[j].w); }
        const float rstd = 1.f / sqrtf(wave_sum(s2) * (1.f / D_MODEL) + LN_EPS);
#pragma unroll
        for (int j = 0; j < 4; ++j) { v[j] = v[j] * rstd * gg[j] + bb[j];
            if (lastl) *((f32x4*)(xout + (size_t)m * D_MODEL) + lane + 64 * j) = v[j];
            else { u32x2 w; w.x = cvt_pk_bf16(v[j].x, v[j].y); w.y = cvt_pk_bf16(v[j].z, v[j].w); *((u32x2*)(XB + (size_t)m * D_MODEL) + lane + 64 * j) = w;
                if (IN_FP8) { constexpr float sx = (float)(1 << F8S_X); *((unsigned*)(ws + WS_XA8 + (size_t)m * D_MODEL) + lane + 64 * j) = pk4_fp8(v[j].x * sx, v[j].y * sx, v[j].z * sx, v[j].w * sx); } } }
    }
#undef P8_LOAD
    PBS_END(4, lds);
    PBS_BEGIN(5, lds);
    if (l + 1 < DEPTH) { __syncthreads(); convert_weights(l + 1, lds); }
    PBS_END(5, lds);
}

__global__ void __launch_bounds__(NWAVES * 64, 2) fwd(Args args) {
    extern __shared__ __attribute__((aligned(16))) unsigned char lds_raw[];
    LAS unsigned char* lds = (LAS unsigned char*)lds_raw;
    volatile LAS unsigned* MISC = (volatile LAS unsigned*)(lds + MISC_OFF);
    for (int u = threadIdx.x; u < (LDS_BYTES - LDSCTL_OFF) / 4; u += NWAVES * 64) ((LAS unsigned*)(lds + LDSCTL_OFF))[u] = 0u;
    __syncthreads();
    XcdBarrier bar; bar.bar = (unsigned*)(arg_ws() + WS_CTL) + CW_BAR + arg_li() * XCD_BAR_WORDS; bar.x = 0; bar.st = nullptr;
    if (!MK_MULTI) bar = xcd_barrier_post((unsigned*)(arg_ws() + WS_CTL) + CW_BAR + arg_li() * XCD_BAR_WORDS, MISC + 8);
    const int lo = arg_lo(), hi = arg_hi();
#define IN(k) (lo <= (k) && (k) < hi)
#define SEAM(k) do { if (!MK_MULTI && IN(k) && IN((k) + 1)) { XcdBarrier b2_ = bar; asm volatile("" : "+s"(b2_.bar)); xcd_barrier(b2_); } } while (0)
    unsigned long long tacc = 0ull, tst = 0ull; (void)tacc; (void)tst;
#define PB_BEGIN(k) do { if (PROBE_PH == (k)) tst = __builtin_amdgcn_s_memrealtime(); } while (0)
#define PB_END(k) do { if (PROBE_PH == (k)) tacc += __builtin_amdgcn_s_memrealtime() - tst; } while (0)
    PB_BEGIN(0);
    if (HAS(0) && IN(0)) phase0(lds);
    SEAM(0);
    PB_END(0);
    for (int l = 0; l < DEPTH; ++l) {
        const int pb = 1 + l * PH_PER_LAYER;
        PB_BEGIN(1);
        if (HAS(1) && IN(pb + 0)) phase1(lds);
        SEAM(pb + 0);
        PB_END(1);
        PB_BEGIN(2);
        if (HAS(2) && IN(pb + 1)) phase2(lds, l);
        SEAM(pb + 1);
        PB_END(2);
        PB_BEGIN(3);
        if (HAS(3) && IN(pb + 2)) phase3(lds);
        SEAM(pb + 2);
        PB_END(3);
        PB_BEGIN(4);
        if (HAS(4) && IN(pb + 3)) phase4(lds, l);
        SEAM(pb + 3);
        PB_END(4);
        PB_BEGIN(5);
        if (HAS(5) && IN(pb + 4)) phase5(lds, l);
        SEAM(pb + 4);
        PB_END(5);
        PB_BEGIN(6);
        if (HAS(6) && IN(pb + 5)) phase6(lds, l);
        SEAM(pb + 5);
        PB_END(6);
        PB_BEGIN(7);
        if (HAS(7) && IN(pb + 6)) phase7(lds, l);
        SEAM(pb + 6);
        PB_END(7);
        PB_BEGIN(8);
        if (HAS(8) && IN(pb + 7)) phase8(lds, l);
        SEAM(pb + 7);
        PB_END(8);
    }
    if (PROBE_PH >= 100) tacc = *(volatile LAS unsigned long long*)(lds + MISC_OFF + 64);
    if (PROBE_PH >= 0 && blockIdx.x == 0) { const unsigned long long t0 = __builtin_amdgcn_s_memrealtime(); while (__builtin_amdgcn_s_memrealtime() - t0 < tacc * PROBE_MULT) __builtin_amdgcn_s_sleep(8); }
#undef IN
#undef SEAM
    (void)args;
}


#ifndef DBG_PROBE
#define DBG_PROBE 0
#endif
#ifndef DBG_LAYER
#define DBG_LAYER 0
#endif
#ifndef DBG_GAIN
#define DBG_GAIN 1.0f
#endif
#if DBG_PROBE
constexpr size_t WS_DXS = 528 * MiB, WS_DKV = 544 * MiB, WS_DST = 610 * MiB;
__device__ __forceinline__ int dbg_tok(int i) { const int sp[8] = {0, 1, 63, 64, 65, 575, 576, 4095}; return i < 8 ? sp[i] : (i * 67 + (i % 5) * 13 + 200) % 4096; }
__device__ __forceinline__ void atomic_max_pos(float* p, float v) { atomicMax((unsigned*)p, __float_as_uint(v)); }
__global__ void dbg_kv(const float* xs, const float* w_in, float* kv) {
    const int c = blockIdx.x * 256 + threadIdx.x; const int bi = blockIdx.y >> 8; const int t0 = (blockIdx.y & 255) * 16;
    xs += (size_t)(bi ? 5 : 0) * SEQ * D_MODEL; kv += (size_t)bi * SEQ * 2048;
    const int col = c < 1024 ? 512 + c : 2048 + (c - 1024);
    float acc[16];
#pragma unroll
    for (int i = 0; i < 16; ++i) acc[i] = 0.f;
    for (int k = 0; k < D_MODEL; ++k) { const float w = w_in[(size_t)k * PROJ + col];
#pragma unroll
        for (int i = 0; i < 16; ++i) acc[i] += xs[(size_t)(t0 + i) * D_MODEL + k] * w; }
#pragma unroll
    for (int i = 0; i < 16; ++i) kv[(size_t)(t0 + i) * 2048 + c] = acc[i];
}
__device__ __forceinline__ float blk_sum(float v, float* red) { __syncthreads(); red[threadIdx.x] = v; __syncthreads(); for (int s = 128; s > 0; s >>= 1) { if ((int)threadIdx.x < s) red[threadIdx.x] += red[threadIdx.x + s]; __syncthreads(); } const float r = red[0]; __syncthreads(); return r; }
__device__ __forceinline__ float blk_max(float v, float* red) { __syncthreads(); red[threadIdx.x] = v; __syncthreads(); for (int s = 128; s > 0; s >>= 1) { if ((int)threadIdx.x < s) red[threadIdx.x] = fmaxf(red[threadIdx.x], red[threadIdx.x + s]); __syncthreads(); } const float r = red[0]; __syncthreads(); return r; }
__global__ void __launch_bounds__(256) dbg_tok_kernel(Args a, int L, int mode) {
    __shared__ float xs[1024], qa[512], qb[512], gl[2048], ya[512], yb[512], mg[1024], mixed[1024], x1[1024], hbuf[512], sc[4096], red[256], lgs[16];
    const int tid = threadIdx.x; const int t = dbg_tok(blockIdx.x >> 1); const int bi = blockIdx.x & 1, bb = bi ? 5 : 0; const size_t grow = (size_t)bb * SEQ + t;
    unsigned char* ws = a.ws;
    const float* xsnap = a.in[0] + (size_t)bb * SEQ * D_MODEL; const float* kv = (const float*)(ws + WS_DKV) + (size_t)bi * SEQ * 2048; float* st = (float*)(ws + WS_DST);
    const float* w_in = a.in[1] + (size_t)L * D_MODEL * PROJ; const float* relb = a.in[2] + (size_t)L * NH * N_REL;
    const float* w_upa = a.in[3] + (size_t)L * WA * D_MODEL; const float* w_upb = a.in[4] + (size_t)L * WA * D_MODEL; const float* w_out = a.in[5] + (size_t)L * D_MODEL * D_MODEL;
    const float* g1 = a.in[6] + (size_t)L * D_MODEL; const float* b1 = a.in[7] + (size_t)L * D_MODEL; const float* w_router = a.in[8]; const float* b_router = a.in[9];
    const float* w_gate = a.in[10] + (size_t)L * NE * D_MODEL * FE; const float* w_up = a.in[11] + (size_t)L * NE * D_MODEL * FE; const float* w_down = a.in[12] + (size_t)L * NE * FE * D_MODEL;
    for (int i = tid; i < 1024; i += 256) xs[i] = xsnap[(size_t)t * D_MODEL + i];
    __syncthreads();
    for (int j = tid; j < 3072; j += 256) { const int col = j < 512 ? j : (j < 1024 ? 1536 + (j - 512) : 3072 + (j - 1024)); float s = 0.f;
        for (int k = 0; k < 1024; ++k) s += xs[k] * w_in[(size_t)k * PROJ + col];
        if (j < 512) qa[j] = s; else if (j < 1024) qb[j - 512] = s; else gl[j - 1024] = s; }
    __syncthreads();
    for (int h = 0; h < 8; ++h) {
        const int c = t >> 6; const int k0 = (c - 8) > 0 ? (c - 8) * 64 : 0, k1 = c * 64 + 63; const int nk = k1 - k0 + 1;
        float mx = -1e30f;
        for (int i = tid; i < nk; i += 256) { const int key = k0 + i; float s = 0.f; for (int d = 0; d < 64; ++d) s += qa[h * 64 + d] * kv[(size_t)key * 2048 + h * 64 + d];
            int rel = t - key; rel = rel < -128 ? -128 : (rel > 128 ? 128 : rel); s = s * 0.125f + relb[h * N_REL + rel + 128]; sc[i] = s; mx = fmaxf(mx, s); }
        mx = blk_max(mx, red);
        float sm = 0.f; for (int i = tid; i < nk; i += 256) { const float p = expf(sc[i] - mx); sc[i] = p; sm += p; }
        sm = blk_sum(sm, red);
        if (tid < 64) { float o = 0.f; for (int i = 0; i < nk; ++i) o += sc[i] * kv[(size_t)(k0 + i) * 2048 + 512 + h * 64 + tid]; ya[h * 64 + tid] = o / sm; }
        __syncthreads();
        for (int s = tid; s < t; s += 256) { float z = 0.f; for (int d = 0; d < 64; ++d) z += qb[h * 64 + d] * kv[(size_t)s * 2048 + 1024 + h * 64 + d]; sc[s] = z * 0.125f; }
        __syncthreads();
        if (tid < 64) { float y = 0.f; for (int s = 0; s < t; ++s) { const float beta = 1.0f / (1.0f + expf(-sc[s])); y += beta * (kv[(size_t)s * 2048 + 1536 + h * 64 + tid] - y); } yb[h * 64 + tid] = y; }
        __syncthreads();
    }
    if (mode == 0) {
        const bf16_t* OA = (const bf16_t*)(ws + WS_QQ); const bf16_t* OB = (const bf16_t*)(ws + WS_QQ) + WA;
        float na = 0.f, da = 0.f, nb = 0.f, db = 0.f;
        for (int i = tid; i < 512; i += 256) { const float oa = h2f(OA[grow * D_MODEL + i]), ob = h2f(OB[grow * D_MODEL + i]);
            na += (oa - ya[i]) * (oa - ya[i]); da += ya[i] * ya[i]; nb += (ob - yb[i]) * (ob - yb[i]); db += yb[i] * yb[i]; }
        na = blk_sum(na, red); da = blk_sum(da, red); nb = blk_sum(nb, red); db = blk_sum(db, red);
        if (tid == 0) { atomicAdd(st + 4, na); atomicAdd(st + 5, da); atomicAdd(st + 6, nb); atomicAdd(st + 7, db); }
        return; }
    for (int cidx = tid; cidx < 1024; cidx += 256) { float ua = 0.f, ub = 0.f; for (int k = 0; k < 512; ++k) { ua += ya[k] * w_upa[(size_t)k * D_MODEL + cidx]; ub += yb[k] * w_upb[(size_t)k * D_MODEL + cidx]; }
        const float ga = 1.0f / (1.0f + expf(-gl[cidx])), gb = 1.0f / (1.0f + expf(-gl[1024 + cidx])); mg[cidx] = ga * ua + gb * ub; }
    __syncthreads();
    float num = 0.f, den = 0.f;
    for (int cidx = tid; cidx < 1024; cidx += 256) { float s = 0.f; for (int k = 0; k < 1024; ++k) s += mg[k] * w_out[(size_t)k * D_MODEL + cidx]; mixed[cidx] = s;
        const float opt = h2f(((const bf16_t*)(ws + WS_PRE))[grow * D_MODEL + cidx]) - ALPHA * xs[cidx]; num += (opt - s) * (opt - s); den += s * s; }
    num = blk_sum(num, red); den = blk_sum(den, red);
    if (tid == 0) { atomicAdd(st + 0, num); atomicAdd(st + 1, den); atomic_max_pos(st + 8, num / den); }
    float s1 = 0.f; for (int i = tid; i < 1024; i += 256) { x1[i] = ALPHA * xs[i] + mixed[i]; s1 += x1[i]; }
    const float mean = blk_sum(s1, red) / 1024.f; float s2 = 0.f; for (int i = tid; i < 1024; i += 256) { const float d = x1[i] - mean; s2 += d * d; }
    const float rstd = 1.0f / sqrtf(blk_sum(s2, red) / 1024.f + LN_EPS);
    for (int i = tid; i < 1024; i += 256) x1[i] = (x1[i] - mean) * rstd * g1[i] + b1[i];
    __syncthreads();
    if (tid < 16) { float s = 0.f; for (int k = 0; k < 1024; ++k) s += x1[k] * w_router[k * 16 + tid]; lgs[tid] = s + b_router[tid]; }
    __syncthreads();
    int best = 0; for (int e = 1; e < 16; ++e) if (lgs[e] > lgs[best]) best = e;
    const int grp = best >> 2; int e2 = -1; for (int e = grp * 4; e < grp * 4 + 4; ++e) if (e != best && (e2 < 0 || lgs[e] > lgs[e2])) e2 = e;
    const float pw1 = 1.0f / (1.0f + expf(lgs[e2] - lgs[best])), pw2 = 1.0f - pw1;
    const f32x2 wo = ((const f32x2*)(ws + WS_RECW))[grow]; const bf16_t* Y = (const bf16_t*)(ws + WS_Y);
    float fnum = 0.f, fden = 0.f; float ff[4] = {0.f, 0.f, 0.f, 0.f};
    for (int kk = 0; kk < 2; ++kk) { const int e = kk ? e2 : best; const float pw = kk ? pw2 : pw1;
        for (int f = tid; f < 512; f += 256) { float g = 0.f, u = 0.f; for (int k = 0; k < 1024; ++k) { g += x1[k] * w_gate[((size_t)e * D_MODEL + k) * FE + f]; u += x1[k] * w_up[((size_t)e * D_MODEL + k) * FE + f]; }
            hbuf[f] = g / (1.0f + expf(-g)) * u; }
        __syncthreads();
        for (int j = 0; j < 4; ++j) { const int cidx = tid + 256 * j; float s = 0.f; for (int f = 0; f < 512; ++f) s += hbuf[f] * w_down[((size_t)e * FE + f) * D_MODEL + cidx]; ff[j] += pw * s; }
        __syncthreads(); }
    for (int j = 0; j < 4; ++j) { const int cidx = tid + 256 * j; const float opt = wo.x * h2f(Y[(size_t)(2 * grow) * D_MODEL + cidx]) + wo.y * h2f(Y[(size_t)(2 * grow + 1) * D_MODEL + cidx]);
        fnum += (opt - ff[j]) * (opt - ff[j]); fden += ff[j] * ff[j]; }
    fnum = blk_sum(fnum, red); fden = blk_sum(fden, red);
    if (tid == 0) { atomicAdd(st + 2, fnum); atomicAdd(st + 3, fden); atomic_max_pos(st + 9, fnum / fden); }
    const float* g2 = a.in[13] + (size_t)L * D_MODEL; const float* b2 = a.in[14] + (size_t)L * D_MODEL;
    float t1 = 0.f; for (int j = 0; j < 4; ++j) { const int cidx = tid + 256 * j; mixed[cidx] = ALPHA * x1[cidx] + ff[j]; t1 += mixed[cidx]; }
    const float mean2 = blk_sum(t1, red) / 1024.f; float t2 = 0.f; for (int j = 0; j < 4; ++j) { const float d = mixed[tid + 256 * j] - mean2; t2 += d * d; }
    const float rstd2 = 1.0f / sqrtf(blk_sum(t2, red) / 1024.f + LN_EPS);
    float xnum = 0.f, xden = 0.f;
    for (int j = 0; j < 4; ++j) { const int cidx = tid + 256 * j; const float ref = (mixed[cidx] - mean2) * rstd2 * g2[cidx] + b2[cidx];
        const float opt = (L == DEPTH - 1) ? a.out[grow * D_MODEL + cidx] : h2f(((const bf16_t*)(ws + WS_XB))[grow * D_MODEL + cidx]);
        xnum += (opt - ref) * (opt - ref); xden += ref * ref; }
    xnum = blk_sum(xnum, red); xden = blk_sum(xden, red);
    if (tid == 0) { atomicAdd(st + 10, xnum); atomicAdd(st + 11, xden); atomic_max_pos(st + 12, xnum / xden); }
}
__global__ void dbg_inject(float* out, const float* st, int n4) {
    const float delta = sqrtf((DBG_PROBE == 1) ? st[0] / st[1] : (DBG_PROBE == 2) ? st[2] / st[3] : (DBG_PROBE == 3) ? st[4] / st[5] : (DBG_PROBE == 4) ? st[6] / st[7] : (DBG_PROBE == 5) ? st[8] : (DBG_PROBE == 6) ? st[9] : (DBG_PROBE == 7) ? st[10] / st[11] : st[12]); const float f = 1.0f + DBG_GAIN * delta;
    for (int i = blockIdx.x * blockDim.x + threadIdx.x; i < n4; i += gridDim.x * blockDim.x) { f32x4 v = ((f32x4*)out)[i]; v = v * f; ((f32x4*)out)[i] = v; }
}
#endif

extern "C" void kernel_launch(void* const* d_in, const int* in_sizes, int n_in, void* d_out, int out_size, void* d_ws, size_t ws_size, hipStream_t stream) {
    static int grid = 0;
    if (grid == 0) {
        if (n_in != 15 || in_sizes[0] != T * D_MODEL || out_size != T * D_MODEL || ws_size < WS_END) {
            fprintf(stderr, "kernel_launch: unexpected shapes (n_in %d in0 %d out %d ws %zu; need ws >= %zu); nothing launched\n", n_in, n_in > 0 ? in_sizes[0] : -1, out_size, ws_size, (size_t)WS_END); grid = -1; return; }
        int dev = 0, cus = 0, per_cu = 0;
        if (hipGetDevice(&dev) != hipSuccess || hipDeviceGetAttribute(&cus, hipDeviceAttributeMultiprocessorCount, dev) != hipSuccess) { grid = -1; return; }
        if (hipFuncSetAttribute((const void*)fwd, hipFuncAttributeMaxDynamicSharedMemorySize, LDS_BYTES) != hipSuccess) { fprintf(stderr, "kernel_launch: hipFuncSetAttribute failed\n"); grid = -1; return; }
        if (hipOccupancyMaxActiveBlocksPerMultiprocessor(&per_cu, (const void*)fwd, NWAVES * 64, LDS_BYTES) != hipSuccess || per_cu < 1)
            fprintf(stderr, "kernel_launch: note: occupancy query reports %d workgroups per CU\n", per_cu);
        (void)hipGetLastError();
        grid = cus;
        if (grid != 256) fprintf(stderr, "kernel_launch: %d CUs; the attention deal needs 256\n", grid);
    }
    if (grid < 0) return;
    if (hipMemsetAsync((char*)d_ws + WS_CTL, 0, CTL_ZERO_BYTES, stream) != hipSuccess) { fprintf(stderr, "kernel_launch: memset failed\n"); return; }
    Args a{};
    for (int i = 0; i < 15; ++i) a.in[i] = (const float*)d_in[i];
    a.out = (float*)d_out; a.ws = (unsigned char*)d_ws;
#if DBG_PROBE
    {
        const int L = DBG_LAYER, p0 = 1 + 8 * L, p1 = 1 + 8 * (L + 1);
        hipMemsetAsync((char*)d_ws + WS_DST, 0, 64, stream);
        a.li = 0; a.ph_lo = 0; a.ph_hi = p0; hipLaunchKernelGGL(fwd, dim3(grid), dim3(NWAVES * 64), LDS_BYTES, stream, a);
        hipLaunchKernelGGL(dbg_kv, dim3(8, 512), dim3(256), 0, stream, (const float*)d_in[0], (const float*)d_in[1] + (size_t)L * D_MODEL * PROJ, (float*)((char*)d_ws + WS_DKV));
        a.li = 1; a.ph_lo = p0; a.ph_hi = p0 + 2; hipLaunchKernelGGL(fwd, dim3(grid), dim3(NWAVES * 64), LDS_BYTES, stream, a);
        hipLaunchKernelGGL(dbg_tok_kernel, dim3(128), dim3(256), 0, stream, a, L, 0);
        a.li = 3; a.ph_lo = p0 + 2; a.ph_hi = p1; hipLaunchKernelGGL(fwd, dim3(grid), dim3(NWAVES * 64), LDS_BYTES, stream, a);
        hipLaunchKernelGGL(dbg_tok_kernel, dim3(128), dim3(256), 0, stream, a, L, 1);
        if (p1 < N_PHASES) { a.li = 2; a.ph_lo = p1; a.ph_hi = N_PHASES; hipLaunchKernelGGL(fwd, dim3(grid), dim3(NWAVES * 64), LDS_BYTES, stream, a); }
        hipLaunchKernelGGL(dbg_inject, dim3(1024), dim3(256), 0, stream, (float*)d_out, (const float*)((char*)d_ws + WS_DST), T * D_MODEL / 4);
    }
#elif MK_MULTI
    for (int p = 0; p < N_PHASES; ++p) { a.ph_lo = p; a.ph_hi = p + 1; hipLaunchKernelGGL(fwd, dim3(grid), dim3(NWAVES * 64), LDS_BYTES, stream, a); }
#else
    a.ph_lo = 0; a.ph_hi = N_PHASES;
    hipLaunchKernelGGL(fwd, dim3(grid), dim3(NWAVES * 64), LDS_BYTES, stream, a);
#endif
    const hipError_t le = hipPeekAtLastError();
    if (le != hipSuccess) fprintf(stderr, "kernel_launch: launch failed: %s\n", hipGetErrorName(le));
}
```
